# Optimizing an MI355X kernel written in HIP

```python
import jax, jax.numpy as jnp
from jax import lax
import numpy as np

D_MODEL = 4096
BATCH = 4
SEQ = 4096
DEPTH = 1

HEAD_DIM = 128
N_HEADS = (D_MODEL // 2) // HEAD_DIM
N_KV_HEADS = N_HEADS // 4
GQA_GROUP = N_HEADS // N_KV_HEADS
WINDOW = 128
BLOCK = 128
CONV_WIDTH = D_MODEL // 2
CONV_K = 3
Q_W = N_HEADS * HEAD_DIM
KV_W = N_KV_HEADS * HEAD_DIM
GATE_W = D_MODEL
OFF_Q = 0
OFF_K = OFF_Q + Q_W
OFF_V = OFF_K + KV_W
OFF_H = OFF_V + KV_W
OFF_B = OFF_H + CONV_WIDTH
OFF_C = OFF_B + CONV_WIDTH
OFF_GA = OFF_C + CONV_WIDTH
OFF_GC = OFF_GA + GATE_W
IN_W = OFF_GC + GATE_W
PEER_HEADS = 8
N_KEYS = 128
N_EXPERTS = N_KEYS * N_KEYS
PEER_KEY_DIM = 128
PEER_TOPK = 16
PEER_CHUNK = 128
EPS = 1e-6

kernel_name = "hybrid_swa_shortconv_peer_encoder"


def rms_norm(x, g):
    xf = x.astype(jnp.float32)
    y = xf * lax.rsqrt(jnp.mean(xf * xf, axis=-1, keepdims=True) + EPS)
    return (y * g.astype(jnp.float32)).astype(x.dtype)


def alibi_slopes():
    h = jnp.arange(1, N_HEADS + 1, dtype=jnp.float32)
    return jnp.exp2(-8.0 * h / N_HEADS).reshape(N_KV_HEADS, GQA_GROUP)


def banded_window_attention(q, k, v, sink_logits):
    b, s = q.shape[0], q.shape[1]
    nb = s // BLOCK
    qb = q.reshape(b, nb, BLOCK, N_KV_HEADS, GQA_GROUP, HEAD_DIM)

    def neighbour_blocks(t):
        tp = jnp.pad(t, ((0, 0), (BLOCK, BLOCK), (0, 0), (0, 0)))
        tb = tp.reshape(b, nb + 2, BLOCK, N_KV_HEADS, HEAD_DIM)
        return jnp.concatenate([tb[:, :-2], tb[:, 1:-1], tb[:, 2:]], axis=2)

    kb = neighbour_blocks(k)
    vb = neighbour_blocks(v)
    scores = jnp.einsum('bnqhgd,bnshd->bnhgqs', qb, kb,
                        preferred_element_type=jnp.float32) * (HEAD_DIM ** -0.5)
    qi = jnp.arange(BLOCK)[:, None]
    kj = jnp.arange(3 * BLOCK)[None, :]
    dist = jnp.abs(kj - BLOCK - qi)
    key_pos = (jnp.arange(nb)[:, None] - 1) * BLOCK + jnp.arange(3 * BLOCK)[None, :]
    in_range = (key_pos >= 0) & (key_pos < s)
    mask = (dist <= WINDOW)[None, :, :] & in_range[:, None, :]
    slopes = alibi_slopes()
    scores = scores - slopes[:, :, None, None] * dist.astype(jnp.float32)
    scores = jnp.where(mask[None, :, None, None], scores, -jnp.inf)
    sink = sink_logits.astype(jnp.float32).reshape(N_KV_HEADS, GQA_GROUP)[:, :, None, None]
    m = jnp.maximum(jnp.max(scores, axis=-1, keepdims=True), sink)
    p = jnp.exp(scores - m)
    denom = jnp.sum(p, axis=-1, keepdims=True) + jnp.exp(sink - m)
    probs = (p / denom).astype(v.dtype)
    out = jnp.einsum('bnhgqs,bnshd->bnqhgd', probs, vb)
    return out.reshape(b, s, Q_W)


def short_gated_conv(h, gate_b, gate_c, conv_w):
    u = gate_c * h
    half = CONV_K // 2
    s = u.shape[1]
    up = jnp.pad(u, ((0, 0), (half, half), (0, 0)))
    y = sum(conv_w[j] * up[:, j:j + s] for j in range(CONV_K))
    return gate_b * y


def peer_ffn(x, w_q_peer, sub_keys, w_down, w_up):
    b, s, d = x.shape
    t = b * s
    xt = x.reshape(t, d)
    q = (xt @ w_q_peer).reshape(t, PEER_HEADS, 2, PEER_KEY_DIM)
    s1 = jnp.einsum('thk,hnk->thn', q[:, :, 0], sub_keys[:, 0], preferred_element_type=jnp.float32)
    s2 = jnp.einsum('thk,hnk->thn', q[:, :, 1], sub_keys[:, 1], preferred_element_type=jnp.float32)
    v1, i1 = lax.top_k(s1, PEER_TOPK)
    v2, i2 = lax.top_k(s2, PEER_TOPK)
    cand = (v1[..., :, None] + v2[..., None, :]).reshape(t, PEER_HEADS, PEER_TOPK * PEER_TOPK)
    cand_idx = (i1[..., :, None] * N_KEYS + i2[..., None, :]).reshape(t, PEER_HEADS, PEER_TOPK * PEER_TOPK)
    top_s, pos = lax.top_k(cand, PEER_TOPK)
    idx = jnp.take_along_axis(cand_idx, pos, axis=-1)
    gates = jax.nn.softmax(top_s, axis=-1)
    n_chunks = t // PEER_CHUNK

    def chunk(args):
        xc, ic, gc = args
        u = jnp.take(w_down, ic, axis=0)
        a = jax.nn.gelu(jnp.einsum('cd,chkd->chk', xc, u, preferred_element_type=jnp.float32),
                        approximate=False)
        wgt = (gc * a).astype(xc.dtype)
        vv = jnp.take(w_up, ic, axis=0)
        return jnp.einsum('chk,chkd->cd', wgt, vv)

    out = lax.map(chunk, (xt.reshape(n_chunks, PEER_CHUNK, d),
                          idx.reshape(n_chunks, PEER_CHUNK, PEER_HEADS, PEER_TOPK),
                          gates.reshape(n_chunks, PEER_CHUNK, PEER_HEADS, PEER_TOPK)))
    return out.reshape(b, s, d)


def setup_inputs(seed: int = 0) -> dict:
    key = jax.random.key(seed)
    ks = jax.random.split(key, 16)
    f32 = jnp.float32
    nrm = lambda k, shape, scale: jax.random.normal(k, shape, f32) * scale
    L = DEPTH
    return {
        "x": nrm(ks[0], (BATCH, SEQ, D_MODEL), 1.0),
        "norm1_g": 1.0 + nrm(ks[1], (L, D_MODEL), 0.01),
        "w_in": nrm(ks[2], (L, D_MODEL, IN_W), D_MODEL ** -0.5),
        "q_norm_g": 1.0 + nrm(ks[3], (L, HEAD_DIM), 0.01),
        "k_norm_g": 1.0 + nrm(ks[4], (L, HEAD_DIM), 0.01),
        "sink_logits": nrm(ks[5], (L, N_HEADS), 0.5),
        "conv_w": nrm(ks[6], (L, CONV_K, CONV_WIDTH), CONV_K ** -0.5),
        "w_o_attn": nrm(ks[7], (L, Q_W, D_MODEL), Q_W ** -0.5),
        "w_o_conv": nrm(ks[8], (L, CONV_WIDTH, D_MODEL), CONV_WIDTH ** -0.5),
        "w_out": nrm(ks[9], (L, D_MODEL, D_MODEL), D_MODEL ** -0.5),
        "norm2_g": 1.0 + nrm(ks[10], (L, D_MODEL), 0.01),
        "w_q_peer": nrm(ks[11], (L, D_MODEL, PEER_HEADS * 2 * PEER_KEY_DIM), D_MODEL ** -0.5),
        "sub_keys": nrm(ks[12], (L, PEER_HEADS, 2, N_KEYS, PEER_KEY_DIM), PEER_KEY_DIM ** -0.5),
        "w_down": nrm(ks[13], (L, N_EXPERTS, D_MODEL), D_MODEL ** -0.5),
        "w_up": nrm(ks[14], (L, N_EXPERTS, D_MODEL), PEER_HEADS ** -0.5 * PEER_TOPK ** -0.5),
    }


def reference(x, norm1_g, w_in, q_norm_g, k_norm_g, sink_logits, conv_w, w_o_attn, w_o_conv,
              w_out, norm2_g, w_q_peer, sub_keys, w_down, w_up):
    b, s, _ = x.shape
    for i in range(DEPTH):
        xn = rms_norm(x, norm1_g[i])
        proj = xn @ w_in[i]
        q = rms_norm(proj[..., OFF_Q:OFF_K].reshape(b, s, N_HEADS, HEAD_DIM), q_norm_g[i])
        k = rms_norm(proj[..., OFF_K:OFF_V].reshape(b, s, N_KV_HEADS, HEAD_DIM), k_norm_g[i])
        v = proj[..., OFF_V:OFF_H].reshape(b, s, N_KV_HEADS, HEAD_DIM)
        attn = banded_window_attention(q, k, v, sink_logits[i])
        conv = short_gated_conv(proj[..., OFF_H:OFF_B], proj[..., OFF_B:OFF_C],
                                proj[..., OFF_C:OFF_GA], conv_w[i])
        branch_a = attn @ w_o_attn[i]
        branch_c = conv @ w_o_conv[i]
        merged = (jax.nn.sigmoid(proj[..., OFF_GA:OFF_GC]) * branch_a
                  + jax.nn.sigmoid(proj[..., OFF_GC:IN_W]) * branch_c)
        x = x + merged @ w_out[i]
        x = x + peer_ffn(rms_norm(x, norm2_g[i]), w_q_peer[i], sub_keys[i], w_down[i], w_up[i])
    return x
```

```cpp
#include <hip/hip_runtime.h>
#include <cstdio>
#include <cstdint>
#include <cmath>
namespace pg8 {
#define PG8_LAS __attribute__((address_space(3)))
typedef unsigned short bf16_t;
typedef short bf16x8 __attribute__((ext_vector_type(8)));
typedef float f32x4 __attribute__((ext_vector_type(4)));
typedef unsigned u32x4 __attribute__((ext_vector_type(4)));
constexpr int BM = 256, BK = 64, HALF = 128, HTB = HALF * BK * 2  , STAGE_BYTES = 8 * HTB, NXCD = 8, WGM = 8;

__host__ __device__ __forceinline__ int lds_byte(int r, int c) { const int st = (r >> 4) * 2 + (c >> 5), rr = r & 15, cc = c & 31, ob = rr * 64 + cc * 2; return st * 1024 + (ob ^ (((ob >> 9) & 1) << 5)); }
__host__ __device__ __forceinline__ void stage_rc(int b, int& R, int& C) { const int st = b / 1024, sb = b % 1024, swz = sb ^ (((sb >> 9) & 1) << 5); R = (st >> 1) * 16 + swz / 64; C = (st & 1) * 32 + (swz % 64) / 2; }
__host__ __device__ __forceinline__ int perm32(int rho) { const int n = rho >> 4, i = rho & 15; return 8 * (i >> 2) + 4 * n + (i & 3); }

struct Unit { int pm, pn; };
struct Gemm { const bf16_t* A; const bf16_t* Bt; int M, N, K; };

struct StaticOrder {
    int nM, nN, nwg, G, c;
    __host__ __device__ void init(int M, int N, int G_, int c_) { nM = M / BM; nN = N / BM; nwg = nM * nN; G = G_; c = c_; }
    __host__ __device__ bool next(int i, Unit& u) const {
        const long L = (long)i * G + c; if (L >= nwg) return false;
        int wgid = (int)L; { const int q = nwg / NXCD, r = nwg % NXCD, xcd = wgid % NXCD, off = wgid / NXCD; wgid = (xcd < r ? xcd * (q + 1) : r * (q + 1) + (xcd - r) * q) + off; }
        const int nig = WGM * nN, gid = wgid / nig, fm = gid * WGM, gsz = (nM - fm) < WGM ? (nM - fm) : WGM;
        u.pm = fm + ((wgid % nig) % gsz); u.pn = (wgid % nig) / gsz; return true;
    }
    __device__ __forceinline__ void a_ready(const Unit&) const {}
    __device__ __forceinline__ void done(const Unit&) const {}
};
__device__ __forceinline__ unsigned cvt_pk_bf16(float lo, float hi) { unsigned r; asm volatile("v_cvt_pk_bf16_f32 %0, %1, %2" : "=v"(r) : "v"(lo), "v"(hi)); return r; }
__device__ __forceinline__ float sigm(float v) { return __builtin_amdgcn_rcpf(1.0f + __builtin_amdgcn_exp2f(-1.4426950408889634f * v)); }
__device__ __forceinline__ u32x4 pack8(const f32x4 a, const f32x4 b) { u32x4 w; w.x = cvt_pk_bf16(a[0], a[1]); w.y = cvt_pk_bf16(a[2], a[3]); w.z = cvt_pk_bf16(b[0], b[1]); w.w = cvt_pk_bf16(b[2], b[3]); return w; }
__device__ __forceinline__ void unpack8(const u32x4 w, f32x4& a, f32x4& b) {
    a[0] = __uint_as_float(w.x << 16); a[1] = __uint_as_float(w.x & 0xffff0000u); a[2] = __uint_as_float(w.y << 16); a[3] = __uint_as_float(w.y & 0xffff0000u);
    b[0] = __uint_as_float(w.z << 16); b[1] = __uint_as_float(w.z & 0xffff0000u); b[2] = __uint_as_float(w.w << 16); b[3] = __uint_as_float(w.w & 0xffff0000u);
}
struct EpiProj {
    static constexpr bool PERM = true, AFTER_DRAIN = false;
    bf16_t *Q, *K, *V, *H, *Bg, *Cg, *GA, *GC;
    __device__ __forceinline__ void operator()(const f32x4 (&acc)[2][2][4][2], const Unit& u, int wr, int wc, int fr, int fq) const {
        const int pn = u.pn; bf16_t* base; int ldc, ct; bool sg = false;
        if (pn < 8) { base = Q; ldc = 2048; ct = pn; } else if (pn < 10) { base = K; ldc = 512; ct = pn - 8; } else if (pn < 12) { base = V; ldc = 512; ct = pn - 10; }
        else if (pn < 20) { base = H; ldc = 2048; ct = pn - 12; } else if (pn < 28) { base = Bg; ldc = 2048; ct = pn - 20; } else if (pn < 36) { base = Cg; ldc = 2048; ct = pn - 28; }
        else if (pn < 52) { base = GA; ldc = 4096; ct = pn - 36; sg = true; } else { base = GC; ldc = 4096; ct = pn - 52; sg = true; }
        const int row0 = u.pm * BM + wr * 64 + fr, col0 = ct * BM + wc * 32 + 8 * fq;
#pragma unroll
        for (int ai = 0; ai < 2; ++ai)
#pragma unroll
            for (int m = 0; m < 4; ++m) { bf16_t* rowp = base + (size_t)(row0 + ai * HALF + m * 16) * ldc + col0;
#pragma unroll
                for (int bj = 0; bj < 2; ++bj) { f32x4 v0 = acc[ai][bj][m][0], v1 = acc[ai][bj][m][1];
                    if (sg) {
#pragma unroll
                        for (int e = 0; e < 4; ++e) { v0[e] = sigm(v0[e]); v1[e] = sigm(v1[e]); } }
                    *(u32x4*)(rowp + bj * HALF) = pack8(v0, v1); } }
    }
};
struct EpiMerge {
    static constexpr bool PERM = true, AFTER_DRAIN = false;
    const bf16_t *GA, *GC; bf16_t *T, *Mg;
    __device__ __forceinline__ void operator()(const f32x4 (&acc)[2][2][4][2], const Unit& u, int wr, int wc, int fr, int fq) const {
        const int which = u.pm >> 6, pm = u.pm & 63, pn = u.pn & 15;
        const bf16_t* G = which ? GC : GA;
        const int row0 = pm * BM + wr * 64 + fr, col0 = pn * BM + wc * 32 + 8 * fq;
#pragma unroll
        for (int ai = 0; ai < 2; ++ai)
#pragma unroll
            for (int m = 0; m < 4; ++m) { const size_t off = (size_t)(row0 + ai * HALF + m * 16) * 4096 + col0;
#pragma unroll
                for (int bj = 0; bj < 2; ++bj) { const size_t o = off + bj * HALF; f32x4 g0, g1; unpack8(*(const u32x4*)(G + o), g0, g1);
                    f32x4 v0 = acc[ai][bj][m][0] * g0, v1 = acc[ai][bj][m][1] * g1;
                    if (which == 0) { *(u32x4*)(T + o) = pack8(v0, v1); }
                    else { f32x4 t0, t1; unpack8(*(const u32x4*)(T + o), t0, t1); *(u32x4*)(Mg + o) = pack8(v0 + t0, v1 + t1); } } }
    }
};
struct EpiRes {
    static constexpr bool PERM = true, AFTER_DRAIN = false;
    const float* X; float* O;
    __device__ __forceinline__ void operator()(const f32x4 (&acc)[2][2][4][2], const Unit& u, int wr, int wc, int fr, int fq) const {
        const int row0 = u.pm * BM + wr * 64 + fr, col0 = u.pn * BM + wc * 32 + 8 * fq;
#pragma unroll
        for (int ai = 0; ai < 2; ++ai)
#pragma unroll
            for (int m = 0; m < 4; ++m) { const size_t off = (size_t)(row0 + ai * HALF + m * 16) * 4096 + col0;
#pragma unroll
                for (int bj = 0; bj < 2; ++bj) { const size_t o = off + bj * HALF; const f32x4 x0 = *(const f32x4*)(X + o), x1 = *(const f32x4*)(X + o + 4);
                    *(f32x4*)(O + o) = x0 + acc[ai][bj][m][0]; *(f32x4*)(O + o + 4) = x1 + acc[ai][bj][m][1]; } }
    }
};
struct EpiStore {
    static constexpr bool PERM = true, AFTER_DRAIN = false;
    bf16_t* O; int ldc;
    __device__ __forceinline__ void operator()(const f32x4 (&acc)[2][2][4][2], const Unit& u, int wr, int wc, int fr, int fq) const {
        const int row0 = u.pm * BM + wr * 64 + fr, col0 = u.pn * BM + wc * 32 + 8 * fq;
#pragma unroll
        for (int ai = 0; ai < 2; ++ai)
#pragma unroll
            for (int m = 0; m < 4; ++m) { bf16_t* rowp = O + (size_t)(row0 + ai * HALF + m * 16) * ldc + col0;
#pragma unroll
                for (int bj = 0; bj < 2; ++bj) *(u32x4*)(rowp + bj * HALF) = pack8(acc[ai][bj][m][0], acc[ai][bj][m][1]); }
    }
};
struct PairOrder {
    StaticOrder so;
    __device__ bool next(int i, Unit& u) const { Unit t; if (!so.next(i >> 1, t)) return false; const int w = i & 1; u.pm = t.pm + 64 * w; u.pn = t.pn + 16 * w; return true; }
    __device__ __forceinline__ void a_ready(const Unit&) const {}
    __device__ __forceinline__ void done(const Unit&) const {}
};
template <class Epi, class Sched, bool ALIGN_EPI = false, bool SP2 = false>
__device__ __forceinline__ void gemm_phase(PG8_LAS unsigned char* lds, const Gemm g, const Sched& S, const Epi& E) {
    const int tid = threadIdx.x, wid = __builtin_amdgcn_readfirstlane(tid >> 6), lane = tid & 63, wr = wid >> 2, wc = wid & 3, fr = lane & 15, fq = lane >> 4;
    const int K = g.K, nt = K / BK;
    unsigned voffA[2], voffB[2];
#pragma unroll
    for (int i = 0; i < 2; ++i) { int R, C; stage_rc(tid * 16 + i * 8192, R, C); const int Rb = Epi::PERM ? ((R & ~31) + perm32(R & 31)) : R;
        voffA[i] = (unsigned)(R * K + C) * 2u; voffB[i] = (unsigned)(Rb * K + C) * 2u; }
    const size_t kstep = (size_t)(BK * 2);
    const size_t hstep = (size_t)HALF * K * 2;
    const size_t tstep = 2 * hstep;
    const unsigned ldsw = (unsigned)wid * 1024u;
    const int aoff = lds_byte(wr * 64 + fr, fq * 8), boff = lds_byte(wc * 32 + fr, fq * 8);
#define PG8_SA(b, h) (((b) * 2 + (h)) * HTB)
#define PG8_SB(b, h) ((4 + (b) * 2 + (h)) * HTB)
#define PG8_STAGE(bufoff, gbase, voff) do { _Pragma("unroll") for (int _i = 0; _i < 2; ++_i) \
        __builtin_amdgcn_global_load_lds((const unsigned*)((const char*)(gbase) + (voff)[_i]), (PG8_LAS unsigned*)(lds + (bufoff) + ldsw + _i * 8192), 16, 0, 0); } while (0)
#define PG8_LDA(dst, b, h) do { _Pragma("unroll") for (int m = 0; m < 4; ++m) _Pragma("unroll") for (int k = 0; k < 2; ++k) dst[m][k] = *(const PG8_LAS bf16x8*)(lds + PG8_SA(b, h) + aoff + m * 2048 + k * 1024); } while (0)
#define PG8_LDB(dst, b, h) do { _Pragma("unroll") for (int n = 0; n < 2; ++n) _Pragma("unroll") for (int k = 0; k < 2; ++k) dst[n][k] = *(const PG8_LAS bf16x8*)(lds + PG8_SB(b, h) + boff + n * 2048 + k * 1024); } while (0)
#define PG8_MMA(ai, bj, At, Bt) do { __builtin_amdgcn_s_setprio(1); _Pragma("unroll") for (int m = 0; m < 4; ++m) _Pragma("unroll") for (int n = 0; n < 2; ++n) _Pragma("unroll") for (int k = 0; k < 2; ++k) \
        acc[ai][bj][m][n] = __builtin_amdgcn_mfma_f32_16x16x32_bf16(Bt[n][k], At[m][k], acc[ai][bj][m][n], 0, 0, 0); __builtin_amdgcn_s_setprio(0); } while (0)
#define PG8_WAIT_V(n) asm volatile("s_waitcnt vmcnt(" #n ")" ::: "memory")
#define PG8_WAIT_L(n) asm volatile("s_waitcnt lgkmcnt(" #n ")" ::: "memory")
#define PG8_BAR __builtin_amdgcn_s_barrier()
#define PG8_SCHED __builtin_amdgcn_sched_barrier(0)
    Unit cur, nxt; int ui = 0;
    if (!S.next(0, cur)) return;
    f32x4 acc[2][2][4][2];
#pragma unroll
    for (int a = 0; a < 2; ++a)
#pragma unroll
        for (int b = 0; b < 2; ++b)
#pragma unroll
            for (int m = 0; m < 4; ++m)
#pragma unroll
                for (int n = 0; n < 2; ++n) acc[a][b][m][n] = (f32x4){0.f, 0.f, 0.f, 0.f};
    bf16x8 At[4][2], B0[2][2], B1[2][2];
    const char* cA = (const char*)g.A + (size_t)cur.pm * tstep; const char* cB = (const char*)g.Bt + (size_t)cur.pn * tstep;
    S.a_ready(cur);
    if constexpr (SP2) {
        PG8_STAGE(PG8_SB(0, 0), cB, voffB); PG8_STAGE(PG8_SB(0, 1), cB + hstep, voffB); PG8_STAGE(PG8_SA(0, 0), cA, voffA); PG8_STAGE(PG8_SA(0, 1), cA + hstep, voffA);
        if (wr == 1) PG8_BAR;
        PG8_WAIT_V(2); PG8_BAR;
        PG8_STAGE(PG8_SB(1, 0), cB + kstep, voffB); PG8_STAGE(PG8_SA(1, 0), cA + kstep, voffA); PG8_STAGE(PG8_SB(1, 1), cB + hstep + kstep, voffB);
        PG8_WAIT_V(6); PG8_BAR;
    } else {
        PG8_STAGE(PG8_SB(0, 0), cB, voffB); PG8_STAGE(PG8_SA(0, 0), cA, voffA); PG8_STAGE(PG8_SB(0, 1), cB + hstep, voffB); PG8_STAGE(PG8_SA(0, 1), cA + hstep, voffA);
        if (wr == 1) PG8_BAR;
        PG8_WAIT_V(4); PG8_BAR;
        PG8_STAGE(PG8_SB(1, 0), cB + kstep, voffB); PG8_STAGE(PG8_SA(1, 0), cA + kstep, voffA); PG8_STAGE(PG8_SB(1, 1), cB + hstep + kstep, voffB);
        PG8_WAIT_V(6); PG8_BAR;
    }
    for (;;) {
        const bool has_next = S.next(ui + 1, nxt);
        const char* nA = has_next ? (const char*)g.A + (size_t)nxt.pm * tstep : cA; const char* nB = has_next ? (const char*)g.Bt + (size_t)nxt.pn * tstep : cB;
        for (int t = 0; t < nt; t += 2) {
            const bool last = (t == nt - 2);
            const char* a1 = cA + (size_t)(t + 1) * kstep;
            const char* a2 = last ? nA : cA + (size_t)(t + 2) * kstep; const char* b2 = last ? nB : cB + (size_t)(t + 2) * kstep;
            const char* a3 = a2 + kstep; const char* b3 = b2 + kstep;
            if (last && has_next) S.a_ready(nxt);
            if constexpr (SP2) {
            PG8_LDB(B0, 0, 0); PG8_LDB(B1, 0, 1); PG8_SCHED; PG8_LDA(At, 0, 0); PG8_STAGE(PG8_SA(1, 1), a1 + hstep, voffA);
            PG8_WAIT_V(8); PG8_WAIT_L(0); PG8_BAR; PG8_MMA(0, 0, At, B0); PG8_MMA(0, 1, At, B1); PG8_BAR; PG8_SCHED;
            PG8_LDA(At, 0, 1); PG8_STAGE(PG8_SB(0, 0), b2, voffB); PG8_STAGE(PG8_SB(0, 1), b2 + hstep, voffB); PG8_STAGE(PG8_SA(0, 0), a2, voffA);
            PG8_WAIT_V(8); PG8_WAIT_L(0); PG8_BAR; PG8_MMA(1, 0, At, B0); PG8_MMA(1, 1, At, B1); PG8_BAR; PG8_SCHED;
            PG8_LDB(B0, 1, 0); PG8_LDB(B1, 1, 1); PG8_SCHED; PG8_LDA(At, 1, 0); PG8_STAGE(PG8_SA(0, 1), a2 + hstep, voffA);
            PG8_WAIT_V(8); PG8_WAIT_L(0); PG8_BAR; PG8_MMA(0, 0, At, B0); PG8_MMA(0, 1, At, B1); PG8_BAR; PG8_SCHED;
            PG8_LDA(At, 1, 1); PG8_STAGE(PG8_SB(1, 0), b3, voffB); PG8_STAGE(PG8_SB(1, 1), b3 + hstep, voffB); PG8_STAGE(PG8_SA(1, 0), a3, voffA);
            PG8_WAIT_V(8); PG8_WAIT_L(0); PG8_BAR; PG8_MMA(1, 0, At, B0); PG8_MMA(1, 1, At, B1); PG8_BAR; PG8_SCHED;
            } else {
            PG8_LDB(B0, 0, 0); PG8_SCHED; PG8_LDA(At, 0, 0); PG8_STAGE(PG8_SA(1, 1), a1 + hstep, voffA);
            PG8_WAIT_L(8); PG8_BAR; PG8_WAIT_L(0); PG8_MMA(0, 0, At, B0); PG8_BAR; PG8_SCHED;
            PG8_LDB(B1, 0, 1); PG8_STAGE(PG8_SB(0, 0), b2, voffB);
            PG8_BAR; PG8_WAIT_L(0); PG8_MMA(0, 1, At, B1); PG8_BAR;
            PG8_LDA(At, 0, 1); PG8_STAGE(PG8_SA(0, 0), a2, voffA);
            PG8_BAR; PG8_WAIT_L(0); PG8_MMA(1, 0, At, B0); PG8_BAR; PG8_SCHED;
            PG8_STAGE(PG8_SB(0, 1), b2 + hstep, voffB);
            PG8_WAIT_V(6); PG8_BAR; PG8_MMA(1, 1, At, B1); PG8_BAR;
            PG8_LDB(B0, 1, 0); PG8_SCHED; PG8_LDA(At, 1, 0); PG8_STAGE(PG8_SA(0, 1), a2 + hstep, voffA);
            PG8_WAIT_L(8); PG8_BAR; PG8_WAIT_L(0); PG8_MMA(0, 0, At, B0); PG8_BAR; PG8_SCHED;
            PG8_LDB(B1, 1, 1); PG8_STAGE(PG8_SB(1, 0), b3, voffB);
            PG8_BAR; PG8_WAIT_L(0); PG8_MMA(0, 1, At, B1); PG8_BAR;
            PG8_LDA(At, 1, 1); PG8_STAGE(PG8_SA(1, 0), a3, voffA);
            PG8_BAR; PG8_WAIT_L(0); PG8_MMA(1, 0, At, B0); PG8_BAR; PG8_SCHED;
            PG8_STAGE(PG8_SB(1, 1), b3 + hstep, voffB);
            PG8_WAIT_V(6); PG8_BAR; PG8_MMA(1, 1, At, B1); PG8_BAR;
            }
        }
        if constexpr (ALIGN_EPI) { if (wr == 0) PG8_BAR; }
        if constexpr (!Epi::AFTER_DRAIN) { E(acc, cur, wr, wc, fr, fq); S.done(cur); }
        if (!has_next) break;
#pragma unroll
        for (int a = 0; a < 2; ++a)
#pragma unroll
            for (int b = 0; b < 2; ++b)
#pragma unroll
                for (int m = 0; m < 4; ++m)
#pragma unroll
                    for (int n = 0; n < 2; ++n) acc[a][b][m][n] = (f32x4){0.f, 0.f, 0.f, 0.f};
        cur = nxt; cA = nA; cB = nB; ++ui;
        if constexpr (ALIGN_EPI) { if (wr == 1) PG8_BAR; }
    }
    PG8_WAIT_V(0);
    if constexpr (!ALIGN_EPI) { if (wr == 0) PG8_BAR; }
    PG8_BAR;
    if constexpr (Epi::AFTER_DRAIN) { E.fused(acc, cur, wr, wc, fr, fq, lds, wid, lane); S.done(cur); }
#undef PG8_SA
#undef PG8_SB
#undef PG8_STAGE
#undef PG8_LDA
#undef PG8_LDB
#undef PG8_MMA
#undef PG8_WAIT_V
#undef PG8_WAIT_L
#undef PG8_BAR
#undef PG8_SCHED
}
}
#ifndef PG8_SP2
#define PG8_SP2 true
#endif
#ifndef PG8_ALIGN
#define PG8_ALIGN true
#endif
constexpr int NWAVES = 8;
#ifndef MK_ONE_LAUNCH
#define MK_ONE_LAUNCH 0
#endif
constexpr int N_PHASES = 9;

constexpr int BATCH = 4, SEQ = 4096, D = 4096, M = BATCH * SEQ;
constexpr int HD = 128, NH = 16, NKV = 4, QW = NH * HD, KVW = NKV * HD, CW = 2048, INW = 17408;
constexpr int PH = 8, NKEYS = 128, TOPK = 16, NEXP = NKEYS * NKEYS, PQW = PH * 2 * 128;
constexpr float EPS = 1e-6f;
constexpr float LOG2E = 1.4426950408889634f;

constexpr size_t MiB = 1u << 20;
constexpr size_t WS_CTL = 0, CTL_ZERO_BYTES = 1 * MiB;
constexpr size_t WS_WIN = 2 * MiB;
constexpr size_t WS_WO = 138 * MiB;
constexpr size_t WS_WOUT = 170 * MiB;
constexpr size_t WS_WQP = 202 * MiB;
constexpr size_t WS_SK = 218 * MiB;
constexpr size_t WS_IDX = 220 * MiB, WS_GATE = 228 * MiB;
constexpr size_t WS_XN = 236 * MiB;
constexpr size_t WS_AB = 364 * MiB;
constexpr size_t WS_Q = 492 * MiB, WS_K = 556 * MiB, WS_V = 572 * MiB, WS_H = 588 * MiB, WS_B = 652 * MiB, WS_C = 716 * MiB;
constexpr size_t WS_GA = 780 * MiB, WS_GC = 908 * MiB;
constexpr size_t WS_T = 492 * MiB;
constexpr size_t WS_X2N = 620 * MiB;
constexpr size_t WS_QP = 780 * MiB;
constexpr size_t WS_END = 1036 * MiB;
static_assert(WS_T + (size_t)M * D * 2 <= WS_X2N && WS_X2N + (size_t)M * D * 2 <= WS_GA && WS_QP + (size_t)M * PQW * 2 <= WS_GC, "d_ws overlays");
static_assert(WS_WIN + (size_t)INW * D * 2 <= WS_WO && WS_C + (size_t)M * CW * 2 <= WS_GA && WS_GC + (size_t)M * D * 2 <= WS_END, "d_ws map");
constexpr int CW_BAR = 4096;

constexpr int RING_OFF = 0, RING_BYTES = 131072;
constexpr int LDSCTL_OFF = RING_BYTES, MISC_OFF = LDSCTL_OFF + 320;
constexpr int LDS_BYTES = 147456;
static_assert(MISC_OFF + 128 <= LDS_BYTES, "LDS map");
#define GAS __attribute__((address_space(1)))
#define LAS __attribute__((address_space(3)))
typedef unsigned short bf16;
typedef unsigned v4u __attribute__((ext_vector_type(4)));
typedef float f32x4 __attribute__((ext_vector_type(4)));
typedef short bf16x8 __attribute__((ext_vector_type(8)));
typedef GAS unsigned gu32;
typedef GAS unsigned long long gu64;
#define RLX_AGENT __ATOMIC_RELAXED, __HIP_MEMORY_SCOPE_AGENT
#define LDS_WAIT() asm volatile("s_waitcnt lgkmcnt(0)" ::: "memory")
#define VM_WAIT() asm volatile("s_waitcnt vmcnt(0)" ::: "memory")
__device__ __forceinline__ unsigned long long rt() { return __builtin_amdgcn_s_memrealtime(); }
__device__ __forceinline__ unsigned f2bf(float f) { unsigned u = __builtin_bit_cast(unsigned, f); return (u + 0x7fffu + ((u >> 16) & 1u)) >> 16; }
__device__ __forceinline__ unsigned pk2(float lo, float hi) { return f2bf(lo) | (f2bf(hi) << 16); }

#define XB_TMO      128
#define XB_XCNT(j)  (256  + 64 * (j))
#define XB_XSUB(j)  (1280 + 64 * (j))
#define XB_XGEN(j)  (2304 + 64 * (j))
#define XB_TOP      3328
#define XB_TOPGEN   3392
#define XCD_BAR_WORDS 3456
#define XB_SPIN_CAP (1u << 18)

__device__ __forceinline__ unsigned xb_ld(unsigned* p)              { return __hip_atomic_load(p, __ATOMIC_RELAXED, __HIP_MEMORY_SCOPE_AGENT); }
__device__ __forceinline__ unsigned xb_add(unsigned* p, unsigned v) { return __hip_atomic_fetch_add(p, v, __ATOMIC_RELAXED, __HIP_MEMORY_SCOPE_AGENT); }
__device__ __forceinline__ unsigned xb_xcc_id() { return (unsigned)__builtin_amdgcn_s_getreg((3 << 11) | 20) & 0xFu; }
#define XB_SPIN(cond, bar) do { unsigned _sp = 0; while (cond) { __builtin_amdgcn_s_sleep(1); \
    if ((++_sp & 255u) == 0u) { if (xb_ld(&(bar)[XB_TMO])) break; if (_sp > XB_SPIN_CAP) { atomicAdd(&(bar)[XB_TMO], 1u); break; } } } } while (0)

struct XcdBarrier {
    unsigned* bar; unsigned x;
    volatile LAS unsigned* st;
};

__device__ __forceinline__ XcdBarrier xcd_barrier_post(unsigned* bar, volatile LAS unsigned* st) {
    XcdBarrier b; b.bar = bar; b.x = xb_xcc_id(); b.st = st;
    if (threadIdx.x == 0) (void)xb_add(&bar[XB_XCNT(b.x)], 1u);
    return b;
}
__device__ __forceinline__ void xcd_barrier_complete(unsigned* bar, unsigned x, unsigned& nloc, unsigned& nx) {
    const unsigned G = gridDim.x * gridDim.y * gridDim.z;
    unsigned sum, cnt, mine, sp = 0u;
    for (;;) {
        sum = 0u; cnt = 0u; mine = 0u;
#pragma unroll
        for (unsigned j = 0; j < 16; ++j) { const unsigned c = xb_ld(&bar[XB_XCNT(j)]); sum += c; cnt += (c > 0u) ? 1u : 0u; mine = (j == x) ? c : mine; }
        if (sum == G) break;
        __builtin_amdgcn_s_sleep(1);
        if ((++sp & 255u) == 0u) { if (xb_ld(&bar[XB_TMO])) break; if (sp > XB_SPIN_CAP) { atomicAdd(&bar[XB_TMO], 1u); break; } }
    }
    nloc = mine > 0u ? mine : 1u; nx = cnt > 0u ? cnt : 1u;
}

__device__ __forceinline__ void xcd_barrier(const XcdBarrier& b) {
    asm volatile("s_waitcnt vmcnt(0)" ::: "memory");
    __syncthreads();
    if (threadIdx.x == 0) {
        unsigned* bar = b.bar;
        __builtin_amdgcn_s_waitcnt(0);
        unsigned nloc = b.st[0], nx = b.st[1];
        if (nloc == 0u) { xcd_barrier_complete(bar, b.x, nloc, nx); b.st[0] = nloc; b.st[1] = nx; }
        const unsigned old = xb_add(&bar[XB_XSUB(b.x)], 1u);
        const unsigned gen = old / nloc;
        if (old + 1u == (gen + 1u) * nloc) {
            __builtin_amdgcn_fence(__ATOMIC_RELEASE, "agent");
            asm volatile("s_waitcnt vmcnt(0)" ::: "memory");
            const unsigned og = xb_add(&bar[XB_TOP], 1u);
            const unsigned tg = og / nx;
            if (og + 1u == (tg + 1u) * nx) xb_add(&bar[XB_TOPGEN], 1u);
            else XB_SPIN(xb_ld(&bar[XB_TOPGEN]) == tg, bar);
            __builtin_amdgcn_fence(__ATOMIC_ACQUIRE, "agent");
            xb_add(&bar[XB_XGEN(b.x)], 1u);
            asm volatile("s_waitcnt vmcnt(0)" ::: "memory");
        } else {
            XB_SPIN(xb_ld(&bar[XB_XGEN(b.x)]) == gen, bar);
            __builtin_amdgcn_fence(__ATOMIC_ACQUIRE, "agent");
            asm volatile("s_waitcnt vmcnt(0)" ::: "memory");
        }
    }
    __syncthreads();
}
typedef unsigned u32x2_t __attribute__((ext_vector_type(2)));
typedef short v4i16_t __attribute__((ext_vector_type(4)));
typedef unsigned long long u64;
typedef int i32x4_t __attribute__((ext_vector_type(4)));
struct Frame {
    LAS unsigned char* lds;
    volatile LAS unsigned* MISC;
    gu32* ctl;
    unsigned char* ws;
    int tid, lane, wave;
    int vcu, G;
    const float *x, *g1, *w_in, *gq, *gk, *sink, *conv_w, *w_oa, *w_oc, *w_out, *g2, *w_qp, *subk, *w_down, *w_up;
    float* out;
};
#define WSP(type, off) ((type*)(F.ws + (off)))
using pg8::cvt_pk_bf16; using pg8::pack8; using pg8::unpack8;

__device__ __forceinline__ float wave_sum(float v) {
#pragma unroll
    for (int o = 1; o < 64; o <<= 1) v += __shfl_xor(v, o);
    return v;
}
__device__ __forceinline__ float dot4(const f32x4 a, const f32x4 b) { return (a[0] * b[0] + a[1] * b[1]) + (a[2] * b[2] + a[3] * b[3]); }
__device__ __forceinline__ float bflo(unsigned w) { return __uint_as_float(w << 16); }
__device__ __forceinline__ float bfhi(unsigned w) { return __uint_as_float(w & 0xffff0000u); }

__device__ __forceinline__ void p0_transpose_item(const float* W, int K, int N, bf16* WT, int row_off, LAS float* scr, int item, int lane) {
    const int nblk = N / 32, kb = item / nblk, nb = item % nblk, k0 = 64 * kb, n0 = 32 * nb;
#pragma unroll 8
    for (int i = 0; i < 32; ++i) { const int kk = 2 * i + (lane >> 5); scr[kk * 33 + (lane & 31)] = W[(size_t)(k0 + kk) * N + n0 + (lane & 31)]; }
    LDS_WAIT(); asm volatile("" ::: "memory");
    const int c = lane & 7;
#pragma unroll
    for (int j = 0; j < 4; ++j) { const int n = (lane >> 3) + 8 * j; const LAS float* s = scr + (8 * c) * 33 + n;
        v4u o; o.x = cvt_pk_bf16(s[0 * 33], s[1 * 33]); o.y = cvt_pk_bf16(s[2 * 33], s[3 * 33]); o.z = cvt_pk_bf16(s[4 * 33], s[5 * 33]); o.w = cvt_pk_bf16(s[6 * 33], s[7 * 33]);
        *(GAS v4u*)(WT + (size_t)(row_off + n0 + n) * K + k0 + 8 * c) = o; }
    LDS_WAIT(); asm volatile("" ::: "memory");
}
__device__ __forceinline__ void rms_row_to_bf16(const float* xrow, const float* g, bf16* orow, int lane) {
    const GAS f32x4* xr = (const GAS f32x4*)xrow + lane; const GAS f32x4* gr = (const GAS f32x4*)g + lane;
    f32x4 v[16]; float s = 0.f;
#pragma unroll
    for (int j = 0; j < 16; ++j) { v[j] = xr[64 * j]; s += dot4(v[j], v[j]); }
    const float r = rsqrtf(wave_sum(s) * (1.f / D) + EPS);
    GAS u32x2_t* o8 = (GAS u32x2_t*)orow + lane;
#pragma unroll
    for (int j = 0; j < 16; ++j) { const f32x4 gg = gr[64 * j]; u32x2_t w; w.x = cvt_pk_bf16(v[j][0] * r * gg[0], v[j][1] * r * gg[1]); w.y = cvt_pk_bf16(v[j][2] * r * gg[2], v[j][3] * r * gg[3]); o8[64 * j] = w; }
}
__device__ __forceinline__ void p0_prologue(Frame& F) {
    LAS float* scr = (LAS float*)(F.lds + RING_OFF + F.wave * 16384);
    const int gw = F.vcu * NWAVES + F.wave, NGW = F.G * NWAVES;
    constexpr int I_IN = (D / 64) * (INW / 32), I_OA = (QW / 64) * (D / 32), I_OC = (CW / 64) * (D / 32), I_OUT = (D / 64) * (D / 32), I_QP = (D / 64) * (PQW / 32);
    constexpr int NITEMS = I_IN + I_OA + I_OC + I_OUT + I_QP;
    bf16* Win_t = WSP(bf16, WS_WIN); bf16* Wo_t = WSP(bf16, WS_WO); bf16* Wout_t = WSP(bf16, WS_WOUT); bf16* Wqp_t = WSP(bf16, WS_WQP);
    for (int it = gw; it < NITEMS; it += NGW) {
        int r = it;
        if (r < I_IN) { p0_transpose_item(F.w_in, D, INW, Win_t, 0, scr, r, F.lane); continue; } r -= I_IN;
        if (r < I_OA) { p0_transpose_item(F.w_oa, QW, D, Wo_t, 0, scr, r, F.lane); continue; } r -= I_OA;
        if (r < I_OC) { p0_transpose_item(F.w_oc, CW, D, Wo_t, D, scr, r, F.lane); continue; } r -= I_OC;
        if (r < I_OUT) { p0_transpose_item(F.w_out, D, D, Wout_t, 0, scr, r, F.lane); continue; } r -= I_OUT;
        p0_transpose_item(F.w_qp, D, PQW, Wqp_t, 0, scr, r, F.lane);
    }
    {
        bf16* SK = WSP(bf16, WS_SK); const int nth = F.G * NWAVES * 64, gt = gw * 64 + F.lane;
        for (int i = gt; i < PH * 2 * NKEYS * 128 / 4; i += nth) { const f32x4 v = ((const GAS f32x4*)F.subk)[i]; u32x2_t w; w.x = cvt_pk_bf16(v[0], v[1]); w.y = cvt_pk_bf16(v[2], v[3]); ((GAS u32x2_t*)SK)[i] = w; }
    }
    bf16* XN = WSP(bf16, WS_XN);
    for (int m = gw; m < M; m += NGW) rms_row_to_bf16(F.x + (size_t)m * D, F.g1, XN + (size_t)m * D, F.lane);
}

__device__ __forceinline__ unsigned off_b(unsigned row, unsigned ch) { return 256u * row + 16u * (ch ^ (((row & 3u) << 2) | ((row >> 2) & 3u))); }
__device__ __forceinline__ unsigned tr_addr16(unsigned lane, unsigned c, unsigned ks, unsigned t) {
    const unsigned g = lane >> 4, q = (lane & 15u) >> 2, p = lane & 3u;
    return off_b(32u * ks + 8u * g + 4u * t + q, 2u * c + (p >> 1)) + 8u * (p & 1u);
}
__device__ __forceinline__ v4i16_t tr_read(LAS unsigned char* p) { return __builtin_amdgcn_ds_read_tr16_b64_v4i16((LAS v4i16_t*)p); }
#define MFMA16(a, b, c) __builtin_amdgcn_mfma_f32_16x16x32_bf16((a), (b), (c), 0, 0, 0)

__device__ __forceinline__ void attn_unit(Frame& F, const int U) {
    const int lane = F.lane, wave = F.wave, c = lane & 15, hg = lane >> 4, tid = F.tid;
    const int hp = U & 1, kvh = (U >> 1) & 3, nblk = (U >> 3) & 31, b = U >> 8;
    const int hq = kvh * 4 + hp * 2 + (wave >> 2), i0 = (wave & 3) * 32;
    const size_t tok0 = (size_t)b * SEQ + (size_t)nblk * 128;
    LAS unsigned char* Kl = F.lds + RING_OFF; LAS unsigned char* Vl = Kl + 32768;
    const bf16* QB = WSP(const bf16, WS_Q); const bf16* KB = WSP(const bf16, WS_K); const bf16* VB = WSP(const bf16, WS_V); bf16* OB = WSP(bf16, WS_AB);
    bf16x8 qf[2][4];
    {
        float g[4][8];
#pragma unroll
        for (int ks = 0; ks < 4; ++ks) { const f32x4 a = *(const GAS f32x4*)(F.gq + 32 * ks + 8 * hg), bb = *(const GAS f32x4*)(F.gq + 32 * ks + 8 * hg + 4);
#pragma unroll
            for (int e = 0; e < 4; ++e) { g[ks][e] = a[e]; g[ks][4 + e] = bb[e]; } }
#pragma unroll
        for (int qt = 0; qt < 2; ++qt) {
            const bf16* qrow = QB + (tok0 + i0 + 16 * qt + c) * QW + hq * HD + 8 * hg;
            f32x4 lo[4], hi[4]; float ss = 0.f;
#pragma unroll
            for (int ks = 0; ks < 4; ++ks) { unpack8(*(const GAS v4u*)(qrow + 32 * ks), lo[ks], hi[ks]); ss += dot4(lo[ks], lo[ks]) + dot4(hi[ks], hi[ks]); }
            ss += __shfl_xor(ss, 16); ss += __shfl_xor(ss, 32);
            const float r = rsqrtf(ss * (1.f / HD) + EPS) * (0.08838834764831845f * LOG2E);
#pragma unroll
            for (int ks = 0; ks < 4; ++ks) { f32x4 a, bb;
#pragma unroll
                for (int e = 0; e < 4; ++e) { a[e] = lo[ks][e] * r * g[ks][e]; bb[e] = hi[ks][e] * r * g[ks][4 + e]; }
                qf[qt][ks] = __builtin_bit_cast(bf16x8, pack8(a, bb)); }
        }
    }
    const float slope2 = __builtin_amdgcn_exp2f(-0.5f * (float)(hq + 1)) * LOG2E;
    const float sink2 = F.sink[hq] * LOG2E;
    float mrun[2] = {sink2, sink2}, lrun[2]; lrun[0] = lrun[1] = (hg == 0) ? 1.f : 0.f;
    f32x4 acc[8][2];
#pragma unroll
    for (int dt = 0; dt < 8; ++dt) { acc[dt][0] = (f32x4){0.f, 0.f, 0.f, 0.f}; acc[dt][1] = (f32x4){0.f, 0.f, 0.f, 0.f}; }
    const f32x4 gk0 = *(const GAS f32x4*)(F.gk + (tid & 15) * 8), gk1 = *(const GAS f32x4*)(F.gk + (tid & 15) * 8 + 4);
#pragma unroll 1
    for (int kbi = -1; kbi <= 1; ++kbi) {
        const int kb = nblk + kbi; if (kb < 0 || kb >= SEQ / 128) continue;
        __syncthreads();
#pragma unroll
        for (int it = 0; it < 4; ++it) {
            const int row = (tid >> 4) + 32 * it, ch = tid & 15;
            const size_t src = ((size_t)b * SEQ + (size_t)kb * 128 + row) * KVW + kvh * HD + ch * 8;
            f32x4 k0, k1; unpack8(*(const GAS v4u*)(KB + src), k0, k1);
            float ss = dot4(k0, k0) + dot4(k1, k1);
            ss += __shfl_xor(ss, 1); ss += __shfl_xor(ss, 2); ss += __shfl_xor(ss, 4); ss += __shfl_xor(ss, 8);
            const float r = rsqrtf(ss * (1.f / HD) + EPS);
            *(LAS v4u*)(Kl + off_b(row, ch)) = pack8(k0 * r * gk0, k1 * r * gk1);
            *(LAS v4u*)(Vl + off_b(row, ch)) = *(const GAS v4u*)(VB + src);
        }
        __syncthreads();
#pragma unroll 1
        for (int ks32 = 0; ks32 < 4; ++ks32) {
            f32x4 sa[2], sb[2];
            sa[0] = sa[1] = sb[0] = sb[1] = (f32x4){0.f, 0.f, 0.f, 0.f};
            const unsigned krow = 32u * ks32 + 8u * (c >> 2) + (c & 3);
#pragma unroll
            for (int ks = 0; ks < 4; ++ks) {
                const bf16x8 ka = *(const LAS bf16x8*)(Kl + off_b(krow, 4 * ks + hg)), kb2 = *(const LAS bf16x8*)(Kl + off_b(krow + 4, 4 * ks + hg));
#pragma unroll
                for (int qt = 0; qt < 2; ++qt) { sa[qt] = MFMA16(ka, qf[qt][ks], sa[qt]); sb[qt] = MFMA16(kb2, qf[qt][ks], sb[qt]); }
            }
            bf16x8 pf[2];
#pragma unroll
            for (int qt = 0; qt < 2; ++qt) {
                float s[8] = {sa[qt][0], sa[qt][1], sa[qt][2], sa[qt][3], sb[qt][0], sb[qt][1], sb[qt][2], sb[qt][3]};
                const int rel0 = kbi * 128 + 32 * ks32 + 8 * hg - (i0 + 16 * qt + c);
                float mx = -INFINITY;
#pragma unroll
                for (int j = 0; j < 8; ++j) { const int rel = rel0 + j, dist = rel < 0 ? -rel : rel; const float sv = s[j] - slope2 * (float)dist; s[j] = (dist <= 128) ? sv : -INFINITY; mx = fmaxf(mx, s[j]); }
                mx = fmaxf(mx, __shfl_xor(mx, 16)); mx = fmaxf(mx, __shfl_xor(mx, 32));
                const float mn = fmaxf(mrun[qt], mx), alpha = __builtin_amdgcn_exp2f(mrun[qt] - mn); mrun[qt] = mn;
                float ps = 0.f;
#pragma unroll
                for (int j = 0; j < 8; ++j) { s[j] = __builtin_amdgcn_exp2f(s[j] - mn); ps += s[j]; }
                lrun[qt] = lrun[qt] * alpha + ps;
                pf[qt] = __builtin_bit_cast(bf16x8, pack8((f32x4){s[0], s[1], s[2], s[3]}, (f32x4){s[4], s[5], s[6], s[7]}));
#pragma unroll
                for (int dt = 0; dt < 8; ++dt) acc[dt][qt] = acc[dt][qt] * alpha;
            }
#pragma unroll
            for (int dt = 0; dt < 8; ++dt) {
                const v4i16_t vlo = tr_read(Vl + tr_addr16(lane, dt, ks32, 0)), vhi = tr_read(Vl + tr_addr16(lane, dt, ks32, 1));
                const bf16x8 vf = {vlo[0], vlo[1], vlo[2], vlo[3], vhi[0], vhi[1], vhi[2], vhi[3]};
#pragma unroll
                for (int qt = 0; qt < 2; ++qt) acc[dt][qt] = MFMA16(vf, pf[qt], acc[dt][qt]);
            }
        }
    }
#pragma unroll
    for (int qt = 0; qt < 2; ++qt) {
        float l = lrun[qt]; l += __shfl_xor(l, 16); l += __shfl_xor(l, 32);
        const float inv = 1.0f / l;
        bf16* orow = OB + (tok0 + i0 + 16 * qt + c) * QW + hq * HD + 4 * hg;
#pragma unroll
        for (int dt = 0; dt < 8; ++dt) { const f32x4 o = acc[dt][qt] * inv; u32x2_t w; w.x = cvt_pk_bf16(o[0], o[1]); w.y = cvt_pk_bf16(o[2], o[3]); *(GAS u32x2_t*)(orow + 16 * dt) = w; }
    }
}
__device__ __forceinline__ void conv_phase(Frame& F) {
    const bf16* HB = WSP(const bf16, WS_H); const bf16* BB = WSP(const bf16, WS_B); const bf16* CB = WSP(const bf16, WS_C); bf16* OC = WSP(bf16, WS_AB) + (size_t)M * CW;
    const unsigned nchunk = (unsigned)M * (CW / 8);
    for (unsigned e = (unsigned)F.vcu * 512u + (unsigned)F.tid; e < nchunk; e += (unsigned)F.G * 512u) {
        const int t = (int)(e >> 8), cc = (int)(e & 255u) * 8, tl = t & (SEQ - 1);
        const size_t o = (size_t)t * CW + cc;
        f32x4 h0, h1, c0, c1, up0, up1, un0, un1;
        unpack8(*(const GAS v4u*)(HB + o), h0, h1); unpack8(*(const GAS v4u*)(CB + o), c0, c1);
        const f32x4 uc0 = h0 * c0, uc1 = h1 * c1;
        up0 = up1 = un0 = un1 = (f32x4){0.f, 0.f, 0.f, 0.f};
        if (tl > 0) { unpack8(*(const GAS v4u*)(HB + o - CW), h0, h1); unpack8(*(const GAS v4u*)(CB + o - CW), c0, c1); up0 = h0 * c0; up1 = h1 * c1; }
        if (tl < SEQ - 1) { unpack8(*(const GAS v4u*)(HB + o + CW), h0, h1); unpack8(*(const GAS v4u*)(CB + o + CW), c0, c1); un0 = h0 * c0; un1 = h1 * c1; }
        const GAS f32x4* w = (const GAS f32x4*)(F.conv_w + cc);
        const f32x4 y0 = w[0] * up0 + w[CW / 4] * uc0 + w[2 * CW / 4] * un0, y1 = w[1] * up1 + w[CW / 4 + 1] * uc1 + w[2 * CW / 4 + 1] * un1;
        f32x4 b0, b1; unpack8(*(const GAS v4u*)(BB + o), b0, b1);
        *(GAS v4u*)(OC + o) = pack8(b0 * y0, b1 * y1);
    }
}

__device__ __forceinline__ unsigned ordf(float f) { const unsigned u = __float_as_uint(f); return u ^ ((u >> 31) ? 0xFFFFFFFFu : 0x80000000u); }
__device__ __forceinline__ float unordf(unsigned k) { return __uint_as_float((k & 0x80000000u) ? (k ^ 0x80000000u) : ~k); }
__device__ __forceinline__ u64 shfl64_xor(u64 v, int m) { const unsigned lo = __shfl_xor((unsigned)v, m), hi = __shfl_xor((unsigned)(v >> 32), m); return ((u64)hi << 32) | lo; }
struct Stair { int i[52], j[52]; };
constexpr Stair make_stair() { Stair s{}; int n = 0; for (int a = 0; a < 16; ++a) for (int b = 0; b < 16; ++b) if ((a + 1) * (b + 1) <= 16) { s.i[n] = a; s.j[n] = b; ++n; } for (; n < 52; ++n) { s.i[n] = -1; s.j[n] = -1; } return s; }
constexpr Stair STAIR = make_stair();
template <int P> __device__ __forceinline__ u64 cand1(const float (&v1)[16], const float (&v2)[16], const unsigned (&n1)[16], const unsigned (&n2)[16]) {
    constexpr int i = STAIR.i[P], j = STAIR.j[P];
    if constexpr (i < 0) return 0ull;
    else return ((u64)ordf(v1[i] + v2[j]) << 32) | (u64)(n1[i] * (unsigned)NKEYS + n2[j]);
}
template <int S> __device__ __forceinline__ void cand_fill(u64 (&ck)[13], const float (&v1)[16], const float (&v2)[16], const unsigned (&n1)[16], const unsigned (&n2)[16], int hg) {
    const u64 k0 = cand1<4 * S + 0>(v1, v2, n1, n2), k1 = cand1<4 * S + 1>(v1, v2, n1, n2), k2 = cand1<4 * S + 2>(v1, v2, n1, n2), k3 = cand1<4 * S + 3>(v1, v2, n1, n2);
    ck[S] = hg == 0 ? k0 : hg == 1 ? k1 : hg == 2 ? k2 : k3;
    if constexpr (S + 1 < 13) cand_fill<S + 1>(ck, v1, v2, n1, n2, hg);
}
__device__ __forceinline__ void route_task(Frame& F, const int tg, const int h) {
    const int lane = F.lane, c = lane & 15, hg = lane >> 4;
    const int tok = tg * 16 + c;
    const bf16* QP = WSP(const bf16, WS_QP); LAS unsigned char* SKl = F.lds + RING_OFF;
    unsigned sel[2][16];
#pragma unroll
    for (int half = 0; half < 2; ++half) {
        bf16x8 bq[4];
#pragma unroll
        for (int ks = 0; ks < 4; ++ks) bq[ks] = *(const GAS bf16x8*)(QP + (size_t)tok * PQW + h * 256 + half * 128 + 32 * ks + 8 * hg);
        unsigned k[32];
#pragma unroll
        for (int tile = 0; tile < 8; ++tile) {
            f32x4 s = (f32x4){0.f, 0.f, 0.f, 0.f};
#pragma unroll
            for (int ks = 0; ks < 4; ++ks) { const bf16x8 a = *(const LAS bf16x8*)(SKl + off_b(half * 128 + 16 * tile + c, 4 * ks + hg)); s = MFMA16(a, bq[ks], s); }
#pragma unroll
            for (int r = 0; r < 4; ++r) k[tile * 4 + r] = (ordf(s[r]) & ~127u) | (unsigned)(16 * tile + 4 * hg + r);
            if (tile & 1) asm volatile("" ::: "memory");
        }
#pragma unroll
        for (int it = 0; it < 16; ++it) {
            unsigned w = k[0];
#pragma unroll
            for (int i = 1; i < 32; ++i) w = w > k[i] ? w : k[i];
            { const unsigned o = __shfl_xor(w, 16); w = w > o ? w : o; } { const unsigned o = __shfl_xor(w, 32); w = w > o ? w : o; }
            sel[half][it] = w;
#pragma unroll
            for (int i = 0; i < 32; ++i) k[i] = (k[i] == w) ? 0u : k[i];
        }
        asm volatile("" ::: "memory");
    }
    float v1[16], v2[16]; unsigned n1[16], n2[16];
#pragma unroll
    for (int i = 0; i < 16; ++i) { v1[i] = unordf(sel[0][i] & ~127u); n1[i] = sel[0][i] & 127u; v2[i] = unordf(sel[1][i] & ~127u); n2[i] = sel[1][i] & 127u; }
    u64 ck[13];
    cand_fill<0>(ck, v1, v2, n1, n2, hg);
    u64 top[16];
#pragma unroll
    for (int it = 0; it < 16; ++it) {
        u64 w = ck[0];
#pragma unroll
        for (int s = 1; s < 13; ++s) w = w > ck[s] ? w : ck[s];
        { const u64 o = shfl64_xor(w, 16); w = w > o ? w : o; } { const u64 o = shfl64_xor(w, 32); w = w > o ? w : o; }
        top[it] = w;
#pragma unroll
        for (int s = 0; s < 13; ++s) ck[s] = (ck[s] == w) ? 0ull : ck[s];
    }
    float ev[16], sum = 0.f; const float t0 = unordf((unsigned)(top[0] >> 32));
#pragma unroll
    for (int it = 0; it < 16; ++it) { ev[it] = __builtin_amdgcn_exp2f((unordf((unsigned)(top[it] >> 32)) - t0) * LOG2E); sum += ev[it]; }
    const float inv = 1.0f / sum;
    int oi[4]; float og[4];
#pragma unroll
    for (int jj = 0; jj < 4; ++jj) {
        oi[jj] = (int)(unsigned)(hg == 0 ? top[jj] : hg == 1 ? top[4 + jj] : hg == 2 ? top[8 + jj] : top[12 + jj]);
        og[jj] = (hg == 0 ? ev[jj] : hg == 1 ? ev[4 + jj] : hg == 2 ? ev[8 + jj] : ev[12 + jj]) * inv;
    }
    const size_t o = ((size_t)tok * PH + h) * TOPK + 4 * hg;
    *(GAS i32x4_t*)(WSP(int, WS_IDX) + o) = (i32x4_t){oi[0], oi[1], oi[2], oi[3]};
    *(GAS f32x4*)(WSP(float, WS_GATE) + o) = (f32x4){og[0], og[1], og[2], og[3]};
}

__device__ __forceinline__ float gelu_erf(float v) { return 0.5f * v * (1.0f + erff(v * 0.70710678118654752f)); }
__device__ __forceinline__ void peer_token(Frame& F, const int t) {
    const int lane = F.lane;
    f32x4 xv[16];
    { const GAS u32x2_t* xr = (const GAS u32x2_t*)(WSP(const bf16, WS_X2N) + (size_t)t * D) + lane;
#pragma unroll
      for (int j = 0; j < 16; ++j) { const u32x2_t w = xr[64 * j]; xv[j] = (f32x4){bflo(w.x), bfhi(w.x), bflo(w.y), bfhi(w.y)}; } }
    const int* ip = WSP(const int, WS_IDX) + (size_t)t * (PH * TOPK); const float* gp = WSP(const float, WS_GATE) + (size_t)t * (PH * TOPK);
    const int id0 = ip[lane], id1 = ip[64 + lane]; const float g0 = gp[lane], g1 = gp[64 + lane];
    float c0 = 0.f, c1 = 0.f;
#pragma unroll 1
    for (int e = 0; e < 64; ++e) {
        const int ia = __builtin_amdgcn_readlane(id0, e), ib = __builtin_amdgcn_readlane(id1, e);
        const GAS f32x4* ra = (const GAS f32x4*)(F.w_down + (size_t)ia * D) + lane; const GAS f32x4* rb = (const GAS f32x4*)(F.w_down + (size_t)ib * D) + lane;
        float sa = 0.f, sb = 0.f;
#pragma unroll
        for (int j = 0; j < 16; ++j) { sa += dot4(ra[64 * j], xv[j]); sb += dot4(rb[64 * j], xv[j]); }
        sa = wave_sum(sa); sb = wave_sum(sb);
        if (lane == e) { c0 = sa; c1 = sb; }
    }
    c0 = g0 * gelu_erf(c0); c1 = g1 * gelu_erf(c1);
    f32x4 acc[16];
#pragma unroll
    for (int j = 0; j < 16; ++j) acc[j] = (f32x4){0.f, 0.f, 0.f, 0.f};
#pragma unroll 1
    for (int e = 0; e < 128; ++e) {
        const int el = e & 63;
        const int id = __builtin_amdgcn_readlane(e < 64 ? id0 : id1, el);
        const float cf = __uint_as_float(__builtin_amdgcn_readlane(__float_as_uint(e < 64 ? c0 : c1), el));
        const GAS f32x4* r = (const GAS f32x4*)(F.w_up + (size_t)id * D) + lane;
#pragma unroll
        for (int j = 0; j < 16; ++j) acc[j] = acc[j] + r[64 * j] * cf;
    }
    GAS f32x4* orow = (GAS f32x4*)(F.out + (size_t)t * D) + lane;
#pragma unroll
    for (int j = 0; j < 16; ++j) orow[64 * j] = orow[64 * j] + acc[j];
}
struct Args { const float* in[15]; float* out; unsigned char* ws; int ph_lo, ph_hi, pad0, pad1; };
__global__ void __launch_bounds__(NWAVES * 64, 2) skel_fwd(Args args) {
    extern __shared__ __attribute__((aligned(16))) unsigned char lds[];
    Frame F;
    F.lds = (LAS unsigned char*)lds;
    F.MISC = (volatile LAS unsigned*)(F.lds + MISC_OFF);
    F.tid = threadIdx.x; F.lane = F.tid & 63; F.wave = __builtin_amdgcn_readfirstlane(F.tid >> 6);
    F.G = gridDim.x; { const int bx = blockIdx.x; F.vcu = (F.G % 8 == 0) ? (bx % 8) * (F.G / 8) + bx / 8 : bx; }
    F.ws = args.ws; F.ctl = (gu32*)(args.ws + WS_CTL);
    F.x = args.in[0]; F.g1 = args.in[1]; F.w_in = args.in[2]; F.gq = args.in[3]; F.gk = args.in[4]; F.sink = args.in[5]; F.conv_w = args.in[6]; F.w_oa = args.in[7];
    F.w_oc = args.in[8]; F.w_out = args.in[9]; F.g2 = args.in[10]; F.w_qp = args.in[11]; F.subk = args.in[12]; F.w_down = args.in[13]; F.w_up = args.in[14]; F.out = args.out;
    for (int u = F.tid; u < (LDS_BYTES - LDSCTL_OFF) / 4; u += NWAVES * 64) ((LAS unsigned*)(F.lds + LDSCTL_OFF))[u] = 0u;
    __syncthreads();
    XcdBarrier bar; bar.bar = (unsigned*)(F.ctl + CW_BAR); bar.x = 0; bar.st = nullptr;
    if (MK_ONE_LAUNCH) bar = xcd_barrier_post((unsigned*)(F.ctl + CW_BAR), F.MISC + 8);
    const int lo = args.ph_lo, hi = args.ph_hi;
#ifndef PHASE_MASK
#define PHASE_MASK 0x1ff
#endif
#define IN(k) (((PHASE_MASK >> (k)) & 1) && lo <= (k) && (k) < hi)
#define SEAM(k) do { if (MK_ONE_LAUNCH && IN(k) && IN((k) + 1)) xcd_barrier(bar); } while (0)
    const int gw = F.vcu * NWAVES + F.wave, NGW = F.G * NWAVES;

    if (IN(0)) { p0_prologue(F); } SEAM(0);

    if (IN(1)) {
        pg8::Gemm g{WSP(const bf16, WS_XN), WSP(const bf16, WS_WIN), M, INW, D}; pg8::StaticOrder S; S.init(M, INW, F.G, (int)blockIdx.x);
        pg8::EpiProj E{WSP(bf16, WS_Q), WSP(bf16, WS_K), WSP(bf16, WS_V), WSP(bf16, WS_H), WSP(bf16, WS_B), WSP(bf16, WS_C), WSP(bf16, WS_GA), WSP(bf16, WS_GC)};
        pg8::gemm_phase<pg8::EpiProj, pg8::StaticOrder, PG8_ALIGN, PG8_SP2>(F.lds + RING_OFF, g, S, E);
    } SEAM(1);

    if (IN(2)) {
        for (int U = F.vcu * 4; U < BATCH * 32 * NKV * 2; U += F.G * 4)
            for (int i = 0; i < 4; ++i) attn_unit(F, U + i);
        conv_phase(F);
    } SEAM(2);

    if (IN(3)) {
        pg8::Gemm g{WSP(const bf16, WS_AB), WSP(const bf16, WS_WO), 2 * M, 2 * D, QW}; pg8::PairOrder S; S.so.init(M, D, F.G, (int)blockIdx.x);
        pg8::EpiMerge E{WSP(const bf16, WS_GA), WSP(const bf16, WS_GC), WSP(bf16, WS_T), WSP(bf16, WS_XN)};
        pg8::gemm_phase<pg8::EpiMerge, pg8::PairOrder, PG8_ALIGN, PG8_SP2>(F.lds + RING_OFF, g, S, E);
    } SEAM(3);

    if (IN(4)) {
        pg8::Gemm g{WSP(const bf16, WS_XN), WSP(const bf16, WS_WOUT), M, D, D}; pg8::StaticOrder S; S.init(M, D, F.G, (int)blockIdx.x);
        pg8::EpiRes E{F.x, F.out};
        pg8::gemm_phase<pg8::EpiRes, pg8::StaticOrder, PG8_ALIGN, PG8_SP2>(F.lds + RING_OFF, g, S, E);
    } SEAM(4);

    if (IN(5)) {
        bf16* X2N = WSP(bf16, WS_X2N);
        for (int m = gw; m < M; m += NGW) rms_row_to_bf16(F.out + (size_t)m * D, F.g2, X2N + (size_t)m * D, F.lane);
    } SEAM(5);

    if (IN(6)) {
        pg8::Gemm g{WSP(const bf16, WS_X2N), WSP(const bf16, WS_WQP), M, PQW, D}; pg8::StaticOrder S; S.init(M, PQW, F.G, (int)blockIdx.x);
        pg8::EpiStore E{WSP(bf16, WS_QP), PQW};
        pg8::gemm_phase<pg8::EpiStore, pg8::StaticOrder, PG8_ALIGN, PG8_SP2>(F.lds + RING_OFF, g, S, E);
    } SEAM(6);

    if (IN(7)) {
        const int h = F.vcu & 7;
        { const bf16* SK = WSP(const bf16, WS_SK) + (size_t)h * (2 * NKEYS * 128);
#pragma unroll
          for (int i = 0; i < 8; ++i) { const int q = F.tid + 512 * i, row = q >> 4, ch = q & 15; *(LAS v4u*)(F.lds + RING_OFF + off_b(row, ch)) = *(const GAS v4u*)(SK + (size_t)row * 128 + ch * 8); } }
        __syncthreads();
        for (int tg = (F.vcu >> 3) * NWAVES + F.wave; tg < M / 16; tg += (F.G >> 3) * NWAVES) route_task(F, tg, h);
    } SEAM(7);

    if (IN(8)) {
        for (int t = gw; t < M; t += NGW) peer_token(F, t);
    }
#undef IN
#undef SEAM
}

extern "C" void kernel_launch(void* const* d_in, const int* in_sizes, int n_in, void* d_out, int out_size, void* d_ws, size_t ws_size, hipStream_t stream) {
    static int grid = 0;
    if (grid == 0) {
        if (n_in != 15 || in_sizes[0] != M * D || out_size != M * D || ws_size < WS_END) { fprintf(stderr, "kernel_launch: built for 15 inputs, x and out of %d floats, >= %zu bytes of workspace; got n_in %d, in0 %d, out %d, ws %zu; nothing launched\n", M * D, (size_t)WS_END, n_in, n_in > 0 ? in_sizes[0] : -1, out_size, ws_size); grid = -1; return; }
        int dev = 0, cus = 0, per_cu = 0;
        if (hipGetDevice(&dev) != hipSuccess || hipDeviceGetAttribute(&cus, hipDeviceAttributeMultiprocessorCount, dev) != hipSuccess) { fprintf(stderr, "kernel_launch: hipGetDevice / hipDeviceGetAttribute failed; nothing launched\n"); grid = -1; return; }
        if (hipFuncSetAttribute((const void*)skel_fwd, hipFuncAttributeMaxDynamicSharedMemorySize, LDS_BYTES) != hipSuccess) { fprintf(stderr, "kernel_launch: hipFuncSetAttribute failed; nothing launched\n"); grid = -1; return; }
        if (hipOccupancyMaxActiveBlocksPerMultiprocessor(&per_cu, (const void*)skel_fwd, NWAVES * 64, LDS_BYTES) != hipSuccess || per_cu < 1)
            fprintf(stderr, "kernel_launch: note: the occupancy query reports %d workgroups per CU\n", per_cu);
        (void)hipGetLastError();
        grid = cus;
        if (grid % 8 != 0) { fprintf(stderr, "kernel_launch: %d CUs: this kernel deals work in groups of 8 workgroups; nothing launched\n", grid); grid = -1; return; }
    }
    if (grid < 0) return;
    if (hipMemsetAsync((char*)d_ws + WS_CTL, 0, CTL_ZERO_BYTES, stream) != hipSuccess) { fprintf(stderr, "kernel_launch: hipMemsetAsync of the control words failed; nothing launched\n"); return; }
    Args a{};
    for (int i = 0; i < 15; ++i) a.in[i] = (const float*)d_in[i];
    a.out = (float*)d_out; a.ws = (unsigned char*)d_ws;
#if MK_ONE_LAUNCH
    a.ph_lo = 0; a.ph_hi = N_PHASES;
    hipLaunchKernelGGL(skel_fwd, dim3(grid), dim3(NWAVES * 64), LDS_BYTES, stream, a);
    { const hipError_t le = hipPeekAtLastError(); if (le != hipSuccess) fprintf(stderr, "kernel_launch: launch failed: %s\n", hipGetErrorName(le)); }
#else
    for (int p = 0; p < N_PHASES; ++p) {
        a.ph_lo = p; a.ph_hi = p + 1;
        hipLaunchKernelGGL(skel_fwd, dim3(grid), dim3(NWAVES * 64), LDS_BYTES, stream, a);
        const hipError_t le = hipPeekAtLastError();
        if (le != hipSuccess) { fprintf(stderr, "kernel_launch: launch %d failed: %s\n", p, hipGetErrorName(le)); break; }
    }
#endif
}
```

```cpp
#include <hip/hip_runtime.h>
#include <cstdio>
#include <cstdint>
#include <cmath>
namespace pg8 {
#define PG8_LAS __attribute__((address_space(3)))
typedef unsigned short bf16_t;
typedef short bf16x8 __attribute__((ext_vector_type(8)));
typedef float f32x4 __attribute__((ext_vector_type(4)));
typedef unsigned u32x4 __attribute__((ext_vector_type(4)));
typedef int i32x4 __attribute__((ext_vector_type(4)));
constexpr int BM = 256, BK = 64, HALF = 128, HTB = HALF * BK * 2  , STAGE_BYTES = 8 * HTB, NXCD = 8, WGM = 8;

__host__ __device__ __forceinline__ int lds_byte(int r, int c) { const int st = (r >> 4) * 2 + (c >> 5), rr = r & 15, cc = c & 31, ob = rr * 64 + cc * 2; return st * 1024 + (ob ^ (((ob >> 9) & 1) << 5)); }
__host__ __device__ __forceinline__ void stage_rc(int b, int& R, int& C) { const int st = b / 1024, sb = b % 1024, swz = sb ^ (((sb >> 9) & 1) << 5); R = (st >> 1) * 16 + swz / 64; C = (st & 1) * 32 + (swz % 64) / 2; }
__host__ __device__ __forceinline__ int perm32(int rho) { const int n = rho >> 4, i = rho & 15; return 8 * (i >> 2) + 4 * n + (i & 3); }

struct Unit { int pm, pn; };
struct Gemm { const bf16_t* A; const bf16_t* Bt; int M, N, K; };

struct StaticOrder {
    int nM, nN, nwg, G, c;
    __host__ __device__ void init(int M, int N, int G_, int c_) { nM = M / BM; nN = N / BM; nwg = nM * nN; G = G_; c = c_; }
    __host__ __device__ bool next(int i, Unit& u) const {
        const long L = (long)i * G + c; if (L >= nwg) return false;
        int wgid = (int)L; { const int q = nwg / NXCD, r = nwg % NXCD, xcd = wgid % NXCD, off = wgid / NXCD; wgid = (xcd < r ? xcd * (q + 1) : r * (q + 1) + (xcd - r) * q) + off; }
        const int nig = WGM * nN, gid = wgid / nig, fm = gid * WGM, gsz = (nM - fm) < WGM ? (nM - fm) : WGM;
        u.pm = fm + ((wgid % nig) % gsz); u.pn = (wgid % nig) / gsz; return true;
    }
    __device__ __forceinline__ void a_ready(const Unit&) const {}
    __device__ __forceinline__ void done(const Unit&) const {}
};
__device__ __forceinline__ unsigned cvt_pk_bf16(float lo, float hi) { unsigned r; asm volatile("v_cvt_pk_bf16_f32 %0, %1, %2" : "=v"(r) : "v"(lo), "v"(hi)); return r; }
typedef unsigned u32x2 __attribute__((ext_vector_type(2)));
__device__ __forceinline__ float sigm(float v) { return __builtin_amdgcn_rcpf(1.0f + __builtin_amdgcn_exp2f(-1.4426950408889634f * v)); }
__device__ __forceinline__ u32x4 pack8(const f32x4 a, const f32x4 b) { u32x4 w; w.x = cvt_pk_bf16(a[0], a[1]); w.y = cvt_pk_bf16(a[2], a[3]); w.z = cvt_pk_bf16(b[0], b[1]); w.w = cvt_pk_bf16(b[2], b[3]); return w; }
__device__ __forceinline__ void unpack8(const u32x4 w, f32x4& a, f32x4& b) {
    a[0] = __uint_as_float(w.x << 16); a[1] = __uint_as_float(w.x & 0xffff0000u); a[2] = __uint_as_float(w.y << 16); a[3] = __uint_as_float(w.y & 0xffff0000u);
    b[0] = __uint_as_float(w.z << 16); b[1] = __uint_as_float(w.z & 0xffff0000u); b[2] = __uint_as_float(w.w << 16); b[3] = __uint_as_float(w.w & 0xffff0000u);
}
template <bool I8> struct EpiProj {
    static constexpr bool PERM = true, AFTER_DRAIN = false;
    bf16_t *Q, *K, *V, *H, *Bg, *Cg, *GA, *GC; const float *sx, *sw;
    __device__ __forceinline__ void operator()(const f32x4 (&acc)[2][2][4][2], const Unit& u, int wr, int wc, int fr, int fq) const {
        const int pn = u.pn; bf16_t* base; int ldc, ct; bool sg = false;
        if (pn < 8) { base = Q; ldc = 2048; ct = pn; } else if (pn < 10) { base = K; ldc = 512; ct = pn - 8; } else if (pn < 12) { base = V; ldc = 512; ct = pn - 10; }
        else if (pn < 20) { base = H; ldc = 2048; ct = pn - 12; } else if (pn < 28) { base = Bg; ldc = 2048; ct = pn - 20; } else if (pn < 36) { base = Cg; ldc = 2048; ct = pn - 28; }
        else if (pn < 52) { base = GA; ldc = 4096; ct = pn - 36; sg = true; } else { base = GC; ldc = 4096; ct = pn - 52; sg = true; }
        const int row0 = u.pm * BM + wr * 64 + fr, col0 = ct * BM + wc * 32 + 8 * fq;
        f32x4 cs[2][2];
        if constexpr (I8) {
#pragma unroll
            for (int bj = 0; bj < 2; ++bj)
#pragma unroll
                for (int n = 0; n < 2; ++n) cs[bj][n] = *(const f32x4*)(sw + pn * BM + bj * HALF + wc * 32 + 8 * fq + 4 * n);
        }
#pragma unroll
        for (int ai = 0; ai < 2; ++ai)
#pragma unroll
            for (int m = 0; m < 4; ++m) { const int row = row0 + ai * HALF + m * 16; bf16_t* rowp = base + (size_t)row * ldc + col0;
                float rs = 1.f; if constexpr (I8) rs = sx[row];
#pragma unroll
                for (int bj = 0; bj < 2; ++bj) { f32x4 v0 = acc[ai][bj][m][0], v1 = acc[ai][bj][m][1];
                    if constexpr (I8) { v0 = __builtin_convertvector(__builtin_bit_cast(i32x4, v0), f32x4) * (cs[bj][0] * rs); v1 = __builtin_convertvector(__builtin_bit_cast(i32x4, v1), f32x4) * (cs[bj][1] * rs); }
                    if (sg) {
#pragma unroll
                        for (int e = 0; e < 4; ++e) { v0[e] = sigm(v0[e]); v1[e] = sigm(v1[e]); } }
                    *(u32x4*)(rowp + bj * HALF) = pack8(v0, v1); } }
    }
};
struct EpiMerge {
    static constexpr bool PERM = true, AFTER_DRAIN = false;
    const bf16_t *GA, *GC; bf16_t *T, *Mg;
    __device__ __forceinline__ void operator()(const f32x4 (&acc)[2][2][4][2], const Unit& u, int wr, int wc, int fr, int fq) const {
        const int which = u.pm >> 6, pm = u.pm & 63, pn = u.pn & 15;
        const bf16_t* G = which ? GC : GA;
        const int row0 = pm * BM + wr * 64 + fr, col0 = pn * BM + wc * 32 + 8 * fq;
#pragma unroll
        for (int ai = 0; ai < 2; ++ai)
#pragma unroll
            for (int m = 0; m < 4; ++m) { const size_t off = (size_t)(row0 + ai * HALF + m * 16) * 4096 + col0;
#pragma unroll
                for (int bj = 0; bj < 2; ++bj) { const size_t o = off + bj * HALF; f32x4 g0, g1; unpack8(*(const u32x4*)(G + o), g0, g1);
                    f32x4 v0 = acc[ai][bj][m][0] * g0, v1 = acc[ai][bj][m][1] * g1;
                    if (which == 0) { *(u32x4*)(T + o) = pack8(v0, v1); }
                    else { f32x4 t0, t1; unpack8(*(const u32x4*)(T + o), t0, t1); *(u32x4*)(Mg + o) = pack8(v0 + t0, v1 + t1); } } }
    }
};
struct EpiRes {
    static constexpr bool PERM = true, AFTER_DRAIN = false;
    const float* X; float* O;
    __device__ __forceinline__ void operator()(const f32x4 (&acc)[2][2][4][2], const Unit& u, int wr, int wc, int fr, int fq) const {
        const int row0 = u.pm * BM + wr * 64 + fr, col0 = u.pn * BM + wc * 32 + 8 * fq;
#pragma unroll
        for (int ai = 0; ai < 2; ++ai)
#pragma unroll
            for (int m = 0; m < 4; ++m) { const size_t off = (size_t)(row0 + ai * HALF + m * 16) * 4096 + col0;
#pragma unroll
                for (int bj = 0; bj < 2; ++bj) { const size_t o = off + bj * HALF; const f32x4 x0 = *(const f32x4*)(X + o), x1 = *(const f32x4*)(X + o + 4);
                    *(f32x4*)(O + o) = x0 + acc[ai][bj][m][0]; *(f32x4*)(O + o + 4) = x1 + acc[ai][bj][m][1]; } }
    }
};
struct EpiStoreI8 {
    static constexpr bool PERM = true, AFTER_DRAIN = false;
    bf16_t* O; int ldc; const float *sx, *sw;
    __device__ __forceinline__ void operator()(const f32x4 (&acc)[2][2][4][2], const Unit& u, int wr, int wc, int fr, int fq) const {
        const int row0 = u.pm * BM + wr * 64 + fr, col0 = u.pn * BM + wc * 32 + 8 * fq;
        f32x4 cs[2][2];
#pragma unroll
        for (int bj = 0; bj < 2; ++bj)
#pragma unroll
            for (int n = 0; n < 2; ++n) cs[bj][n] = *(const f32x4*)(sw + col0 + bj * HALF + 4 * n);
#pragma unroll
        for (int ai = 0; ai < 2; ++ai)
#pragma unroll
            for (int m = 0; m < 4; ++m) { const int row = row0 + ai * HALF + m * 16; bf16_t* rowp = O + (size_t)row * ldc + col0; const float rs = sx[row];
#pragma unroll
                for (int bj = 0; bj < 2; ++bj) *(u32x4*)(rowp + bj * HALF) = pack8(__builtin_convertvector(__builtin_bit_cast(i32x4, acc[ai][bj][m][0]), f32x4) * (cs[bj][0] * rs), __builtin_convertvector(__builtin_bit_cast(i32x4, acc[ai][bj][m][1]), f32x4) * (cs[bj][1] * rs)); }
    }
};
struct EpiStore {
    static constexpr bool PERM = true, AFTER_DRAIN = false;
    bf16_t* O; int ldc;
    __device__ __forceinline__ void operator()(const f32x4 (&acc)[2][2][4][2], const Unit& u, int wr, int wc, int fr, int fq) const {
        const int row0 = u.pm * BM + wr * 64 + fr, col0 = u.pn * BM + wc * 32 + 8 * fq;
#pragma unroll
        for (int ai = 0; ai < 2; ++ai)
#pragma unroll
            for (int m = 0; m < 4; ++m) { bf16_t* rowp = O + (size_t)(row0 + ai * HALF + m * 16) * ldc + col0;
#pragma unroll
                for (int bj = 0; bj < 2; ++bj) *(u32x4*)(rowp + bj * HALF) = pack8(acc[ai][bj][m][0], acc[ai][bj][m][1]); }
    }
};
struct PairOrder {
    StaticOrder so;
    __device__ bool next(int i, Unit& u) const { Unit t; if (!so.next(i >> 1, t)) return false; const int w = i & 1; u.pm = t.pm + 64 * w; u.pn = t.pn + 16 * w; return true; }
    __device__ __forceinline__ void a_ready(const Unit&) const {}
    __device__ __forceinline__ void done(const Unit&) const {}
};
struct RangeOrder {
    StaticOrder so; int base, cut, skip;
    __device__ bool next(int i, Unit& u) const { if (!so.next(i, u)) return false; u.pn = base + (u.pn < cut ? u.pn : u.pn + skip); return true; }
    __device__ __forceinline__ void a_ready(const Unit&) const {}
    __device__ __forceinline__ void done(const Unit&) const {}
};
template <class Epi, class Sched, bool ALIGN_EPI = false, bool SP2 = false, bool I8 = false>
__device__ __forceinline__ void gemm_phase(PG8_LAS unsigned char* lds, const Gemm g, const Sched& S, const Epi& E) {
    const int tid = threadIdx.x, wid = __builtin_amdgcn_readfirstlane(tid >> 6), lane = tid & 63, wr = wid >> 2, wc = wid & 3, fr = lane & 15, fq = lane >> 4;
    const int K = g.K, nt = K / BK;
    unsigned voffA[2], voffB[2];
#pragma unroll
    for (int i = 0; i < 2; ++i) { int R, C; stage_rc(tid * 16 + i * 8192, R, C); const int Rb = Epi::PERM ? ((R & ~31) + perm32(R & 31)) : R;
        voffA[i] = (unsigned)(R * K + C) * 2u; voffB[i] = (unsigned)(Rb * K + C) * 2u; }
    const size_t kstep = (size_t)(BK * 2);
    const size_t hstep = (size_t)HALF * K * 2;
    const size_t tstep = 2 * hstep;
    const unsigned ldsw = (unsigned)wid * 1024u;
    const int aoff = lds_byte(wr * 64 + fr, fq * 8), boff = lds_byte(wc * 32 + fr, fq * 8);
#define PG8_SA(b, h) (((b) * 2 + (h)) * HTB)
#define PG8_SB(b, h) ((4 + (b) * 2 + (h)) * HTB)
#define PG8_STAGE(bufoff, gbase, voff) do { _Pragma("unroll") for (int _i = 0; _i < 2; ++_i) \
        __builtin_amdgcn_global_load_lds((const unsigned*)((const char*)(gbase) + (voff)[_i]), (PG8_LAS unsigned*)(lds + (bufoff) + ldsw + _i * 8192), 16, 0, 0); } while (0)
#define PG8_LDA(dst, b, h) do { _Pragma("unroll") for (int m = 0; m < 4; ++m) _Pragma("unroll") for (int k = 0; k < 2; ++k) dst[m][k] = *(const PG8_LAS bf16x8*)(lds + PG8_SA(b, h) + aoff + m * 2048 + k * 1024); } while (0)
#define PG8_LDB(dst, b, h) do { _Pragma("unroll") for (int n = 0; n < 2; ++n) _Pragma("unroll") for (int k = 0; k < 2; ++k) dst[n][k] = *(const PG8_LAS bf16x8*)(lds + PG8_SB(b, h) + boff + n * 2048 + k * 1024); } while (0)
#define PG8_MMA(ai, bj, At, Bt) do { __builtin_amdgcn_s_setprio(1); _Pragma("unroll") for (int m = 0; m < 4; ++m) _Pragma("unroll") for (int n = 0; n < 2; ++n) _Pragma("unroll") for (int k = 0; k < 2; ++k) \
        { if constexpr (I8) acc[ai][bj][m][n] = __builtin_bit_cast(f32x4, __builtin_amdgcn_mfma_i32_16x16x64_i8(__builtin_bit_cast(i32x4, Bt[n][k]), __builtin_bit_cast(i32x4, At[m][k]), __builtin_bit_cast(i32x4, acc[ai][bj][m][n]), 0, 0, 0)); \
          else acc[ai][bj][m][n] = __builtin_amdgcn_mfma_f32_16x16x32_bf16(Bt[n][k], At[m][k], acc[ai][bj][m][n], 0, 0, 0); } __builtin_amdgcn_s_setprio(0); } while (0)
#define PG8_WAIT_V(n) asm volatile("s_waitcnt vmcnt(" #n ")" ::: "memory")
#define PG8_WAIT_L(n) asm volatile("s_waitcnt lgkmcnt(" #n ")" ::: "memory")
#define PG8_BAR __builtin_amdgcn_s_barrier()
#define PG8_SCHED __builtin_amdgcn_sched_barrier(0)
    Unit cur, nxt; int ui = 0;
    if (!S.next(0, cur)) return;
    f32x4 acc[2][2][4][2];
#pragma unroll
    for (int a = 0; a < 2; ++a)
#pragma unroll
        for (int b = 0; b < 2; ++b)
#pragma unroll
            for (int m = 0; m < 4; ++m)
#pragma unroll
                for (int n = 0; n < 2; ++n) acc[a][b][m][n] = (f32x4){0.f, 0.f, 0.f, 0.f};
    bf16x8 At[4][2], B0[2][2], B1[2][2];
    const char* cA = (const char*)g.A + (size_t)cur.pm * tstep; const char* cB = (const char*)g.Bt + (size_t)cur.pn * tstep;
    S.a_ready(cur);
    if constexpr (SP2) {
        PG8_STAGE(PG8_SB(0, 0), cB, voffB); PG8_STAGE(PG8_SB(0, 1), cB + hstep, voffB); PG8_STAGE(PG8_SA(0, 0), cA, voffA); PG8_STAGE(PG8_SA(0, 1), cA + hstep, voffA);
        if (wr == 1) PG8_BAR;
        PG8_WAIT_V(2); PG8_BAR;
        PG8_STAGE(PG8_SB(1, 0), cB + kstep, voffB); PG8_STAGE(PG8_SA(1, 0), cA + kstep, voffA); PG8_STAGE(PG8_SB(1, 1), cB + hstep + kstep, voffB);
        PG8_WAIT_V(6); PG8_BAR;
    } else {
        PG8_STAGE(PG8_SB(0, 0), cB, voffB); PG8_STAGE(PG8_SA(0, 0), cA, voffA); PG8_STAGE(PG8_SB(0, 1), cB + hstep, voffB); PG8_STAGE(PG8_SA(0, 1), cA + hstep, voffA);
        if (wr == 1) PG8_BAR;
        PG8_WAIT_V(4); PG8_BAR;
        PG8_STAGE(PG8_SB(1, 0), cB + kstep, voffB); PG8_STAGE(PG8_SA(1, 0), cA + kstep, voffA); PG8_STAGE(PG8_SB(1, 1), cB + hstep + kstep, voffB);
        PG8_WAIT_V(6); PG8_BAR;
    }
    for (;;) {
        const bool has_next = S.next(ui + 1, nxt);
        const char* nA = has_next ? (const char*)g.A + (size_t)nxt.pm * tstep : cA; const char* nB = has_next ? (const char*)g.Bt + (size_t)nxt.pn * tstep : cB;
        for (int t = 0; t < nt; t += 2) {
            const bool last = (t == nt - 2);
            const char* a1 = cA + (size_t)(t + 1) * kstep;
            const char* a2 = last ? nA : cA + (size_t)(t + 2) * kstep; const char* b2 = last ? nB : cB + (size_t)(t + 2) * kstep;
            const char* a3 = a2 + kstep; const char* b3 = b2 + kstep;
            if (last && has_next) S.a_ready(nxt);
            if constexpr (SP2) {
            PG8_LDB(B0, 0, 0); PG8_LDB(B1, 0, 1); PG8_SCHED; PG8_LDA(At, 0, 0); PG8_STAGE(PG8_SA(1, 1), a1 + hstep, voffA);
            PG8_WAIT_V(8); PG8_WAIT_L(0); PG8_BAR; PG8_MMA(0, 0, At, B0); PG8_MMA(0, 1, At, B1); PG8_BAR; PG8_SCHED;
            PG8_LDA(At, 0, 1); PG8_STAGE(PG8_SB(0, 0), b2, voffB); PG8_STAGE(PG8_SB(0, 1), b2 + hstep, voffB); PG8_STAGE(PG8_SA(0, 0), a2, voffA);
            PG8_WAIT_V(8); PG8_WAIT_L(0); PG8_BAR; PG8_MMA(1, 0, At, B0); PG8_MMA(1, 1, At, B1); PG8_BAR; PG8_SCHED;
            PG8_LDB(B0, 1, 0); PG8_LDB(B1, 1, 1); PG8_SCHED; PG8_LDA(At, 1, 0); PG8_STAGE(PG8_SA(0, 1), a2 + hstep, voffA);
            PG8_WAIT_V(8); PG8_WAIT_L(0); PG8_BAR; PG8_MMA(0, 0, At, B0); PG8_MMA(0, 1, At, B1); PG8_BAR; PG8_SCHED;
            PG8_LDA(At, 1, 1); PG8_STAGE(PG8_SB(1, 0), b3, voffB); PG8_STAGE(PG8_SB(1, 1), b3 + hstep, voffB); PG8_STAGE(PG8_SA(1, 0), a3, voffA);
            PG8_WAIT_V(8); PG8_WAIT_L(0); PG8_BAR; PG8_MMA(1, 0, At, B0); PG8_MMA(1, 1, At, B1); PG8_BAR; PG8_SCHED;
            } else {
            PG8_LDB(B0, 0, 0); PG8_SCHED; PG8_LDA(At, 0, 0); PG8_STAGE(PG8_SA(1, 1), a1 + hstep, voffA);
            PG8_WAIT_L(8); PG8_BAR; PG8_WAIT_L(0); PG8_MMA(0, 0, At, B0); PG8_BAR; PG8_SCHED;
            PG8_LDB(B1, 0, 1); PG8_STAGE(PG8_SB(0, 0), b2, voffB);
            PG8_BAR; PG8_WAIT_L(0); PG8_MMA(0, 1, At, B1); PG8_BAR;
            PG8_LDA(At, 0, 1); PG8_STAGE(PG8_SA(0, 0), a2, voffA);
            PG8_BAR; PG8_WAIT_L(0); PG8_MMA(1, 0, At, B0); PG8_BAR; PG8_SCHED;
            PG8_STAGE(PG8_SB(0, 1), b2 + hstep, voffB);
            PG8_WAIT_V(6); PG8_BAR; PG8_MMA(1, 1, At, B1); PG8_BAR;
            PG8_LDB(B0, 1, 0); PG8_SCHED; PG8_LDA(At, 1, 0); PG8_STAGE(PG8_SA(0, 1), a2 + hstep, voffA);
            PG8_WAIT_L(8); PG8_BAR; PG8_WAIT_L(0); PG8_MMA(0, 0, At, B0); PG8_BAR; PG8_SCHED;
            PG8_LDB(B1, 1, 1); PG8_STAGE(PG8_SB(1, 0), b3, voffB);
            PG8_BAR; PG8_WAIT_L(0); PG8_MMA(0, 1, At, B1); PG8_BAR;
            PG8_LDA(At, 1, 1); PG8_STAGE(PG8_SA(1, 0), a3, voffA);
            PG8_BAR; PG8_WAIT_L(0); PG8_MMA(1, 0, At, B0); PG8_BAR; PG8_SCHED;
            PG8_STAGE(PG8_SB(1, 1), b3 + hstep, voffB);
            PG8_WAIT_V(6); PG8_BAR; PG8_MMA(1, 1, At, B1); PG8_BAR;
            }
        }
        if constexpr (ALIGN_EPI) { if (wr == 0) PG8_BAR; }
        if constexpr (!Epi::AFTER_DRAIN) { E(acc, cur, wr, wc, fr, fq); S.done(cur); }
        if (!has_next) break;
#pragma unroll
        for (int a = 0; a < 2; ++a)
#pragma unroll
            for (int b = 0; b < 2; ++b)
#pragma unroll
                for (int m = 0; m < 4; ++m)
#pragma unroll
                    for (int n = 0; n < 2; ++n) acc[a][b][m][n] = (f32x4){0.f, 0.f, 0.f, 0.f};
        cur = nxt; cA = nA; cB = nB; ++ui;
        if constexpr (ALIGN_EPI) { if (wr == 1) PG8_BAR; }
    }
    PG8_WAIT_V(0);
    if constexpr (!ALIGN_EPI) { if (wr == 0) PG8_BAR; }
    PG8_BAR;
    if constexpr (Epi::AFTER_DRAIN) { E.fused(acc, cur, wr, wc, fr, fq, lds, wid, lane); S.done(cur); }
#undef PG8_SA
#undef PG8_SB
#undef PG8_STAGE
#undef PG8_LDA
#undef PG8_LDB
#undef PG8_MMA
#undef PG8_WAIT_V
#undef PG8_WAIT_L
#undef PG8_BAR
#undef PG8_SCHED
}
}
#ifndef PG8_SP2
#define PG8_SP2 true
#endif
#ifndef PG8_ALIGN
#define PG8_ALIGN true
#endif
constexpr int NWAVES = 8;
#ifndef MK_ONE_LAUNCH
#define MK_ONE_LAUNCH 1
#endif
constexpr int N_PHASES = 12;
#ifndef NIBBLE_SWAP_DOWN
#define NIBBLE_SWAP_DOWN 0
#endif
#ifndef I8_CFG
#define I8_CFG 1
#endif
#if I8_CFG == 0
constexpr int I8_TILES = 44, I8_CUT = 12, I8_SKIP = 24, BF_BASE = 12, BF_TILES = 24;
#elif I8_CFG == 1
constexpr int I8_TILES = 60, I8_CUT = 12, I8_SKIP = 8, BF_BASE = 12, BF_TILES = 8;
#else
constexpr int I8_TILES = 68, I8_CUT = 68, I8_SKIP = 0, BF_BASE = 12, BF_TILES = 0;
#endif

constexpr int BATCH = 4, SEQ = 4096, D = 4096, M = BATCH * SEQ;
constexpr int HD = 128, NH = 16, NKV = 4, QW = NH * HD, KVW = NKV * HD, CW = 2048, INW = 17408;
constexpr int PH = 8, NKEYS = 128, TOPK = 16, NEXP = NKEYS * NKEYS, PQW = PH * 2 * 128;
constexpr float EPS = 1e-6f;
constexpr size_t SLICE_BYTES = (size_t)NEXP * 128;
constexpr float LOG2E = 1.4426950408889634f;

constexpr size_t MiB = 1u << 20;
constexpr size_t WS_CTL = 0, CTL_ZERO_BYTES = 1 * MiB;
constexpr size_t WS_WIN = 2 * MiB;
constexpr size_t WS_WO = 138 * MiB;
constexpr size_t WS_WOUT = 170 * MiB;
constexpr size_t WS_WQP = 202 * MiB;
constexpr size_t WS_SK = 218 * MiB;
constexpr size_t WS_IDX = 220 * MiB, WS_GATE = 228 * MiB;
constexpr size_t WS_XN = 236 * MiB;
constexpr size_t WS_AB = 364 * MiB;
constexpr size_t WS_Q = 492 * MiB, WS_K = 556 * MiB, WS_V = 572 * MiB, WS_H = 588 * MiB, WS_B = 652 * MiB, WS_C = 716 * MiB;
constexpr size_t WS_GA = 780 * MiB, WS_GC = 908 * MiB;
constexpr size_t WS_T = 492 * MiB;
constexpr size_t WS_X2N = 620 * MiB;
constexpr size_t WS_PART = 236 * MiB;
constexpr size_t WS_X2N8 = 492 * MiB;
constexpr size_t WS_CF4 = 780 * MiB;
constexpr size_t WS_QP = 780 * MiB;
constexpr size_t WS_W4D = 1036 * MiB, WS_W4U = 1068 * MiB;
constexpr size_t WS_SCD = 1100 * MiB, WS_SCU = WS_SCD + 65536;
constexpr size_t WS_SX = WS_SCD + 131072, WS_SW = WS_SCD + 262144;
constexpr size_t WS_XN8 = 364 * MiB;
constexpr size_t WS_W8 = 1101 * MiB;
constexpr size_t WS_W8QP = 1169 * MiB;
constexpr size_t WS_SWQ = WS_SCD + 393216, WS_SX2 = WS_SCD + 458752;
constexpr size_t WS_X2I8 = 364 * MiB;
constexpr size_t WS_END = 1177 * MiB;
static_assert(WS_T + (size_t)M * D * 2 <= WS_X2N && WS_X2N + (size_t)M * D * 2 <= WS_GA && WS_QP + (size_t)M * PQW * 2 <= WS_GC, "d_ws overlays");
static_assert(WS_WIN + (size_t)INW * D * 2 <= WS_WO && WS_C + (size_t)M * CW * 2 <= WS_GA && WS_GC + (size_t)M * D * 2 <= WS_END, "d_ws map");
constexpr int CW_XRANK = 8192;
constexpr int CW_BAR = 4096;

constexpr int RING_OFF = 0, RING_BYTES = 131072;
constexpr int LDSCTL_OFF = RING_BYTES, MISC_OFF = LDSCTL_OFF + 320;
constexpr int OBUF_OFF = 132096;
constexpr int LDS_BYTES = 147456;
static_assert(MISC_OFF + 128 <= OBUF_OFF && OBUF_OFF + 8192 <= LDS_BYTES, "LDS map");
#define GAS __attribute__((address_space(1)))
#define LAS __attribute__((address_space(3)))
typedef unsigned short bf16;
typedef unsigned v4u __attribute__((ext_vector_type(4)));
typedef float f32x4 __attribute__((ext_vector_type(4)));
typedef short bf16x8 __attribute__((ext_vector_type(8)));
typedef GAS unsigned gu32;
typedef GAS unsigned long long gu64;
#define RLX_AGENT __ATOMIC_RELAXED, __HIP_MEMORY_SCOPE_AGENT
#define LDS_WAIT() asm volatile("s_waitcnt lgkmcnt(0)" ::: "memory")
#define VM_WAIT() asm volatile("s_waitcnt vmcnt(0)" ::: "memory")
__device__ __forceinline__ unsigned long long rt() { return __builtin_amdgcn_s_memrealtime(); }
__device__ __forceinline__ unsigned f2bf(float f) { unsigned u = __builtin_bit_cast(unsigned, f); return (u + 0x7fffu + ((u >> 16) & 1u)) >> 16; }
__device__ __forceinline__ unsigned pk2(float lo, float hi) { return f2bf(lo) | (f2bf(hi) << 16); }

#define XB_TMO      128
#define XB_XCNT(j)  (256  + 64 * (j))
#define XB_XSUB(j)  (1280 + 64 * (j))
#define XB_XGEN(j)  (2304 + 64 * (j))
#define XB_TOP      3328
#define XB_TOPGEN   3392
#define XCD_BAR_WORDS 3456
#define XB_SPIN_CAP (1u << 18)

__device__ __forceinline__ unsigned xb_ld(unsigned* p)              { return __hip_atomic_load(p, __ATOMIC_RELAXED, __HIP_MEMORY_SCOPE_AGENT); }
__device__ __forceinline__ unsigned xb_add(unsigned* p, unsigned v) { return __hip_atomic_fetch_add(p, v, __ATOMIC_RELAXED, __HIP_MEMORY_SCOPE_AGENT); }
__device__ __forceinline__ unsigned xb_xcc_id() { return (unsigned)__builtin_amdgcn_s_getreg((3 << 11) | 20) & 0xFu; }
#define XB_SPIN(cond, bar) do { unsigned _sp = 0; while (cond) { __builtin_amdgcn_s_sleep(1); \
    if ((++_sp & 255u) == 0u) { if (xb_ld(&(bar)[XB_TMO])) break; if (_sp > XB_SPIN_CAP) { atomicAdd(&(bar)[XB_TMO], 1u); break; } } } } while (0)

struct XcdBarrier {
    unsigned* bar; unsigned x;
    volatile LAS unsigned* st;
};

__device__ __forceinline__ XcdBarrier xcd_barrier_post(unsigned* bar, volatile LAS unsigned* st) {
    XcdBarrier b; b.bar = bar; b.x = xb_xcc_id(); b.st = st;
    if (threadIdx.x == 0) (void)xb_add(&bar[XB_XCNT(b.x)], 1u);
    return b;
}
__device__ __forceinline__ void xcd_barrier_complete(unsigned* bar, unsigned x, unsigned& nloc, unsigned& nx) {
    const unsigned G = gridDim.x * gridDim.y * gridDim.z;
    unsigned sum, cnt, mine, sp = 0u;
    for (;;) {
        sum = 0u; cnt = 0u; mine = 0u;
#pragma unroll
        for (unsigned j = 0; j < 16; ++j) { const unsigned c = xb_ld(&bar[XB_XCNT(j)]); sum += c; cnt += (c > 0u) ? 1u : 0u; mine = (j == x) ? c : mine; }
        if (sum == G) break;
        __builtin_amdgcn_s_sleep(1);
        if ((++sp & 255u) == 0u) { if (xb_ld(&bar[XB_TMO])) break; if (sp > XB_SPIN_CAP) { atomicAdd(&bar[XB_TMO], 1u); break; } }
    }
    nloc = mine > 0u ? mine : 1u; nx = cnt > 0u ? cnt : 1u;
}

__device__ __forceinline__ void xcd_barrier(const XcdBarrier& b) {
    asm volatile("s_waitcnt vmcnt(0)" ::: "memory");
    __syncthreads();
    if (threadIdx.x == 0) {
        unsigned* bar = b.bar;
        __builtin_amdgcn_s_waitcnt(0);
        unsigned nloc = b.st[0], nx = b.st[1];
        if (nloc == 0u) { xcd_barrier_complete(bar, b.x, nloc, nx); b.st[0] = nloc; b.st[1] = nx; }
        const unsigned old = xb_add(&bar[XB_XSUB(b.x)], 1u);
        const unsigned gen = old / nloc;
        if (old + 1u == (gen + 1u) * nloc) {
            __builtin_amdgcn_fence(__ATOMIC_RELEASE, "agent");
            asm volatile("s_waitcnt vmcnt(0)" ::: "memory");
            const unsigned og = xb_add(&bar[XB_TOP], 1u);
            const unsigned tg = og / nx;
            if (og + 1u == (tg + 1u) * nx) xb_add(&bar[XB_TOPGEN], 1u);
            else XB_SPIN(xb_ld(&bar[XB_TOPGEN]) == tg, bar);
            __builtin_amdgcn_fence(__ATOMIC_ACQUIRE, "agent");
            xb_add(&bar[XB_XGEN(b.x)], 1u);
            asm volatile("s_waitcnt vmcnt(0)" ::: "memory");
        } else {
            XB_SPIN(xb_ld(&bar[XB_XGEN(b.x)]) == gen, bar);
            __builtin_amdgcn_fence(__ATOMIC_ACQUIRE, "agent");
            asm volatile("s_waitcnt vmcnt(0)" ::: "memory");
        }
    }
    __syncthreads();
}
typedef unsigned u32x2_t __attribute__((ext_vector_type(2)));
typedef short v4i16_t __attribute__((ext_vector_type(4)));
typedef unsigned long long u64;
typedef float f32x2_t __attribute__((ext_vector_type(2)));
typedef int i32x4_t __attribute__((ext_vector_type(4)));
struct Frame {
    LAS unsigned char* lds;
    volatile LAS unsigned* MISC;
    gu32* ctl;
    unsigned char* ws;
    int tid, lane, wave;
    int vcu, G;
    const float *x, *g1, *w_in, *gq, *gk, *sink, *conv_w, *w_oa, *w_oc, *w_out, *g2, *w_qp, *subk, *w_down, *w_up;
    float* out;
};
#define WSP(type, off) ((type*)(F.ws + (off)))
using pg8::cvt_pk_bf16; using pg8::pack8; using pg8::unpack8;

__device__ __forceinline__ float wave_sum(float v) {
#pragma unroll
    for (int o = 1; o < 64; o <<= 1) v += __shfl_xor(v, o);
    return v;
}
__device__ __forceinline__ float dot4(const f32x4 a, const f32x4 b) { return (a[0] * b[0] + a[1] * b[1]) + (a[2] * b[2] + a[3] * b[3]); }
__device__ __forceinline__ float bflo(unsigned w) { return __uint_as_float(w << 16); }
__device__ __forceinline__ float bfhi(unsigned w) { return __uint_as_float(w & 0xffff0000u); }

typedef int v2i32_t __attribute__((ext_vector_type(2)));
__device__ __forceinline__ bool tr4_selfcheck(LAS unsigned char* tp, int lane) {
    const int g = lane >> 4, j = lane & 15;
    unsigned lo = 0u, hi = 0u;
#pragma unroll
    for (int c = 0; c < 8; ++c) { lo |= (unsigned)((j * 5 + c * 3 + g + 1) & 15) << (4 * c); hi |= (unsigned)((j * 5 + (c + 8) * 3 + g + 1) & 15) << (4 * c); }
    *(LAS u32x2_t*)(tp + lane * 8) = (u32x2_t){lo, hi};
    LDS_WAIT(); asm volatile("" ::: "memory");
    const v2i32_t rv = __builtin_amdgcn_ds_read_tr4_b64_v2i32((LAS v2i32_t*)(tp + lane * 8));
    bool ok = true;
#pragma unroll
    for (int e = 0; e < 8; ++e) { ok = ok && ((((unsigned)rv.x >> (4 * e)) & 15u) == (unsigned)((e * 5 + j * 3 + g + 1) & 15)) && ((((unsigned)rv.y >> (4 * e)) & 15u) == (unsigned)(((e + 8) * 5 + j * 3 + g + 1) & 15)); }
    return __all(ok);
}

__device__ __forceinline__ void p0_transpose_item(const float* W, int K, int N, bf16* WT, int row_off, LAS float* scr, int item, int lane) {
    const int nblk = N / 32, kb = item / nblk, nb = item % nblk, k0 = 64 * kb, n0 = 32 * nb;
#pragma unroll 8
    for (int i = 0; i < 32; ++i) { const int kk = 2 * i + (lane >> 5); scr[kk * 33 + (lane & 31)] = W[(size_t)(k0 + kk) * N + n0 + (lane & 31)]; }
    LDS_WAIT(); asm volatile("" ::: "memory");
    const int c = lane & 7;
#pragma unroll
    for (int j = 0; j < 4; ++j) { const int n = (lane >> 3) + 8 * j; const LAS float* s = scr + (8 * c) * 33 + n;
        v4u o; o.x = cvt_pk_bf16(s[0 * 33], s[1 * 33]); o.y = cvt_pk_bf16(s[2 * 33], s[3 * 33]); o.z = cvt_pk_bf16(s[4 * 33], s[5 * 33]); o.w = cvt_pk_bf16(s[6 * 33], s[7 * 33]);
        *(GAS v4u*)(WT + (size_t)(row_off + n0 + n) * K + k0 + 8 * c) = o; }
    LDS_WAIT(); asm volatile("" ::: "memory");
}
template <int QMODE  > __device__ __forceinline__ void rms_row_to_bf16(const float* xrow, const float* g, bf16* orow, unsigned* q8row, float* sxp, int lane) {
    const GAS f32x4* xr = (const GAS f32x4*)xrow + lane; const GAS f32x4* gr = (const GAS f32x4*)g + lane;
    f32x4 v[16]; float s = 0.f;
#pragma unroll
    for (int j = 0; j < 16; ++j) { v[j] = xr[64 * j]; s += dot4(v[j], v[j]); }
    const float r = rsqrtf(wave_sum(s) * (1.f / D) + EPS);
    GAS u32x2_t* o8 = (GAS u32x2_t*)orow + lane; float am = 0.f;
#pragma unroll
    for (int j = 0; j < 16; ++j) { v[j] = v[j] * r * gr[64 * j]; u32x2_t w; w.x = cvt_pk_bf16(v[j][0], v[j][1]); w.y = cvt_pk_bf16(v[j][2], v[j][3]); o8[64 * j] = w;
        am = fmaxf(am, fmaxf(fmaxf(fabsf(v[j][0]), fabsf(v[j][1])), fmaxf(fabsf(v[j][2]), fabsf(v[j][3])))); }
    if constexpr (QMODE == 2) {
#pragma unroll
        for (int j = 0; j < 16; ++j) { int p = 0; p = __builtin_amdgcn_cvt_pk_fp8_f32(v[j][0], v[j][1], p, false); p = __builtin_amdgcn_cvt_pk_fp8_f32(v[j][2], v[j][3], p, true); ((GAS unsigned*)q8row)[64 * j + lane] = (unsigned)p; }
    }
    if constexpr (QMODE == 1) {
#pragma unroll
        for (int o = 1; o < 64; o <<= 1) am = fmaxf(am, __shfl_xor(am, o));
        const float qs = am > 0.f ? 127.0f / am : 0.f;
#pragma unroll
        for (int j = 0; j < 16; ++j) { const int q0 = (int)__builtin_rintf(v[j][0] * qs), q1 = (int)__builtin_rintf(v[j][1] * qs), q2 = (int)__builtin_rintf(v[j][2] * qs), q3 = (int)__builtin_rintf(v[j][3] * qs);
            ((GAS unsigned*)q8row)[64 * j + lane] = (unsigned)(q0 & 255) | ((unsigned)(q1 & 255) << 8) | ((unsigned)(q2 & 255) << 16) | ((unsigned)q3 << 24); }
        if (lane == 0) *sxp = am * (1.0f / 127.0f);
    }
}
__device__ __forceinline__ void rms2_row(const float* xrow, const float* g, unsigned char* q8row, float* sxp, unsigned char* x4row, int lane) {
    const GAS f32x4* xr = (const GAS f32x4*)xrow + 2 * lane; const GAS f32x4* gr = (const GAS f32x4*)g + 2 * lane;
    f32x4 v[8][2]; float s = 0.f;
#pragma unroll
    for (int j = 0; j < 8; ++j) { v[j][0] = xr[128 * j]; v[j][1] = xr[128 * j + 1]; s += dot4(v[j][0], v[j][0]) + dot4(v[j][1], v[j][1]); }
    const float r = rsqrtf(wave_sum(s) * (1.f / D) + EPS);
    float am = 0.f;
#pragma unroll
    for (int j = 0; j < 8; ++j) { v[j][0] = v[j][0] * r * gr[128 * j]; v[j][1] = v[j][1] * r * gr[128 * j + 1];
#pragma unroll
        for (int e = 0; e < 4; ++e) am = fmaxf(am, fmaxf(fabsf(v[j][0][e]), fabsf(v[j][1][e]))); }
#pragma unroll
    for (int o = 1; o < 64; o <<= 1) am = fmaxf(am, __shfl_xor(am, o));
    const float qs = am > 0.f ? 127.0f / am : 0.f;
    if (lane == 0) *sxp = am * (1.0f / 127.0f);
#pragma unroll
    for (int j = 0; j < 8; ++j) {
        const f32x4 y0 = v[j][0], y1 = v[j][1];
        { u32x2_t w;
          w.x = (unsigned)((int)__builtin_rintf(y0[0] * qs) & 255) | ((unsigned)((int)__builtin_rintf(y0[1] * qs) & 255) << 8) | ((unsigned)((int)__builtin_rintf(y0[2] * qs) & 255) << 16) | ((unsigned)(int)__builtin_rintf(y0[3] * qs) << 24);
          w.y = (unsigned)((int)__builtin_rintf(y1[0] * qs) & 255) | ((unsigned)((int)__builtin_rintf(y1[1] * qs) & 255) << 8) | ((unsigned)((int)__builtin_rintf(y1[2] * qs) & 255) << 16) | ((unsigned)(int)__builtin_rintf(y1[3] * qs) << 24);
          ((GAS u32x2_t*)q8row)[64 * j + lane] = w; }
        unsigned hi = 0u, lo = 0u;
        hi = __builtin_amdgcn_cvt_scalef32_pk_fp4_f32(hi, y0[0], y0[1], 1.0f, 0); hi = __builtin_amdgcn_cvt_scalef32_pk_fp4_f32(hi, y0[2], y0[3], 1.0f, 1);
        hi = __builtin_amdgcn_cvt_scalef32_pk_fp4_f32(hi, y1[0], y1[1], 1.0f, 2); hi = __builtin_amdgcn_cvt_scalef32_pk_fp4_f32(hi, y1[2], y1[3], 1.0f, 3);
        const f32x2_t d0 = __builtin_amdgcn_cvt_scalef32_pk_f32_fp4(hi, 1.0f, 0), d1 = __builtin_amdgcn_cvt_scalef32_pk_f32_fp4(hi, 1.0f, 1), d2 = __builtin_amdgcn_cvt_scalef32_pk_f32_fp4(hi, 1.0f, 2), d3 = __builtin_amdgcn_cvt_scalef32_pk_f32_fp4(hi, 1.0f, 3);
        lo = __builtin_amdgcn_cvt_scalef32_pk_fp4_f32(lo, (y0[0] - d0.x) * 8.f, (y0[1] - d0.y) * 8.f, 1.0f, 0); lo = __builtin_amdgcn_cvt_scalef32_pk_fp4_f32(lo, (y0[2] - d1.x) * 8.f, (y0[3] - d1.y) * 8.f, 1.0f, 1);
        lo = __builtin_amdgcn_cvt_scalef32_pk_fp4_f32(lo, (y1[0] - d2.x) * 8.f, (y1[1] - d2.y) * 8.f, 1.0f, 2); lo = __builtin_amdgcn_cvt_scalef32_pk_fp4_f32(lo, (y1[2] - d3.x) * 8.f, (y1[3] - d3.y) * 8.f, 1.0f, 3);
        unsigned char* const xd = x4row + (size_t)(2 * j + (lane >> 5)) * ((size_t)M * 256) + (lane & 31) * 4;
        *(GAS unsigned*)xd = hi; *(GAS unsigned*)(xd + 128) = lo;
    }
}
__device__ __forceinline__ void quant_w8(Frame& F) {
    const int gw = F.vcu * NWAVES + F.wave, NGW = F.G * NWAVES, lane = F.lane;
    for (int nn = gw; nn < INW + PQW; nn += NGW) {
        const bool qp = nn >= INW; const int n = qp ? nn - INW : nn;
        const GAS v4u* src = (const GAS v4u*)((qp ? WSP(const bf16, WS_WQP) : WSP(const bf16, WS_WIN)) + (size_t)n * D) + lane;
        f32x4 lo[8], hi[8]; float am = 0.f;
#pragma unroll
        for (int j = 0; j < 8; ++j) { unpack8(src[64 * j], lo[j], hi[j]);
            am = fmaxf(am, fmaxf(fmaxf(fmaxf(fabsf(lo[j][0]), fabsf(lo[j][1])), fmaxf(fabsf(lo[j][2]), fabsf(lo[j][3]))), fmaxf(fmaxf(fabsf(hi[j][0]), fabsf(hi[j][1])), fmaxf(fabsf(hi[j][2]), fabsf(hi[j][3]))))); }
#pragma unroll
        for (int o = 1; o < 64; o <<= 1) am = fmaxf(am, __shfl_xor(am, o));
        const float qs = am > 0.f ? 127.0f / am : 0.f;
        GAS u32x2_t* dst = (GAS u32x2_t*)(F.ws + (qp ? WS_W8QP : WS_W8) + (size_t)n * D) + lane;
#pragma unroll
        for (int j = 0; j < 8; ++j) { u32x2_t w;
            w.x = (unsigned)((int)__builtin_rintf(lo[j][0] * qs) & 255) | ((unsigned)((int)__builtin_rintf(lo[j][1] * qs) & 255) << 8) | ((unsigned)((int)__builtin_rintf(lo[j][2] * qs) & 255) << 16) | ((unsigned)(int)__builtin_rintf(lo[j][3] * qs) << 24);
            w.y = (unsigned)((int)__builtin_rintf(hi[j][0] * qs) & 255) | ((unsigned)((int)__builtin_rintf(hi[j][1] * qs) & 255) << 8) | ((unsigned)((int)__builtin_rintf(hi[j][2] * qs) & 255) << 16) | ((unsigned)(int)__builtin_rintf(hi[j][3] * qs) << 24);
            dst[64 * j] = w; }
        if (lane == 0) (qp ? WSP(float, WS_SWQ) : WSP(float, WS_SW))[n] = am * (1.0f / 127.0f);
    }
}
__device__ __forceinline__ void p0_prologue(Frame& F) {
    LAS float* scr = (LAS float*)(F.lds + RING_OFF + F.wave * 16384);
    const int gw = F.vcu * NWAVES + F.wave, NGW = F.G * NWAVES;
    constexpr int I_IN = (D / 64) * (INW / 32), I_OA = (QW / 64) * (D / 32), I_OC = (CW / 64) * (D / 32), I_OUT = (D / 64) * (D / 32), I_QP = (D / 64) * (PQW / 32);
    constexpr int NITEMS = I_IN + I_OA + I_OC + I_OUT + I_QP;
    bf16* Win_t = WSP(bf16, WS_WIN); bf16* Wo_t = WSP(bf16, WS_WO); bf16* Wout_t = WSP(bf16, WS_WOUT); bf16* Wqp_t = WSP(bf16, WS_WQP);
    for (int it = gw; it < NITEMS; it += NGW) {
        int r = it;
        if (r < I_IN) { p0_transpose_item(F.w_in, D, INW, Win_t, 0, scr, r, F.lane); continue; } r -= I_IN;
        if (r < I_OA) { p0_transpose_item(F.w_oa, QW, D, Wo_t, 0, scr, r, F.lane); continue; } r -= I_OA;
        if (r < I_OC) { p0_transpose_item(F.w_oc, CW, D, Wo_t, D, scr, r, F.lane); continue; } r -= I_OC;
        if (r < I_OUT) { p0_transpose_item(F.w_out, D, D, Wout_t, 0, scr, r, F.lane); continue; } r -= I_OUT;
        p0_transpose_item(F.w_qp, D, PQW, Wqp_t, 0, scr, r, F.lane);
    }
    {
        bf16* SK = WSP(bf16, WS_SK); const int nth = F.G * NWAVES * 64, gt = gw * 64 + F.lane;
        for (int i = gt; i < PH * 2 * NKEYS * 128 / 4; i += nth) { const f32x4 v = ((const GAS f32x4*)F.subk)[i]; u32x2_t w; w.x = cvt_pk_bf16(v[0], v[1]); w.y = cvt_pk_bf16(v[2], v[3]); ((GAS u32x2_t*)SK)[i] = w; }
    }
    bf16* XN = WSP(bf16, WS_XN);
    for (int m = gw; m < M; m += NGW) rms_row_to_bf16<1>(F.x + (size_t)m * D, F.g1, XN + (size_t)m * D, (unsigned*)(F.ws + WS_XN8 + (size_t)m * D), WSP(float, WS_SX) + m, F.lane);
    for (int r = gw; r < 2 * NEXP; r += NGW) {
        const bool up = r >= NEXP; const int rr = up ? r - NEXP : r;
        const GAS f32x4* src = (const GAS f32x4*)((up ? F.w_up : F.w_down) + (size_t)rr * D) + 2 * F.lane;
        f32x4 v[16]; float am = 0.f;
#pragma unroll
        for (int i = 0; i < 8; ++i) { v[2 * i] = src[128 * i]; v[2 * i + 1] = src[128 * i + 1]; }
#pragma unroll
        for (int i = 0; i < 16; ++i) am = fmaxf(am, fmaxf(fmaxf(fabsf(v[i][0]), fabsf(v[i][1])), fmaxf(fabsf(v[i][2]), fabsf(v[i][3]))));
#pragma unroll
        for (int o = 1; o < 64; o <<= 1) am = fmaxf(am, __shfl_xor(am, o));
        const float sc = am > 0.f ? 6.0f / am : 1.0f;
        unsigned char* const dstb = F.ws + (up ? WS_W4U : WS_W4D) + (size_t)rr * 128 + (size_t)(F.lane >> 5) * SLICE_BYTES + (F.lane & 31) * 4;
#pragma unroll
        for (int i = 0; i < 8; ++i) { unsigned p = 0u;
            if (NIBBLE_SWAP_DOWN && !up) {
            p = __builtin_amdgcn_cvt_scalef32_pk_fp4_f32(p, v[2 * i][1] * sc, v[2 * i][0] * sc, 1.0f, 0); p = __builtin_amdgcn_cvt_scalef32_pk_fp4_f32(p, v[2 * i][3] * sc, v[2 * i][2] * sc, 1.0f, 1);
            p = __builtin_amdgcn_cvt_scalef32_pk_fp4_f32(p, v[2 * i + 1][1] * sc, v[2 * i + 1][0] * sc, 1.0f, 2); p = __builtin_amdgcn_cvt_scalef32_pk_fp4_f32(p, v[2 * i + 1][3] * sc, v[2 * i + 1][2] * sc, 1.0f, 3);
            } else {
            p = __builtin_amdgcn_cvt_scalef32_pk_fp4_f32(p, v[2 * i][0] * sc, v[2 * i][1] * sc, 1.0f, 0); p = __builtin_amdgcn_cvt_scalef32_pk_fp4_f32(p, v[2 * i][2] * sc, v[2 * i][3] * sc, 1.0f, 1);
            p = __builtin_amdgcn_cvt_scalef32_pk_fp4_f32(p, v[2 * i + 1][0] * sc, v[2 * i + 1][1] * sc, 1.0f, 2); p = __builtin_amdgcn_cvt_scalef32_pk_fp4_f32(p, v[2 * i + 1][2] * sc, v[2 * i + 1][3] * sc, 1.0f, 3);
            }
            *(GAS unsigned*)(dstb + (size_t)(2 * i) * SLICE_BYTES) = p; }
        if (F.lane == 0) WSP(float, up ? WS_SCU : WS_SCD)[rr] = am > 0.f ? am * (1.0f / 6.0f) : 1.0f;
    }
}

__device__ __forceinline__ unsigned off_b(unsigned row, unsigned ch) { return 256u * row + 16u * (ch ^ (((row & 3u) << 2) | ((row >> 2) & 3u))); }
__device__ __forceinline__ unsigned tr_addr16(unsigned lane, unsigned c, unsigned ks, unsigned t) {
    const unsigned g = lane >> 4, q = (lane & 15u) >> 2, p = lane & 3u;
    return off_b(32u * ks + 8u * g + 4u * t + q, 2u * c + (p >> 1)) + 8u * (p & 1u);
}
__device__ __forceinline__ v4i16_t tr_read(LAS unsigned char* p) { return __builtin_amdgcn_ds_read_tr16_b64_v4i16((LAS v4i16_t*)p); }
#define MFMA16(a, b, c) __builtin_amdgcn_mfma_f32_16x16x32_bf16((a), (b), (c), 0, 0, 0)

__device__ __forceinline__ void attn_unit(Frame& F, const int U) {
    const int lane = F.lane, wave = F.wave, c = lane & 15, hg = lane >> 4, tid = F.tid;
    const int hp = U & 1, kvh = (U >> 1) & 3, nblk = (U >> 3) & 31, b = U >> 8;
    const int hq = kvh * 4 + hp * 2 + (wave >> 2), i0 = (wave & 3) * 32;
    const size_t tok0 = (size_t)b * SEQ + (size_t)nblk * 128;
    LAS unsigned char* Kl = F.lds + RING_OFF; LAS unsigned char* Vl = Kl + 32768;
    const bf16* QB = WSP(const bf16, WS_Q); const bf16* KB = WSP(const bf16, WS_K); const bf16* VB = WSP(const bf16, WS_V); bf16* OB = WSP(bf16, WS_AB);
    bf16x8 qf[2][4];
    {
        float g[4][8];
#pragma unroll
        for (int ks = 0; ks < 4; ++ks) { const f32x4 a = *(const GAS f32x4*)(F.gq + 32 * ks + 8 * hg), bb = *(const GAS f32x4*)(F.gq + 32 * ks + 8 * hg + 4);
#pragma unroll
            for (int e = 0; e < 4; ++e) { g[ks][e] = a[e]; g[ks][4 + e] = bb[e]; } }
#pragma unroll
        for (int qt = 0; qt < 2; ++qt) {
            const bf16* qrow = QB + (tok0 + i0 + 16 * qt + c) * QW + hq * HD + 8 * hg;
            f32x4 lo[4], hi[4]; float ss = 0.f;
#pragma unroll
            for (int ks = 0; ks < 4; ++ks) { unpack8(*(const GAS v4u*)(qrow + 32 * ks), lo[ks], hi[ks]); ss += dot4(lo[ks], lo[ks]) + dot4(hi[ks], hi[ks]); }
            ss += __shfl_xor(ss, 16); ss += __shfl_xor(ss, 32);
            const float r = rsqrtf(ss * (1.f / HD) + EPS) * (0.08838834764831845f * LOG2E);
#pragma unroll
            for (int ks = 0; ks < 4; ++ks) { f32x4 a, bb;
#pragma unroll
                for (int e = 0; e < 4; ++e) { a[e] = lo[ks][e] * r * g[ks][e]; bb[e] = hi[ks][e] * r * g[ks][4 + e]; }
                qf[qt][ks] = __builtin_bit_cast(bf16x8, pack8(a, bb)); }
        }
    }
    const float slope2 = __builtin_amdgcn_exp2f(-0.5f * (float)(hq + 1)) * LOG2E;
    const float sink2 = F.sink[hq] * LOG2E;
    float mrun[2] = {sink2, sink2}, lrun[2]; lrun[0] = lrun[1] = (hg == 0) ? 1.f : 0.f;
    f32x4 acc[8][2];
#pragma unroll
    for (int dt = 0; dt < 8; ++dt) { acc[dt][0] = (f32x4){0.f, 0.f, 0.f, 0.f}; acc[dt][1] = (f32x4){0.f, 0.f, 0.f, 0.f}; }
    const f32x4 gk0 = *(const GAS f32x4*)(F.gk + (tid & 15) * 8), gk1 = *(const GAS f32x4*)(F.gk + (tid & 15) * 8 + 4);
#pragma unroll 1
    for (int kbi = -1; kbi <= 1; ++kbi) {
        const int kb = nblk + kbi; if (kb < 0 || kb >= SEQ / 128) continue;
        __syncthreads();
#pragma unroll
        for (int it = 0; it < 4; ++it) {
            const int row = (tid >> 4) + 32 * it, ch = tid & 15;
            const size_t src = ((size_t)b * SEQ + (size_t)kb * 128 + row) * KVW + kvh * HD + ch * 8;
            f32x4 k0, k1; unpack8(*(const GAS v4u*)(KB + src), k0, k1);
            float ss = dot4(k0, k0) + dot4(k1, k1);
            ss += __shfl_xor(ss, 1); ss += __shfl_xor(ss, 2); ss += __shfl_xor(ss, 4); ss += __shfl_xor(ss, 8);
            const float r = rsqrtf(ss * (1.f / HD) + EPS);
            *(LAS v4u*)(Kl + off_b(row, ch)) = pack8(k0 * r * gk0, k1 * r * gk1);
            *(LAS v4u*)(Vl + off_b(row, ch)) = *(const GAS v4u*)(VB + src);
        }
        __syncthreads();
        const int ks_lo = kbi < 0 ? (i0 >> 5) : 0, ks_hi = kbi > 0 ? (i0 >> 5) + 1 : 4;
#pragma unroll 2
        for (int ks32 = ks_lo; ks32 < ks_hi; ++ks32) {
            f32x4 sa[2], sb[2];
            sa[0] = sa[1] = sb[0] = sb[1] = (f32x4){0.f, 0.f, 0.f, 0.f};
            const unsigned krow = 32u * ks32 + 8u * (c >> 2) + (c & 3);
#pragma unroll
            for (int ks = 0; ks < 4; ++ks) {
                const bf16x8 ka = *(const LAS bf16x8*)(Kl + off_b(krow, 4 * ks + hg)), kb2 = *(const LAS bf16x8*)(Kl + off_b(krow + 4, 4 * ks + hg));
#pragma unroll
                for (int qt = 0; qt < 2; ++qt) { sa[qt] = MFMA16(ka, qf[qt][ks], sa[qt]); sb[qt] = MFMA16(kb2, qf[qt][ks], sb[qt]); }
            }
            bf16x8 pf[2];
#pragma unroll
            for (int qt = 0; qt < 2; ++qt) {
                float s[8] = {sa[qt][0], sa[qt][1], sa[qt][2], sa[qt][3], sb[qt][0], sb[qt][1], sb[qt][2], sb[qt][3]};
                const int rel0 = kbi * 128 + 32 * ks32 + 8 * hg - (i0 + 16 * qt + c);
                float mx = -INFINITY;
#pragma unroll
                for (int j = 0; j < 8; ++j) { const int rel = rel0 + j, dist = rel < 0 ? -rel : rel; const float sv = s[j] - slope2 * (float)dist; s[j] = (dist <= 128) ? sv : -INFINITY; mx = fmaxf(mx, s[j]); }
                mx = fmaxf(mx, __shfl_xor(mx, 16)); mx = fmaxf(mx, __shfl_xor(mx, 32));
                const float mn = fmaxf(mrun[qt], mx), alpha = __builtin_amdgcn_exp2f(mrun[qt] - mn); mrun[qt] = mn;
                float ps = 0.f;
#pragma unroll
                for (int j = 0; j < 8; ++j) { s[j] = __builtin_amdgcn_exp2f(s[j] - mn); ps += s[j]; }
                lrun[qt] = lrun[qt] * alpha + ps;
                pf[qt] = __builtin_bit_cast(bf16x8, pack8((f32x4){s[0], s[1], s[2], s[3]}, (f32x4){s[4], s[5], s[6], s[7]}));
#pragma unroll
                for (int dt = 0; dt < 8; ++dt) acc[dt][qt] = acc[dt][qt] * alpha;
            }
#pragma unroll
            for (int dt = 0; dt < 8; ++dt) {
                const v4i16_t vlo = tr_read(Vl + tr_addr16(lane, dt, ks32, 0)), vhi = tr_read(Vl + tr_addr16(lane, dt, ks32, 1));
                const bf16x8 vf = {vlo[0], vlo[1], vlo[2], vlo[3], vhi[0], vhi[1], vhi[2], vhi[3]};
#pragma unroll
                for (int qt = 0; qt < 2; ++qt) acc[dt][qt] = MFMA16(vf, pf[qt], acc[dt][qt]);
            }
        }
    }
#pragma unroll
    for (int qt = 0; qt < 2; ++qt) {
        float l = lrun[qt]; l += __shfl_xor(l, 16); l += __shfl_xor(l, 32);
        const float inv = 1.0f / l;
        bf16* orow = OB + (tok0 + i0 + 16 * qt + c) * QW + hq * HD + 4 * hg;
#pragma unroll
        for (int dt = 0; dt < 8; ++dt) { const f32x4 o = acc[dt][qt] * inv; u32x2_t w; w.x = cvt_pk_bf16(o[0], o[1]); w.y = cvt_pk_bf16(o[2], o[3]); *(GAS u32x2_t*)(orow + 16 * dt) = w; }
    }
}
__device__ __forceinline__ void conv_phase(Frame& F) {
    const bf16* HB = WSP(const bf16, WS_H); const bf16* BB = WSP(const bf16, WS_B); const bf16* CB = WSP(const bf16, WS_C); bf16* OC = WSP(bf16, WS_AB) + (size_t)M * CW;
    const unsigned nchunk = (unsigned)M * (CW / 8);
    for (unsigned e = (unsigned)F.vcu * 512u + (unsigned)F.tid; e < nchunk; e += (unsigned)F.G * 512u) {
        const int t = (int)(e >> 8), cc = (int)(e & 255u) * 8, tl = t & (SEQ - 1);
        const size_t o = (size_t)t * CW + cc;
        f32x4 h0, h1, c0, c1, up0, up1, un0, un1;
        unpack8(*(const GAS v4u*)(HB + o), h0, h1); unpack8(*(const GAS v4u*)(CB + o), c0, c1);
        const f32x4 uc0 = h0 * c0, uc1 = h1 * c1;
        up0 = up1 = un0 = un1 = (f32x4){0.f, 0.f, 0.f, 0.f};
        if (tl > 0) { unpack8(*(const GAS v4u*)(HB + o - CW), h0, h1); unpack8(*(const GAS v4u*)(CB + o - CW), c0, c1); up0 = h0 * c0; up1 = h1 * c1; }
        if (tl < SEQ - 1) { unpack8(*(const GAS v4u*)(HB + o + CW), h0, h1); unpack8(*(const GAS v4u*)(CB + o + CW), c0, c1); un0 = h0 * c0; un1 = h1 * c1; }
        const GAS f32x4* w = (const GAS f32x4*)(F.conv_w + cc);
        const f32x4 y0 = w[0] * up0 + w[CW / 4] * uc0 + w[2 * CW / 4] * un0, y1 = w[1] * up1 + w[CW / 4 + 1] * uc1 + w[2 * CW / 4 + 1] * un1;
        f32x4 b0, b1; unpack8(*(const GAS v4u*)(BB + o), b0, b1);
        *(GAS v4u*)(OC + o) = pack8(b0 * y0, b1 * y1);
    }
}

__device__ __forceinline__ unsigned ordf(float f) { const unsigned u = __float_as_uint(f); return u ^ ((u >> 31) ? 0xFFFFFFFFu : 0x80000000u); }
__device__ __forceinline__ float unordf(unsigned k) { return __uint_as_float((k & 0x80000000u) ? (k ^ 0x80000000u) : ~k); }
__device__ __forceinline__ u64 shfl64_xor(u64 v, int m) { const unsigned lo = __shfl_xor((unsigned)v, m), hi = __shfl_xor((unsigned)(v >> 32), m); return ((u64)hi << 32) | lo; }
template <int N> __device__ __forceinline__ void bitonic_merge_desc(unsigned (&a)[N]) {
#pragma unroll
    for (int j = N >> 1; j > 0; j >>= 1)
#pragma unroll
        for (int i = 0; i < N; ++i) { const int l = i ^ j; if (l > i) { const unsigned hi = a[i] > a[l] ? a[i] : a[l], lo = a[i] > a[l] ? a[l] : a[i]; a[i] = hi; a[l] = lo; } }
}
template <int N> __device__ __forceinline__ void bitonic_sort_desc(unsigned (&a)[N]) {
#pragma unroll
    for (int k = 2; k <= N; k <<= 1)
#pragma unroll
        for (int j = k >> 1; j > 0; j >>= 1)
#pragma unroll
            for (int i = 0; i < N; ++i) { const int l = i ^ j; if (l > i) { const unsigned hi = a[i] > a[l] ? a[i] : a[l], lo = a[i] > a[l] ? a[l] : a[i]; const bool desc = ((i & k) == 0); a[i] = desc ? hi : lo; a[l] = desc ? lo : hi; } }
}
__device__ __forceinline__ void xlane_top16(unsigned (&t)[16], const int mask) {
    unsigned m[16];
#pragma unroll
    for (int i = 0; i < 16; ++i) { const unsigned p = __shfl_xor(t[15 - i], mask); m[i] = t[i] > p ? t[i] : p; }
    bitonic_merge_desc<16>(m);
#pragma unroll
    for (int i = 0; i < 16; ++i) t[i] = m[i];
}
struct Stair { int i[52], j[52]; };
constexpr Stair make_stair() { Stair s{}; int n = 0; for (int a = 0; a < 16; ++a) for (int b = 0; b < 16; ++b) if ((a + 1) * (b + 1) <= 16) { s.i[n] = a; s.j[n] = b; ++n; } for (; n < 52; ++n) { s.i[n] = -1; s.j[n] = -1; } return s; }
constexpr Stair STAIR = make_stair();
template <int P> __device__ __forceinline__ unsigned cand1(const float (&v1)[16], const float (&v2)[16]) {
    constexpr int i = STAIR.i[P], j = STAIR.j[P];
    if constexpr (i < 0) return 0u;
    else return (ordf(v1[i] + v2[j]) & ~255u) | (unsigned)(16 * i + j);
}
template <int S> __device__ __forceinline__ void cand_fill(unsigned (&ck)[16], const float (&v1)[16], const float (&v2)[16], int hg) {
    const unsigned k0 = cand1<4 * S + 0>(v1, v2), k1 = cand1<4 * S + 1>(v1, v2), k2 = cand1<4 * S + 2>(v1, v2), k3 = cand1<4 * S + 3>(v1, v2);
    ck[S] = hg == 0 ? k0 : hg == 1 ? k1 : hg == 2 ? k2 : k3;
    if constexpr (S + 1 < 13) cand_fill<S + 1>(ck, v1, v2, hg);
}
__device__ __forceinline__ void route_task(Frame& F, const int tg, const int h) {
    const int lane = F.lane, c = lane & 15, hg = lane >> 4;
    const int tok = tg * 16 + c;
    const bf16* QP = WSP(const bf16, WS_QP); LAS unsigned char* SKl = F.lds + RING_OFF;
    unsigned sel[2][16];
#pragma unroll
    for (int half = 0; half < 2; ++half) {
        bf16x8 bq[4];
#pragma unroll
        for (int ks = 0; ks < 4; ++ks) bq[ks] = *(const GAS bf16x8*)(QP + (size_t)tok * PQW + h * 256 + half * 128 + 32 * ks + 8 * hg);
        unsigned k[32];
#pragma unroll
        for (int tile = 0; tile < 8; ++tile) {
            f32x4 s = (f32x4){0.f, 0.f, 0.f, 0.f};
#pragma unroll
            for (int ks = 0; ks < 4; ++ks) { const bf16x8 a = *(const LAS bf16x8*)(SKl + off_b(half * 128 + 16 * tile + c, 4 * ks + hg)); s = MFMA16(a, bq[ks], s); }
#pragma unroll
            for (int r = 0; r < 4; ++r) k[tile * 4 + r] = (ordf(s[r]) & ~127u) | (unsigned)(16 * tile + 4 * hg + r);
            if (tile & 1) asm volatile("" ::: "memory");
        }
        bitonic_sort_desc<32>(k);
        unsigned t[16];
#pragma unroll
        for (int i = 0; i < 16; ++i) t[i] = k[i];
        xlane_top16(t, 16); xlane_top16(t, 32);
#pragma unroll
        for (int i = 0; i < 16; ++i) sel[half][i] = t[i];
        asm volatile("" ::: "memory");
    }
    float v1[16], v2[16]; unsigned n1[16], n2[16];
#pragma unroll
    for (int i = 0; i < 16; ++i) { v1[i] = unordf(sel[0][i] & ~127u); n1[i] = sel[0][i] & 127u; v2[i] = unordf(sel[1][i] & ~127u); n2[i] = sel[1][i] & 127u; }
    LAS unsigned char* scr = F.lds + RING_OFF + 65536 + F.wave * 4096 + c * 256;
    if (hg == 0) {
#pragma unroll
        for (int q4 = 0; q4 < 4; ++q4) { *(LAS f32x4*)(scr + 16 * q4) = (f32x4){v1[4 * q4], v1[4 * q4 + 1], v1[4 * q4 + 2], v1[4 * q4 + 3]}; *(LAS f32x4*)(scr + 64 + 16 * q4) = (f32x4){v2[4 * q4], v2[4 * q4 + 1], v2[4 * q4 + 2], v2[4 * q4 + 3]};
            *(LAS v4u*)(scr + 128 + 16 * q4) = (v4u){n1[4 * q4], n1[4 * q4 + 1], n1[4 * q4 + 2], n1[4 * q4 + 3]}; *(LAS v4u*)(scr + 192 + 16 * q4) = (v4u){n2[4 * q4], n2[4 * q4 + 1], n2[4 * q4 + 2], n2[4 * q4 + 3]}; } }
    unsigned ck[16];
    cand_fill<0>(ck, v1, v2, hg); ck[13] = ck[14] = ck[15] = 0u;
    bitonic_sort_desc<16>(ck);
    xlane_top16(ck, 16); xlane_top16(ck, 32);
    int oi[4]; float sc[4]; float mx = -INFINITY;
#pragma unroll
    for (int jj = 0; jj < 4; ++jj) {
        const unsigned w = hg == 0 ? ck[jj] : hg == 1 ? ck[4 + jj] : hg == 2 ? ck[8 + jj] : ck[12 + jj];
        const unsigned i4 = (w >> 2) & 0x3Cu, j4 = (w & 15u) << 2;
        sc[jj] = *(const LAS float*)(scr + i4) + *(const LAS float*)(scr + 64 + j4);
        oi[jj] = (int)(*(const LAS unsigned*)(scr + 128 + i4) * (unsigned)NKEYS + *(const LAS unsigned*)(scr + 192 + j4));
        mx = fmaxf(mx, sc[jj]);
    }
    mx = fmaxf(mx, __shfl_xor(mx, 16)); mx = fmaxf(mx, __shfl_xor(mx, 32));
    float ev[4], sum = 0.f;
#pragma unroll
    for (int jj = 0; jj < 4; ++jj) { ev[jj] = __builtin_amdgcn_exp2f((sc[jj] - mx) * LOG2E); sum += ev[jj]; }
    sum += __shfl_xor(sum, 16); sum += __shfl_xor(sum, 32);
    const float inv = 1.0f / sum;
    const size_t o = ((size_t)tok * PH + h) * TOPK + 4 * hg;
    *(GAS i32x4_t*)(WSP(int, WS_IDX) + o) = (i32x4_t){oi[0], oi[1], oi[2], oi[3]};
    *(GAS f32x4*)(WSP(float, WS_GATE) + o) = (f32x4){ev[0] * inv, ev[1] * inv, ev[2] * inv, ev[3] * inv};
}

__device__ __forceinline__ float gelu_erf(float v) { return 0.5f * v * (1.0f + erff(v * 0.70710678118654752f)); }
typedef int i32x8_t __attribute__((ext_vector_type(8)));
#define FP4X2(w, b) __builtin_amdgcn_cvt_scalef32_pk_f32_fp4((w), 1.0f, (b))
__device__ __forceinline__ void fmac(float& acc, float a, float b) { asm("v_fmac_f32 %0, %1, %2" : "+v"(acc) : "v"(a), "v"(b)); }
struct PeerDeal { int ox, nx, t0, stride, cnt, ns; };
__device__ __forceinline__ void pd_item(int n, const PeerDeal& d, int& t, int& sl) { const int N = d.ns * d.cnt, nn = n < N ? n : N - 1, j = nn / d.cnt; sl = d.ox + j * d.nx; t = d.t0 + (nn - j * d.cnt) * d.stride; }
__device__ __forceinline__ void pd_idx(Frame& F, int t, int lane, i32x4_t (&idv)[4]) {
    const GAS i32x4_t* ip = (const GAS i32x4_t*)(WSP(const int, WS_IDX) + (size_t)t * 128 + (lane >> 3) * 16);
#pragma unroll
    for (int a = 0; a < 4; ++a) idv[a] = ip[a];
}
__device__ __forceinline__ void pd_rows(Frame& F, int t, int sl, int lane, const i32x4_t (&idv)[4], v4u (&rows)[16], v4u (&xw)[2][2]) {
    const unsigned char* xr = F.ws + WS_X2N8 + ((size_t)sl * M + t) * 256 + 16 * (lane >> 4);
#pragma unroll
    for (int pl = 0; pl < 2; ++pl)
#pragma unroll
        for (int ks = 0; ks < 2; ++ks) xw[pl][ks] = *(const GAS v4u*)(xr + pl * 128 + 64 * ks);
    const unsigned char* WD = F.ws + WS_W4D + (size_t)sl * SLICE_BYTES + 16 * (lane & 7);
#pragma unroll
    for (int j = 0; j < 16; ++j) rows[j] = *(const GAS v4u*)(WD + (size_t)idv[j >> 2][j & 3] * 128);
}
__device__ __forceinline__ void pd_compute(Frame& F, int t, int sl, int lane, const v4u (&rows)[16], const v4u (&xw)[2][2]) {
    const int r = lane & 15, g = lane >> 4;
    LAS unsigned char* tile = F.lds + RING_OFF + F.wave * 16384;
    { LAS unsigned char* wp = tile + (lane >> 3) * 2048;
#pragma unroll
      for (int j = 0; j < 16; ++j) *(LAS v4u*)(wp + j * 128 + (((lane & 7) ^ ((j >> 1) & 7)) << 4)) = rows[j]; }
    float* pp = WSP(float, WS_PART) + ((size_t)sl * M + t) * 128 + 4 * g;
    i32x8_t xb[2][2];
#pragma unroll
    for (int pl = 0; pl < 2; ++pl)
#pragma unroll
        for (int ks = 0; ks < 2; ++ks) xb[pl][ks] = (i32x8_t){(int)xw[pl][ks].x, (int)xw[pl][ks].y, (int)xw[pl][ks].z, (int)xw[pl][ks].w, 0, 0, 0, 0};
    const LAS unsigned char* rp = tile + r * 128; const int fr = (r >> 1) & 7;
#pragma unroll
    for (int i = 0; i < 8; ++i) { f32x4 c = (f32x4){0.f, 0.f, 0.f, 0.f};
#pragma unroll
        for (int ks = 0; ks < 2; ++ks) { const v4u w = *(const LAS v4u*)(rp + i * 2048 + (((4 * ks + g) ^ fr) << 4)); const i32x8_t a = (i32x8_t){(int)w.x, (int)w.y, (int)w.z, (int)w.w, 0, 0, 0, 0};
            c = __builtin_amdgcn_mfma_scale_f32_16x16x128_f8f6f4(a, xb[0][ks], c, 4  , 4  , 0, 0x7F7F7F7F, 0, 0x7F7F7F7F);
            c = __builtin_amdgcn_mfma_scale_f32_16x16x128_f8f6f4(a, xb[1][ks], c, 4, 4, 0, 0x7F7F7F7F, 0, 0x7C7C7C7C  ); }
        if (r == 0) *(GAS f32x4*)(pp + 16 * i) = c; }
}
__device__ __forceinline__ void peer_down_pass(Frame& F, const PeerDeal& d) {
    const int lane = F.lane;
    const int N = d.ns * d.cnt; if (N <= 0) return;
    i32x4_t I0[4], I1[4]; v4u R0[16], R1[16], X0[2][2], X1[2][2];
    int ta, sa, tb, sb, tc, sc;
    pd_item(0, d, ta, sa); pd_idx(F, ta, lane, I0);
    pd_item(1, d, tb, sb); pd_idx(F, tb, lane, I1);
    pd_rows(F, ta, sa, lane, I0, R0, X0);
#pragma unroll 1
    for (int n = 0; n < N; n += 2) {
        pd_rows(F, tb, sb, lane, I1, R1, X1);
        pd_item(n + 2, d, tc, sc); pd_idx(F, tc, lane, I0);
        pd_compute(F, ta, sa, lane, R0, X0);
        pd_rows(F, tc, sc, lane, I0, R0, X0);
        pd_item(n + 3, d, ta, sa); pd_idx(F, ta, lane, I1);
        pd_compute(F, tb, sb, lane, R1, X1);
        tb = ta; sb = sa; ta = tc; sa = sc;
    }
}
__device__ __forceinline__ void peer_combine_token(Frame& F, const int t) {
    const int lane = F.lane;
    const float* PART = WSP(const float, WS_PART) + (size_t)t * 128 + 2 * lane; float* GATEP = WSP(float, WS_GATE) + (size_t)t * 128 + 2 * lane;
    f32x2_t a = (f32x2_t){0.f, 0.f};
#pragma unroll
    for (int sl = 0; sl < 16; ++sl) a += *(const GAS f32x2_t*)(PART + (size_t)sl * M * 128);
    const int id0 = WSP(const int, WS_IDX)[(size_t)t * 128 + 2 * lane], id1 = WSP(const int, WS_IDX)[(size_t)t * 128 + 2 * lane + 1];
    const f32x2_t gt = *(const GAS f32x2_t*)GATEP;
    const float c0 = gt.x * gelu_erf(a.x * WSP(const float, WS_SCD)[id0]) * WSP(const float, WS_SCU)[id0], c1 = gt.y * gelu_erf(a.y * WSP(const float, WS_SCD)[id1]) * WSP(const float, WS_SCU)[id1];
    *(GAS f32x2_t*)GATEP = (f32x2_t){c0, c1};
    float bm = fmaxf(fabsf(c0), fabsf(c1));
    bm = fmaxf(bm, __shfl_xor(bm, 1)); bm = fmaxf(bm, __shfl_xor(bm, 2)); bm = fmaxf(bm, __shfl_xor(bm, 4)); bm = fmaxf(bm, __shfl_xor(bm, 8));
    int eb = (int)((__float_as_uint(bm) >> 23) & 255u) - 1;
    eb = eb < 3 ? 3 : eb > 250 ? 250 : eb;
    const float inv = __uint_as_float((unsigned)(254 - eb) << 23);
    const float s0 = c0 * inv, s1 = c1 * inv;
    const unsigned hi = __builtin_amdgcn_cvt_scalef32_pk_fp4_f32(0u, s0, s1, 1.0f, 0);
    const f32x2_t dq = __builtin_amdgcn_cvt_scalef32_pk_f32_fp4(hi, 1.0f, 0);
    const unsigned lo = __builtin_amdgcn_cvt_scalef32_pk_fp4_f32(0u, (s0 - dq.x) * 8.f, (s1 - dq.y) * 8.f, 1.0f, 0);
    unsigned char* cf4 = F.ws + WS_CF4 + (size_t)t * 160;
    ((GAS unsigned char*)cf4)[lane] = (unsigned char)hi; ((GAS unsigned char*)cf4)[64 + lane] = (unsigned char)lo;
    if ((lane & 15) == 0) ((GAS unsigned*)(cf4 + 128))[lane >> 4] = (unsigned)eb * 0x01010101u;
}
struct PmBuf { v4u rows[16]; v4u aw; unsigned sca; f32x4 ov; };
__device__ __forceinline__ void pm_rows(Frame& F, int t, int sl, int lane, const i32x4_t (&idv)[4], PmBuf& b) {
    const int n = lane & 15, g = lane >> 4;
    const unsigned char* WU = F.ws + WS_W4U + (size_t)sl * SLICE_BYTES + 16 * (lane & 7);
#pragma unroll
    for (int j = 0; j < 16; ++j) b.rows[j] = *(const GAS v4u*)(WU + (size_t)idv[j >> 2][j & 3] * 128);
    const unsigned char* cf4 = F.ws + WS_CF4 + (size_t)t * 160;
    b.aw = (v4u){0u, 0u, 0u, 0u}; b.sca = 0x7F7F7F7Fu;
    if (n < 2) { b.aw = *(const GAS v4u*)(cf4 + 64 * n + 16 * g); const unsigned e = *(const GAS unsigned*)(cf4 + 128 + 4 * g); b.sca = n == 0 ? e : e - 0x03030303u; }
    b.ov = *(const GAS f32x4*)(F.out + (size_t)t * D + 256 * sl + 4 * lane);
}
__device__ __forceinline__ void pm_compute(Frame& F, int t, int sl, int lane, const PmBuf& b) {
    const int n = lane & 15, g = lane >> 4;
    LAS unsigned char* tile = F.lds + RING_OFF + F.wave * 16384;
    LAS float* obuf = (LAS float*)(F.lds + OBUF_OFF + F.wave * 1024);
    const i32x8_t afr = (i32x8_t){(int)b.aw.x, (int)b.aw.y, (int)b.aw.z, (int)b.aw.w, 0, 0, 0, 0};
    { LAS unsigned char* wp = tile + (lane >> 3) * 2048; const int cc = lane & 7;
#pragma unroll
      for (int j = 0; j < 16; ++j) { const v4u w = b.rows[j]; *(LAS v4u*)(wp + j * 128 + ((cc ^ (j >> 1)) << 4)) = (j & 1) ? (v4u){w.z, w.w, w.x, w.y} : w; } }
    const LAS unsigned char* rp = tile + (32 * g + n) * 128;
#pragma unroll
    for (int c0 = 0; c0 < 16; ++c0) {
        const int off = ((c0 ^ n) << 3);
        const v2i32_t b0 = __builtin_amdgcn_ds_read_tr4_b64_v2i32((LAS v2i32_t*)(rp + off)), b1 = __builtin_amdgcn_ds_read_tr4_b64_v2i32((LAS v2i32_t*)(rp + 2048 + off));
        const i32x8_t bfr = (i32x8_t){b0.x, b0.y, b1.x, b1.y, 0, 0, 0, 0};
        const f32x4 c = __builtin_amdgcn_mfma_scale_f32_16x16x128_f8f6f4(afr, bfr, (f32x4){0.f, 0.f, 0.f, 0.f}, 4, 4, 0, (int)b.sca, 0, 0x7F7F7F7F);
        if (g == 0) obuf[16 * c0 + n] = c[0] + c[1];
    }
    *(GAS f32x4*)(F.out + (size_t)t * D + 256 * sl + 4 * lane) = b.ov + *(const LAS f32x4*)(obuf + 4 * lane);
}
__device__ __forceinline__ void peer_up_pass_mfma(Frame& F, const PeerDeal& d) {
    const int lane = F.lane;
    const int N = d.ns * d.cnt; if (N <= 0) return;
    i32x4_t I0[4], I1[4]; PmBuf B0, B1;
    int ta, sa, tb, sb, tc, sc;
    pd_item(0, d, ta, sa); pd_idx(F, ta, lane, I0);
    pd_item(1, d, tb, sb); pd_idx(F, tb, lane, I1);
    pm_rows(F, ta, sa, lane, I0, B0);
#pragma unroll 1
    for (int n = 0; n < N; n += 2) {
        if (n + 1 < N) pm_rows(F, tb, sb, lane, I1, B1);
        pd_item(n + 2, d, tc, sc); pd_idx(F, tc, lane, I0);
        pm_compute(F, ta, sa, lane, B0);
        if (n + 2 < N) pm_rows(F, tc, sc, lane, I0, B0);
        pd_item(n + 3, d, ta, sa); pd_idx(F, ta, lane, I1);
        if (n + 1 < N) pm_compute(F, tb, sb, lane, B1);
        tb = ta; sb = sa; ta = tc; sa = sc;
    }
}
typedef _Float16 h2_t __attribute__((ext_vector_type(2)));
#define FP4H2(w, b) __builtin_bit_cast(h2_t, __builtin_amdgcn_cvt_scalef32_pk_f16_fp4((w), 1.0f, (b)))
__device__ __forceinline__ void pu_idx(Frame& F, int t, int lane, i32x4_t (&idv)[8], f32x4 (&cfv)[8]) {
    const GAS i32x4_t* ip = (const GAS i32x4_t*)(WSP(const int, WS_IDX) + (size_t)t * 128 + (lane >> 4) * 32); const GAS f32x4* cp = (const GAS f32x4*)(WSP(const float, WS_GATE) + (size_t)t * 128 + (lane >> 4) * 32);
#pragma unroll
    for (int a = 0; a < 8; ++a) { idv[a] = ip[a]; cfv[a] = cp[a]; }
}
template <int H> __device__ __forceinline__ void pu_rows(Frame& F, int sl, int lane, const i32x4_t (&idv)[8], u32x2_t (&rows)[16]) {
    const unsigned char* WU = F.ws + WS_W4U + (size_t)sl * SLICE_BYTES + (lane & 15) * 8;
#pragma unroll
    for (int i = 0; i < 16; ++i) rows[i] = *(const GAS u32x2_t*)(WU + (size_t)idv[4 * H + (i >> 2)][i & 3] * 128);
}
template <int H> __device__ __forceinline__ void pu_compute(const u32x2_t (&rows)[16], const f32x4 (&cfv)[8], h2_t (&acc)[8]) {
#pragma unroll
    for (int i = 0; i < 16; ++i) { const float c = cfv[4 * H + (i >> 2)][i & 3] * 256.0f; const h2_t cc = __builtin_bit_cast(h2_t, __builtin_amdgcn_cvt_pkrtz(c, c));
#pragma unroll
        for (int k = 0; k < 2; ++k) { const unsigned w = rows[i][k];
            acc[4 * k + 0] = FP4H2(w, 0) * cc + acc[4 * k + 0]; acc[4 * k + 1] = FP4H2(w, 1) * cc + acc[4 * k + 1]; acc[4 * k + 2] = FP4H2(w, 2) * cc + acc[4 * k + 2]; acc[4 * k + 3] = FP4H2(w, 3) * cc + acc[4 * k + 3]; } }
}
__device__ __forceinline__ void pu_finish(Frame& F, int t, int sl, int lane, h2_t (&acc)[8]) {
    const int eg = lane >> 4, q = lane & 15;
#pragma unroll
    for (int a = 0; a < 8; ++a) {
        acc[a] = acc[a] + __builtin_bit_cast(h2_t, __shfl_xor(__builtin_bit_cast(unsigned, acc[a]), 16)); acc[a] = acc[a] + __builtin_bit_cast(h2_t, __shfl_xor(__builtin_bit_cast(unsigned, acc[a]), 32)); }
    const h2_t o01 = eg == 0 ? acc[0] : eg == 1 ? acc[2] : eg == 2 ? acc[4] : acc[6], o23 = eg == 0 ? acc[1] : eg == 1 ? acc[3] : eg == 2 ? acc[5] : acc[7];
    GAS f32x4* op = (GAS f32x4*)(F.out + (size_t)t * D + 256 * sl + 16 * q + 4 * eg);
    const f32x4 o = *op;
    *op = (f32x4){o[0] + (float)o01.x * (1.0f / 256.0f), o[1] + (float)o01.y * (1.0f / 256.0f), o[2] + (float)o23.x * (1.0f / 256.0f), o[3] + (float)o23.y * (1.0f / 256.0f)};
#pragma unroll
    for (int a = 0; a < 8; ++a) acc[a] = (h2_t){(_Float16)0.f, (_Float16)0.f};
}
__device__ __forceinline__ void peer_up_pass(Frame& F, const PeerDeal& d) {
    const int lane = F.lane;
    const int N = d.ns * d.cnt; if (N <= 0) return;
    i32x4_t IA[8], IB[8]; f32x4 CA[8], CB[8]; u32x2_t Ra[16], Rb[16]; h2_t acc[8];
#pragma unroll
    for (int a = 0; a < 8; ++a) acc[a] = (h2_t){(_Float16)0.f, (_Float16)0.f};
    int ta, sa, tb, sb, tc, sc;
    pd_item(0, d, ta, sa); pu_idx(F, ta, lane, IA, CA);
    pd_item(1, d, tb, sb); pu_idx(F, tb, lane, IB, CB);
    pu_rows<0>(F, sa, lane, IA, Ra);
#pragma unroll 1
    for (int n = 0; n < N; n += 2) {
        pu_rows<1>(F, sa, lane, IA, Rb);
        pu_compute<0>(Ra, CA, acc);
        pu_rows<0>(F, sb, lane, IB, Ra);
        pu_compute<1>(Rb, CA, acc);
        pu_finish(F, ta, sa, lane, acc);
        pd_item(n + 2, d, tc, sc); pu_idx(F, tc, lane, IA, CA);
        if (n + 1 < N) {
            pu_rows<1>(F, sb, lane, IB, Rb);
            pu_compute<0>(Ra, CB, acc);
            pu_rows<0>(F, sc, lane, IA, Ra);
            pu_compute<1>(Rb, CB, acc);
            pu_finish(F, tb, sb, lane, acc);
        }
        pd_item(n + 3, d, tb, sb); pu_idx(F, tb, lane, IB, CB);
        ta = tc; sa = sc;
    }
}
struct Args { const float* in[15]; float* out; unsigned char* ws; int ph_lo, ph_hi, pad0, pad1; };
__global__ void __launch_bounds__(NWAVES * 64, 2) skel_fwd(Args args) {
    extern __shared__ __attribute__((aligned(16))) unsigned char lds[];
    Frame F;
    F.lds = (LAS unsigned char*)lds;
    F.MISC = (volatile LAS unsigned*)(F.lds + MISC_OFF);
    F.tid = threadIdx.x; F.lane = F.tid & 63; F.wave = __builtin_amdgcn_readfirstlane(F.tid >> 6);
    F.G = gridDim.x; { const int bx = blockIdx.x; F.vcu = (F.G % 8 == 0) ? (bx % 8) * (F.G / 8) + bx / 8 : bx; }
    F.ws = args.ws; F.ctl = (gu32*)(args.ws + WS_CTL);
    F.x = args.in[0]; F.g1 = args.in[1]; F.w_in = args.in[2]; F.gq = args.in[3]; F.gk = args.in[4]; F.sink = args.in[5]; F.conv_w = args.in[6]; F.w_oa = args.in[7];
    F.w_oc = args.in[8]; F.w_out = args.in[9]; F.g2 = args.in[10]; F.w_qp = args.in[11]; F.subk = args.in[12]; F.w_down = args.in[13]; F.w_up = args.in[14]; F.out = args.out;
    for (int u = F.tid; u < (LDS_BYTES - LDSCTL_OFF) / 4; u += NWAVES * 64) ((LAS unsigned*)(F.lds + LDSCTL_OFF))[u] = 0u;
    __syncthreads();
    XcdBarrier bar; bar.bar = (unsigned*)(F.ctl + CW_BAR); bar.x = 0; bar.st = nullptr;
    if (MK_ONE_LAUNCH) bar = xcd_barrier_post((unsigned*)(F.ctl + CW_BAR), F.MISC + 8);
    if (MK_ONE_LAUNCH && F.tid == 0) { const unsigned xcc = xb_xcc_id(); F.MISC[10] = xcc; F.MISC[11] = __hip_atomic_fetch_add((unsigned*)(F.ctl + CW_XRANK) + 64 * xcc, 1u, RLX_AGENT); }
    if (F.wave == 0) { const bool ok = tr4_selfcheck(F.lds + RING_OFF, F.lane); if (F.lane == 0) F.MISC[15] = ok ? 1u : 0u; }
    __syncthreads();
    const bool tr4_ok = F.MISC[15] != 0u;
    const int lo = args.ph_lo, hi = args.ph_hi;
#ifndef PHASE_MASK
#define PHASE_MASK 0xfff
#endif
#define IN(k) (((PHASE_MASK >> (k)) & 1) && lo <= (k) && (k) < hi)
#ifndef DUP_MASK
#define DUP_MASK 0
#endif
#define REP(k) _Pragma("unroll") for (int rep_ = 0; rep_ < 1 + ((DUP_MASK >> (k)) & 1); ++rep_)
#define SEAM(k) do { if (MK_ONE_LAUNCH && IN(k) && IN((k) + 1)) xcd_barrier(bar); } while (0)
    const int gw = F.vcu * NWAVES + F.wave, NGW = F.G * NWAVES;

    if (IN(0)) REP(0) { p0_prologue(F); } SEAM(0);

    if (IN(1)) REP(1) { quant_w8(F); } SEAM(1);

    if (IN(2)) REP(2) {
        bf16* const pQ = WSP(bf16, WS_Q); bf16* const pK = WSP(bf16, WS_K); bf16* const pV = WSP(bf16, WS_V); bf16* const pH = WSP(bf16, WS_H); bf16* const pB = WSP(bf16, WS_B); bf16* const pC = WSP(bf16, WS_C);
        bf16* const pGA = WSP(bf16, WS_GA); bf16* const pGC = WSP(bf16, WS_GC);
        {   pg8::Gemm g{(const bf16*)(F.ws + WS_XN8), (const bf16*)(F.ws + WS_W8), M, INW, D / 2};
            pg8::RangeOrder S; S.so.init(M, I8_TILES * 256, F.G, (int)blockIdx.x); S.base = 0; S.cut = I8_CUT; S.skip = I8_SKIP;
            pg8::EpiProj<true> E{pQ, pK, pV, pH, pB, pC, pGA, pGC, WSP(const float, WS_SX), WSP(const float, WS_SW)};
            pg8::gemm_phase<pg8::EpiProj<true>, pg8::RangeOrder, PG8_ALIGN, PG8_SP2, true>(F.lds + RING_OFF, g, S, E); }
        {   pg8::Gemm g{WSP(const bf16, WS_XN), WSP(const bf16, WS_WIN), M, INW, D};
            pg8::RangeOrder S; S.so.init(M, BF_TILES * 256, F.G, (int)blockIdx.x); S.base = BF_BASE; S.cut = 68; S.skip = 0;
            pg8::EpiProj<false> E{pQ, pK, pV, pH, pB, pC, pGA, pGC, nullptr, nullptr};
            pg8::gemm_phase<pg8::EpiProj<false>, pg8::RangeOrder, PG8_ALIGN, PG8_SP2, false>(F.lds + RING_OFF, g, S, E); }
    } SEAM(2);

    if (IN(3)) REP(3) {
        for (int U = F.vcu * 4; U < BATCH * 32 * NKV * 2; U += F.G * 4)
            for (int i = 0; i < 4; ++i) attn_unit(F, U + i);
        conv_phase(F);
#ifdef CONV_DUP
        conv_phase(F);
#endif
        if (DUP_MASK) __syncthreads();
    } SEAM(3);

    if (IN(4)) REP(4) {
        pg8::Gemm g{WSP(const bf16, WS_AB), WSP(const bf16, WS_WO), 2 * M, 2 * D, QW}; pg8::PairOrder S; S.so.init(M, D, F.G, (int)blockIdx.x);
        pg8::EpiMerge E{WSP(const bf16, WS_GA), WSP(const bf16, WS_GC), WSP(bf16, WS_T), WSP(bf16, WS_XN)};
        pg8::gemm_phase<pg8::EpiMerge, pg8::PairOrder, PG8_ALIGN, PG8_SP2>(F.lds + RING_OFF, g, S, E);
    } SEAM(4);

    if (IN(5)) REP(5) {
        pg8::Gemm g{WSP(const bf16, WS_XN), WSP(const bf16, WS_WOUT), M, D, D}; pg8::StaticOrder S; S.init(M, D, F.G, (int)blockIdx.x);
        pg8::EpiRes E{F.x, F.out};
        pg8::gemm_phase<pg8::EpiRes, pg8::StaticOrder, PG8_ALIGN, PG8_SP2>(F.lds + RING_OFF, g, S, E);
    } SEAM(5);

    if (IN(6)) REP(6) {
        for (int m = gw; m < M; m += NGW) rms2_row(F.out + (size_t)m * D, F.g2, F.ws + WS_X2I8 + (size_t)m * D, WSP(float, WS_SX2) + m, F.ws + WS_X2N8 + (size_t)m * 256, F.lane);
    } SEAM(6);

    if (IN(7)) REP(7) {
        pg8::Gemm g{(const bf16*)(F.ws + WS_X2I8), (const bf16*)(F.ws + WS_W8QP), M, PQW, D / 2}; pg8::StaticOrder S; S.init(M, PQW, F.G, (int)blockIdx.x);
        pg8::EpiStoreI8 E{WSP(bf16, WS_QP), PQW, WSP(const float, WS_SX2), WSP(const float, WS_SWQ)};
        pg8::gemm_phase<pg8::EpiStoreI8, pg8::StaticOrder, PG8_ALIGN, PG8_SP2, true>(F.lds + RING_OFF, g, S, E);
    } SEAM(7);

    if (IN(8)) REP(8) {
        const int h = F.vcu & 7;
        { const bf16* SK = WSP(const bf16, WS_SK) + (size_t)h * (2 * NKEYS * 128);
#pragma unroll
          for (int i = 0; i < 8; ++i) { const int q = F.tid + 512 * i, row = q >> 4, ch = q & 15; *(LAS v4u*)(F.lds + RING_OFF + off_b(row, ch)) = *(const GAS v4u*)(SK + (size_t)row * 128 + ch * 8); } }
        __syncthreads();
        for (int tg = (F.vcu >> 3) * NWAVES + F.wave; tg < M / 16; tg += (F.G >> 3) * NWAVES) route_task(F, tg, h);
        if (DUP_MASK) __syncthreads();
    } SEAM(8);

    PeerDeal deal;
    if (IN(9) || IN(11)) {
        if (MK_ONE_LAUNCH) {
            if (F.tid == 0) { const unsigned xcc = F.MISC[10]; unsigned nloc = 0, ox = 0, nx = 0;
                for (unsigned j = 0; j < 16; ++j) { const unsigned c = __hip_atomic_load((unsigned*)(F.ctl + CW_XRANK) + 64 * j, RLX_AGENT); if (c) { ++nx; if (j < xcc) ++ox; } if (j == xcc) nloc = c; }
                F.MISC[12] = nloc; F.MISC[13] = ox; F.MISC[14] = nx; }
            __syncthreads();
            const int nloc = (int)F.MISC[12], rank = (int)F.MISC[11];
            deal.ox = (int)F.MISC[13]; deal.nx = (int)F.MISC[14]; deal.t0 = rank * NWAVES + F.wave; deal.stride = nloc * NWAVES;
        } else { const int nper = F.G >> 3; deal.ox = F.vcu / nper; deal.nx = 8; deal.t0 = (F.vcu % nper) * NWAVES + F.wave; deal.stride = nper * NWAVES; }
        deal.cnt = deal.t0 < M ? (M - deal.t0 + deal.stride - 1) / deal.stride : 0; deal.ns = deal.ox < 16 ? (16 - deal.ox + deal.nx - 1) / deal.nx : 0;
    }
    if (IN(9)) {
        peer_down_pass(F, deal);
    } SEAM(9);
    if (IN(10)) {
        for (int t = gw; t < M; t += NGW) peer_combine_token(F, t);
    } SEAM(10);
    if (IN(11)) {
        if (tr4_ok) peer_up_pass_mfma(F, deal); else peer_up_pass(F, deal);
    }
#undef IN
#undef SEAM
}

extern "C" void kernel_launch(void* const* d_in, const int* in_sizes, int n_in, void* d_out, int out_size, void* d_ws, size_t ws_size, hipStream_t stream) {
    static int grid = 0;
    if (grid == 0) {
        if (n_in != 15 || in_sizes[0] != M * D || out_size != M * D || ws_size < WS_END) { fprintf(stderr, "kernel_launch: built for 15 inputs, x and out of %d floats, >= %zu bytes of workspace; got n_in %d, in0 %d, out %d, ws %zu; nothing launched\n", M * D, (size_t)WS_END, n_in, n_in > 0 ? in_sizes[0] : -1, out_size, ws_size); grid = -1; return; }
        int dev = 0, cus = 0, per_cu = 0;
        if (hipGetDevice(&dev) != hipSuccess || hipDeviceGetAttribute(&cus, hipDeviceAttributeMultiprocessorCount, dev) != hipSuccess) { fprintf(stderr, "kernel_launch: hipGetDevice / hipDeviceGetAttribute failed; nothing launched\n"); grid = -1; return; }
        if (hipFuncSetAttribute((const void*)skel_fwd, hipFuncAttributeMaxDynamicSharedMemorySize, LDS_BYTES) != hipSuccess) { fprintf(stderr, "kernel_launch: hipFuncSetAttribute failed; nothing launched\n"); grid = -1; return; }
        if (hipOccupancyMaxActiveBlocksPerMultiprocessor(&per_cu, (const void*)skel_fwd, NWAVES * 64, LDS_BYTES) != hipSuccess || per_cu < 1)
            fprintf(stderr, "kernel_launch: note: the occupancy query reports %d workgroups per CU\n", per_cu);
        (void)hipGetLastError();
        grid = cus;
        if (grid % 8 != 0) { fprintf(stderr, "kernel_launch: %d CUs: this kernel deals work in groups of 8 workgroups; nothing launched\n", grid); grid = -1; return; }
    }
    if (grid < 0) return;
    if (hipMemsetAsync((char*)d_ws + WS_CTL, 0, CTL_ZERO_BYTES, stream) != hipSuccess) { fprintf(stderr, "kernel_launch: hipMemsetAsync of the control words failed; nothing launched\n"); return; }
    Args a{};
    for (int i = 0; i < 15; ++i) a.in[i] = (const float*)d_in[i];
    a.out = (float*)d_out; a.ws = (unsigned char*)d_ws;
#if MK_ONE_LAUNCH
    a.ph_lo = 0; a.ph_hi = N_PHASES;
    hipLaunchKernelGGL(skel_fwd, dim3(grid), dim3(NWAVES * 64), LDS_BYTES, stream, a);
    { const hipError_t le = hipPeekAtLastError(); if (le != hipSuccess) fprintf(stderr, "kernel_launch: launch failed: %s\n", hipGetErrorName(le)); }
#else
    for (int p = 0; p < N_PHASES; ++p) {
        a.ph_lo = p; a.ph_hi = p + 1;
        hipLaunchKernelGGL(skel_fwd, dim3(grid), dim3(NWAVES * 64), LDS_BYTES, stream, a);
        const hipError_t le = hipPeekAtLastError();
        if (le != hipSuccess) { fprintf(stderr, "kernel_launch: launch %d failed: %s\n", p, hipGetErrorName(le)); break; }
    }
#endif
}
```

```cpp
#include <hip/hip_runtime.h>
#include <cstdio>
#include <cstdint>
#include <cmath>
namespace pg8 {
#define PG8_LAS __attribute__((address_space(3)))
typedef unsigned short bf16_t;
typedef short bf16x8 __attribute__((ext_vector_type(8)));
typedef float f32x4 __attribute__((ext_vector_type(4)));
typedef unsigned u32x4 __attribute__((ext_vector_type(4)));
typedef int i32x4 __attribute__((ext_vector_type(4)));
constexpr int BM = 256, BK = 64, HALF = 128, HTB = HALF * BK * 2  , STAGE_BYTES = 8 * HTB, NXCD = 8, WGM = 8;

__host__ __device__ __forceinline__ int lds_byte(int r, int c) { const int st = (r >> 4) * 2 + (c >> 5), rr = r & 15, cc = c & 31, ob = rr * 64 + cc * 2; return st * 1024 + (ob ^ (((ob >> 9) & 1) << 5)); }
__host__ __device__ __forceinline__ void stage_rc(int b, int& R, int& C) { const int st = b / 1024, sb = b % 1024, swz = sb ^ (((sb >> 9) & 1) << 5); R = (st >> 1) * 16 + swz / 64; C = (st & 1) * 32 + (swz % 64) / 2; }
__host__ __device__ __forceinline__ int perm32(int rho) { const int n = rho >> 4, i = rho & 15; return 8 * (i >> 2) + 4 * n + (i & 3); }

struct Unit { int pm, pn; };
struct Gemm { const bf16_t* A; const bf16_t* Bt; int M, N, K; };

struct StaticOrder {
    int nM, nN, nwg, G, c;
    __host__ __device__ void init(int M, int N, int G_, int c_) { nM = M / BM; nN = N / BM; nwg = nM * nN; G = G_; c = c_; }
    __host__ __device__ bool next(int i, Unit& u) const {
        const long L = (long)i * G + c; if (L >= nwg) return false;
        int wgid = (int)L; { const int q = nwg / NXCD, r = nwg % NXCD, xcd = wgid % NXCD, off = wgid / NXCD; wgid = (xcd < r ? xcd * (q + 1) : r * (q + 1) + (xcd - r) * q) + off; }
        const int nig = WGM * nN, gid = wgid / nig, fm = gid * WGM, gsz = (nM - fm) < WGM ? (nM - fm) : WGM;
        u.pm = fm + ((wgid % nig) % gsz); u.pn = (wgid % nig) / gsz; return true;
    }
    __device__ __forceinline__ void a_ready(const Unit&) const {}
    __device__ __forceinline__ void done(const Unit&) const {}
};
__device__ __forceinline__ unsigned cvt_pk_bf16(float lo, float hi) { unsigned r; asm volatile("v_cvt_pk_bf16_f32 %0, %1, %2" : "=v"(r) : "v"(lo), "v"(hi)); return r; }
typedef unsigned u32x2 __attribute__((ext_vector_type(2)));
__device__ __forceinline__ float sigm(float v) { return __builtin_amdgcn_rcpf(1.0f + __builtin_amdgcn_exp2f(-1.4426950408889634f * v)); }
__device__ __forceinline__ u32x4 pack8(const f32x4 a, const f32x4 b) { u32x4 w; w.x = cvt_pk_bf16(a[0], a[1]); w.y = cvt_pk_bf16(a[2], a[3]); w.z = cvt_pk_bf16(b[0], b[1]); w.w = cvt_pk_bf16(b[2], b[3]); return w; }
__device__ __forceinline__ void unpack8(const u32x4 w, f32x4& a, f32x4& b) {
    a[0] = __uint_as_float(w.x << 16); a[1] = __uint_as_float(w.x & 0xffff0000u); a[2] = __uint_as_float(w.y << 16); a[3] = __uint_as_float(w.y & 0xffff0000u);
    b[0] = __uint_as_float(w.z << 16); b[1] = __uint_as_float(w.z & 0xffff0000u); b[2] = __uint_as_float(w.w << 16); b[3] = __uint_as_float(w.w & 0xffff0000u);
}
template <bool I8> struct EpiProj {
    static constexpr bool PERM = true, AFTER_DRAIN = false;
    bf16_t *Q, *K, *V, *H, *Bg, *Cg, *GA, *GC; const float *sx, *sw;
    __device__ __forceinline__ void operator()(const f32x4 (&acc)[2][2][4][2], const Unit& u, int wr, int wc, int fr, int fq) const {
        const int pn = u.pn; bf16_t* base; int ldc, ct; bool sg = false;
        if (pn < 8) { base = Q; ldc = 2048; ct = pn; } else if (pn < 10) { base = K; ldc = 512; ct = pn - 8; } else if (pn < 12) { base = V; ldc = 512; ct = pn - 10; }
        else if (pn < 20) { base = H; ldc = 2048; ct = pn - 12; } else if (pn < 28) { base = Bg; ldc = 2048; ct = pn - 20; } else if (pn < 36) { base = Cg; ldc = 2048; ct = pn - 28; }
        else if (pn < 52) { base = GA; ldc = 4096; ct = pn - 36; sg = true; } else { base = GC; ldc = 4096; ct = pn - 52; sg = true; }
        const int row0 = u.pm * BM + wr * 64 + fr, col0 = ct * BM + wc * 32 + 8 * fq;
        f32x4 cs[2][2];
        if constexpr (I8) {
#pragma unroll
            for (int bj = 0; bj < 2; ++bj)
#pragma unroll
                for (int n = 0; n < 2; ++n) cs[bj][n] = *(const f32x4*)(sw + pn * BM + bj * HALF + wc * 32 + 8 * fq + 4 * n);
        }
#pragma unroll
        for (int ai = 0; ai < 2; ++ai)
#pragma unroll
            for (int m = 0; m < 4; ++m) { const int row = row0 + ai * HALF + m * 16; bf16_t* rowp = base + (size_t)row * ldc + col0;
                float rs = 1.f; if constexpr (I8) rs = sx[row];
#pragma unroll
                for (int bj = 0; bj < 2; ++bj) { f32x4 v0 = acc[ai][bj][m][0], v1 = acc[ai][bj][m][1];
                    if constexpr (I8) { v0 = __builtin_convertvector(__builtin_bit_cast(i32x4, v0), f32x4) * (cs[bj][0] * rs); v1 = __builtin_convertvector(__builtin_bit_cast(i32x4, v1), f32x4) * (cs[bj][1] * rs); }
                    if (sg) {
#pragma unroll
                        for (int e = 0; e < 4; ++e) { v0[e] = sigm(v0[e]); v1[e] = sigm(v1[e]); } }
                    *(u32x4*)(rowp + bj * HALF) = pack8(v0, v1); } }
    }
};
struct EpiMerge {
    static constexpr bool PERM = true, AFTER_DRAIN = false;
    const bf16_t *GA, *GC; bf16_t *T, *Mg;
    __device__ __forceinline__ void operator()(const f32x4 (&acc)[2][2][4][2], const Unit& u, int wr, int wc, int fr, int fq) const {
        const int which = u.pm >> 6, pm = u.pm & 63, pn = u.pn & 15;
        const bf16_t* G = which ? GC : GA;
        const int row0 = pm * BM + wr * 64 + fr, col0 = pn * BM + wc * 32 + 8 * fq;
#pragma unroll
        for (int ai = 0; ai < 2; ++ai)
#pragma unroll
            for (int m = 0; m < 4; ++m) { const size_t off = (size_t)(row0 + ai * HALF + m * 16) * 4096 + col0;
#pragma unroll
                for (int bj = 0; bj < 2; ++bj) { const size_t o = off + bj * HALF; f32x4 g0, g1; unpack8(*(const u32x4*)(G + o), g0, g1);
                    f32x4 v0 = acc[ai][bj][m][0] * g0, v1 = acc[ai][bj][m][1] * g1;
                    if (which == 0) { *(u32x4*)(T + o) = pack8(v0, v1); }
                    else { f32x4 t0, t1; unpack8(*(const u32x4*)(T + o), t0, t1); *(u32x4*)(Mg + o) = pack8(v0 + t0, v1 + t1); } } }
    }
};
struct EpiRes {
    static constexpr bool PERM = true, AFTER_DRAIN = false;
    const float* X; bf16_t* O;
    __device__ __forceinline__ void operator()(const f32x4 (&acc)[2][2][4][2], const Unit& u, int wr, int wc, int fr, int fq) const {
        const int row0 = u.pm * BM + wr * 64 + fr, col0 = u.pn * BM + wc * 32 + 8 * fq;
#pragma unroll
        for (int ai = 0; ai < 2; ++ai)
#pragma unroll
            for (int m = 0; m < 4; ++m) { const size_t off = (size_t)(row0 + ai * HALF + m * 16) * 4096 + col0;
#pragma unroll
                for (int bj = 0; bj < 2; ++bj) { const size_t o = off + bj * HALF; const f32x4 x0 = *(const f32x4*)(X + o), x1 = *(const f32x4*)(X + o + 4);
                    *(u32x4*)(O + o) = pack8(x0 + acc[ai][bj][m][0], x1 + acc[ai][bj][m][1]); } }
    }
};
struct EpiStoreI8 {
    static constexpr bool PERM = true, AFTER_DRAIN = false;
    bf16_t* O; int ldc; const float *sx, *sw;
    __device__ __forceinline__ void operator()(const f32x4 (&acc)[2][2][4][2], const Unit& u, int wr, int wc, int fr, int fq) const {
        const int row0 = u.pm * BM + wr * 64 + fr, col0 = u.pn * BM + wc * 32 + 8 * fq;
        f32x4 cs[2][2];
#pragma unroll
        for (int bj = 0; bj < 2; ++bj)
#pragma unroll
            for (int n = 0; n < 2; ++n) cs[bj][n] = *(const f32x4*)(sw + col0 + bj * HALF + 4 * n);
#pragma unroll
        for (int ai = 0; ai < 2; ++ai)
#pragma unroll
            for (int m = 0; m < 4; ++m) { const int row = row0 + ai * HALF + m * 16; bf16_t* rowp = O + (size_t)row * ldc + col0; const float rs = sx[row];
#pragma unroll
                for (int bj = 0; bj < 2; ++bj) *(u32x4*)(rowp + bj * HALF) = pack8(__builtin_convertvector(__builtin_bit_cast(i32x4, acc[ai][bj][m][0]), f32x4) * (cs[bj][0] * rs), __builtin_convertvector(__builtin_bit_cast(i32x4, acc[ai][bj][m][1]), f32x4) * (cs[bj][1] * rs)); }
    }
};
struct EpiStore {
    static constexpr bool PERM = true, AFTER_DRAIN = false;
    bf16_t* O; int ldc;
    __device__ __forceinline__ void operator()(const f32x4 (&acc)[2][2][4][2], const Unit& u, int wr, int wc, int fr, int fq) const {
        const int row0 = u.pm * BM + wr * 64 + fr, col0 = u.pn * BM + wc * 32 + 8 * fq;
#pragma unroll
        for (int ai = 0; ai < 2; ++ai)
#pragma unroll
            for (int m = 0; m < 4; ++m) { bf16_t* rowp = O + (size_t)(row0 + ai * HALF + m * 16) * ldc + col0;
#pragma unroll
                for (int bj = 0; bj < 2; ++bj) *(u32x4*)(rowp + bj * HALF) = pack8(acc[ai][bj][m][0], acc[ai][bj][m][1]); }
    }
};
struct PairOrder {
    StaticOrder so;
    __device__ bool next(int i, Unit& u) const { Unit t; if (!so.next(i >> 1, t)) return false; const int w = i & 1; u.pm = t.pm + 64 * w; u.pn = t.pn + 16 * w; return true; }
    __device__ __forceinline__ void a_ready(const Unit&) const {}
    __device__ __forceinline__ void done(const Unit&) const {}
};
struct RangeOrder {
    StaticOrder so; int base, cut, skip;
    __device__ bool next(int i, Unit& u) const { if (!so.next(i, u)) return false; u.pn = base + (u.pn < cut ? u.pn : u.pn + skip); return true; }
    __device__ __forceinline__ void a_ready(const Unit&) const {}
    __device__ __forceinline__ void done(const Unit&) const {}
};
template <class Epi, class Sched, bool ALIGN_EPI = false, bool SP2 = false, bool I8 = false>
__device__ __forceinline__ void gemm_phase(PG8_LAS unsigned char* lds, const Gemm g, const Sched& S, const Epi& E) {
    const int tid = threadIdx.x, wid = __builtin_amdgcn_readfirstlane(tid >> 6), lane = tid & 63, wr = wid >> 2, wc = wid & 3, fr = lane & 15, fq = lane >> 4;
    const int K = g.K, nt = K / BK;
    unsigned voffA[2], voffB[2];
#pragma unroll
    for (int i = 0; i < 2; ++i) { int R, C; stage_rc(tid * 16 + i * 8192, R, C); const int Rb = Epi::PERM ? ((R & ~31) + perm32(R & 31)) : R;
        voffA[i] = (unsigned)(R * K + C) * 2u; voffB[i] = (unsigned)(Rb * K + C) * 2u; }
    const size_t kstep = (size_t)(BK * 2);
    const size_t hstep = (size_t)HALF * K * 2;
    const size_t tstep = 2 * hstep;
    const unsigned ldsw = (unsigned)wid * 1024u;
    const int aoff = lds_byte(wr * 64 + fr, fq * 8), boff = lds_byte(wc * 32 + fr, fq * 8);
#define PG8_SA(b, h) (((b) * 2 + (h)) * HTB)
#define PG8_SB(b, h) ((4 + (b) * 2 + (h)) * HTB)
#define PG8_STAGE(bufoff, gbase, voff) do { _Pragma("unroll") for (int _i = 0; _i < 2; ++_i) \
        __builtin_amdgcn_global_load_lds((const unsigned*)((const char*)(gbase) + (voff)[_i]), (PG8_LAS unsigned*)(lds + (bufoff) + ldsw + _i * 8192), 16, 0, 0); } while (0)
#define PG8_LDA(dst, b, h) do { _Pragma("unroll") for (int m = 0; m < 4; ++m) _Pragma("unroll") for (int k = 0; k < 2; ++k) dst[m][k] = *(const PG8_LAS bf16x8*)(lds + PG8_SA(b, h) + aoff + m * 2048 + k * 1024); } while (0)
#define PG8_LDB(dst, b, h) do { _Pragma("unroll") for (int n = 0; n < 2; ++n) _Pragma("unroll") for (int k = 0; k < 2; ++k) dst[n][k] = *(const PG8_LAS bf16x8*)(lds + PG8_SB(b, h) + boff + n * 2048 + k * 1024); } while (0)
#define PG8_MMA(ai, bj, At, Bt) do { __builtin_amdgcn_s_setprio(1); _Pragma("unroll") for (int m = 0; m < 4; ++m) _Pragma("unroll") for (int n = 0; n < 2; ++n) _Pragma("unroll") for (int k = 0; k < 2; ++k) \
        { if constexpr (I8) acc[ai][bj][m][n] = __builtin_bit_cast(f32x4, __builtin_amdgcn_mfma_i32_16x16x64_i8(__builtin_bit_cast(i32x4, Bt[n][k]), __builtin_bit_cast(i32x4, At[m][k]), __builtin_bit_cast(i32x4, acc[ai][bj][m][n]), 0, 0, 0)); \
          else acc[ai][bj][m][n] = __builtin_amdgcn_mfma_f32_16x16x32_bf16(Bt[n][k], At[m][k], acc[ai][bj][m][n], 0, 0, 0); } __builtin_amdgcn_s_setprio(0); } while (0)
#define PG8_WAIT_V(n) asm volatile("s_waitcnt vmcnt(" #n ")" ::: "memory")
#define PG8_WAIT_L(n) asm volatile("s_waitcnt lgkmcnt(" #n ")" ::: "memory")
#define PG8_BAR __builtin_amdgcn_s_barrier()
#define PG8_SCHED __builtin_amdgcn_sched_barrier(0)
    Unit cur, nxt; int ui = 0;
    if (!S.next(0, cur)) return;
    f32x4 acc[2][2][4][2];
#pragma unroll
    for (int a = 0; a < 2; ++a)
#pragma unroll
        for (int b = 0; b < 2; ++b)
#pragma unroll
            for (int m = 0; m < 4; ++m)
#pragma unroll
                for (int n = 0; n < 2; ++n) acc[a][b][m][n] = (f32x4){0.f, 0.f, 0.f, 0.f};
    bf16x8 At[4][2], B0[2][2], B1[2][2];
    const char* cA = (const char*)g.A + (size_t)cur.pm * tstep; const char* cB = (const char*)g.Bt + (size_t)cur.pn * tstep;
    S.a_ready(cur);
    if constexpr (SP2) {
        PG8_STAGE(PG8_SB(0, 0), cB, voffB); PG8_STAGE(PG8_SB(0, 1), cB + hstep, voffB); PG8_STAGE(PG8_SA(0, 0), cA, voffA); PG8_STAGE(PG8_SA(0, 1), cA + hstep, voffA);
        if (wr == 1) PG8_BAR;
        PG8_WAIT_V(2); PG8_BAR;
        PG8_STAGE(PG8_SB(1, 0), cB + kstep, voffB); PG8_STAGE(PG8_SA(1, 0), cA + kstep, voffA); PG8_STAGE(PG8_SB(1, 1), cB + hstep + kstep, voffB);
        PG8_WAIT_V(6); PG8_BAR;
    } else {
        PG8_STAGE(PG8_SB(0, 0), cB, voffB); PG8_STAGE(PG8_SA(0, 0), cA, voffA); PG8_STAGE(PG8_SB(0, 1), cB + hstep, voffB); PG8_STAGE(PG8_SA(0, 1), cA + hstep, voffA);
        if (wr == 1) PG8_BAR;
        PG8_WAIT_V(4); PG8_BAR;
        PG8_STAGE(PG8_SB(1, 0), cB + kstep, voffB); PG8_STAGE(PG8_SA(1, 0), cA + kstep, voffA); PG8_STAGE(PG8_SB(1, 1), cB + hstep + kstep, voffB);
        PG8_WAIT_V(6); PG8_BAR;
    }
    for (;;) {
        const bool has_next = S.next(ui + 1, nxt);
        const char* nA = has_next ? (const char*)g.A + (size_t)nxt.pm * tstep : cA; const char* nB = has_next ? (const char*)g.Bt + (size_t)nxt.pn * tstep : cB;
        for (int t = 0; t < nt; t += 2) {
            const bool last = (t == nt - 2);
            const char* a1 = cA + (size_t)(t + 1) * kstep;
            const char* a2 = last ? nA : cA + (size_t)(t + 2) * kstep; const char* b2 = last ? nB : cB + (size_t)(t + 2) * kstep;
            const char* a3 = a2 + kstep; const char* b3 = b2 + kstep;
            if (last && has_next) S.a_ready(nxt);
            if constexpr (SP2) {
            PG8_LDB(B0, 0, 0); PG8_LDB(B1, 0, 1); PG8_SCHED; PG8_LDA(At, 0, 0); PG8_STAGE(PG8_SA(1, 1), a1 + hstep, voffA);
            PG8_WAIT_V(8); PG8_WAIT_L(0); PG8_BAR; PG8_MMA(0, 0, At, B0); PG8_MMA(0, 1, At, B1); PG8_BAR; PG8_SCHED;
            PG8_LDA(At, 0, 1); PG8_STAGE(PG8_SB(0, 0), b2, voffB); PG8_STAGE(PG8_SB(0, 1), b2 + hstep, voffB); PG8_STAGE(PG8_SA(0, 0), a2, voffA);
            PG8_WAIT_V(8); PG8_WAIT_L(0); PG8_BAR; PG8_MMA(1, 0, At, B0); PG8_MMA(1, 1, At, B1); PG8_BAR; PG8_SCHED;
            PG8_LDB(B0, 1, 0); PG8_LDB(B1, 1, 1); PG8_SCHED; PG8_LDA(At, 1, 0); PG8_STAGE(PG8_SA(0, 1), a2 + hstep, voffA);
            PG8_WAIT_V(8); PG8_WAIT_L(0); PG8_BAR; PG8_MMA(0, 0, At, B0); PG8_MMA(0, 1, At, B1); PG8_BAR; PG8_SCHED;
            PG8_LDA(At, 1, 1); PG8_STAGE(PG8_SB(1, 0), b3, voffB); PG8_STAGE(PG8_SB(1, 1), b3 + hstep, voffB); PG8_STAGE(PG8_SA(1, 0), a3, voffA);
            PG8_WAIT_V(8); PG8_WAIT_L(0); PG8_BAR; PG8_MMA(1, 0, At, B0); PG8_MMA(1, 1, At, B1); PG8_BAR; PG8_SCHED;
            } else {
            PG8_LDB(B0, 0, 0); PG8_SCHED; PG8_LDA(At, 0, 0); PG8_STAGE(PG8_SA(1, 1), a1 + hstep, voffA);
            PG8_WAIT_L(8); PG8_BAR; PG8_WAIT_L(0); PG8_MMA(0, 0, At, B0); PG8_BAR; PG8_SCHED;
            PG8_LDB(B1, 0, 1); PG8_STAGE(PG8_SB(0, 0), b2, voffB);
            PG8_BAR; PG8_WAIT_L(0); PG8_MMA(0, 1, At, B1); PG8_BAR;
            PG8_LDA(At, 0, 1); PG8_STAGE(PG8_SA(0, 0), a2, voffA);
            PG8_BAR; PG8_WAIT_L(0); PG8_MMA(1, 0, At, B0); PG8_BAR; PG8_SCHED;
            PG8_STAGE(PG8_SB(0, 1), b2 + hstep, voffB);
            PG8_WAIT_V(6); PG8_BAR; PG8_MMA(1, 1, At, B1); PG8_BAR;
            PG8_LDB(B0, 1, 0); PG8_SCHED; PG8_LDA(At, 1, 0); PG8_STAGE(PG8_SA(0, 1), a2 + hstep, voffA);
            PG8_WAIT_L(8); PG8_BAR; PG8_WAIT_L(0); PG8_MMA(0, 0, At, B0); PG8_BAR; PG8_SCHED;
            PG8_LDB(B1, 1, 1); PG8_STAGE(PG8_SB(1, 0), b3, voffB);
            PG8_BAR; PG8_WAIT_L(0); PG8_MMA(0, 1, At, B1); PG8_BAR;
            PG8_LDA(At, 1, 1); PG8_STAGE(PG8_SA(1, 0), a3, voffA);
            PG8_BAR; PG8_WAIT_L(0); PG8_MMA(1, 0, At, B0); PG8_BAR; PG8_SCHED;
            PG8_STAGE(PG8_SB(1, 1), b3 + hstep, voffB);
            PG8_WAIT_V(6); PG8_BAR; PG8_MMA(1, 1, At, B1); PG8_BAR;
            }
        }
        if constexpr (ALIGN_EPI) { if (wr == 0) PG8_BAR; }
        if constexpr (!Epi::AFTER_DRAIN) { E(acc, cur, wr, wc, fr, fq); S.done(cur); }
        if (!has_next) break;
#pragma unroll
        for (int a = 0; a < 2; ++a)
#pragma unroll
            for (int b = 0; b < 2; ++b)
#pragma unroll
                for (int m = 0; m < 4; ++m)
#pragma unroll
                    for (int n = 0; n < 2; ++n) acc[a][b][m][n] = (f32x4){0.f, 0.f, 0.f, 0.f};
        cur = nxt; cA = nA; cB = nB; ++ui;
        if constexpr (ALIGN_EPI) { if (wr == 1) PG8_BAR; }
    }
    PG8_WAIT_V(0);
    if constexpr (!ALIGN_EPI) { if (wr == 0) PG8_BAR; }
    PG8_BAR;
    if constexpr (Epi::AFTER_DRAIN) { E.fused(acc, cur, wr, wc, fr, fq, lds, wid, lane); S.done(cur); }
#undef PG8_SA
#undef PG8_SB
#undef PG8_STAGE
#undef PG8_LDA
#undef PG8_LDB
#undef PG8_MMA
#undef PG8_WAIT_V
#undef PG8_WAIT_L
#undef PG8_BAR
#undef PG8_SCHED
}
}
#ifndef PG8_SP2
#define PG8_SP2 true
#endif
#ifndef PG8_ALIGN
#define PG8_ALIGN true
#endif
constexpr int NWAVES = 8;
#ifndef MK_ONE_LAUNCH
#define MK_ONE_LAUNCH 1
#endif
constexpr int N_PHASES = 12;
#ifndef NIBBLE_SWAP_DOWN
#define NIBBLE_SWAP_DOWN 0
#endif
#ifndef I8_CFG
#define I8_CFG 1
#endif
#if I8_CFG == 0
constexpr int I8_TILES = 44, I8_CUT = 12, I8_SKIP = 24, BF_BASE = 12, BF_TILES = 24;
#elif I8_CFG == 1
constexpr int I8_TILES = 60, I8_CUT = 12, I8_SKIP = 8, BF_BASE = 12, BF_TILES = 8;
#else
constexpr int I8_TILES = 68, I8_CUT = 68, I8_SKIP = 0, BF_BASE = 12, BF_TILES = 0;
#endif

constexpr int BATCH = 4, SEQ = 4096, D = 4096, M = BATCH * SEQ;
constexpr int HD = 128, NH = 16, NKV = 4, QW = NH * HD, KVW = NKV * HD, CW = 2048, INW = 17408;
constexpr int PH = 8, NKEYS = 128, TOPK = 16, NEXP = NKEYS * NKEYS, PQW = PH * 2 * 128;
constexpr float EPS = 1e-6f;
constexpr size_t SLICE_BYTES = (size_t)NEXP * 128;
constexpr float LOG2E = 1.4426950408889634f;

constexpr size_t MiB = 1u << 20;
constexpr size_t WS_CTL = 0, CTL_ZERO_BYTES = 1 * MiB;
constexpr size_t WS_WIN = 2 * MiB;
constexpr size_t WS_WO = 138 * MiB;
constexpr size_t WS_WOUT = 170 * MiB;
constexpr size_t WS_WQP = 202 * MiB;
constexpr size_t WS_SK = 218 * MiB;
constexpr size_t WS_IDX = 220 * MiB, WS_GATE = 228 * MiB;
constexpr size_t WS_XN = 236 * MiB;
constexpr size_t WS_AB = 364 * MiB;
constexpr size_t WS_Q = 492 * MiB, WS_K = 556 * MiB, WS_V = 572 * MiB, WS_H = 588 * MiB, WS_B = 652 * MiB, WS_C = 716 * MiB;
constexpr size_t WS_GA = 780 * MiB, WS_GC = 908 * MiB;
constexpr size_t WS_T = 492 * MiB;
constexpr size_t WS_X1B = 620 * MiB;
constexpr size_t WS_X2N = 620 * MiB;
constexpr size_t WS_PART = 236 * MiB;
constexpr size_t WS_X2N8 = 492 * MiB;
constexpr size_t WS_CF4 = 780 * MiB;
constexpr size_t WS_QP = 780 * MiB;
constexpr size_t WS_W4D = 1036 * MiB, WS_W4U = 1068 * MiB;
constexpr size_t WS_SCD = 1100 * MiB, WS_SCU = WS_SCD + 65536;
constexpr size_t WS_SX = WS_SCD + 131072, WS_SW = WS_SCD + 262144;
constexpr size_t WS_XN8 = 364 * MiB;
constexpr size_t WS_W8 = 1101 * MiB;
constexpr size_t WS_W8QP = 1169 * MiB;
constexpr size_t WS_SWQ = WS_SCD + 393216, WS_SX2 = WS_SCD + 458752;
constexpr size_t WS_X2I8 = 364 * MiB;
constexpr size_t WS_END = 1177 * MiB;
static_assert(WS_T + (size_t)M * D * 2 <= WS_X2N && WS_X2N + (size_t)M * D * 2 <= WS_GA && WS_QP + (size_t)M * PQW * 2 <= WS_GC, "d_ws overlays");
static_assert(WS_WIN + (size_t)INW * D * 2 <= WS_WO && WS_C + (size_t)M * CW * 2 <= WS_GA && WS_GC + (size_t)M * D * 2 <= WS_END, "d_ws map");
constexpr int CW_XRANK = 8192;
constexpr int CW_BAR = 4096;

constexpr int RING_OFF = 0, RING_BYTES = 131072;
constexpr int LDSCTL_OFF = RING_BYTES, MISC_OFF = LDSCTL_OFF + 320;
constexpr int OBUF_OFF = 132096;
constexpr int LDS_BYTES = 147456;
static_assert(MISC_OFF + 128 <= OBUF_OFF && OBUF_OFF + 8192 <= LDS_BYTES, "LDS map");
#define GAS __attribute__((address_space(1)))
#define LAS __attribute__((address_space(3)))
typedef unsigned short bf16;
typedef unsigned v4u __attribute__((ext_vector_type(4)));
typedef float f32x4 __attribute__((ext_vector_type(4)));
typedef short bf16x8 __attribute__((ext_vector_type(8)));
typedef GAS unsigned gu32;
typedef GAS unsigned long long gu64;
#define RLX_AGENT __ATOMIC_RELAXED, __HIP_MEMORY_SCOPE_AGENT
#define LDS_WAIT() asm volatile("s_waitcnt lgkmcnt(0)" ::: "memory")
#define VM_WAIT() asm volatile("s_waitcnt vmcnt(0)" ::: "memory")
__device__ __forceinline__ unsigned long long rt() { return __builtin_amdgcn_s_memrealtime(); }
__device__ __forceinline__ unsigned f2bf(float f) { unsigned u = __builtin_bit_cast(unsigned, f); return (u + 0x7fffu + ((u >> 16) & 1u)) >> 16; }
__device__ __forceinline__ unsigned pk2(float lo, float hi) { return f2bf(lo) | (f2bf(hi) << 16); }

#define XB_TMO      128
#define XB_XCNT(j)  (256  + 64 * (j))
#define XB_XSUB(j)  (1280 + 64 * (j))
#define XB_XGEN(j)  (2304 + 64 * (j))
#define XB_TOP      3328
#define XB_TOPGEN   3392
#define XCD_BAR_WORDS 3456
#define XB_SPIN_CAP (1u << 18)

__device__ __forceinline__ unsigned xb_ld(unsigned* p)              { return __hip_atomic_load(p, __ATOMIC_RELAXED, __HIP_MEMORY_SCOPE_AGENT); }
__device__ __forceinline__ unsigned xb_add(unsigned* p, unsigned v) { return __hip_atomic_fetch_add(p, v, __ATOMIC_RELAXED, __HIP_MEMORY_SCOPE_AGENT); }
__device__ __forceinline__ unsigned xb_xcc_id() { return (unsigned)__builtin_amdgcn_s_getreg((3 << 11) | 20) & 0xFu; }
#define XB_SPIN(cond, bar) do { unsigned _sp = 0; while (cond) { __builtin_amdgcn_s_sleep(1); \
    if ((++_sp & 255u) == 0u) { if (xb_ld(&(bar)[XB_TMO])) break; if (_sp > XB_SPIN_CAP) { atomicAdd(&(bar)[XB_TMO], 1u); break; } } } } while (0)

struct XcdBarrier {
    unsigned* bar; unsigned x;
    volatile LAS unsigned* st;
};

__device__ __forceinline__ XcdBarrier xcd_barrier_post(unsigned* bar, volatile LAS unsigned* st) {
    XcdBarrier b; b.bar = bar; b.x = xb_xcc_id(); b.st = st;
    if (threadIdx.x == 0) (void)xb_add(&bar[XB_XCNT(b.x)], 1u);
    return b;
}
__device__ __forceinline__ void xcd_barrier_complete(unsigned* bar, unsigned x, unsigned& nloc, unsigned& nx) {
    const unsigned G = gridDim.x * gridDim.y * gridDim.z;
    unsigned sum, cnt, mine, sp = 0u;
    for (;;) {
        sum = 0u; cnt = 0u; mine = 0u;
#pragma unroll
        for (unsigned j = 0; j < 16; ++j) { const unsigned c = xb_ld(&bar[XB_XCNT(j)]); sum += c; cnt += (c > 0u) ? 1u : 0u; mine = (j == x) ? c : mine; }
        if (sum == G) break;
        __builtin_amdgcn_s_sleep(1);
        if ((++sp & 255u) == 0u) { if (xb_ld(&bar[XB_TMO])) break; if (sp > XB_SPIN_CAP) { atomicAdd(&bar[XB_TMO], 1u); break; } }
    }
    nloc = mine > 0u ? mine : 1u; nx = cnt > 0u ? cnt : 1u;
}

__device__ __forceinline__ void xcd_barrier(const XcdBarrier& b) {
    asm volatile("s_waitcnt vmcnt(0)" ::: "memory");
    __syncthreads();
    if (threadIdx.x == 0) {
        unsigned* bar = b.bar;
        __builtin_amdgcn_s_waitcnt(0);
        unsigned nloc = b.st[0], nx = b.st[1];
        if (nloc == 0u) { xcd_barrier_complete(bar, b.x, nloc, nx); b.st[0] = nloc; b.st[1] = nx; }
        const unsigned old = xb_add(&bar[XB_XSUB(b.x)], 1u);
        const unsigned gen = old / nloc;
        if (old + 1u == (gen + 1u) * nloc) {
            __builtin_amdgcn_fence(__ATOMIC_RELEASE, "agent");
            asm volatile("s_waitcnt vmcnt(0)" ::: "memory");
            const unsigned og = xb_add(&bar[XB_TOP], 1u);
            const unsigned tg = og / nx;
            if (og + 1u == (tg + 1u) * nx) xb_add(&bar[XB_TOPGEN], 1u);
            else XB_SPIN(xb_ld(&bar[XB_TOPGEN]) == tg, bar);
            __builtin_amdgcn_fence(__ATOMIC_ACQUIRE, "agent");
            xb_add(&bar[XB_XGEN(b.x)], 1u);
            asm volatile("s_waitcnt vmcnt(0)" ::: "memory");
        } else {
            XB_SPIN(xb_ld(&bar[XB_XGEN(b.x)]) == gen, bar);
            __builtin_amdgcn_fence(__ATOMIC_ACQUIRE, "agent");
            asm volatile("s_waitcnt vmcnt(0)" ::: "memory");
        }
    }
    __syncthreads();
}
typedef unsigned u32x2_t __attribute__((ext_vector_type(2)));
typedef short v4i16_t __attribute__((ext_vector_type(4)));
typedef unsigned long long u64;
typedef float f32x2_t __attribute__((ext_vector_type(2)));
typedef int i32x4_t __attribute__((ext_vector_type(4)));
struct Frame {
    LAS unsigned char* lds;
    volatile LAS unsigned* MISC;
    gu32* ctl;
    unsigned char* ws;
    int tid, lane, wave;
    int vcu, G;
    const float *x, *g1, *w_in, *gq, *gk, *sink, *conv_w, *w_oa, *w_oc, *w_out, *g2, *w_qp, *subk, *w_down, *w_up;
    float* out;
};
#define WSP(type, off) ((type*)(F.ws + (off)))
using pg8::cvt_pk_bf16; using pg8::pack8; using pg8::unpack8;

__device__ __forceinline__ float wave_sum(float v) {
#pragma unroll
    for (int o = 1; o < 64; o <<= 1) v += __shfl_xor(v, o);
    return v;
}
__device__ __forceinline__ float dot4(const f32x4 a, const f32x4 b) { return (a[0] * b[0] + a[1] * b[1]) + (a[2] * b[2] + a[3] * b[3]); }
__device__ __forceinline__ float bflo(unsigned w) { return __uint_as_float(w << 16); }
__device__ __forceinline__ float bfhi(unsigned w) { return __uint_as_float(w & 0xffff0000u); }

typedef int v2i32_t __attribute__((ext_vector_type(2)));
__device__ __forceinline__ bool tr4_selfcheck(LAS unsigned char* tp, int lane) {
    const int g = lane >> 4, j = lane & 15;
    unsigned lo = 0u, hi = 0u;
#pragma unroll
    for (int c = 0; c < 8; ++c) { lo |= (unsigned)((j * 5 + c * 3 + g + 1) & 15) << (4 * c); hi |= (unsigned)((j * 5 + (c + 8) * 3 + g + 1) & 15) << (4 * c); }
    *(LAS u32x2_t*)(tp + lane * 8) = (u32x2_t){lo, hi};
    LDS_WAIT(); asm volatile("" ::: "memory");
    const v2i32_t rv = __builtin_amdgcn_ds_read_tr4_b64_v2i32((LAS v2i32_t*)(tp + lane * 8));
    bool ok = true;
#pragma unroll
    for (int e = 0; e < 8; ++e) { ok = ok && ((((unsigned)rv.x >> (4 * e)) & 15u) == (unsigned)((e * 5 + j * 3 + g + 1) & 15)) && ((((unsigned)rv.y >> (4 * e)) & 15u) == (unsigned)(((e + 8) * 5 + j * 3 + g + 1) & 15)); }
    return __all(ok);
}

__device__ __forceinline__ void p0_transpose_item(const float* W, int K, int N, bf16* WT, int row_off, LAS float* scr, int item, int lane) {
    const int nblk = N / 32, kb = item / nblk, nb = item % nblk, k0 = 64 * kb, n0 = 32 * nb;
#pragma unroll 8
    for (int i = 0; i < 32; ++i) { const int kk = 2 * i + (lane >> 5); scr[kk * 33 + (lane & 31)] = W[(size_t)(k0 + kk) * N + n0 + (lane & 31)]; }
    LDS_WAIT(); asm volatile("" ::: "memory");
    const int c = lane & 7;
#pragma unroll
    for (int j = 0; j < 4; ++j) { const int n = (lane >> 3) + 8 * j; const LAS float* s = scr + (8 * c) * 33 + n;
        v4u o; o.x = cvt_pk_bf16(s[0 * 33], s[1 * 33]); o.y = cvt_pk_bf16(s[2 * 33], s[3 * 33]); o.z = cvt_pk_bf16(s[4 * 33], s[5 * 33]); o.w = cvt_pk_bf16(s[6 * 33], s[7 * 33]);
        *(GAS v4u*)(WT + (size_t)(row_off + n0 + n) * K + k0 + 8 * c) = o; }
    LDS_WAIT(); asm volatile("" ::: "memory");
}
template <int QMODE  > __device__ __forceinline__ void rms_row_to_bf16(const float* xrow, const float* g, bf16* orow, unsigned* q8row, float* sxp, int lane) {
    const GAS f32x4* xr = (const GAS f32x4*)xrow + lane; const GAS f32x4* gr = (const GAS f32x4*)g + lane;
    f32x4 v[16]; float s = 0.f;
#pragma unroll
    for (int j = 0; j < 16; ++j) { v[j] = xr[64 * j]; s += dot4(v[j], v[j]); }
    const float r = rsqrtf(wave_sum(s) * (1.f / D) + EPS);
    GAS u32x2_t* o8 = (GAS u32x2_t*)orow + lane; float am = 0.f;
#pragma unroll
    for (int j = 0; j < 16; ++j) { v[j] = v[j] * r * gr[64 * j]; u32x2_t w; w.x = cvt_pk_bf16(v[j][0], v[j][1]); w.y = cvt_pk_bf16(v[j][2], v[j][3]); o8[64 * j] = w;
        am = fmaxf(am, fmaxf(fmaxf(fabsf(v[j][0]), fabsf(v[j][1])), fmaxf(fabsf(v[j][2]), fabsf(v[j][3])))); }
    if constexpr (QMODE == 2) {
#pragma unroll
        for (int j = 0; j < 16; ++j) { int p = 0; p = __builtin_amdgcn_cvt_pk_fp8_f32(v[j][0], v[j][1], p, false); p = __builtin_amdgcn_cvt_pk_fp8_f32(v[j][2], v[j][3], p, true); ((GAS unsigned*)q8row)[64 * j + lane] = (unsigned)p; }
    }
    if constexpr (QMODE == 1) {
#pragma unroll
        for (int o = 1; o < 64; o <<= 1) am = fmaxf(am, __shfl_xor(am, o));
        const float qs = am > 0.f ? 127.0f / am : 0.f;
#pragma unroll
        for (int j = 0; j < 16; ++j) { const int q0 = (int)__builtin_rintf(v[j][0] * qs), q1 = (int)__builtin_rintf(v[j][1] * qs), q2 = (int)__builtin_rintf(v[j][2] * qs), q3 = (int)__builtin_rintf(v[j][3] * qs);
            ((GAS unsigned*)q8row)[64 * j + lane] = (unsigned)(q0 & 255) | ((unsigned)(q1 & 255) << 8) | ((unsigned)(q2 & 255) << 16) | ((unsigned)q3 << 24); }
        if (lane == 0) *sxp = am * (1.0f / 127.0f);
    }
}
__device__ __forceinline__ void rms2_row(const bf16* xrow, const float* g, unsigned char* q8row, float* sxp, unsigned char* x4row, int lane) {
    const GAS v4u* xr = (const GAS v4u*)xrow + lane; const GAS f32x4* gr = (const GAS f32x4*)g + 2 * lane;
    f32x4 v[8][2]; float s = 0.f;
#pragma unroll
    for (int j = 0; j < 8; ++j) { unpack8(xr[64 * j], v[j][0], v[j][1]); s += dot4(v[j][0], v[j][0]) + dot4(v[j][1], v[j][1]); }
    const float r = rsqrtf(wave_sum(s) * (1.f / D) + EPS);
    float am = 0.f;
#pragma unroll
    for (int j = 0; j < 8; ++j) { v[j][0] = v[j][0] * r * gr[128 * j]; v[j][1] = v[j][1] * r * gr[128 * j + 1];
#pragma unroll
        for (int e = 0; e < 4; ++e) am = fmaxf(am, fmaxf(fabsf(v[j][0][e]), fabsf(v[j][1][e]))); }
#pragma unroll
    for (int o = 1; o < 64; o <<= 1) am = fmaxf(am, __shfl_xor(am, o));
    const float qs = am > 0.f ? 127.0f / am : 0.f;
    if (lane == 0) *sxp = am * (1.0f / 127.0f);
#pragma unroll
    for (int j = 0; j < 8; ++j) {
        const f32x4 y0 = v[j][0], y1 = v[j][1];
        { u32x2_t w;
          w.x = (unsigned)((int)__builtin_rintf(y0[0] * qs) & 255) | ((unsigned)((int)__builtin_rintf(y0[1] * qs) & 255) << 8) | ((unsigned)((int)__builtin_rintf(y0[2] * qs) & 255) << 16) | ((unsigned)(int)__builtin_rintf(y0[3] * qs) << 24);
          w.y = (unsigned)((int)__builtin_rintf(y1[0] * qs) & 255) | ((unsigned)((int)__builtin_rintf(y1[1] * qs) & 255) << 8) | ((unsigned)((int)__builtin_rintf(y1[2] * qs) & 255) << 16) | ((unsigned)(int)__builtin_rintf(y1[3] * qs) << 24);
          ((GAS u32x2_t*)q8row)[64 * j + lane] = w; }
        unsigned hi = 0u, lo = 0u;
        hi = __builtin_amdgcn_cvt_scalef32_pk_fp4_f32(hi, y0[0], y0[1], 1.0f, 0); hi = __builtin_amdgcn_cvt_scalef32_pk_fp4_f32(hi, y0[2], y0[3], 1.0f, 1);
        hi = __builtin_amdgcn_cvt_scalef32_pk_fp4_f32(hi, y1[0], y1[1], 1.0f, 2); hi = __builtin_amdgcn_cvt_scalef32_pk_fp4_f32(hi, y1[2], y1[3], 1.0f, 3);
        const f32x2_t d0 = __builtin_amdgcn_cvt_scalef32_pk_f32_fp4(hi, 1.0f, 0), d1 = __builtin_amdgcn_cvt_scalef32_pk_f32_fp4(hi, 1.0f, 1), d2 = __builtin_amdgcn_cvt_scalef32_pk_f32_fp4(hi, 1.0f, 2), d3 = __builtin_amdgcn_cvt_scalef32_pk_f32_fp4(hi, 1.0f, 3);
        lo = __builtin_amdgcn_cvt_scalef32_pk_fp4_f32(lo, (y0[0] - d0.x) * 8.f, (y0[1] - d0.y) * 8.f, 1.0f, 0); lo = __builtin_amdgcn_cvt_scalef32_pk_fp4_f32(lo, (y0[2] - d1.x) * 8.f, (y0[3] - d1.y) * 8.f, 1.0f, 1);
        lo = __builtin_amdgcn_cvt_scalef32_pk_fp4_f32(lo, (y1[0] - d2.x) * 8.f, (y1[1] - d2.y) * 8.f, 1.0f, 2); lo = __builtin_amdgcn_cvt_scalef32_pk_fp4_f32(lo, (y1[2] - d3.x) * 8.f, (y1[3] - d3.y) * 8.f, 1.0f, 3);
        unsigned char* const xd = x4row + (size_t)(2 * j + (lane >> 5)) * ((size_t)M * 256) + (lane & 31) * 4;
        *(GAS unsigned*)xd = hi; *(GAS unsigned*)(xd + 128) = lo;
    }
}
__device__ __forceinline__ void quant_w8(Frame& F) {
    const int gw = F.vcu * NWAVES + F.wave, NGW = F.G * NWAVES, lane = F.lane;
    for (int nn = gw; nn < INW + PQW; nn += NGW) {
        const bool qp = nn >= INW; const int n = qp ? nn - INW : nn;
        if (!qp && n >= BF_BASE * 256 && n < (BF_BASE + BF_TILES) * 256) continue;
        const GAS v4u* src = (const GAS v4u*)((qp ? WSP(const bf16, WS_WQP) : WSP(const bf16, WS_WIN)) + (size_t)n * D) + lane;
        f32x4 lo[8], hi[8]; float am = 0.f;
#pragma unroll
        for (int j = 0; j < 8; ++j) { unpack8(src[64 * j], lo[j], hi[j]);
            am = fmaxf(am, fmaxf(fmaxf(fmaxf(fabsf(lo[j][0]), fabsf(lo[j][1])), fmaxf(fabsf(lo[j][2]), fabsf(lo[j][3]))), fmaxf(fmaxf(fabsf(hi[j][0]), fabsf(hi[j][1])), fmaxf(fabsf(hi[j][2]), fabsf(hi[j][3]))))); }
#pragma unroll
        for (int o = 1; o < 64; o <<= 1) am = fmaxf(am, __shfl_xor(am, o));
        const float qs = am > 0.f ? 127.0f / am : 0.f;
        GAS u32x2_t* dst = (GAS u32x2_t*)(F.ws + (qp ? WS_W8QP : WS_W8) + (size_t)n * D) + lane;
#pragma unroll
        for (int j = 0; j < 8; ++j) { u32x2_t w;
            w.x = (unsigned)((int)__builtin_rintf(lo[j][0] * qs) & 255) | ((unsigned)((int)__builtin_rintf(lo[j][1] * qs) & 255) << 8) | ((unsigned)((int)__builtin_rintf(lo[j][2] * qs) & 255) << 16) | ((unsigned)(int)__builtin_rintf(lo[j][3] * qs) << 24);
            w.y = (unsigned)((int)__builtin_rintf(hi[j][0] * qs) & 255) | ((unsigned)((int)__builtin_rintf(hi[j][1] * qs) & 255) << 8) | ((unsigned)((int)__builtin_rintf(hi[j][2] * qs) & 255) << 16) | ((unsigned)(int)__builtin_rintf(hi[j][3] * qs) << 24);
            dst[64 * j] = w; }
        if (lane == 0) (qp ? WSP(float, WS_SWQ) : WSP(float, WS_SW))[n] = am * (1.0f / 127.0f);
    }
}
__device__ __forceinline__ void p0_prologue(Frame& F) {
    LAS float* scr = (LAS float*)(F.lds + RING_OFF + F.wave * 16384);
    const int gw = F.vcu * NWAVES + F.wave, NGW = F.G * NWAVES;
    constexpr int I_IN = (D / 64) * (INW / 32), I_OA = (QW / 64) * (D / 32), I_OC = (CW / 64) * (D / 32), I_OUT = (D / 64) * (D / 32), I_QP = (D / 64) * (PQW / 32);
    constexpr int NITEMS = I_IN + I_OA + I_OC + I_OUT + I_QP;
    bf16* Win_t = WSP(bf16, WS_WIN); bf16* Wo_t = WSP(bf16, WS_WO); bf16* Wout_t = WSP(bf16, WS_WOUT); bf16* Wqp_t = WSP(bf16, WS_WQP);
    for (int it = gw; it < NITEMS; it += NGW) {
        int r = it;
        if (r < I_IN) { p0_transpose_item(F.w_in, D, INW, Win_t, 0, scr, r, F.lane); continue; } r -= I_IN;
        if (r < I_OA) { p0_transpose_item(F.w_oa, QW, D, Wo_t, 0, scr, r, F.lane); continue; } r -= I_OA;
        if (r < I_OC) { p0_transpose_item(F.w_oc, CW, D, Wo_t, D, scr, r, F.lane); continue; } r -= I_OC;
        if (r < I_OUT) { p0_transpose_item(F.w_out, D, D, Wout_t, 0, scr, r, F.lane); continue; } r -= I_OUT;
        p0_transpose_item(F.w_qp, D, PQW, Wqp_t, 0, scr, r, F.lane);
    }
    {
        bf16* SK = WSP(bf16, WS_SK); const int nth = F.G * NWAVES * 64, gt = gw * 64 + F.lane;
        for (int i = gt; i < PH * 2 * NKEYS * 128 / 4; i += nth) { const f32x4 v = ((const GAS f32x4*)F.subk)[i]; u32x2_t w; w.x = cvt_pk_bf16(v[0], v[1]); w.y = cvt_pk_bf16(v[2], v[3]); ((GAS u32x2_t*)SK)[i] = w; }
    }
    bf16* XN = WSP(bf16, WS_XN);
    for (int m = gw; m < M; m += NGW) rms_row_to_bf16<1>(F.x + (size_t)m * D, F.g1, XN + (size_t)m * D, (unsigned*)(F.ws + WS_XN8 + (size_t)m * D), WSP(float, WS_SX) + m, F.lane);
    for (int r = gw; r < 2 * NEXP; r += NGW) {
        const bool up = r >= NEXP; const int rr = up ? r - NEXP : r;
        const GAS f32x4* src = (const GAS f32x4*)((up ? F.w_up : F.w_down) + (size_t)rr * D) + 2 * F.lane;
        f32x4 v[16]; float am = 0.f;
#pragma unroll
        for (int i = 0; i < 8; ++i) { v[2 * i] = src[128 * i]; v[2 * i + 1] = src[128 * i + 1]; }
#pragma unroll
        for (int i = 0; i < 16; ++i) am = fmaxf(am, fmaxf(fmaxf(fabsf(v[i][0]), fabsf(v[i][1])), fmaxf(fabsf(v[i][2]), fabsf(v[i][3]))));
#pragma unroll
        for (int o = 1; o < 64; o <<= 1) am = fmaxf(am, __shfl_xor(am, o));
        const float sc = am > 0.f ? 6.0f / am : 1.0f;
        unsigned char* const dstb = F.ws + (up ? WS_W4U : WS_W4D) + (size_t)rr * 128 + (size_t)(F.lane >> 5) * SLICE_BYTES + (F.lane & 31) * 4;
#pragma unroll
        for (int i = 0; i < 8; ++i) { unsigned p = 0u;
            if (NIBBLE_SWAP_DOWN && !up) {
            p = __builtin_amdgcn_cvt_scalef32_pk_fp4_f32(p, v[2 * i][1] * sc, v[2 * i][0] * sc, 1.0f, 0); p = __builtin_amdgcn_cvt_scalef32_pk_fp4_f32(p, v[2 * i][3] * sc, v[2 * i][2] * sc, 1.0f, 1);
            p = __builtin_amdgcn_cvt_scalef32_pk_fp4_f32(p, v[2 * i + 1][1] * sc, v[2 * i + 1][0] * sc, 1.0f, 2); p = __builtin_amdgcn_cvt_scalef32_pk_fp4_f32(p, v[2 * i + 1][3] * sc, v[2 * i + 1][2] * sc, 1.0f, 3);
            } else {
            p = __builtin_amdgcn_cvt_scalef32_pk_fp4_f32(p, v[2 * i][0] * sc, v[2 * i][1] * sc, 1.0f, 0); p = __builtin_amdgcn_cvt_scalef32_pk_fp4_f32(p, v[2 * i][2] * sc, v[2 * i][3] * sc, 1.0f, 1);
            p = __builtin_amdgcn_cvt_scalef32_pk_fp4_f32(p, v[2 * i + 1][0] * sc, v[2 * i + 1][1] * sc, 1.0f, 2); p = __builtin_amdgcn_cvt_scalef32_pk_fp4_f32(p, v[2 * i + 1][2] * sc, v[2 * i + 1][3] * sc, 1.0f, 3);
            }
            *(GAS unsigned*)(dstb + (size_t)(2 * i) * SLICE_BYTES) = p; }
        if (F.lane == 0) WSP(float, up ? WS_SCU : WS_SCD)[rr] = am > 0.f ? am * (1.0f / 6.0f) : 1.0f;
    }
}

__device__ __forceinline__ unsigned off_b(unsigned row, unsigned ch) { return 256u * row + 16u * (ch ^ (((row & 3u) << 2) | ((row >> 2) & 3u))); }
__device__ __forceinline__ unsigned tr_addr16(unsigned lane, unsigned c, unsigned ks, unsigned t) {
    const unsigned g = lane >> 4, q = (lane & 15u) >> 2, p = lane & 3u;
    return off_b(32u * ks + 8u * g + 4u * t + q, 2u * c + (p >> 1)) + 8u * (p & 1u);
}
__device__ __forceinline__ v4i16_t tr_read(LAS unsigned char* p) { return __builtin_amdgcn_ds_read_tr16_b64_v4i16((LAS v4i16_t*)p); }
#define MFMA16(a, b, c) __builtin_amdgcn_mfma_f32_16x16x32_bf16((a), (b), (c), 0, 0, 0)

template <int PROBE> __device__ __forceinline__ void attn_unit(Frame& F, const int U) {
    const int lane = F.lane, wave = F.wave, c = lane & 15, hg = lane >> 4, tid = F.tid;
    const int hp = U & 1, kvh = (U >> 1) & 3, nblk = (U >> 3) & 31, b = U >> 8;
    const int hq = kvh * 4 + hp * 2 + (wave >> 2), i0 = (wave & 3) * 32;
    const size_t tok0 = (size_t)b * SEQ + (size_t)nblk * 128;
    const bf16* QB = WSP(const bf16, WS_Q); const bf16* KB = WSP(const bf16, WS_K); const bf16* VB = WSP(const bf16, WS_V); bf16* OB = PROBE ? WSP(bf16, WS_XN) : WSP(bf16, WS_AB);
    bf16x8 qf[2][4];
    {
        float g[4][8];
#pragma unroll
        for (int ks = 0; ks < 4; ++ks) { const f32x4 a = *(const GAS f32x4*)(F.gq + 32 * ks + 8 * hg), bb = *(const GAS f32x4*)(F.gq + 32 * ks + 8 * hg + 4);
#pragma unroll
            for (int e = 0; e < 4; ++e) { g[ks][e] = a[e]; g[ks][4 + e] = bb[e]; } }
#pragma unroll
        for (int qt = 0; qt < 2; ++qt) {
            const bf16* qrow = QB + (tok0 + i0 + 16 * qt + c) * QW + hq * HD + 8 * hg;
            f32x4 lo[4], hi[4]; float ss = 0.f;
#pragma unroll
            for (int ks = 0; ks < 4; ++ks) { unpack8(*(const GAS v4u*)(qrow + 32 * ks), lo[ks], hi[ks]); ss += dot4(lo[ks], lo[ks]) + dot4(hi[ks], hi[ks]); }
            ss += __shfl_xor(ss, 16); ss += __shfl_xor(ss, 32);
            const float r = rsqrtf(ss * (1.f / HD) + EPS) * (0.08838834764831845f * LOG2E);
#pragma unroll
            for (int ks = 0; ks < 4; ++ks) { f32x4 a, bb;
#pragma unroll
                for (int e = 0; e < 4; ++e) { a[e] = lo[ks][e] * r * g[ks][e]; bb[e] = hi[ks][e] * r * g[ks][4 + e]; }
                qf[qt][ks] = __builtin_bit_cast(bf16x8, pack8(a, bb)); }
        }
    }
    const float slope2 = __builtin_amdgcn_exp2f(-0.5f * (float)(hq + 1)) * LOG2E;
    const float sink2 = F.sink[hq] * LOG2E;
    float mrun[2] = {sink2, sink2}, lrun[2]; lrun[0] = lrun[1] = (hg == 0) ? 1.f : 0.f;
    f32x4 acc[8][2];
#pragma unroll
    for (int dt = 0; dt < 8; ++dt) { acc[dt][0] = (f32x4){0.f, 0.f, 0.f, 0.f}; acc[dt][1] = (f32x4){0.f, 0.f, 0.f, 0.f}; }
    const f32x4 gk0 = *(const GAS f32x4*)(F.gk + (tid & 15) * 8), gk1 = *(const GAS f32x4*)(F.gk + (tid & 15) * 8 + 4);
    __syncthreads();
    int bufi = 0;
#pragma unroll 1
    for (int kbi = -1; kbi <= 1; ++kbi) {
        const int kb = nblk + kbi; if (kb < 0 || kb >= SEQ / 128) continue;
        LAS unsigned char* Kl = F.lds + RING_OFF + bufi * 65536; LAS unsigned char* Vl = Kl + 32768; bufi ^= 1;
#pragma unroll
        for (int it = 0; it < (PROBE == 3 ? 0 : 4); ++it) {
            const int row = (tid >> 4) + 32 * it, ch = tid & 15;
            const size_t src = ((size_t)b * SEQ + (size_t)kb * 128 + row) * KVW + kvh * HD + ch * 8;
            f32x4 k0, k1; unpack8(*(const GAS v4u*)(KB + src), k0, k1);
            float ss = dot4(k0, k0) + dot4(k1, k1);
            ss += __shfl_xor(ss, 1); ss += __shfl_xor(ss, 2); ss += __shfl_xor(ss, 4); ss += __shfl_xor(ss, 8);
            const float r = rsqrtf(ss * (1.f / HD) + EPS);
            *(LAS v4u*)(Kl + off_b(row, ch)) = pack8(k0 * r * gk0, k1 * r * gk1);
            *(LAS v4u*)(Vl + off_b(row, ch)) = *(const GAS v4u*)(VB + src);
        }
        __syncthreads();
        const int ks_lo = kbi < 0 ? (i0 >> 5) : 0, ks_hi = kbi > 0 ? (i0 >> 5) + 1 : 4;
#pragma unroll 2
        for (int ks32 = (PROBE == 2 ? ks_hi : ks_lo); ks32 < ks_hi; ++ks32) {
            f32x4 sa[2], sb[2];
            sa[0] = sa[1] = sb[0] = sb[1] = (f32x4){0.f, 0.f, 0.f, 0.f};
            const unsigned krow = 32u * ks32 + 8u * (c >> 2) + (c & 3);
#pragma unroll
            for (int ks = 0; ks < 4; ++ks) {
                const bf16x8 ka = *(const LAS bf16x8*)(Kl + off_b(krow, 4 * ks + hg)), kb2 = *(const LAS bf16x8*)(Kl + off_b(krow + 4, 4 * ks + hg));
#pragma unroll
                for (int qt = 0; qt < 2; ++qt) { sa[qt] = MFMA16(ka, qf[qt][ks], sa[qt]); sb[qt] = MFMA16(kb2, qf[qt][ks], sb[qt]); }
            }
            bf16x8 pf[2];
#pragma unroll
            for (int qt = 0; qt < 2; ++qt) {
                float s[8] = {sa[qt][0], sa[qt][1], sa[qt][2], sa[qt][3], sb[qt][0], sb[qt][1], sb[qt][2], sb[qt][3]};
                const int rel0 = kbi * 128 + 32 * ks32 + 8 * hg - (i0 + 16 * qt + c);
                float mx = -INFINITY;
#pragma unroll
                for (int j = 0; j < 8; ++j) { const int rel = rel0 + j, dist = rel < 0 ? -rel : rel; const float sv = s[j] - slope2 * (float)dist; s[j] = (dist <= 128) ? sv : -INFINITY; mx = fmaxf(mx, s[j]); }
                mx = fmaxf(mx, __shfl_xor(mx, 16)); mx = fmaxf(mx, __shfl_xor(mx, 32));
                const float mn = fmaxf(mrun[qt], mx), alpha = __builtin_amdgcn_exp2f(mrun[qt] - mn); mrun[qt] = mn;
                float ps = 0.f;
#pragma unroll
                for (int j = 0; j < 8; ++j) { s[j] = __builtin_amdgcn_exp2f(s[j] - mn); ps += s[j]; }
                lrun[qt] = lrun[qt] * alpha + ps;
                pf[qt] = __builtin_bit_cast(bf16x8, pack8((f32x4){s[0], s[1], s[2], s[3]}, (f32x4){s[4], s[5], s[6], s[7]}));
#pragma unroll
                for (int dt = 0; dt < 8; ++dt) acc[dt][qt] = acc[dt][qt] * alpha;
            }
#pragma unroll
            for (int dt = 0; dt < 8; ++dt) {
                const v4i16_t vlo = tr_read(Vl + tr_addr16(lane, dt, ks32, 0)), vhi = tr_read(Vl + tr_addr16(lane, dt, ks32, 1));
                const bf16x8 vf = {vlo[0], vlo[1], vlo[2], vlo[3], vhi[0], vhi[1], vhi[2], vhi[3]};
#pragma unroll
                for (int qt = 0; qt < 2; ++qt) acc[dt][qt] = MFMA16(vf, pf[qt], acc[dt][qt]);
            }
        }
    }
#pragma unroll
    for (int qt = 0; qt < 2; ++qt) {
        float l = lrun[qt]; l += __shfl_xor(l, 16); l += __shfl_xor(l, 32);
        const float inv = 1.0f / l;
        bf16* orow = OB + (tok0 + i0 + 16 * qt + c) * QW + hq * HD + 4 * hg;
#pragma unroll
        for (int dt = 0; dt < 8; ++dt) { const f32x4 o = acc[dt][qt] * inv; u32x2_t w; w.x = cvt_pk_bf16(o[0], o[1]); w.y = cvt_pk_bf16(o[2], o[3]); *(GAS u32x2_t*)(orow + 16 * dt) = w; }
    }
}
__device__ __forceinline__ void conv_phase(Frame& F) {
    const bf16* HB = WSP(const bf16, WS_H); const bf16* BB = WSP(const bf16, WS_B); const bf16* CB = WSP(const bf16, WS_C); bf16* OC = WSP(bf16, WS_AB) + (size_t)M * CW;
    const unsigned nchunk = (unsigned)M * (CW / 8);
    for (unsigned e = (unsigned)F.vcu * 512u + (unsigned)F.tid; e < nchunk; e += (unsigned)F.G * 512u) {
        const int t = (int)(e >> 8), cc = (int)(e & 255u) * 8, tl = t & (SEQ - 1);
        const size_t o = (size_t)t * CW + cc;
        f32x4 h0, h1, c0, c1, up0, up1, un0, un1;
        unpack8(*(const GAS v4u*)(HB + o), h0, h1); unpack8(*(const GAS v4u*)(CB + o), c0, c1);
        const f32x4 uc0 = h0 * c0, uc1 = h1 * c1;
        up0 = up1 = un0 = un1 = (f32x4){0.f, 0.f, 0.f, 0.f};
        if (tl > 0) { unpack8(*(const GAS v4u*)(HB + o - CW), h0, h1); unpack8(*(const GAS v4u*)(CB + o - CW), c0, c1); up0 = h0 * c0; up1 = h1 * c1; }
        if (tl < SEQ - 1) { unpack8(*(const GAS v4u*)(HB + o + CW), h0, h1); unpack8(*(const GAS v4u*)(CB + o + CW), c0, c1); un0 = h0 * c0; un1 = h1 * c1; }
        const GAS f32x4* w = (const GAS f32x4*)(F.conv_w + cc);
        const f32x4 y0 = w[0] * up0 + w[CW / 4] * uc0 + w[2 * CW / 4] * un0, y1 = w[1] * up1 + w[CW / 4 + 1] * uc1 + w[2 * CW / 4 + 1] * un1;
        f32x4 b0, b1; unpack8(*(const GAS v4u*)(BB + o), b0, b1);
        *(GAS v4u*)(OC + o) = pack8(b0 * y0, b1 * y1);
    }
}

__device__ __forceinline__ unsigned ordf(float f) { const unsigned u = __float_as_uint(f); return u ^ ((u >> 31) ? 0xFFFFFFFFu : 0x80000000u); }
__device__ __forceinline__ float unordf(unsigned k) { return __uint_as_float((k & 0x80000000u) ? (k ^ 0x80000000u) : ~k); }
__device__ __forceinline__ u64 shfl64_xor(u64 v, int m) { const unsigned lo = __shfl_xor((unsigned)v, m), hi = __shfl_xor((unsigned)(v >> 32), m); return ((u64)hi << 32) | lo; }
template <int N> __device__ __forceinline__ void bitonic_merge_desc(unsigned (&a)[N]) {
#pragma unroll
    for (int j = N >> 1; j > 0; j >>= 1)
#pragma unroll
        for (int i = 0; i < N; ++i) { const int l = i ^ j; if (l > i) { const unsigned hi = a[i] > a[l] ? a[i] : a[l], lo = a[i] > a[l] ? a[l] : a[i]; a[i] = hi; a[l] = lo; } }
}
template <int N> __device__ __forceinline__ void bitonic_sort_desc(unsigned (&a)[N]) {
#pragma unroll
    for (int k = 2; k <= N; k <<= 1)
#pragma unroll
        for (int j = k >> 1; j > 0; j >>= 1)
#pragma unroll
            for (int i = 0; i < N; ++i) { const int l = i ^ j; if (l > i) { const unsigned hi = a[i] > a[l] ? a[i] : a[l], lo = a[i] > a[l] ? a[l] : a[i]; const bool desc = ((i & k) == 0); a[i] = desc ? hi : lo; a[l] = desc ? lo : hi; } }
}
__device__ __forceinline__ void xlane_top16(unsigned (&t)[16], const int mask) {
    unsigned m[16];
#pragma unroll
    for (int i = 0; i < 16; ++i) { const unsigned p = __shfl_xor(t[15 - i], mask); m[i] = t[i] > p ? t[i] : p; }
    bitonic_merge_desc<16>(m);
#pragma unroll
    for (int i = 0; i < 16; ++i) t[i] = m[i];
}
struct Stair { int i[52], j[52]; };
constexpr Stair make_stair() { Stair s{}; int n = 0; for (int a = 0; a < 16; ++a) for (int b = 0; b < 16; ++b) if ((a + 1) * (b + 1) <= 16) { s.i[n] = a; s.j[n] = b; ++n; } for (; n < 52; ++n) { s.i[n] = -1; s.j[n] = -1; } return s; }
constexpr Stair STAIR = make_stair();
template <int P> __device__ __forceinline__ unsigned cand1(const float (&v1)[16], const float (&v2)[16]) {
    constexpr int i = STAIR.i[P], j = STAIR.j[P];
    if constexpr (i < 0) return 0u;
    else return (ordf(v1[i] + v2[j]) & ~255u) | (unsigned)(16 * i + j);
}
template <int S> __device__ __forceinline__ void cand_fill(unsigned (&ck)[16], const float (&v1)[16], const float (&v2)[16], int hg) {
    const unsigned k0 = cand1<4 * S + 0>(v1, v2), k1 = cand1<4 * S + 1>(v1, v2), k2 = cand1<4 * S + 2>(v1, v2), k3 = cand1<4 * S + 3>(v1, v2);
    ck[S] = hg == 0 ? k0 : hg == 1 ? k1 : hg == 2 ? k2 : k3;
    if constexpr (S + 1 < 13) cand_fill<S + 1>(ck, v1, v2, hg);
}
__device__ __forceinline__ void route_task(Frame& F, const int tg, const int h) {
    const int lane = F.lane, c = lane & 15, hg = lane >> 4;
    const int tok = tg * 16 + c;
    const bf16* QP = WSP(const bf16, WS_QP); LAS unsigned char* SKl = F.lds + RING_OFF;
    unsigned sel[2][16];
#pragma unroll
    for (int half = 0; half < 2; ++half) {
        bf16x8 bq[4];
#pragma unroll
        for (int ks = 0; ks < 4; ++ks) bq[ks] = *(const GAS bf16x8*)(QP + (size_t)tok * PQW + h * 256 + half * 128 + 32 * ks + 8 * hg);
        unsigned k[32];
#pragma unroll
        for (int tile = 0; tile < 8; ++tile) {
            f32x4 s = (f32x4){0.f, 0.f, 0.f, 0.f};
#pragma unroll
            for (int ks = 0; ks < 4; ++ks) { const bf16x8 a = *(const LAS bf16x8*)(SKl + off_b(half * 128 + 16 * tile + c, 4 * ks + hg)); s = MFMA16(a, bq[ks], s); }
#pragma unroll
            for (int r = 0; r < 4; ++r) k[tile * 4 + r] = (ordf(s[r]) & ~127u) | (unsigned)(16 * tile + 4 * hg + r);
            if (tile & 1) asm volatile("" ::: "memory");
        }
        bitonic_sort_desc<32>(k);
        unsigned t[16];
#pragma unroll
        for (int i = 0; i < 16; ++i) t[i] = k[i];
        xlane_top16(t, 16); xlane_top16(t, 32);
#pragma unroll
        for (int i = 0; i < 16; ++i) sel[half][i] = t[i];
        asm volatile("" ::: "memory");
    }
    float v1[16], v2[16]; unsigned n1[16], n2[16];
#pragma unroll
    for (int i = 0; i < 16; ++i) { v1[i] = unordf(sel[0][i] & ~127u); n1[i] = sel[0][i] & 127u; v2[i] = unordf(sel[1][i] & ~127u); n2[i] = sel[1][i] & 127u; }
    LAS unsigned char* scr = F.lds + RING_OFF + 65536 + F.wave * 4096 + c * 256;
    if (hg == 0) {
#pragma unroll
        for (int q4 = 0; q4 < 4; ++q4) { *(LAS f32x4*)(scr + 16 * q4) = (f32x4){v1[4 * q4], v1[4 * q4 + 1], v1[4 * q4 + 2], v1[4 * q4 + 3]}; *(LAS f32x4*)(scr + 64 + 16 * q4) = (f32x4){v2[4 * q4], v2[4 * q4 + 1], v2[4 * q4 + 2], v2[4 * q4 + 3]};
            *(LAS v4u*)(scr + 128 + 16 * q4) = (v4u){n1[4 * q4], n1[4 * q4 + 1], n1[4 * q4 + 2], n1[4 * q4 + 3]}; *(LAS v4u*)(scr + 192 + 16 * q4) = (v4u){n2[4 * q4], n2[4 * q4 + 1], n2[4 * q4 + 2], n2[4 * q4 + 3]}; } }
    unsigned ck[16];
    cand_fill<0>(ck, v1, v2, hg); ck[13] = ck[14] = ck[15] = 0u;
    bitonic_sort_desc<16>(ck);
    xlane_top16(ck, 16); xlane_top16(ck, 32);
    int oi[4]; float sc[4]; float mx = -INFINITY;
#pragma unroll
    for (int jj = 0; jj < 4; ++jj) {
        const unsigned w = hg == 0 ? ck[jj] : hg == 1 ? ck[4 + jj] : hg == 2 ? ck[8 + jj] : ck[12 + jj];
        const unsigned i4 = (w >> 2) & 0x3Cu, j4 = (w & 15u) << 2;
        sc[jj] = *(const LAS float*)(scr + i4) + *(const LAS float*)(scr + 64 + j4);
        oi[jj] = (int)(*(const LAS unsigned*)(scr + 128 + i4) * (unsigned)NKEYS + *(const LAS unsigned*)(scr + 192 + j4));
        mx = fmaxf(mx, sc[jj]);
    }
    mx = fmaxf(mx, __shfl_xor(mx, 16)); mx = fmaxf(mx, __shfl_xor(mx, 32));
    float ev[4], sum = 0.f;
#pragma unroll
    for (int jj = 0; jj < 4; ++jj) { ev[jj] = __builtin_amdgcn_exp2f((sc[jj] - mx) * LOG2E); sum += ev[jj]; }
    sum += __shfl_xor(sum, 16); sum += __shfl_xor(sum, 32);
    const float inv = 1.0f / sum;
    const size_t o = ((size_t)tok * PH + h) * TOPK + 4 * hg;
    *(GAS i32x4_t*)(WSP(int, WS_IDX) + o) = (i32x4_t){oi[0], oi[1], oi[2], oi[3]};
    *(GAS f32x4*)(WSP(float, WS_GATE) + o) = (f32x4){ev[0] * inv, ev[1] * inv, ev[2] * inv, ev[3] * inv};
}

__device__ __forceinline__ float gelu_erf(float v) { return 0.5f * v * (1.0f + erff(v * 0.70710678118654752f)); }
typedef int i32x8_t __attribute__((ext_vector_type(8)));
#define FP4X2(w, b) __builtin_amdgcn_cvt_scalef32_pk_f32_fp4((w), 1.0f, (b))
__device__ __forceinline__ void fmac(float& acc, float a, float b) { asm("v_fmac_f32 %0, %1, %2" : "+v"(acc) : "v"(a), "v"(b)); }
struct PeerDeal { int ox, nx, t0, stride, cnt, ns; };
__device__ __forceinline__ void pd_item(int n, const PeerDeal& d, int& t, int& sl) { const int N = d.ns * d.cnt, nn = n < N ? n : N - 1, j = nn / d.cnt; sl = d.ox + j * d.nx; t = d.t0 + (nn - j * d.cnt) * d.stride; }
__device__ __forceinline__ void pd_idx(Frame& F, int t, int lane, i32x4_t (&idv)[4]) {
    const GAS i32x4_t* ip = (const GAS i32x4_t*)(WSP(const int, WS_IDX) + (size_t)t * 128 + (lane >> 3) * 16);
#pragma unroll
    for (int a = 0; a < 4; ++a) idv[a] = ip[a];
}
__device__ __forceinline__ void pd_rows(Frame& F, int t, int sl, int lane, const i32x4_t (&idv)[4], v4u (&rows)[16], v4u (&xw)[2][2]) {
    const unsigned char* xr = F.ws + WS_X2N8 + ((size_t)sl * M + t) * 256 + 16 * (lane >> 4);
#pragma unroll
    for (int pl = 0; pl < 2; ++pl)
#pragma unroll
        for (int ks = 0; ks < 2; ++ks) xw[pl][ks] = *(const GAS v4u*)(xr + pl * 128 + 64 * ks);
    const unsigned char* WD = F.ws + WS_W4D + (size_t)sl * SLICE_BYTES + 16 * (lane & 7);
#pragma unroll
    for (int j = 0; j < 16; ++j) rows[j] = *(const GAS v4u*)(WD + (size_t)idv[j >> 2][j & 3] * 128);
}
__device__ __forceinline__ void pd_compute(Frame& F, int t, int sl, int lane, const v4u (&rows)[16], const v4u (&xw)[2][2]) {
    const int r = lane & 15, g = lane >> 4;
    LAS unsigned char* tile = F.lds + RING_OFF + F.wave * 16384;
    { LAS unsigned char* wp = tile + (lane >> 3) * 2048;
#pragma unroll
      for (int j = 0; j < 16; ++j) *(LAS v4u*)(wp + j * 128 + (((lane & 7) ^ ((j >> 1) & 7)) << 4)) = rows[j]; }
    float* pp = WSP(float, WS_PART) + ((size_t)sl * M + t) * 128 + 4 * g;
    i32x8_t xb[2][2];
#pragma unroll
    for (int pl = 0; pl < 2; ++pl)
#pragma unroll
        for (int ks = 0; ks < 2; ++ks) xb[pl][ks] = (i32x8_t){(int)xw[pl][ks].x, (int)xw[pl][ks].y, (int)xw[pl][ks].z, (int)xw[pl][ks].w, 0, 0, 0, 0};
    const LAS unsigned char* rp = tile + r * 128; const int fr = (r >> 1) & 7;
#pragma unroll
    for (int i = 0; i < 8; ++i) { f32x4 c = (f32x4){0.f, 0.f, 0.f, 0.f};
#pragma unroll
        for (int ks = 0; ks < 2; ++ks) { const v4u w = *(const LAS v4u*)(rp + i * 2048 + (((4 * ks + g) ^ fr) << 4)); const i32x8_t a = (i32x8_t){(int)w.x, (int)w.y, (int)w.z, (int)w.w, 0, 0, 0, 0};
            c = __builtin_amdgcn_mfma_scale_f32_16x16x128_f8f6f4(a, xb[0][ks], c, 4  , 4  , 0, 0x7F7F7F7F, 0, 0x7F7F7F7F);
            c = __builtin_amdgcn_mfma_scale_f32_16x16x128_f8f6f4(a, xb[1][ks], c, 4, 4, 0, 0x7F7F7F7F, 0, 0x7C7C7C7C  ); }
        if (r == 0) *(GAS f32x4*)(pp + 16 * i) = c; }
}
__device__ __forceinline__ void peer_down_pass(Frame& F, const PeerDeal& d) {
    const int lane = F.lane;
    const int N = d.ns * d.cnt; if (N <= 0) return;
    i32x4_t I0[4], I1[4]; v4u R0[16], R1[16], X0[2][2], X1[2][2];
    int ta, sa, tb, sb, tc, sc;
    pd_item(0, d, ta, sa); pd_idx(F, ta, lane, I0);
    pd_item(1, d, tb, sb); pd_idx(F, tb, lane, I1);
    pd_rows(F, ta, sa, lane, I0, R0, X0);
#pragma unroll 1
    for (int n = 0; n < N; n += 2) {
        pd_rows(F, tb, sb, lane, I1, R1, X1);
        pd_item(n + 2, d, tc, sc); pd_idx(F, tc, lane, I0);
        pd_compute(F, ta, sa, lane, R0, X0);
        pd_rows(F, tc, sc, lane, I0, R0, X0);
        pd_item(n + 3, d, ta, sa); pd_idx(F, ta, lane, I1);
        pd_compute(F, tb, sb, lane, R1, X1);
        tb = ta; sb = sa; ta = tc; sa = sc;
    }
}
__device__ __forceinline__ void peer_combine_token(Frame& F, const int t) {
    const int lane = F.lane;
    const float* PART = WSP(const float, WS_PART) + (size_t)t * 128 + 2 * lane; float* GATEP = WSP(float, WS_GATE) + (size_t)t * 128 + 2 * lane;
    f32x2_t a = (f32x2_t){0.f, 0.f};
#pragma unroll
    for (int sl = 0; sl < 16; ++sl) a += *(const GAS f32x2_t*)(PART + (size_t)sl * M * 128);
    const int id0 = WSP(const int, WS_IDX)[(size_t)t * 128 + 2 * lane], id1 = WSP(const int, WS_IDX)[(size_t)t * 128 + 2 * lane + 1];
    const f32x2_t gt = *(const GAS f32x2_t*)GATEP;
    const float c0 = gt.x * gelu_erf(a.x * WSP(const float, WS_SCD)[id0]) * WSP(const float, WS_SCU)[id0], c1 = gt.y * gelu_erf(a.y * WSP(const float, WS_SCD)[id1]) * WSP(const float, WS_SCU)[id1];
    *(GAS f32x2_t*)GATEP = (f32x2_t){c0, c1};
    float bm = fmaxf(fabsf(c0), fabsf(c1));
    bm = fmaxf(bm, __shfl_xor(bm, 1)); bm = fmaxf(bm, __shfl_xor(bm, 2)); bm = fmaxf(bm, __shfl_xor(bm, 4)); bm = fmaxf(bm, __shfl_xor(bm, 8));
    int eb = (int)((__float_as_uint(bm) >> 23) & 255u) - 1;
    eb = eb < 3 ? 3 : eb > 250 ? 250 : eb;
    const float inv = __uint_as_float((unsigned)(254 - eb) << 23);
    const float s0 = c0 * inv, s1 = c1 * inv;
    const unsigned hi = __builtin_amdgcn_cvt_scalef32_pk_fp4_f32(0u, s0, s1, 1.0f, 0);
    const f32x2_t dq = __builtin_amdgcn_cvt_scalef32_pk_f32_fp4(hi, 1.0f, 0);
    const unsigned lo = __builtin_amdgcn_cvt_scalef32_pk_fp4_f32(0u, (s0 - dq.x) * 8.f, (s1 - dq.y) * 8.f, 1.0f, 0);
    unsigned char* cf4 = F.ws + WS_CF4 + (size_t)t * 160;
    ((GAS unsigned char*)cf4)[lane] = (unsigned char)hi; ((GAS unsigned char*)cf4)[64 + lane] = (unsigned char)lo;
    if ((lane & 15) == 0) ((GAS unsigned*)(cf4 + 128))[lane >> 4] = (unsigned)eb * 0x01010101u;
}
struct PmBuf { v4u rows[16]; v4u aw; unsigned sca; f32x4 ov; };
__device__ __forceinline__ void pm_rows(Frame& F, int t, int sl, int lane, const i32x4_t (&idv)[4], PmBuf& b) {
    const int n = lane & 15, g = lane >> 4;
    const unsigned char* WU = F.ws + WS_W4U + (size_t)sl * SLICE_BYTES + 16 * (lane & 7);
#pragma unroll
    for (int j = 0; j < 16; ++j) b.rows[j] = *(const GAS v4u*)(WU + (size_t)idv[j >> 2][j & 3] * 128);
    const unsigned char* cf4 = F.ws + WS_CF4 + (size_t)t * 160;
    b.aw = (v4u){0u, 0u, 0u, 0u}; b.sca = 0x7F7F7F7Fu;
    if (n < 2) { b.aw = *(const GAS v4u*)(cf4 + 64 * n + 16 * g); const unsigned e = *(const GAS unsigned*)(cf4 + 128 + 4 * g); b.sca = n == 0 ? e : e - 0x03030303u; }
    { const u32x2_t w = *(const GAS u32x2_t*)(WSP(const bf16, WS_X1B) + (size_t)t * D + 256 * sl + 4 * lane); b.ov = (f32x4){bflo(w.x), bfhi(w.x), bflo(w.y), bfhi(w.y)}; }
}
__device__ __forceinline__ void pm_compute(Frame& F, int t, int sl, int lane, const PmBuf& b) {
    const int n = lane & 15, g = lane >> 4;
    LAS unsigned char* tile = F.lds + RING_OFF + F.wave * 16384;
    LAS float* obuf = (LAS float*)(F.lds + OBUF_OFF + F.wave * 1024);
    const i32x8_t afr = (i32x8_t){(int)b.aw.x, (int)b.aw.y, (int)b.aw.z, (int)b.aw.w, 0, 0, 0, 0};
    { LAS unsigned char* wp = tile + (lane >> 3) * 2048; const int cc = lane & 7;
#pragma unroll
      for (int j = 0; j < 16; ++j) { const v4u w = b.rows[j]; *(LAS v4u*)(wp + j * 128 + ((cc ^ (j >> 1)) << 4)) = (j & 1) ? (v4u){w.z, w.w, w.x, w.y} : w; } }
    const LAS unsigned char* rp = tile + (32 * g + n) * 128;
#pragma unroll
    for (int c0 = 0; c0 < 16; ++c0) {
        const int off = ((c0 ^ n) << 3);
        const v2i32_t b0 = __builtin_amdgcn_ds_read_tr4_b64_v2i32((LAS v2i32_t*)(rp + off)), b1 = __builtin_amdgcn_ds_read_tr4_b64_v2i32((LAS v2i32_t*)(rp + 2048 + off));
        const i32x8_t bfr = (i32x8_t){b0.x, b0.y, b1.x, b1.y, 0, 0, 0, 0};
        const f32x4 c = __builtin_amdgcn_mfma_scale_f32_16x16x128_f8f6f4(afr, bfr, (f32x4){0.f, 0.f, 0.f, 0.f}, 4, 4, 0, (int)b.sca, 0, 0x7F7F7F7F);
        if (g == 0) obuf[16 * c0 + n] = c[0] + c[1];
    }
    *(GAS f32x4*)(F.out + (size_t)t * D + 256 * sl + 4 * lane) = b.ov + *(const LAS f32x4*)(obuf + 4 * lane);
}
__device__ __forceinline__ void peer_up_pass_mfma(Frame& F, const PeerDeal& d) {
    const int lane = F.lane;
    const int N = d.ns * d.cnt; if (N <= 0) return;
    i32x4_t I0[4], I1[4]; PmBuf B0, B1;
    int ta, sa, tb, sb, tc, sc;
    pd_item(0, d, ta, sa); pd_idx(F, ta, lane, I0);
    pd_item(1, d, tb, sb); pd_idx(F, tb, lane, I1);
    pm_rows(F, ta, sa, lane, I0, B0);
#pragma unroll 1
    for (int n = 0; n < N; n += 2) {
        if (n + 1 < N) pm_rows(F, tb, sb, lane, I1, B1);
        pd_item(n + 2, d, tc, sc); pd_idx(F, tc, lane, I0);
        pm_compute(F, ta, sa, lane, B0);
        if (n + 2 < N) pm_rows(F, tc, sc, lane, I0, B0);
        pd_item(n + 3, d, ta, sa); pd_idx(F, ta, lane, I1);
        if (n + 1 < N) pm_compute(F, tb, sb, lane, B1);
        tb = ta; sb = sa; ta = tc; sa = sc;
    }
}
typedef _Float16 h2_t __attribute__((ext_vector_type(2)));
#define FP4H2(w, b) __builtin_bit_cast(h2_t, __builtin_amdgcn_cvt_scalef32_pk_f16_fp4((w), 1.0f, (b)))
__device__ __forceinline__ void pu_idx(Frame& F, int t, int lane, i32x4_t (&idv)[8], f32x4 (&cfv)[8]) {
    const GAS i32x4_t* ip = (const GAS i32x4_t*)(WSP(const int, WS_IDX) + (size_t)t * 128 + (lane >> 4) * 32); const GAS f32x4* cp = (const GAS f32x4*)(WSP(const float, WS_GATE) + (size_t)t * 128 + (lane >> 4) * 32);
#pragma unroll
    for (int a = 0; a < 8; ++a) { idv[a] = ip[a]; cfv[a] = cp[a]; }
}
template <int H> __device__ __forceinline__ void pu_rows(Frame& F, int sl, int lane, const i32x4_t (&idv)[8], u32x2_t (&rows)[16]) {
    const unsigned char* WU = F.ws + WS_W4U + (size_t)sl * SLICE_BYTES + (lane & 15) * 8;
#pragma unroll
    for (int i = 0; i < 16; ++i) rows[i] = *(const GAS u32x2_t*)(WU + (size_t)idv[4 * H + (i >> 2)][i & 3] * 128);
}
template <int H> __device__ __forceinline__ void pu_compute(const u32x2_t (&rows)[16], const f32x4 (&cfv)[8], h2_t (&acc)[8]) {
#pragma unroll
    for (int i = 0; i < 16; ++i) { const float c = cfv[4 * H + (i >> 2)][i & 3] * 256.0f; const h2_t cc = __builtin_bit_cast(h2_t, __builtin_amdgcn_cvt_pkrtz(c, c));
#pragma unroll
        for (int k = 0; k < 2; ++k) { const unsigned w = rows[i][k];
            acc[4 * k + 0] = FP4H2(w, 0) * cc + acc[4 * k + 0]; acc[4 * k + 1] = FP4H2(w, 1) * cc + acc[4 * k + 1]; acc[4 * k + 2] = FP4H2(w, 2) * cc + acc[4 * k + 2]; acc[4 * k + 3] = FP4H2(w, 3) * cc + acc[4 * k + 3]; } }
}
__device__ __forceinline__ void pu_finish(Frame& F, int t, int sl, int lane, h2_t (&acc)[8]) {
    const int eg = lane >> 4, q = lane & 15;
#pragma unroll
    for (int a = 0; a < 8; ++a) {
        acc[a] = acc[a] + __builtin_bit_cast(h2_t, __shfl_xor(__builtin_bit_cast(unsigned, acc[a]), 16)); acc[a] = acc[a] + __builtin_bit_cast(h2_t, __shfl_xor(__builtin_bit_cast(unsigned, acc[a]), 32)); }
    const h2_t o01 = eg == 0 ? acc[0] : eg == 1 ? acc[2] : eg == 2 ? acc[4] : acc[6], o23 = eg == 0 ? acc[1] : eg == 1 ? acc[3] : eg == 2 ? acc[5] : acc[7];
    GAS f32x4* op = (GAS f32x4*)(F.out + (size_t)t * D + 256 * sl + 16 * q + 4 * eg);
    f32x4 o; { const u32x2_t w = *(const GAS u32x2_t*)(WSP(const bf16, WS_X1B) + (size_t)t * D + 256 * sl + 16 * q + 4 * eg); o = (f32x4){bflo(w.x), bfhi(w.x), bflo(w.y), bfhi(w.y)}; }
    *op = (f32x4){o[0] + (float)o01.x * (1.0f / 256.0f), o[1] + (float)o01.y * (1.0f / 256.0f), o[2] + (float)o23.x * (1.0f / 256.0f), o[3] + (float)o23.y * (1.0f / 256.0f)};
#pragma unroll
    for (int a = 0; a < 8; ++a) acc[a] = (h2_t){(_Float16)0.f, (_Float16)0.f};
}
__device__ __forceinline__ void peer_up_pass(Frame& F, const PeerDeal& d) {
    const int lane = F.lane;
    const int N = d.ns * d.cnt; if (N <= 0) return;
    i32x4_t IA[8], IB[8]; f32x4 CA[8], CB[8]; u32x2_t Ra[16], Rb[16]; h2_t acc[8];
#pragma unroll
    for (int a = 0; a < 8; ++a) acc[a] = (h2_t){(_Float16)0.f, (_Float16)0.f};
    int ta, sa, tb, sb, tc, sc;
    pd_item(0, d, ta, sa); pu_idx(F, ta, lane, IA, CA);
    pd_item(1, d, tb, sb); pu_idx(F, tb, lane, IB, CB);
    pu_rows<0>(F, sa, lane, IA, Ra);
#pragma unroll 1
    for (int n = 0; n < N; n += 2) {
        pu_rows<1>(F, sa, lane, IA, Rb);
        pu_compute<0>(Ra, CA, acc);
        pu_rows<0>(F, sb, lane, IB, Ra);
        pu_compute<1>(Rb, CA, acc);
        pu_finish(F, ta, sa, lane, acc);
        pd_item(n + 2, d, tc, sc); pu_idx(F, tc, lane, IA, CA);
        if (n + 1 < N) {
            pu_rows<1>(F, sb, lane, IB, Rb);
            pu_compute<0>(Ra, CB, acc);
            pu_rows<0>(F, sc, lane, IA, Ra);
            pu_compute<1>(Rb, CB, acc);
            pu_finish(F, tb, sb, lane, acc);
        }
        pd_item(n + 3, d, tb, sb); pu_idx(F, tb, lane, IB, CB);
        ta = tc; sa = sc;
    }
}
struct Args { const float* in[15]; float* out; unsigned char* ws; int ph_lo, ph_hi, pad0, pad1; };
__global__ void __launch_bounds__(NWAVES * 64, 2) skel_fwd(Args args) {
    extern __shared__ __attribute__((aligned(16))) unsigned char lds[];
    Frame F;
    F.lds = (LAS unsigned char*)lds;
    F.MISC = (volatile LAS unsigned*)(F.lds + MISC_OFF);
    F.tid = threadIdx.x; F.lane = F.tid & 63; F.wave = __builtin_amdgcn_readfirstlane(F.tid >> 6);
    F.G = gridDim.x; { const int bx = blockIdx.x; F.vcu = (F.G % 8 == 0) ? (bx % 8) * (F.G / 8) + bx / 8 : bx; }
    F.ws = args.ws; F.ctl = (gu32*)(args.ws + WS_CTL);
    F.x = args.in[0]; F.g1 = args.in[1]; F.w_in = args.in[2]; F.gq = args.in[3]; F.gk = args.in[4]; F.sink = args.in[5]; F.conv_w = args.in[6]; F.w_oa = args.in[7];
    F.w_oc = args.in[8]; F.w_out = args.in[9]; F.g2 = args.in[10]; F.w_qp = args.in[11]; F.subk = args.in[12]; F.w_down = args.in[13]; F.w_up = args.in[14]; F.out = args.out;
    for (int u = F.tid; u < (LDS_BYTES - LDSCTL_OFF) / 4; u += NWAVES * 64) ((LAS unsigned*)(F.lds + LDSCTL_OFF))[u] = 0u;
    __syncthreads();
    XcdBarrier bar; bar.bar = (unsigned*)(F.ctl + CW_BAR); bar.x = 0; bar.st = nullptr;
    if (MK_ONE_LAUNCH) bar = xcd_barrier_post((unsigned*)(F.ctl + CW_BAR), F.MISC + 8);
    if (MK_ONE_LAUNCH && F.tid == 0) { const unsigned xcc = xb_xcc_id(); F.MISC[10] = xcc; F.MISC[11] = __hip_atomic_fetch_add((unsigned*)(F.ctl + CW_XRANK) + 64 * xcc, 1u, RLX_AGENT); }
    if (F.wave == 0) { const bool ok = tr4_selfcheck(F.lds + RING_OFF, F.lane); if (F.lane == 0) F.MISC[15] = ok ? 1u : 0u; }
    __syncthreads();
    const bool tr4_ok = F.MISC[15] != 0u;
    const int lo = args.ph_lo, hi = args.ph_hi;
#ifndef PHASE_MASK
#define PHASE_MASK 0xfff
#endif
#define IN(k) (((PHASE_MASK >> (k)) & 1) && lo <= (k) && (k) < hi)
#ifndef DUP_MASK
#define DUP_MASK 0
#endif
#define REP(k) _Pragma("unroll") for (int rep_ = 0; rep_ < 1 + ((DUP_MASK >> (k)) & 1); ++rep_)
#define SEAM(k) do { if (MK_ONE_LAUNCH && IN(k) && IN((k) + 1)) xcd_barrier(bar); } while (0)
    const int gw = F.vcu * NWAVES + F.wave, NGW = F.G * NWAVES;

    if (IN(0)) REP(0) { p0_prologue(F); } SEAM(0);

    if (IN(1)) REP(1) { quant_w8(F); } SEAM(1);

    if (IN(2)) REP(2) {
        bf16* const pQ = WSP(bf16, WS_Q); bf16* const pK = WSP(bf16, WS_K); bf16* const pV = WSP(bf16, WS_V); bf16* const pH = WSP(bf16, WS_H); bf16* const pB = WSP(bf16, WS_B); bf16* const pC = WSP(bf16, WS_C);
        bf16* const pGA = WSP(bf16, WS_GA); bf16* const pGC = WSP(bf16, WS_GC);
        {   pg8::Gemm g{(const bf16*)(F.ws + WS_XN8), (const bf16*)(F.ws + WS_W8), M, INW, D / 2};
            pg8::RangeOrder S; S.so.init(M, I8_TILES * 256, F.G, (int)blockIdx.x); S.base = 0; S.cut = I8_CUT; S.skip = I8_SKIP;
            pg8::EpiProj<true> E{pQ, pK, pV, pH, pB, pC, pGA, pGC, WSP(const float, WS_SX), WSP(const float, WS_SW)};
            pg8::gemm_phase<pg8::EpiProj<true>, pg8::RangeOrder, PG8_ALIGN, PG8_SP2, true>(F.lds + RING_OFF, g, S, E); }
        {   pg8::Gemm g{WSP(const bf16, WS_XN), WSP(const bf16, WS_WIN), M, INW, D};
            pg8::RangeOrder S; S.so.init(M, BF_TILES * 256, F.G, (int)blockIdx.x); S.base = BF_BASE; S.cut = 68; S.skip = 0;
            pg8::EpiProj<false> E{pQ, pK, pV, pH, pB, pC, pGA, pGC, nullptr, nullptr};
            pg8::gemm_phase<pg8::EpiProj<false>, pg8::RangeOrder, PG8_ALIGN, PG8_SP2, false>(F.lds + RING_OFF, g, S, E); }
    } SEAM(2);

    if (IN(3)) REP(3) {
        for (int U = F.vcu * 4; U < BATCH * 32 * NKV * 2; U += F.G * 4)
            for (int i = 0; i < 4; ++i) attn_unit<0>(F, U + i);
#ifdef ATTN_PROBE
        for (int U = F.vcu * 4; U < BATCH * 32 * NKV * 2; U += F.G * 4)
            for (int i = 0; i < 4; ++i) attn_unit<ATTN_PROBE>(F, U + i);
#endif
        conv_phase(F);
#ifdef CONV_DUP
        conv_phase(F);
#endif
        if (DUP_MASK) __syncthreads();
    } SEAM(3);

    if (IN(4)) REP(4) {
        pg8::Gemm g{WSP(const bf16, WS_AB), WSP(const bf16, WS_WO), 2 * M, 2 * D, QW}; pg8::PairOrder S; S.so.init(M, D, F.G, (int)blockIdx.x);
        pg8::EpiMerge E{WSP(const bf16, WS_GA), WSP(const bf16, WS_GC), WSP(bf16, WS_T), WSP(bf16, WS_XN)};
        pg8::gemm_phase<pg8::EpiMerge, pg8::PairOrder, PG8_ALIGN, PG8_SP2>(F.lds + RING_OFF, g, S, E);
    } SEAM(4);

    if (IN(5)) REP(5) {
        pg8::Gemm g{WSP(const bf16, WS_XN), WSP(const bf16, WS_WOUT), M, D, D}; pg8::StaticOrder S; S.init(M, D, F.G, (int)blockIdx.x);
        pg8::EpiRes E{F.x, WSP(bf16, WS_X1B)};
        pg8::gemm_phase<pg8::EpiRes, pg8::StaticOrder, PG8_ALIGN, PG8_SP2>(F.lds + RING_OFF, g, S, E);
    } SEAM(5);

    if (IN(6)) REP(6) {
        for (int m = gw; m < M; m += NGW) rms2_row(WSP(const bf16, WS_X1B) + (size_t)m * D, F.g2, F.ws + WS_X2I8 + (size_t)m * D, WSP(float, WS_SX2) + m, F.ws + WS_X2N8 + (size_t)m * 256, F.lane);
    } SEAM(6);

    if (IN(7)) REP(7) {
        pg8::Gemm g{(const bf16*)(F.ws + WS_X2I8), (const bf16*)(F.ws + WS_W8QP), M, PQW, D / 2}; pg8::StaticOrder S; S.init(M, PQW, F.G, (int)blockIdx.x);
        pg8::EpiStoreI8 E{WSP(bf16, WS_QP), PQW, WSP(const float, WS_SX2), WSP(const float, WS_SWQ)};
        pg8::gemm_phase<pg8::EpiStoreI8, pg8::StaticOrder, PG8_ALIGN, PG8_SP2, true>(F.lds + RING_OFF, g, S, E);
    } SEAM(7);

    if (IN(8)) REP(8) {
        const int h = F.vcu & 7;
        { const bf16* SK = WSP(const bf16, WS_SK) + (size_t)h * (2 * NKEYS * 128);
#pragma unroll
          for (int i = 0; i < 8; ++i) { const int q = F.tid + 512 * i, row = q >> 4, ch = q & 15; *(LAS v4u*)(F.lds + RING_OFF + off_b(row, ch)) = *(const GAS v4u*)(SK + (size_t)row * 128 + ch * 8); } }
        __syncthreads();
        for (int tg = (F.vcu >> 3) * NWAVES + F.wave; tg < M / 16; tg += (F.G >> 3) * NWAVES) route_task(F, tg, h);
        if (DUP_MASK) __syncthreads();
    } SEAM(8);

    PeerDeal deal;
    if (IN(9) || IN(11)) {
        if (MK_ONE_LAUNCH) {
            if (F.tid == 0) { const unsigned xcc = F.MISC[10]; unsigned nloc = 0, ox = 0, nx = 0;
                for (unsigned j = 0; j < 16; ++j) { const unsigned c = __hip_atomic_load((unsigned*)(F.ctl + CW_XRANK) + 64 * j, RLX_AGENT); if (c) { ++nx; if (j < xcc) ++ox; } if (j == xcc) nloc = c; }
                F.MISC[12] = nloc; F.MISC[13] = ox; F.MISC[14] = nx; }
            __syncthreads();
            const int nloc = (int)F.MISC[12], rank = (int)F.MISC[11];
            deal.ox = (int)F.MISC[13]; deal.nx = (int)F.MISC[14]; deal.t0 = rank * NWAVES + F.wave; deal.stride = nloc * NWAVES;
        } else { const int nper = F.G >> 3; deal.ox = F.vcu / nper; deal.nx = 8; deal.t0 = (F.vcu % nper) * NWAVES + F.wave; deal.stride = nper * NWAVES; }
        deal.cnt = deal.t0 < M ? (M - deal.t0 + deal.stride - 1) / deal.stride : 0; deal.ns = deal.ox < 16 ? (16 - deal.ox + deal.nx - 1) / deal.nx : 0;
    }
    if (IN(9)) {
        peer_down_pass(F, deal);
    } SEAM(9);
    if (IN(10)) {
        for (int t = gw; t < M; t += NGW) peer_combine_token(F, t);
    } SEAM(10);
    if (IN(11)) {
        if (tr4_ok) peer_up_pass_mfma(F, deal); else peer_up_pass(F, deal);
    }
#undef IN
#undef SEAM
}

extern "C" void kernel_launch(void* const* d_in, const int* in_sizes, int n_in, void* d_out, int out_size, void* d_ws, size_t ws_size, hipStream_t stream) {
    static int grid = 0;
    if (grid == 0) {
        if (n_in != 15 || in_sizes[0] != M * D || out_size != M * D || ws_size < WS_END) { fprintf(stderr, "kernel_launch: built for 15 inputs, x and out of %d floats, >= %zu bytes of workspace; got n_in %d, in0 %d, out %d, ws %zu; nothing launched\n", M * D, (size_t)WS_END, n_in, n_in > 0 ? in_sizes[0] : -1, out_size, ws_size); grid = -1; return; }
        int dev = 0, cus = 0, per_cu = 0;
        if (hipGetDevice(&dev) != hipSuccess || hipDeviceGetAttribute(&cus, hipDeviceAttributeMultiprocessorCount, dev) != hipSuccess) { fprintf(stderr, "kernel_launch: hipGetDevice / hipDeviceGetAttribute failed; nothing launched\n"); grid = -1; return; }
        if (hipFuncSetAttribute((const void*)skel_fwd, hipFuncAttributeMaxDynamicSharedMemorySize, LDS_BYTES) != hipSuccess) { fprintf(stderr, "kernel_launch: hipFuncSetAttribute failed; nothing launched\n"); grid = -1; return; }
        if (hipOccupancyMaxActiveBlocksPerMultiprocessor(&per_cu, (const void*)skel_fwd, NWAVES * 64, LDS_BYTES) != hipSuccess || per_cu < 1)
            fprintf(stderr, "kernel_launch: note: the occupancy query reports %d workgroups per CU\n", per_cu);
        (void)hipGetLastError();
        grid = cus;
        if (grid % 8 != 0) { fprintf(stderr, "kernel_launch: %d CUs: this kernel deals work in groups of 8 workgroups; nothing launched\n", grid); grid = -1; return; }
    }
    if (grid < 0) return;
    if (hipMemsetAsync((char*)d_ws + WS_CTL, 0, CTL_ZERO_BYTES, stream) != hipSuccess) { fprintf(stderr, "kernel_launch: hipMemsetAsync of the control words failed; nothing launched\n"); return; }
    Args a{};
    for (int i = 0; i < 15; ++i) a.in[i] = (const float*)d_in[i];
    a.out = (float*)d_out; a.ws = (unsigned char*)d_ws;
#if MK_ONE_LAUNCH
    a.ph_lo = 0; a.ph_hi = N_PHASES;
    hipLaunchKernelGGL(skel_fwd, dim3(grid), dim3(NWAVES * 64), LDS_BYTES, stream, a);
    { const hipError_t le = hipPeekAtLastError(); if (le != hipSuccess) fprintf(stderr, "kernel_launch: launch failed: %s\n", hipGetErrorName(le)); }
#else
    for (int p = 0; p < N_PHASES; ++p) {
        a.ph_lo = p; a.ph_hi = p + 1;
        hipLaunchKernelGGL(skel_fwd, dim3(grid), dim3(NWAVES * 64), LDS_BYTES, stream, a);
        const hipError_t le = hipPeekAtLastError();
        if (le != hipSuccess) { fprintf(stderr, "kernel_launch: launch %d failed: %s\n", p, hipGetErrorName(le)); break; }
    }
#endif
}
```

```cpp
#include <hip/hip_runtime.h>
#include <cstdio>
#include <cstdint>
#include <cmath>
namespace pg8 {
#define PG8_LAS __attribute__((address_space(3)))
typedef unsigned short bf16_t;
typedef short bf16x8 __attribute__((ext_vector_type(8)));
typedef float f32x4 __attribute__((ext_vector_type(4)));
typedef unsigned u32x4 __attribute__((ext_vector_type(4)));
typedef int i32x4 __attribute__((ext_vector_type(4)));
constexpr int BM = 256, BK = 64, HALF = 128, HTB = HALF * BK * 2  , STAGE_BYTES = 8 * HTB, NXCD = 8, WGM = 8;

__host__ __device__ __forceinline__ int lds_byte(int r, int c) { const int st = (r >> 4) * 2 + (c >> 5), rr = r & 15, cc = c & 31, ob = rr * 64 + cc * 2; return st * 1024 + (ob ^ (((ob >> 9) & 1) << 5)); }
__host__ __device__ __forceinline__ void stage_rc(int b, int& R, int& C) { const int st = b / 1024, sb = b % 1024, swz = sb ^ (((sb >> 9) & 1) << 5); R = (st >> 1) * 16 + swz / 64; C = (st & 1) * 32 + (swz % 64) / 2; }
__host__ __device__ __forceinline__ int perm32(int rho) { const int n = rho >> 4, i = rho & 15; return 8 * (i >> 2) + 4 * n + (i & 3); }

struct Unit { int pm, pn; };
struct Gemm { const bf16_t* A; const bf16_t* Bt; int M, N, K; };

struct StaticOrder {
    int nM, nN, nwg, G, c;
    __host__ __device__ void init(int M, int N, int G_, int c_) { nM = M / BM; nN = N / BM; nwg = nM * nN; G = G_; c = c_; }
    __host__ __device__ bool next(int i, Unit& u) const {
        const long L = (long)i * G + c; if (L >= nwg) return false;
        int wgid = (int)L; { const int q = nwg / NXCD, r = nwg % NXCD, xcd = wgid % NXCD, off = wgid / NXCD; wgid = (xcd < r ? xcd * (q + 1) : r * (q + 1) + (xcd - r) * q) + off; }
        const int nig = WGM * nN, gid = wgid / nig, fm = gid * WGM, gsz = (nM - fm) < WGM ? (nM - fm) : WGM;
        u.pm = fm + ((wgid % nig) % gsz); u.pn = (wgid % nig) / gsz; return true;
    }
    __device__ __forceinline__ void a_ready(const Unit&) const {}
    __device__ __forceinline__ void done(const Unit&) const {}
};
__device__ __forceinline__ unsigned cvt_pk_bf16(float lo, float hi) { unsigned r; asm volatile("v_cvt_pk_bf16_f32 %0, %1, %2" : "=v"(r) : "v"(lo), "v"(hi)); return r; }
typedef unsigned u32x2 __attribute__((ext_vector_type(2)));
__device__ __forceinline__ float sigm(float v) { return __builtin_amdgcn_rcpf(1.0f + __builtin_amdgcn_exp2f(-1.4426950408889634f * v)); }
__device__ __forceinline__ u32x4 pack8(const f32x4 a, const f32x4 b) { u32x4 w; w.x = cvt_pk_bf16(a[0], a[1]); w.y = cvt_pk_bf16(a[2], a[3]); w.z = cvt_pk_bf16(b[0], b[1]); w.w = cvt_pk_bf16(b[2], b[3]); return w; }
__device__ __forceinline__ void unpack8(const u32x4 w, f32x4& a, f32x4& b) {
    a[0] = __uint_as_float(w.x << 16); a[1] = __uint_as_float(w.x & 0xffff0000u); a[2] = __uint_as_float(w.y << 16); a[3] = __uint_as_float(w.y & 0xffff0000u);
    b[0] = __uint_as_float(w.z << 16); b[1] = __uint_as_float(w.z & 0xffff0000u); b[2] = __uint_as_float(w.w << 16); b[3] = __uint_as_float(w.w & 0xffff0000u);
}
template <bool I8> struct EpiProj {
    static constexpr bool PERM = true, AFTER_DRAIN = false;
    bf16_t *Q, *K, *V, *H, *Bg, *Cg, *GA, *GC; const float *sx, *sw;
    __device__ __forceinline__ void operator()(const f32x4 (&acc)[2][2][4][2], const Unit& u, int wr, int wc, int fr, int fq) const {
        const int pn = u.pn; bf16_t* base; int ldc, ct; bool sg = false;
        if (pn < 8) { base = Q; ldc = 2048; ct = pn; } else if (pn < 10) { base = K; ldc = 512; ct = pn - 8; } else if (pn < 12) { base = V; ldc = 512; ct = pn - 10; }
        else if (pn < 20) { base = H; ldc = 2048; ct = pn - 12; } else if (pn < 28) { base = Bg; ldc = 2048; ct = pn - 20; } else if (pn < 36) { base = Cg; ldc = 2048; ct = pn - 28; }
        else if (pn < 52) { base = GA; ldc = 4096; ct = pn - 36; sg = true; } else { base = GC; ldc = 4096; ct = pn - 52; sg = true; }
        const int row0 = u.pm * BM + wr * 64 + fr, col0 = ct * BM + wc * 32 + 8 * fq;
        f32x4 cs[2][2];
        if constexpr (I8) {
#pragma unroll
            for (int bj = 0; bj < 2; ++bj)
#pragma unroll
                for (int n = 0; n < 2; ++n) cs[bj][n] = *(const f32x4*)(sw + pn * BM + bj * HALF + wc * 32 + 8 * fq + 4 * n);
        }
#pragma unroll
        for (int ai = 0; ai < 2; ++ai)
#pragma unroll
            for (int m = 0; m < 4; ++m) { const int row = row0 + ai * HALF + m * 16; bf16_t* rowp = base + (size_t)row * ldc + col0;
                float rs = 1.f; if constexpr (I8) rs = sx[row];
#pragma unroll
                for (int bj = 0; bj < 2; ++bj) { f32x4 v0 = acc[ai][bj][m][0], v1 = acc[ai][bj][m][1];
                    if constexpr (I8) { v0 = __builtin_convertvector(__builtin_bit_cast(i32x4, v0), f32x4) * (cs[bj][0] * rs); v1 = __builtin_convertvector(__builtin_bit_cast(i32x4, v1), f32x4) * (cs[bj][1] * rs); }
                    if (sg) {
#pragma unroll
                        for (int e = 0; e < 4; ++e) { v0[e] = sigm(v0[e]); v1[e] = sigm(v1[e]); } }
                    *(u32x4*)(rowp + bj * HALF) = pack8(v0, v1); } }
    }
};
struct EpiMerge {
    static constexpr bool PERM = true, AFTER_DRAIN = false;
    const bf16_t *GA, *GC; bf16_t *T, *Mg;
    __device__ __forceinline__ void operator()(const f32x4 (&acc)[2][2][4][2], const Unit& u, int wr, int wc, int fr, int fq) const {
        const int which = u.pm >> 6, pm = u.pm & 63, pn = u.pn & 15;
        const bf16_t* G = which ? GC : GA;
        const int row0 = pm * BM + wr * 64 + fr, col0 = pn * BM + wc * 32 + 8 * fq;
#pragma unroll
        for (int ai = 0; ai < 2; ++ai)
#pragma unroll
            for (int m = 0; m < 4; ++m) { const size_t off = (size_t)(row0 + ai * HALF + m * 16) * 4096 + col0;
#pragma unroll
                for (int bj = 0; bj < 2; ++bj) { const size_t o = off + bj * HALF; f32x4 g0, g1; unpack8(*(const u32x4*)(G + o), g0, g1);
                    f32x4 v0 = acc[ai][bj][m][0] * g0, v1 = acc[ai][bj][m][1] * g1;
                    if (which == 0) { *(u32x4*)(T + o) = pack8(v0, v1); }
                    else { f32x4 t0, t1; unpack8(*(const u32x4*)(T + o), t0, t1); *(u32x4*)(Mg + o) = pack8(v0 + t0, v1 + t1); } } }
    }
};
struct EpiRes {
    static constexpr bool PERM = true, AFTER_DRAIN = false;
    const float* X; bf16_t* O;
    __device__ __forceinline__ void operator()(const f32x4 (&acc)[2][2][4][2], const Unit& u, int wr, int wc, int fr, int fq) const {
        const int row0 = u.pm * BM + wr * 64 + fr, col0 = u.pn * BM + wc * 32 + 8 * fq;
#pragma unroll
        for (int ai = 0; ai < 2; ++ai)
#pragma unroll
            for (int m = 0; m < 4; ++m) { const size_t off = (size_t)(row0 + ai * HALF + m * 16) * 4096 + col0;
#pragma unroll
                for (int bj = 0; bj < 2; ++bj) { const size_t o = off + bj * HALF; const f32x4 x0 = *(const f32x4*)(X + o), x1 = *(const f32x4*)(X + o + 4);
                    *(u32x4*)(O + o) = pack8(x0 + acc[ai][bj][m][0], x1 + acc[ai][bj][m][1]); } }
    }
};
struct EpiStoreI8 {
    static constexpr bool PERM = true, AFTER_DRAIN = false;
    bf16_t* O; int ldc; const float *sx, *sw;
    __device__ __forceinline__ void operator()(const f32x4 (&acc)[2][2][4][2], const Unit& u, int wr, int wc, int fr, int fq) const {
        const int row0 = u.pm * BM + wr * 64 + fr, col0 = u.pn * BM + wc * 32 + 8 * fq;
        f32x4 cs[2][2];
#pragma unroll
        for (int bj = 0; bj < 2; ++bj)
#pragma unroll
            for (int n = 0; n < 2; ++n) cs[bj][n] = *(const f32x4*)(sw + col0 + bj * HALF + 4 * n);
#pragma unroll
        for (int ai = 0; ai < 2; ++ai)
#pragma unroll
            for (int m = 0; m < 4; ++m) { const int row = row0 + ai * HALF + m * 16; bf16_t* rowp = O + (size_t)row * ldc + col0; const float rs = sx[row];
#pragma unroll
                for (int bj = 0; bj < 2; ++bj) *(u32x4*)(rowp + bj * HALF) = pack8(__builtin_convertvector(__builtin_bit_cast(i32x4, acc[ai][bj][m][0]), f32x4) * (cs[bj][0] * rs), __builtin_convertvector(__builtin_bit_cast(i32x4, acc[ai][bj][m][1]), f32x4) * (cs[bj][1] * rs)); }
    }
};
struct EpiStore {
    static constexpr bool PERM = true, AFTER_DRAIN = false;
    bf16_t* O; int ldc;
    __device__ __forceinline__ void operator()(const f32x4 (&acc)[2][2][4][2], const Unit& u, int wr, int wc, int fr, int fq) const {
        const int row0 = u.pm * BM + wr * 64 + fr, col0 = u.pn * BM + wc * 32 + 8 * fq;
#pragma unroll
        for (int ai = 0; ai < 2; ++ai)
#pragma unroll
            for (int m = 0; m < 4; ++m) { bf16_t* rowp = O + (size_t)(row0 + ai * HALF + m * 16) * ldc + col0;
#pragma unroll
                for (int bj = 0; bj < 2; ++bj) *(u32x4*)(rowp + bj * HALF) = pack8(acc[ai][bj][m][0], acc[ai][bj][m][1]); }
    }
};
struct PairOrder {
    StaticOrder so;
    __device__ bool next(int i, Unit& u) const { Unit t; if (!so.next(i >> 1, t)) return false; const int w = i & 1; u.pm = t.pm + 64 * w; u.pn = t.pn + 16 * w; return true; }
    __device__ __forceinline__ void a_ready(const Unit&) const {}
    __device__ __forceinline__ void done(const Unit&) const {}
};
struct RangeOrder {
    StaticOrder so; int base, cut, skip;
    __device__ bool next(int i, Unit& u) const { if (!so.next(i, u)) return false; u.pn = base + (u.pn < cut ? u.pn : u.pn + skip); return true; }
    __device__ __forceinline__ void a_ready(const Unit&) const {}
    __device__ __forceinline__ void done(const Unit&) const {}
};
template <class Epi, class Sched, bool ALIGN_EPI = false, bool SP2 = false, bool I8 = false>
__device__ __forceinline__ void gemm_phase(PG8_LAS unsigned char* lds, const Gemm g, const Sched& S, const Epi& E) {
    const int tid = threadIdx.x, wid = __builtin_amdgcn_readfirstlane(tid >> 6), lane = tid & 63, wr = wid >> 2, wc = wid & 3, fr = lane & 15, fq = lane >> 4;
    const int K = g.K, nt = K / BK;
    unsigned voffA[2], voffB[2];
#pragma unroll
    for (int i = 0; i < 2; ++i) { int R, C; stage_rc(tid * 16 + i * 8192, R, C); const int Rb = Epi::PERM ? ((R & ~31) + perm32(R & 31)) : R;
        voffA[i] = (unsigned)(R * K + C) * 2u; voffB[i] = (unsigned)(Rb * K + C) * 2u; }
    const size_t kstep = (size_t)(BK * 2);
    const size_t hstep = (size_t)HALF * K * 2;
    const size_t tstep = 2 * hstep;
    const unsigned ldsw = (unsigned)wid * 1024u;
    const int aoff = lds_byte(wr * 64 + fr, fq * 8), boff = lds_byte(wc * 32 + fr, fq * 8);
#define PG8_SA(b, h) (((b) * 2 + (h)) * HTB)
#define PG8_SB(b, h) ((4 + (b) * 2 + (h)) * HTB)
#define PG8_STAGE(bufoff, gbase, voff) do { _Pragma("unroll") for (int _i = 0; _i < 2; ++_i) \
        __builtin_amdgcn_global_load_lds((const unsigned*)((const char*)(gbase) + (voff)[_i]), (PG8_LAS unsigned*)(lds + (bufoff) + ldsw + _i * 8192), 16, 0, 0); } while (0)
#define PG8_LDA(dst, b, h) do { _Pragma("unroll") for (int m = 0; m < 4; ++m) _Pragma("unroll") for (int k = 0; k < 2; ++k) dst[m][k] = *(const PG8_LAS bf16x8*)(lds + PG8_SA(b, h) + aoff + m * 2048 + k * 1024); } while (0)
#define PG8_LDB(dst, b, h) do { _Pragma("unroll") for (int n = 0; n < 2; ++n) _Pragma("unroll") for (int k = 0; k < 2; ++k) dst[n][k] = *(const PG8_LAS bf16x8*)(lds + PG8_SB(b, h) + boff + n * 2048 + k * 1024); } while (0)
#define PG8_MMA(ai, bj, At, Bt) do { __builtin_amdgcn_s_setprio(1); _Pragma("unroll") for (int m = 0; m < 4; ++m) _Pragma("unroll") for (int n = 0; n < 2; ++n) _Pragma("unroll") for (int k = 0; k < 2; ++k) \
        { if constexpr (I8) acc[ai][bj][m][n] = __builtin_bit_cast(f32x4, __builtin_amdgcn_mfma_i32_16x16x64_i8(__builtin_bit_cast(i32x4, Bt[n][k]), __builtin_bit_cast(i32x4, At[m][k]), __builtin_bit_cast(i32x4, acc[ai][bj][m][n]), 0, 0, 0)); \
          else acc[ai][bj][m][n] = __builtin_amdgcn_mfma_f32_16x16x32_bf16(Bt[n][k], At[m][k], acc[ai][bj][m][n], 0, 0, 0); } __builtin_amdgcn_s_setprio(0); } while (0)
#define PG8_WAIT_V(n) asm volatile("s_waitcnt vmcnt(" #n ")" ::: "memory")
#define PG8_WAIT_L(n) asm volatile("s_waitcnt lgkmcnt(" #n ")" ::: "memory")
#define PG8_BAR __builtin_amdgcn_s_barrier()
#define PG8_SCHED __builtin_amdgcn_sched_barrier(0)
    Unit cur, nxt; int ui = 0;
    if (!S.next(0, cur)) return;
    f32x4 acc[2][2][4][2];
#pragma unroll
    for (int a = 0; a < 2; ++a)
#pragma unroll
        for (int b = 0; b < 2; ++b)
#pragma unroll
            for (int m = 0; m < 4; ++m)
#pragma unroll
                for (int n = 0; n < 2; ++n) acc[a][b][m][n] = (f32x4){0.f, 0.f, 0.f, 0.f};
    bf16x8 At[4][2], B0[2][2], B1[2][2];
    const char* cA = (const char*)g.A + (size_t)cur.pm * tstep; const char* cB = (const char*)g.Bt + (size_t)cur.pn * tstep;
    S.a_ready(cur);
    if constexpr (SP2) {
        PG8_STAGE(PG8_SB(0, 0), cB, voffB); PG8_STAGE(PG8_SB(0, 1), cB + hstep, voffB); PG8_STAGE(PG8_SA(0, 0), cA, voffA); PG8_STAGE(PG8_SA(0, 1), cA + hstep, voffA);
        if (wr == 1) PG8_BAR;
        PG8_WAIT_V(2); PG8_BAR;
        PG8_STAGE(PG8_SB(1, 0), cB + kstep, voffB); PG8_STAGE(PG8_SA(1, 0), cA + kstep, voffA); PG8_STAGE(PG8_SB(1, 1), cB + hstep + kstep, voffB);
        PG8_WAIT_V(6); PG8_BAR;
    } else {
        PG8_STAGE(PG8_SB(0, 0), cB, voffB); PG8_STAGE(PG8_SA(0, 0), cA, voffA); PG8_STAGE(PG8_SB(0, 1), cB + hstep, voffB); PG8_STAGE(PG8_SA(0, 1), cA + hstep, voffA);
        if (wr == 1) PG8_BAR;
        PG8_WAIT_V(4); PG8_BAR;
        PG8_STAGE(PG8_SB(1, 0), cB + kstep, voffB); PG8_STAGE(PG8_SA(1, 0), cA + kstep, voffA); PG8_STAGE(PG8_SB(1, 1), cB + hstep + kstep, voffB);
        PG8_WAIT_V(6); PG8_BAR;
    }
    for (;;) {
        const bool has_next = S.next(ui + 1, nxt);
        const char* nA = has_next ? (const char*)g.A + (size_t)nxt.pm * tstep : cA; const char* nB = has_next ? (const char*)g.Bt + (size_t)nxt.pn * tstep : cB;
        for (int t = 0; t < nt; t += 2) {
            const bool last = (t == nt - 2);
            const char* a1 = cA + (size_t)(t + 1) * kstep;
            const char* a2 = last ? nA : cA + (size_t)(t + 2) * kstep; const char* b2 = last ? nB : cB + (size_t)(t + 2) * kstep;
            const char* a3 = a2 + kstep; const char* b3 = b2 + kstep;
            if (last && has_next) S.a_ready(nxt);
            if constexpr (SP2) {
            PG8_LDB(B0, 0, 0); PG8_LDB(B1, 0, 1); PG8_SCHED; PG8_LDA(At, 0, 0); PG8_STAGE(PG8_SA(1, 1), a1 + hstep, voffA);
            PG8_WAIT_V(8); PG8_WAIT_L(0); PG8_BAR; PG8_MMA(0, 0, At, B0); PG8_MMA(0, 1, At, B1); PG8_BAR; PG8_SCHED;
            PG8_LDA(At, 0, 1); PG8_STAGE(PG8_SB(0, 0), b2, voffB); PG8_STAGE(PG8_SB(0, 1), b2 + hstep, voffB); PG8_STAGE(PG8_SA(0, 0), a2, voffA);
            PG8_WAIT_V(8); PG8_WAIT_L(0); PG8_BAR; PG8_MMA(1, 0, At, B0); PG8_MMA(1, 1, At, B1); PG8_BAR; PG8_SCHED;
            PG8_LDB(B0, 1, 0); PG8_LDB(B1, 1, 1); PG8_SCHED; PG8_LDA(At, 1, 0); PG8_STAGE(PG8_SA(0, 1), a2 + hstep, voffA);
            PG8_WAIT_V(8); PG8_WAIT_L(0); PG8_BAR; PG8_MMA(0, 0, At, B0); PG8_MMA(0, 1, At, B1); PG8_BAR; PG8_SCHED;
            PG8_LDA(At, 1, 1); PG8_STAGE(PG8_SB(1, 0), b3, voffB); PG8_STAGE(PG8_SB(1, 1), b3 + hstep, voffB); PG8_STAGE(PG8_SA(1, 0), a3, voffA);
            PG8_WAIT_V(8); PG8_WAIT_L(0); PG8_BAR; PG8_MMA(1, 0, At, B0); PG8_MMA(1, 1, At, B1); PG8_BAR; PG8_SCHED;
            } else {
            PG8_LDB(B0, 0, 0); PG8_SCHED; PG8_LDA(At, 0, 0); PG8_STAGE(PG8_SA(1, 1), a1 + hstep, voffA);
            PG8_WAIT_L(8); PG8_BAR; PG8_WAIT_L(0); PG8_MMA(0, 0, At, B0); PG8_BAR; PG8_SCHED;
            PG8_LDB(B1, 0, 1); PG8_STAGE(PG8_SB(0, 0), b2, voffB);
            PG8_BAR; PG8_WAIT_L(0); PG8_MMA(0, 1, At, B1); PG8_BAR;
            PG8_LDA(At, 0, 1); PG8_STAGE(PG8_SA(0, 0), a2, voffA);
            PG8_BAR; PG8_WAIT_L(0); PG8_MMA(1, 0, At, B0); PG8_BAR; PG8_SCHED;
            PG8_STAGE(PG8_SB(0, 1), b2 + hstep, voffB);
            PG8_WAIT_V(6); PG8_BAR; PG8_MMA(1, 1, At, B1); PG8_BAR;
            PG8_LDB(B0, 1, 0); PG8_SCHED; PG8_LDA(At, 1, 0); PG8_STAGE(PG8_SA(0, 1), a2 + hstep, voffA);
            PG8_WAIT_L(8); PG8_BAR; PG8_WAIT_L(0); PG8_MMA(0, 0, At, B0); PG8_BAR; PG8_SCHED;
            PG8_LDB(B1, 1, 1); PG8_STAGE(PG8_SB(1, 0), b3, voffB);
            PG8_BAR; PG8_WAIT_L(0); PG8_MMA(0, 1, At, B1); PG8_BAR;
            PG8_LDA(At, 1, 1); PG8_STAGE(PG8_SA(1, 0), a3, voffA);
            PG8_BAR; PG8_WAIT_L(0); PG8_MMA(1, 0, At, B0); PG8_BAR; PG8_SCHED;
            PG8_STAGE(PG8_SB(1, 1), b3 + hstep, voffB);
            PG8_WAIT_V(6); PG8_BAR; PG8_MMA(1, 1, At, B1); PG8_BAR;
            }
        }
        if constexpr (ALIGN_EPI) { if (wr == 0) PG8_BAR; }
        if constexpr (!Epi::AFTER_DRAIN) { E(acc, cur, wr, wc, fr, fq); S.done(cur); }
        if (!has_next) break;
#pragma unroll
        for (int a = 0; a < 2; ++a)
#pragma unroll
            for (int b = 0; b < 2; ++b)
#pragma unroll
                for (int m = 0; m < 4; ++m)
#pragma unroll
                    for (int n = 0; n < 2; ++n) acc[a][b][m][n] = (f32x4){0.f, 0.f, 0.f, 0.f};
        cur = nxt; cA = nA; cB = nB; ++ui;
        if constexpr (ALIGN_EPI) { if (wr == 1) PG8_BAR; }
    }
    PG8_WAIT_V(0);
    if constexpr (!ALIGN_EPI) { if (wr == 0) PG8_BAR; }
    PG8_BAR;
    if constexpr (Epi::AFTER_DRAIN) { E.fused(acc, cur, wr, wc, fr, fq, lds, wid, lane); S.done(cur); }
#undef PG8_SA
#undef PG8_SB
#undef PG8_STAGE
#undef PG8_LDA
#undef PG8_LDB
#undef PG8_MMA
#undef PG8_WAIT_V
#undef PG8_WAIT_L
#undef PG8_BAR
#undef PG8_SCHED
}
}
#ifndef PG8_SP2
#define PG8_SP2 true
#endif
#ifndef PG8_ALIGN
#define PG8_ALIGN true
#endif
constexpr int NWAVES = 8;
#ifndef MK_ONE_LAUNCH
#define MK_ONE_LAUNCH 1
#endif
constexpr int N_PHASES = 12;
#ifndef NIBBLE_SWAP_DOWN
#define NIBBLE_SWAP_DOWN 0
#endif
#ifndef I8_CFG
#define I8_CFG 1
#endif
#if I8_CFG == 0
constexpr int I8_TILES = 44, I8_CUT = 12, I8_SKIP = 24, BF_BASE = 12, BF_TILES = 24;
#elif I8_CFG == 1
constexpr int I8_TILES = 60, I8_CUT = 12, I8_SKIP = 8, BF_BASE = 12, BF_TILES = 8;
#else
constexpr int I8_TILES = 68, I8_CUT = 68, I8_SKIP = 0, BF_BASE = 12, BF_TILES = 0;
#endif

constexpr int BATCH = 4, SEQ = 4096, D = 4096, M = BATCH * SEQ;
constexpr int HD = 128, NH = 16, NKV = 4, QW = NH * HD, KVW = NKV * HD, CW = 2048, INW = 17408;
constexpr int PH = 8, NKEYS = 128, TOPK = 16, NEXP = NKEYS * NKEYS, PQW = PH * 2 * 128;
constexpr float EPS = 1e-6f;
constexpr size_t SLICE_BYTES = (size_t)NEXP * 128;
constexpr float LOG2E = 1.4426950408889634f;

constexpr size_t MiB = 1u << 20;
constexpr size_t WS_CTL = 0, CTL_ZERO_BYTES = 1 * MiB;
constexpr size_t WS_WIN = 2 * MiB;
constexpr size_t WS_WO = 138 * MiB;
constexpr size_t WS_WOUT = 170 * MiB;
constexpr size_t WS_WQP = 202 * MiB;
constexpr size_t WS_SK = 218 * MiB;
constexpr size_t WS_IDX = 220 * MiB, WS_GATE = 228 * MiB;
constexpr size_t WS_XN = 236 * MiB;
constexpr size_t WS_AB = 364 * MiB;
constexpr size_t WS_Q = 492 * MiB, WS_K = 556 * MiB, WS_V = 572 * MiB, WS_H = 588 * MiB, WS_B = 652 * MiB, WS_C = 716 * MiB;
constexpr size_t WS_GA = 780 * MiB, WS_GC = 908 * MiB;
constexpr size_t WS_T = 492 * MiB;
constexpr size_t WS_X1B = 620 * MiB;
constexpr size_t WS_X2N = 620 * MiB;
constexpr size_t WS_PART = 236 * MiB;
constexpr size_t WS_X2N8 = 492 * MiB;
constexpr size_t WS_CF4 = 780 * MiB;
constexpr size_t WS_QP = 780 * MiB;
constexpr size_t WS_W4D = 1036 * MiB, WS_W4U = 1068 * MiB;
constexpr size_t WS_SCD = 1100 * MiB, WS_SCU = WS_SCD + 65536;
constexpr size_t WS_SX = WS_SCD + 131072, WS_SW = WS_SCD + 262144;
constexpr size_t WS_XN8 = 364 * MiB;
constexpr size_t WS_W8 = 1101 * MiB;
constexpr size_t WS_W8QP = 1169 * MiB;
constexpr size_t WS_SWQ = WS_SCD + 393216, WS_SX2 = WS_SCD + 458752;
constexpr size_t WS_X2I8 = 364 * MiB;
constexpr size_t WS_END = 1177 * MiB;
static_assert(WS_T + (size_t)M * D * 2 <= WS_X2N && WS_X2N + (size_t)M * D * 2 <= WS_GA && WS_QP + (size_t)M * PQW * 2 <= WS_GC, "d_ws overlays");
static_assert(WS_WIN + (size_t)INW * D * 2 <= WS_WO && WS_C + (size_t)M * CW * 2 <= WS_GA && WS_GC + (size_t)M * D * 2 <= WS_END, "d_ws map");
constexpr int CW_XRANK = 8192;
constexpr int CW_BAR = 4096;

constexpr int RING_OFF = 0, RING_BYTES = 131072;
constexpr int LDSCTL_OFF = RING_BYTES, MISC_OFF = LDSCTL_OFF + 320;
constexpr int OBUF_OFF = 132096;
constexpr int ODUMP_OFF = OBUF_OFF + 8192;
constexpr int LDS_BYTES = 147456;
static_assert(MISC_OFF + 128 <= OBUF_OFF && ODUMP_OFF + 2048 <= LDS_BYTES, "LDS map");
#define GAS __attribute__((address_space(1)))
#define LAS __attribute__((address_space(3)))
typedef unsigned short bf16;
typedef unsigned v4u __attribute__((ext_vector_type(4)));
typedef float f32x4 __attribute__((ext_vector_type(4)));
typedef short bf16x8 __attribute__((ext_vector_type(8)));
typedef GAS unsigned gu32;
typedef GAS unsigned long long gu64;
#define RLX_AGENT __ATOMIC_RELAXED, __HIP_MEMORY_SCOPE_AGENT
#define LDS_WAIT() asm volatile("s_waitcnt lgkmcnt(0)" ::: "memory")
#define VM_WAIT() asm volatile("s_waitcnt vmcnt(0)" ::: "memory")
__device__ __forceinline__ unsigned long long rt() { return __builtin_amdgcn_s_memrealtime(); }
__device__ __forceinline__ unsigned f2bf(float f) { unsigned u = __builtin_bit_cast(unsigned, f); return (u + 0x7fffu + ((u >> 16) & 1u)) >> 16; }
__device__ __forceinline__ unsigned pk2(float lo, float hi) { return f2bf(lo) | (f2bf(hi) << 16); }

#define XB_TMO      128
#define XB_XCNT(j)  (256  + 64 * (j))
#define XB_XSUB(j)  (1280 + 64 * (j))
#define XB_XGEN(j)  (2304 + 64 * (j))
#define XB_TOP      3328
#define XB_TOPGEN   3392
#define XCD_BAR_WORDS 3456
#define XB_SPIN_CAP (1u << 18)

__device__ __forceinline__ unsigned xb_ld(unsigned* p)              { return __hip_atomic_load(p, __ATOMIC_RELAXED, __HIP_MEMORY_SCOPE_AGENT); }
__device__ __forceinline__ unsigned xb_add(unsigned* p, unsigned v) { return __hip_atomic_fetch_add(p, v, __ATOMIC_RELAXED, __HIP_MEMORY_SCOPE_AGENT); }
__device__ __forceinline__ unsigned xb_xcc_id() { return (unsigned)__builtin_amdgcn_s_getreg((3 << 11) | 20) & 0xFu; }
#define XB_SPIN(cond, bar) do { unsigned _sp = 0; while (cond) { __builtin_amdgcn_s_sleep(1); \
    if ((++_sp & 255u) == 0u) { if (xb_ld(&(bar)[XB_TMO])) break; if (_sp > XB_SPIN_CAP) { atomicAdd(&(bar)[XB_TMO], 1u); break; } } } } while (0)

struct XcdBarrier {
    unsigned* bar; unsigned x;
    volatile LAS unsigned* st;
};

__device__ __forceinline__ XcdBarrier xcd_barrier_post(unsigned* bar, volatile LAS unsigned* st) {
    XcdBarrier b; b.bar = bar; b.x = xb_xcc_id(); b.st = st;
    if (threadIdx.x == 0) (void)xb_add(&bar[XB_XCNT(b.x)], 1u);
    return b;
}
__device__ __forceinline__ void xcd_barrier_complete(unsigned* bar, unsigned x, unsigned& nloc, unsigned& nx) {
    const unsigned G = gridDim.x * gridDim.y * gridDim.z;
    unsigned sum, cnt, mine, sp = 0u;
    for (;;) {
        sum = 0u; cnt = 0u; mine = 0u;
#pragma unroll
        for (unsigned j = 0; j < 16; ++j) { const unsigned c = xb_ld(&bar[XB_XCNT(j)]); sum += c; cnt += (c > 0u) ? 1u : 0u; mine = (j == x) ? c : mine; }
        if (sum == G) break;
        __builtin_amdgcn_s_sleep(1);
        if ((++sp & 255u) == 0u) { if (xb_ld(&bar[XB_TMO])) break; if (sp > XB_SPIN_CAP) { atomicAdd(&bar[XB_TMO], 1u); break; } }
    }
    nloc = mine > 0u ? mine : 1u; nx = cnt > 0u ? cnt : 1u;
}

__device__ __forceinline__ void xcd_barrier(const XcdBarrier& b) {
    asm volatile("s_waitcnt vmcnt(0)" ::: "memory");
    __syncthreads();
    if (threadIdx.x == 0) {
        unsigned* bar = b.bar;
        __builtin_amdgcn_s_waitcnt(0);
        unsigned nloc = b.st[0], nx = b.st[1];
        if (nloc == 0u) { xcd_barrier_complete(bar, b.x, nloc, nx); b.st[0] = nloc; b.st[1] = nx; }
        const unsigned old = xb_add(&bar[XB_XSUB(b.x)], 1u);
        const unsigned gen = old / nloc;
        if (old + 1u == (gen + 1u) * nloc) {
            __builtin_amdgcn_fence(__ATOMIC_RELEASE, "agent");
            asm volatile("s_waitcnt vmcnt(0)" ::: "memory");
            const unsigned og = xb_add(&bar[XB_TOP], 1u);
            const unsigned tg = og / nx;
            if (og + 1u == (tg + 1u) * nx) xb_add(&bar[XB_TOPGEN], 1u);
            else XB_SPIN(xb_ld(&bar[XB_TOPGEN]) == tg, bar);
            __builtin_amdgcn_fence(__ATOMIC_ACQUIRE, "agent");
            xb_add(&bar[XB_XGEN(b.x)], 1u);
            asm volatile("s_waitcnt vmcnt(0)" ::: "memory");
        } else {
            XB_SPIN(xb_ld(&bar[XB_XGEN(b.x)]) == gen, bar);
            __builtin_amdgcn_fence(__ATOMIC_ACQUIRE, "agent");
            asm volatile("s_waitcnt vmcnt(0)" ::: "memory");
        }
    }
    __syncthreads();
}
typedef unsigned u32x2_t __attribute__((ext_vector_type(2)));
typedef short v4i16_t __attribute__((ext_vector_type(4)));
typedef unsigned long long u64;
typedef float f32x2_t __attribute__((ext_vector_type(2)));
typedef int i32x4_t __attribute__((ext_vector_type(4)));
struct Frame {
    LAS unsigned char* lds;
    volatile LAS unsigned* MISC;
    gu32* ctl;
    unsigned char* ws;
    int tid, lane, wave;
    int vcu, G;
    const float *x, *g1, *w_in, *gq, *gk, *sink, *conv_w, *w_oa, *w_oc, *w_out, *g2, *w_qp, *subk, *w_down, *w_up;
    float* out;
};
#define WSP(type, off) ((type*)(F.ws + (off)))
using pg8::cvt_pk_bf16; using pg8::pack8; using pg8::unpack8;

__device__ __forceinline__ float wave_sum(float v) {
#pragma unroll
    for (int o = 1; o < 64; o <<= 1) v += __shfl_xor(v, o);
    return v;
}
__device__ __forceinline__ float dot4(const f32x4 a, const f32x4 b) { return (a[0] * b[0] + a[1] * b[1]) + (a[2] * b[2] + a[3] * b[3]); }
__device__ __forceinline__ float bflo(unsigned w) { return __uint_as_float(w << 16); }
__device__ __forceinline__ float bfhi(unsigned w) { return __uint_as_float(w & 0xffff0000u); }

typedef int v2i32_t __attribute__((ext_vector_type(2)));
__device__ __forceinline__ bool tr4_selfcheck(LAS unsigned char* tp, int lane) {
    const int g = lane >> 4, j = lane & 15;
    unsigned lo = 0u, hi = 0u;
#pragma unroll
    for (int c = 0; c < 8; ++c) { lo |= (unsigned)((j * 5 + c * 3 + g + 1) & 15) << (4 * c); hi |= (unsigned)((j * 5 + (c + 8) * 3 + g + 1) & 15) << (4 * c); }
    *(LAS u32x2_t*)(tp + lane * 8) = (u32x2_t){lo, hi};
    LDS_WAIT(); asm volatile("" ::: "memory");
    const v2i32_t rv = __builtin_amdgcn_ds_read_tr4_b64_v2i32((LAS v2i32_t*)(tp + lane * 8));
    bool ok = true;
#pragma unroll
    for (int e = 0; e < 8; ++e) { ok = ok && ((((unsigned)rv.x >> (4 * e)) & 15u) == (unsigned)((e * 5 + j * 3 + g + 1) & 15)) && ((((unsigned)rv.y >> (4 * e)) & 15u) == (unsigned)(((e + 8) * 5 + j * 3 + g + 1) & 15)); }
    return __all(ok);
}

__device__ __forceinline__ void p0_transpose_item(const float* W, int K, int N, bf16* WT, int row_off, LAS float* scr, int item, int lane) {
    const int nblk = N / 32, kb = item / nblk, nb = item % nblk, k0 = 64 * kb, n0 = 32 * nb;
#pragma unroll 8
    for (int i = 0; i < 32; ++i) { const int kk = 2 * i + (lane >> 5); scr[kk * 33 + (lane & 31)] = W[(size_t)(k0 + kk) * N + n0 + (lane & 31)]; }
    LDS_WAIT(); asm volatile("" ::: "memory");
    const int c = lane & 7;
#pragma unroll
    for (int j = 0; j < 4; ++j) { const int n = (lane >> 3) + 8 * j; const LAS float* s = scr + (8 * c) * 33 + n;
        v4u o; o.x = cvt_pk_bf16(s[0 * 33], s[1 * 33]); o.y = cvt_pk_bf16(s[2 * 33], s[3 * 33]); o.z = cvt_pk_bf16(s[4 * 33], s[5 * 33]); o.w = cvt_pk_bf16(s[6 * 33], s[7 * 33]);
        *(GAS v4u*)(WT + (size_t)(row_off + n0 + n) * K + k0 + 8 * c) = o; }
    LDS_WAIT(); asm volatile("" ::: "memory");
}
template <int QMODE  > __device__ __forceinline__ void rms_row_to_bf16(const float* xrow, const float* g, bf16* orow, unsigned* q8row, float* sxp, int lane) {
    const GAS f32x4* xr = (const GAS f32x4*)xrow + lane; const GAS f32x4* gr = (const GAS f32x4*)g + lane;
    f32x4 v[16]; float s = 0.f;
#pragma unroll
    for (int j = 0; j < 16; ++j) { v[j] = xr[64 * j]; s += dot4(v[j], v[j]); }
    const float r = rsqrtf(wave_sum(s) * (1.f / D) + EPS);
    GAS u32x2_t* o8 = (GAS u32x2_t*)orow + lane; float am = 0.f;
#pragma unroll
    for (int j = 0; j < 16; ++j) { v[j] = v[j] * r * gr[64 * j]; u32x2_t w; w.x = cvt_pk_bf16(v[j][0], v[j][1]); w.y = cvt_pk_bf16(v[j][2], v[j][3]); o8[64 * j] = w;
        am = fmaxf(am, fmaxf(fmaxf(fabsf(v[j][0]), fabsf(v[j][1])), fmaxf(fabsf(v[j][2]), fabsf(v[j][3])))); }
    if constexpr (QMODE == 2) {
#pragma unroll
        for (int j = 0; j < 16; ++j) { int p = 0; p = __builtin_amdgcn_cvt_pk_fp8_f32(v[j][0], v[j][1], p, false); p = __builtin_amdgcn_cvt_pk_fp8_f32(v[j][2], v[j][3], p, true); ((GAS unsigned*)q8row)[64 * j + lane] = (unsigned)p; }
    }
    if constexpr (QMODE == 1) {
#pragma unroll
        for (int o = 1; o < 64; o <<= 1) am = fmaxf(am, __shfl_xor(am, o));
        const float qs = am > 0.f ? 127.0f / am : 0.f;
#pragma unroll
        for (int j = 0; j < 16; ++j) { const int q0 = (int)__builtin_rintf(v[j][0] * qs), q1 = (int)__builtin_rintf(v[j][1] * qs), q2 = (int)__builtin_rintf(v[j][2] * qs), q3 = (int)__builtin_rintf(v[j][3] * qs);
            ((GAS unsigned*)q8row)[64 * j + lane] = (unsigned)(q0 & 255) | ((unsigned)(q1 & 255) << 8) | ((unsigned)(q2 & 255) << 16) | ((unsigned)q3 << 24); }
        if (lane == 0) *sxp = am * (1.0f / 127.0f);
    }
}
__device__ __forceinline__ void rms2_row(const bf16* xrow, const float* g, unsigned char* q8row, float* sxp, unsigned char* x4row, int lane) {
    const GAS v4u* xr = (const GAS v4u*)xrow + lane; const GAS f32x4* gr = (const GAS f32x4*)g + 2 * lane;
    f32x4 v[8][2]; float s = 0.f;
#pragma unroll
    for (int j = 0; j < 8; ++j) { unpack8(xr[64 * j], v[j][0], v[j][1]); s += dot4(v[j][0], v[j][0]) + dot4(v[j][1], v[j][1]); }
    const float r = rsqrtf(wave_sum(s) * (1.f / D) + EPS);
    float am = 0.f;
#pragma unroll
    for (int j = 0; j < 8; ++j) { v[j][0] = v[j][0] * r * gr[128 * j]; v[j][1] = v[j][1] * r * gr[128 * j + 1];
#pragma unroll
        for (int e = 0; e < 4; ++e) am = fmaxf(am, fmaxf(fabsf(v[j][0][e]), fabsf(v[j][1][e]))); }
#pragma unroll
    for (int o = 1; o < 64; o <<= 1) am = fmaxf(am, __shfl_xor(am, o));
    const float qs = am > 0.f ? 127.0f / am : 0.f;
    if (lane == 0) *sxp = am * (1.0f / 127.0f);
#pragma unroll
    for (int j = 0; j < 8; ++j) {
        const f32x4 y0 = v[j][0], y1 = v[j][1];
        { u32x2_t w;
          w.x = (unsigned)((int)__builtin_rintf(y0[0] * qs) & 255) | ((unsigned)((int)__builtin_rintf(y0[1] * qs) & 255) << 8) | ((unsigned)((int)__builtin_rintf(y0[2] * qs) & 255) << 16) | ((unsigned)(int)__builtin_rintf(y0[3] * qs) << 24);
          w.y = (unsigned)((int)__builtin_rintf(y1[0] * qs) & 255) | ((unsigned)((int)__builtin_rintf(y1[1] * qs) & 255) << 8) | ((unsigned)((int)__builtin_rintf(y1[2] * qs) & 255) << 16) | ((unsigned)(int)__builtin_rintf(y1[3] * qs) << 24);
          ((GAS u32x2_t*)q8row)[64 * j + lane] = w; }
        unsigned hi = 0u, lo = 0u;
        hi = __builtin_amdgcn_cvt_scalef32_pk_fp4_f32(hi, y0[0], y0[1], 1.0f, 0); hi = __builtin_amdgcn_cvt_scalef32_pk_fp4_f32(hi, y0[2], y0[3], 1.0f, 1);
        hi = __builtin_amdgcn_cvt_scalef32_pk_fp4_f32(hi, y1[0], y1[1], 1.0f, 2); hi = __builtin_amdgcn_cvt_scalef32_pk_fp4_f32(hi, y1[2], y1[3], 1.0f, 3);
        const f32x2_t d0 = __builtin_amdgcn_cvt_scalef32_pk_f32_fp4(hi, 1.0f, 0), d1 = __builtin_amdgcn_cvt_scalef32_pk_f32_fp4(hi, 1.0f, 1), d2 = __builtin_amdgcn_cvt_scalef32_pk_f32_fp4(hi, 1.0f, 2), d3 = __builtin_amdgcn_cvt_scalef32_pk_f32_fp4(hi, 1.0f, 3);
        lo = __builtin_amdgcn_cvt_scalef32_pk_fp4_f32(lo, (y0[0] - d0.x) * 8.f, (y0[1] - d0.y) * 8.f, 1.0f, 0); lo = __builtin_amdgcn_cvt_scalef32_pk_fp4_f32(lo, (y0[2] - d1.x) * 8.f, (y0[3] - d1.y) * 8.f, 1.0f, 1);
        lo = __builtin_amdgcn_cvt_scalef32_pk_fp4_f32(lo, (y1[0] - d2.x) * 8.f, (y1[1] - d2.y) * 8.f, 1.0f, 2); lo = __builtin_amdgcn_cvt_scalef32_pk_fp4_f32(lo, (y1[2] - d3.x) * 8.f, (y1[3] - d3.y) * 8.f, 1.0f, 3);
        unsigned char* const xd = x4row + (size_t)(2 * j + (lane >> 5)) * ((size_t)M * 256) + (lane & 31) * 4;
        *(GAS unsigned*)xd = hi; *(GAS unsigned*)(xd + 128) = lo;
    }
}
__device__ __forceinline__ void quant_w8(Frame& F) {
    const int gw = F.vcu * NWAVES + F.wave, NGW = F.G * NWAVES, lane = F.lane;
    for (int nn = gw; nn < INW + PQW; nn += NGW) {
        const bool qp = nn >= INW; const int n = qp ? nn - INW : nn;
        if (!qp && n >= BF_BASE * 256 && n < (BF_BASE + BF_TILES) * 256) continue;
        const GAS v4u* src = (const GAS v4u*)((qp ? WSP(const bf16, WS_WQP) : WSP(const bf16, WS_WIN)) + (size_t)n * D) + lane;
        f32x4 lo[8], hi[8]; float am = 0.f;
#pragma unroll
        for (int j = 0; j < 8; ++j) { unpack8(src[64 * j], lo[j], hi[j]);
            am = fmaxf(am, fmaxf(fmaxf(fmaxf(fabsf(lo[j][0]), fabsf(lo[j][1])), fmaxf(fabsf(lo[j][2]), fabsf(lo[j][3]))), fmaxf(fmaxf(fabsf(hi[j][0]), fabsf(hi[j][1])), fmaxf(fabsf(hi[j][2]), fabsf(hi[j][3]))))); }
#pragma unroll
        for (int o = 1; o < 64; o <<= 1) am = fmaxf(am, __shfl_xor(am, o));
        const float qs = am > 0.f ? 127.0f / am : 0.f;
        GAS u32x2_t* dst = (GAS u32x2_t*)(F.ws + (qp ? WS_W8QP : WS_W8) + (size_t)n * D) + lane;
#pragma unroll
        for (int j = 0; j < 8; ++j) { u32x2_t w;
            w.x = (unsigned)((int)__builtin_rintf(lo[j][0] * qs) & 255) | ((unsigned)((int)__builtin_rintf(lo[j][1] * qs) & 255) << 8) | ((unsigned)((int)__builtin_rintf(lo[j][2] * qs) & 255) << 16) | ((unsigned)(int)__builtin_rintf(lo[j][3] * qs) << 24);
            w.y = (unsigned)((int)__builtin_rintf(hi[j][0] * qs) & 255) | ((unsigned)((int)__builtin_rintf(hi[j][1] * qs) & 255) << 8) | ((unsigned)((int)__builtin_rintf(hi[j][2] * qs) & 255) << 16) | ((unsigned)(int)__builtin_rintf(hi[j][3] * qs) << 24);
            dst[64 * j] = w; }
        if (lane == 0) (qp ? WSP(float, WS_SWQ) : WSP(float, WS_SW))[n] = am * (1.0f / 127.0f);
    }
}
__device__ __forceinline__ void p0_prologue(Frame& F) {
    LAS float* scr = (LAS float*)(F.lds + RING_OFF + F.wave * 16384);
    const int gw = F.vcu * NWAVES + F.wave, NGW = F.G * NWAVES;
    constexpr int I_IN = (D / 64) * (INW / 32), I_OA = (QW / 64) * (D / 32), I_OC = (CW / 64) * (D / 32), I_OUT = (D / 64) * (D / 32), I_QP = (D / 64) * (PQW / 32);
    constexpr int NITEMS = I_IN + I_OA + I_OC + I_OUT + I_QP;
    bf16* Win_t = WSP(bf16, WS_WIN); bf16* Wo_t = WSP(bf16, WS_WO); bf16* Wout_t = WSP(bf16, WS_WOUT); bf16* Wqp_t = WSP(bf16, WS_WQP);
    for (int it = gw; it < NITEMS; it += NGW) {
        int r = it;
        if (r < I_IN) { p0_transpose_item(F.w_in, D, INW, Win_t, 0, scr, r, F.lane); continue; } r -= I_IN;
        if (r < I_OA) { p0_transpose_item(F.w_oa, QW, D, Wo_t, 0, scr, r, F.lane); continue; } r -= I_OA;
        if (r < I_OC) { p0_transpose_item(F.w_oc, CW, D, Wo_t, D, scr, r, F.lane); continue; } r -= I_OC;
        if (r < I_OUT) { p0_transpose_item(F.w_out, D, D, Wout_t, 0, scr, r, F.lane); continue; } r -= I_OUT;
        p0_transpose_item(F.w_qp, D, PQW, Wqp_t, 0, scr, r, F.lane);
    }
    {
        bf16* SK = WSP(bf16, WS_SK); const int nth = F.G * NWAVES * 64, gt = gw * 64 + F.lane;
        for (int i = gt; i < PH * 2 * NKEYS * 128 / 4; i += nth) { const f32x4 v = ((const GAS f32x4*)F.subk)[i]; u32x2_t w; w.x = cvt_pk_bf16(v[0], v[1]); w.y = cvt_pk_bf16(v[2], v[3]); ((GAS u32x2_t*)SK)[i] = w; }
    }
    bf16* XN = WSP(bf16, WS_XN);
    for (int m = gw; m < M; m += NGW) rms_row_to_bf16<1>(F.x + (size_t)m * D, F.g1, XN + (size_t)m * D, (unsigned*)(F.ws + WS_XN8 + (size_t)m * D), WSP(float, WS_SX) + m, F.lane);
    for (int r = gw; r < 2 * NEXP; r += NGW) {
        const bool up = r >= NEXP; const int rr = up ? r - NEXP : r;
        const GAS f32x4* src = (const GAS f32x4*)((up ? F.w_up : F.w_down) + (size_t)rr * D) + 2 * F.lane;
        f32x4 v[16]; float am = 0.f;
#pragma unroll
        for (int i = 0; i < 8; ++i) { v[2 * i] = src[128 * i]; v[2 * i + 1] = src[128 * i + 1]; }
#pragma unroll
        for (int i = 0; i < 16; ++i) am = fmaxf(am, fmaxf(fmaxf(fabsf(v[i][0]), fabsf(v[i][1])), fmaxf(fabsf(v[i][2]), fabsf(v[i][3]))));
#pragma unroll
        for (int o = 1; o < 64; o <<= 1) am = fmaxf(am, __shfl_xor(am, o));
        const float sc = am > 0.f ? 6.0f / am : 1.0f;
        unsigned char* const dstb = F.ws + (up ? WS_W4U : WS_W4D) + (size_t)rr * 128 + (size_t)(F.lane >> 5) * SLICE_BYTES + (F.lane & 31) * 4;
#pragma unroll
        for (int i = 0; i < 8; ++i) { unsigned p = 0u;
            if (NIBBLE_SWAP_DOWN && !up) {
            p = __builtin_amdgcn_cvt_scalef32_pk_fp4_f32(p, v[2 * i][1] * sc, v[2 * i][0] * sc, 1.0f, 0); p = __builtin_amdgcn_cvt_scalef32_pk_fp4_f32(p, v[2 * i][3] * sc, v[2 * i][2] * sc, 1.0f, 1);
            p = __builtin_amdgcn_cvt_scalef32_pk_fp4_f32(p, v[2 * i + 1][1] * sc, v[2 * i + 1][0] * sc, 1.0f, 2); p = __builtin_amdgcn_cvt_scalef32_pk_fp4_f32(p, v[2 * i + 1][3] * sc, v[2 * i + 1][2] * sc, 1.0f, 3);
            } else {
            p = __builtin_amdgcn_cvt_scalef32_pk_fp4_f32(p, v[2 * i][0] * sc, v[2 * i][1] * sc, 1.0f, 0); p = __builtin_amdgcn_cvt_scalef32_pk_fp4_f32(p, v[2 * i][2] * sc, v[2 * i][3] * sc, 1.0f, 1);
            p = __builtin_amdgcn_cvt_scalef32_pk_fp4_f32(p, v[2 * i + 1][0] * sc, v[2 * i + 1][1] * sc, 1.0f, 2); p = __builtin_amdgcn_cvt_scalef32_pk_fp4_f32(p, v[2 * i + 1][2] * sc, v[2 * i + 1][3] * sc, 1.0f, 3);
            }
            *(GAS unsigned*)(dstb + (size_t)(2 * i) * SLICE_BYTES) = p; }
        if (F.lane == 0) WSP(float, up ? WS_SCU : WS_SCD)[rr] = am > 0.f ? am * (1.0f / 6.0f) : 1.0f;
    }
}

__device__ __forceinline__ unsigned off_b(unsigned row, unsigned ch) { return 256u * row + 16u * (ch ^ (((row & 3u) << 2) | ((row >> 2) & 3u))); }
__device__ __forceinline__ unsigned tr_addr16(unsigned lane, unsigned c, unsigned ks, unsigned t) {
    const unsigned g = lane >> 4, q = (lane & 15u) >> 2, p = lane & 3u;
    return off_b(32u * ks + 8u * g + 4u * t + q, 2u * c + (p >> 1)) + 8u * (p & 1u);
}
__device__ __forceinline__ v4i16_t tr_read(LAS unsigned char* p) { return __builtin_amdgcn_ds_read_tr16_b64_v4i16((LAS v4i16_t*)p); }
#define MFMA16(a, b, c) __builtin_amdgcn_mfma_f32_16x16x32_bf16((a), (b), (c), 0, 0, 0)

template <int PROBE> __device__ __forceinline__ void attn_unit(Frame& F, const int U) {
    const int lane = F.lane, wave = F.wave, c = lane & 15, hg = lane >> 4, tid = F.tid;
    const int hp = U & 1, kvh = (U >> 1) & 3, nblk = (U >> 3) & 31, b = U >> 8;
    const int hq = kvh * 4 + hp * 2 + (wave >> 2), i0 = (wave & 3) * 32;
    const size_t tok0 = (size_t)b * SEQ + (size_t)nblk * 128;
    const bf16* QB = WSP(const bf16, WS_Q); const bf16* KB = WSP(const bf16, WS_K); const bf16* VB = WSP(const bf16, WS_V); bf16* OB = PROBE ? WSP(bf16, WS_XN) : WSP(bf16, WS_AB);
    bf16x8 qf[2][4];
    {
        float g[4][8];
#pragma unroll
        for (int ks = 0; ks < 4; ++ks) { const f32x4 a = *(const GAS f32x4*)(F.gq + 32 * ks + 8 * hg), bb = *(const GAS f32x4*)(F.gq + 32 * ks + 8 * hg + 4);
#pragma unroll
            for (int e = 0; e < 4; ++e) { g[ks][e] = a[e]; g[ks][4 + e] = bb[e]; } }
#pragma unroll
        for (int qt = 0; qt < 2; ++qt) {
            const bf16* qrow = QB + (tok0 + i0 + 16 * qt + c) * QW + hq * HD + 8 * hg;
            f32x4 lo[4], hi[4]; float ss = 0.f;
#pragma unroll
            for (int ks = 0; ks < 4; ++ks) { unpack8(*(const GAS v4u*)(qrow + 32 * ks), lo[ks], hi[ks]); ss += dot4(lo[ks], lo[ks]) + dot4(hi[ks], hi[ks]); }
            ss += __shfl_xor(ss, 16); ss += __shfl_xor(ss, 32);
            const float r = rsqrtf(ss * (1.f / HD) + EPS) * (0.08838834764831845f * LOG2E);
#pragma unroll
            for (int ks = 0; ks < 4; ++ks) { f32x4 a, bb;
#pragma unroll
                for (int e = 0; e < 4; ++e) { a[e] = lo[ks][e] * r * g[ks][e]; bb[e] = hi[ks][e] * r * g[ks][4 + e]; }
                qf[qt][ks] = __builtin_bit_cast(bf16x8, pack8(a, bb)); }
        }
    }
    const float slope2 = __builtin_amdgcn_exp2f(-0.5f * (float)(hq + 1)) * LOG2E;
    const float sink2 = F.sink[hq] * LOG2E;
    float mrun[2] = {sink2, sink2}, lrun[2]; lrun[0] = lrun[1] = (hg == 0) ? 1.f : 0.f;
    f32x4 acc[8][2];
#pragma unroll
    for (int dt = 0; dt < 8; ++dt) { acc[dt][0] = (f32x4){0.f, 0.f, 0.f, 0.f}; acc[dt][1] = (f32x4){0.f, 0.f, 0.f, 0.f}; }
    const f32x4 gk0 = *(const GAS f32x4*)(F.gk + (tid & 15) * 8), gk1 = *(const GAS f32x4*)(F.gk + (tid & 15) * 8 + 4);
    __syncthreads();
    int bufi = 0;
#pragma unroll 1
    for (int kbi = -1; kbi <= 1; ++kbi) {
        const int kb = nblk + kbi; if (kb < 0 || kb >= SEQ / 128) continue;
        LAS unsigned char* Kl = F.lds + RING_OFF + bufi * 65536; LAS unsigned char* Vl = Kl + 32768; bufi ^= 1;
#pragma unroll
        for (int it = 0; it < (PROBE == 3 ? 0 : 4); ++it) {
            const int row = (tid >> 4) + 32 * it, ch = tid & 15;
            const size_t src = ((size_t)b * SEQ + (size_t)kb * 128 + row) * KVW + kvh * HD + ch * 8;
            f32x4 k0, k1; unpack8(*(const GAS v4u*)(KB + src), k0, k1);
            float ss = dot4(k0, k0) + dot4(k1, k1);
            ss += __shfl_xor(ss, 1); ss += __shfl_xor(ss, 2); ss += __shfl_xor(ss, 4); ss += __shfl_xor(ss, 8);
            const float r = rsqrtf(ss * (1.f / HD) + EPS);
            *(LAS v4u*)(Kl + off_b(row, ch)) = pack8(k0 * r * gk0, k1 * r * gk1);
            *(LAS v4u*)(Vl + off_b(row, ch)) = *(const GAS v4u*)(VB + src);
        }
        __syncthreads();
        const int ks_lo = kbi < 0 ? (i0 >> 5) : 0, ks_hi = kbi > 0 ? (i0 >> 5) + 1 : 4;
#pragma unroll 2
        for (int ks32 = (PROBE == 2 ? ks_hi : ks_lo); ks32 < ks_hi; ++ks32) {
            f32x4 sa[2], sb[2];
            sa[0] = sa[1] = sb[0] = sb[1] = (f32x4){0.f, 0.f, 0.f, 0.f};
            const unsigned krow = 32u * ks32 + 8u * (c >> 2) + (c & 3);
#pragma unroll
            for (int ks = 0; ks < 4; ++ks) {
                const bf16x8 ka = *(const LAS bf16x8*)(Kl + off_b(krow, 4 * ks + hg)), kb2 = *(const LAS bf16x8*)(Kl + off_b(krow + 4, 4 * ks + hg));
#pragma unroll
                for (int qt = 0; qt < 2; ++qt) { sa[qt] = MFMA16(ka, qf[qt][ks], sa[qt]); sb[qt] = MFMA16(kb2, qf[qt][ks], sb[qt]); }
            }
            bf16x8 pf[2];
#pragma unroll
            for (int qt = 0; qt < 2; ++qt) {
                float s[8] = {sa[qt][0], sa[qt][1], sa[qt][2], sa[qt][3], sb[qt][0], sb[qt][1], sb[qt][2], sb[qt][3]};
                const int rel0 = kbi * 128 + 32 * ks32 + 8 * hg - (i0 + 16 * qt + c);
                float mx = -INFINITY;
#pragma unroll
                for (int j = 0; j < 8; ++j) { const int rel = rel0 + j, dist = rel < 0 ? -rel : rel; const float sv = s[j] - slope2 * (float)dist; s[j] = (dist <= 128) ? sv : -INFINITY; mx = fmaxf(mx, s[j]); }
                mx = fmaxf(mx, __shfl_xor(mx, 16)); mx = fmaxf(mx, __shfl_xor(mx, 32));
                const float mn = fmaxf(mrun[qt], mx), alpha = __builtin_amdgcn_exp2f(mrun[qt] - mn); mrun[qt] = mn;
                float ps = 0.f;
#pragma unroll
                for (int j = 0; j < 8; ++j) { s[j] = __builtin_amdgcn_exp2f(s[j] - mn); ps += s[j]; }
                lrun[qt] = lrun[qt] * alpha + ps;
                pf[qt] = __builtin_bit_cast(bf16x8, pack8((f32x4){s[0], s[1], s[2], s[3]}, (f32x4){s[4], s[5], s[6], s[7]}));
#pragma unroll
                for (int dt = 0; dt < 8; ++dt) acc[dt][qt] = acc[dt][qt] * alpha;
            }
#pragma unroll
            for (int dt = 0; dt < 8; ++dt) {
                const v4i16_t vlo = tr_read(Vl + tr_addr16(lane, dt, ks32, 0)), vhi = tr_read(Vl + tr_addr16(lane, dt, ks32, 1));
                const bf16x8 vf = {vlo[0], vlo[1], vlo[2], vlo[3], vhi[0], vhi[1], vhi[2], vhi[3]};
#pragma unroll
                for (int qt = 0; qt < 2; ++qt) acc[dt][qt] = MFMA16(vf, pf[qt], acc[dt][qt]);
            }
        }
    }
#pragma unroll
    for (int qt = 0; qt < 2; ++qt) {
        float l = lrun[qt]; l += __shfl_xor(l, 16); l += __shfl_xor(l, 32);
        const float inv = 1.0f / l;
        bf16* orow = OB + (tok0 + i0 + 16 * qt + c) * QW + hq * HD + 4 * hg;
#pragma unroll
        for (int dt = 0; dt < 8; ++dt) { const f32x4 o = acc[dt][qt] * inv; u32x2_t w; w.x = cvt_pk_bf16(o[0], o[1]); w.y = cvt_pk_bf16(o[2], o[3]); *(GAS u32x2_t*)(orow + 16 * dt) = w; }
    }
}
__device__ __forceinline__ void conv_phase(Frame& F) {
    const bf16* HB = WSP(const bf16, WS_H); const bf16* BB = WSP(const bf16, WS_B); const bf16* CB = WSP(const bf16, WS_C); bf16* OC = WSP(bf16, WS_AB) + (size_t)M * CW;
    const unsigned nchunk = (unsigned)M * (CW / 8);
    for (unsigned e = (unsigned)F.vcu * 512u + (unsigned)F.tid; e < nchunk; e += (unsigned)F.G * 512u) {
        const int t = (int)(e >> 8), cc = (int)(e & 255u) * 8, tl = t & (SEQ - 1);
        const size_t o = (size_t)t * CW + cc;
        f32x4 h0, h1, c0, c1, up0, up1, un0, un1;
        unpack8(*(const GAS v4u*)(HB + o), h0, h1); unpack8(*(const GAS v4u*)(CB + o), c0, c1);
        const f32x4 uc0 = h0 * c0, uc1 = h1 * c1;
        up0 = up1 = un0 = un1 = (f32x4){0.f, 0.f, 0.f, 0.f};
        if (tl > 0) { unpack8(*(const GAS v4u*)(HB + o - CW), h0, h1); unpack8(*(const GAS v4u*)(CB + o - CW), c0, c1); up0 = h0 * c0; up1 = h1 * c1; }
        if (tl < SEQ - 1) { unpack8(*(const GAS v4u*)(HB + o + CW), h0, h1); unpack8(*(const GAS v4u*)(CB + o + CW), c0, c1); un0 = h0 * c0; un1 = h1 * c1; }
        const GAS f32x4* w = (const GAS f32x4*)(F.conv_w + cc);
        const f32x4 y0 = w[0] * up0 + w[CW / 4] * uc0 + w[2 * CW / 4] * un0, y1 = w[1] * up1 + w[CW / 4 + 1] * uc1 + w[2 * CW / 4 + 1] * un1;
        f32x4 b0, b1; unpack8(*(const GAS v4u*)(BB + o), b0, b1);
        *(GAS v4u*)(OC + o) = pack8(b0 * y0, b1 * y1);
    }
}

__device__ __forceinline__ unsigned ordf(float f) { const unsigned u = __float_as_uint(f); return u ^ ((u >> 31) ? 0xFFFFFFFFu : 0x80000000u); }
__device__ __forceinline__ float unordf(unsigned k) { return __uint_as_float((k & 0x80000000u) ? (k ^ 0x80000000u) : ~k); }
__device__ __forceinline__ u64 shfl64_xor(u64 v, int m) { const unsigned lo = __shfl_xor((unsigned)v, m), hi = __shfl_xor((unsigned)(v >> 32), m); return ((u64)hi << 32) | lo; }
template <int N> __device__ __forceinline__ void bitonic_merge_desc(unsigned (&a)[N]) {
#pragma unroll
    for (int j = N >> 1; j > 0; j >>= 1)
#pragma unroll
        for (int i = 0; i < N; ++i) { const int l = i ^ j; if (l > i) { const unsigned hi = a[i] > a[l] ? a[i] : a[l], lo = a[i] > a[l] ? a[l] : a[i]; a[i] = hi; a[l] = lo; } }
}
template <int N> __device__ __forceinline__ void bitonic_sort_desc(unsigned (&a)[N]) {
#pragma unroll
    for (int k = 2; k <= N; k <<= 1)
#pragma unroll
        for (int j = k >> 1; j > 0; j >>= 1)
#pragma unroll
            for (int i = 0; i < N; ++i) { const int l = i ^ j; if (l > i) { const unsigned hi = a[i] > a[l] ? a[i] : a[l], lo = a[i] > a[l] ? a[l] : a[i]; const bool desc = ((i & k) == 0); a[i] = desc ? hi : lo; a[l] = desc ? lo : hi; } }
}
__device__ __forceinline__ void xlane_top16(unsigned (&t)[16], const int mask) {
    unsigned m[16];
#pragma unroll
    for (int i = 0; i < 16; ++i) { const unsigned p = __shfl_xor(t[15 - i], mask); m[i] = t[i] > p ? t[i] : p; }
    bitonic_merge_desc<16>(m);
#pragma unroll
    for (int i = 0; i < 16; ++i) t[i] = m[i];
}
struct Stair { int i[52], j[52]; };
constexpr Stair make_stair() { Stair s{}; int n = 0; for (int a = 0; a < 16; ++a) for (int b = 0; b < 16; ++b) if ((a + 1) * (b + 1) <= 16) { s.i[n] = a; s.j[n] = b; ++n; } for (; n < 52; ++n) { s.i[n] = -1; s.j[n] = -1; } return s; }
constexpr Stair STAIR = make_stair();
template <int P> __device__ __forceinline__ unsigned cand1(const float (&v1)[16], const float (&v2)[16]) {
    constexpr int i = STAIR.i[P], j = STAIR.j[P];
    if constexpr (i < 0) return 0u;
    else return (ordf(v1[i] + v2[j]) & ~255u) | (unsigned)(16 * i + j);
}
template <int S> __device__ __forceinline__ void cand_fill(unsigned (&ck)[16], const float (&v1)[16], const float (&v2)[16], int hg) {
    const unsigned k0 = cand1<4 * S + 0>(v1, v2), k1 = cand1<4 * S + 1>(v1, v2), k2 = cand1<4 * S + 2>(v1, v2), k3 = cand1<4 * S + 3>(v1, v2);
    ck[S] = hg == 0 ? k0 : hg == 1 ? k1 : hg == 2 ? k2 : k3;
    if constexpr (S + 1 < 13) cand_fill<S + 1>(ck, v1, v2, hg);
}
__device__ __forceinline__ void route_task(Frame& F, const int tg, const int h) {
    const int lane = F.lane, c = lane & 15, hg = lane >> 4;
    const int tok = tg * 16 + c;
    const bf16* QP = WSP(const bf16, WS_QP); LAS unsigned char* SKl = F.lds + RING_OFF;
    unsigned sel[2][16];
#pragma unroll
    for (int half = 0; half < 2; ++half) {
        bf16x8 bq[4];
#pragma unroll
        for (int ks = 0; ks < 4; ++ks) bq[ks] = *(const GAS bf16x8*)(QP + (size_t)tok * PQW + h * 256 + half * 128 + 32 * ks + 8 * hg);
        unsigned k[32];
#pragma unroll
        for (int tile = 0; tile < 8; ++tile) {
            f32x4 s = (f32x4){0.f, 0.f, 0.f, 0.f};
#pragma unroll
            for (int ks = 0; ks < 4; ++ks) { const bf16x8 a = *(const LAS bf16x8*)(SKl + off_b(half * 128 + 16 * tile + c, 4 * ks + hg)); s = MFMA16(a, bq[ks], s); }
#pragma unroll
            for (int r = 0; r < 4; ++r) k[tile * 4 + r] = (ordf(s[r]) & ~127u) | (unsigned)(16 * tile + 4 * hg + r);
            if (tile & 1) asm volatile("" ::: "memory");
        }
        bitonic_sort_desc<32>(k);
        unsigned t[16];
#pragma unroll
        for (int i = 0; i < 16; ++i) t[i] = k[i];
        xlane_top16(t, 16); xlane_top16(t, 32);
#pragma unroll
        for (int i = 0; i < 16; ++i) sel[half][i] = t[i];
        asm volatile("" ::: "memory");
    }
    float v1[16], v2[16]; unsigned n1[16], n2[16];
#pragma unroll
    for (int i = 0; i < 16; ++i) { v1[i] = unordf(sel[0][i] & ~127u); n1[i] = sel[0][i] & 127u; v2[i] = unordf(sel[1][i] & ~127u); n2[i] = sel[1][i] & 127u; }
    LAS unsigned char* scr = F.lds + RING_OFF + 65536 + F.wave * 4096 + c * 256;
    if (hg == 0) {
#pragma unroll
        for (int q4 = 0; q4 < 4; ++q4) { *(LAS f32x4*)(scr + 16 * q4) = (f32x4){v1[4 * q4], v1[4 * q4 + 1], v1[4 * q4 + 2], v1[4 * q4 + 3]}; *(LAS f32x4*)(scr + 64 + 16 * q4) = (f32x4){v2[4 * q4], v2[4 * q4 + 1], v2[4 * q4 + 2], v2[4 * q4 + 3]};
            *(LAS v4u*)(scr + 128 + 16 * q4) = (v4u){n1[4 * q4], n1[4 * q4 + 1], n1[4 * q4 + 2], n1[4 * q4 + 3]}; *(LAS v4u*)(scr + 192 + 16 * q4) = (v4u){n2[4 * q4], n2[4 * q4 + 1], n2[4 * q4 + 2], n2[4 * q4 + 3]}; } }
    unsigned ck[16];
    cand_fill<0>(ck, v1, v2, hg); ck[13] = ck[14] = ck[15] = 0u;
    bitonic_sort_desc<16>(ck);
    xlane_top16(ck, 16); xlane_top16(ck, 32);
    int oi[4]; float sc[4]; float mx = -INFINITY;
#pragma unroll
    for (int jj = 0; jj < 4; ++jj) {
        const unsigned w = hg == 0 ? ck[jj] : hg == 1 ? ck[4 + jj] : hg == 2 ? ck[8 + jj] : ck[12 + jj];
        const unsigned i4 = (w >> 2) & 0x3Cu, j4 = (w & 15u) << 2;
        sc[jj] = *(const LAS float*)(scr + i4) + *(const LAS float*)(scr + 64 + j4);
        oi[jj] = (int)(*(const LAS unsigned*)(scr + 128 + i4) * (unsigned)NKEYS + *(const LAS unsigned*)(scr + 192 + j4));
        mx = fmaxf(mx, sc[jj]);
    }
    mx = fmaxf(mx, __shfl_xor(mx, 16)); mx = fmaxf(mx, __shfl_xor(mx, 32));
    float ev[4], sum = 0.f;
#pragma unroll
    for (int jj = 0; jj < 4; ++jj) { ev[jj] = __builtin_amdgcn_exp2f((sc[jj] - mx) * LOG2E); sum += ev[jj]; }
    sum += __shfl_xor(sum, 16); sum += __shfl_xor(sum, 32);
    const float inv = 1.0f / sum;
    const size_t o = ((size_t)tok * PH + h) * TOPK + 4 * hg;
    *(GAS i32x4_t*)(WSP(int, WS_IDX) + o) = (i32x4_t){oi[0], oi[1], oi[2], oi[3]};
    *(GAS f32x4*)(WSP(float, WS_GATE) + o) = (f32x4){ev[0] * inv, ev[1] * inv, ev[2] * inv, ev[3] * inv};
}

__device__ __forceinline__ float gelu_erf(float v) { return 0.5f * v * (1.0f + erff(v * 0.70710678118654752f)); }
typedef int i32x8_t __attribute__((ext_vector_type(8)));
#define FP4X2(w, b) __builtin_amdgcn_cvt_scalef32_pk_f32_fp4((w), 1.0f, (b))
__device__ __forceinline__ void fmac(float& acc, float a, float b) { asm("v_fmac_f32 %0, %1, %2" : "+v"(acc) : "v"(a), "v"(b)); }
struct PeerDeal { int ox, nx, t0, stride, cnt, ns; };
__device__ __forceinline__ void pd_item(int n, const PeerDeal& d, int& t, int& sl) { const int N = d.ns * d.cnt, nn = n < N ? n : N - 1, j = nn / d.cnt; sl = d.ox + j * d.nx; t = d.t0 + (nn - j * d.cnt) * d.stride; }
__device__ __forceinline__ void pd_idx(Frame& F, int t, int lane, i32x4_t (&idv)[4]) {
    const GAS i32x4_t* ip = (const GAS i32x4_t*)(WSP(const int, WS_IDX) + (size_t)t * 128 + (lane >> 3) * 16);
#pragma unroll
    for (int a = 0; a < 4; ++a) idv[a] = ip[a];
}
__device__ __forceinline__ void pd_rows(Frame& F, int t, int sl, int lane, const i32x4_t (&idv)[4], v4u (&rows)[16], v4u (&xw)[2]) {
    const unsigned char* xr = F.ws + WS_X2N8 + ((size_t)sl * M + t) * 256 + 16 * (lane >> 4) + ((lane & 15) == 1 ? 128 : 0);
#pragma unroll
    for (int ks = 0; ks < 2; ++ks) xw[ks] = *(const GAS v4u*)(xr + 64 * ks);
    const unsigned char* WD = F.ws + WS_W4D + (size_t)sl * SLICE_BYTES;
    const unsigned lo16 = 16u * (unsigned)(lane & 7);
#pragma unroll
    for (int j = 0; j < 16; ++j) rows[j] = *(const GAS v4u*)(WD + (size_t)(((unsigned)idv[j >> 2][j & 3] << 7) + lo16));
}
__device__ __forceinline__ float dpp_swap1(float v) { return __builtin_bit_cast(float, __builtin_amdgcn_update_dpp(0, __builtin_bit_cast(int, v), 0xB1  , 0xF, 0xF, true)); }
__device__ __forceinline__ void pd_compute(Frame& F, int t, int sl, int lane, const v4u (&rows)[16], const v4u (&xw)[2]) {
    const int r = lane & 15, g = lane >> 4;
    LAS unsigned char* tile = F.lds + RING_OFF + F.wave * 16384;
    { LAS unsigned char* wp = tile + (lane >> 3) * 2048;
#pragma unroll
      for (int j = 0; j < 16; ++j) *(LAS v4u*)(wp + j * 128 + (((lane & 7) ^ ((j >> 1) & 7)) << 4)) = rows[j]; }
    float* pp = WSP(float, WS_PART) + ((size_t)sl * M + t) * 128 + 4 * g;
    const int scb = (r == 1) ? 0x7C7C7C7C   : 0x7F7F7F7F;
    i32x8_t xb[2];
#pragma unroll
    for (int ks = 0; ks < 2; ++ks) xb[ks] = (i32x8_t){(int)xw[ks].x, (int)xw[ks].y, (int)xw[ks].z, (int)xw[ks].w, 0, 0, 0, 0};
    const LAS unsigned char* rp = tile + r * 128; const int fr = (r >> 1) & 7;
    v4u a[8][2];
#pragma unroll
    for (int i = 0; i < 8; ++i)
#pragma unroll
        for (int ks = 0; ks < 2; ++ks) a[i][ks] = *(const LAS v4u*)(rp + i * 2048 + (((4 * ks + g) ^ fr) << 4));
    f32x4 c[8];
#pragma unroll
    for (int i = 0; i < 8; ++i) { const v4u w = a[i][0]; c[i] = __builtin_amdgcn_mfma_scale_f32_16x16x128_f8f6f4((i32x8_t){(int)w.x, (int)w.y, (int)w.z, (int)w.w, 0, 0, 0, 0}, xb[0], (f32x4){0.f, 0.f, 0.f, 0.f}, 4  , 4  , 0, 0x7F7F7F7F, 0, scb); }
#pragma unroll
    for (int i = 0; i < 8; ++i) { const v4u w = a[i][1]; c[i] = __builtin_amdgcn_mfma_scale_f32_16x16x128_f8f6f4((i32x8_t){(int)w.x, (int)w.y, (int)w.z, (int)w.w, 0, 0, 0, 0}, xb[1], c[i], 4, 4, 0, 0x7F7F7F7F, 0, scb); }
#pragma unroll
    for (int i = 0; i < 8; ++i)
#pragma unroll
        for (int e = 0; e < 4; ++e) c[i][e] += dpp_swap1(c[i][e]);
    if (r == 0) {
#pragma unroll
        for (int i = 0; i < 8; ++i) *(GAS f32x4*)(pp + 16 * i) = c[i]; }
}
__device__ __forceinline__ void peer_down_pass(Frame& F, const PeerDeal& d) {
    const int lane = F.lane;
    const int N = d.ns * d.cnt; if (N <= 0) return;
    i32x4_t I0[4], I1[4]; v4u R0[16], R1[16], X0[2], X1[2];
    int t0, s0, t1, s1, t2, s2, t3, s3;
    pd_item(0, d, t0, s0); pd_idx(F, t0, lane, I0);
    pd_item(1, d, t1, s1); pd_idx(F, t1, lane, I1);
    pd_rows(F, t0, s0, lane, I0, R0, X0);
#pragma unroll 1
    for (int n = 0; n < N; n += 2) {
        pd_item(n + 2, d, t2, s2); pd_idx(F, t2, lane, I0);
        __builtin_amdgcn_sched_barrier(0);
        pd_rows(F, t1, s1, lane, I1, R1, X1);
        __builtin_amdgcn_sched_barrier(0);
        pd_compute(F, t0, s0, lane, R0, X0);
        __builtin_amdgcn_sched_barrier(0);
        pd_item(n + 3, d, t3, s3); pd_idx(F, t3, lane, I1);
        __builtin_amdgcn_sched_barrier(0);
        pd_rows(F, t2, s2, lane, I0, R0, X0);
        __builtin_amdgcn_sched_barrier(0);
        pd_compute(F, t1, s1, lane, R1, X1);
        __builtin_amdgcn_sched_barrier(0);
        t0 = t2; s0 = s2; t1 = t3; s1 = s3;
    }
}
__device__ __forceinline__ void peer_combine_token(Frame& F, const int t) {
    const int lane = F.lane;
    const float* PART = WSP(const float, WS_PART) + (size_t)t * 128 + 2 * lane; float* GATEP = WSP(float, WS_GATE) + (size_t)t * 128 + 2 * lane;
    f32x2_t a = (f32x2_t){0.f, 0.f};
#pragma unroll
    for (int sl = 0; sl < 16; ++sl) a += *(const GAS f32x2_t*)(PART + (size_t)sl * M * 128);
    const int id0 = WSP(const int, WS_IDX)[(size_t)t * 128 + 2 * lane], id1 = WSP(const int, WS_IDX)[(size_t)t * 128 + 2 * lane + 1];
    const f32x2_t gt = *(const GAS f32x2_t*)GATEP;
    const float c0 = gt.x * gelu_erf(a.x * WSP(const float, WS_SCD)[id0]) * WSP(const float, WS_SCU)[id0], c1 = gt.y * gelu_erf(a.y * WSP(const float, WS_SCD)[id1]) * WSP(const float, WS_SCU)[id1];
    *(GAS f32x2_t*)GATEP = (f32x2_t){c0, c1};
    float bm = fmaxf(fabsf(c0), fabsf(c1));
    bm = fmaxf(bm, __shfl_xor(bm, 1)); bm = fmaxf(bm, __shfl_xor(bm, 2)); bm = fmaxf(bm, __shfl_xor(bm, 4)); bm = fmaxf(bm, __shfl_xor(bm, 8));
    int eb = (int)((__float_as_uint(bm) >> 23) & 255u) - 1;
    eb = eb < 3 ? 3 : eb > 250 ? 250 : eb;
    const float inv = __uint_as_float((unsigned)(254 - eb) << 23);
    const float s0 = c0 * inv, s1 = c1 * inv;
    const unsigned hi = __builtin_amdgcn_cvt_scalef32_pk_fp4_f32(0u, s0, s1, 1.0f, 0);
    const f32x2_t dq = __builtin_amdgcn_cvt_scalef32_pk_f32_fp4(hi, 1.0f, 0);
    const unsigned lo = __builtin_amdgcn_cvt_scalef32_pk_fp4_f32(0u, (s0 - dq.x) * 8.f, (s1 - dq.y) * 8.f, 1.0f, 0);
    unsigned char* cf4 = F.ws + WS_CF4 + (size_t)t * 160;
    ((GAS unsigned char*)cf4)[lane] = (unsigned char)hi; ((GAS unsigned char*)cf4)[64 + lane] = (unsigned char)lo;
    if ((lane & 15) == 0) ((GAS unsigned*)(cf4 + 128))[lane >> 4] = (unsigned)eb * 0x01010101u;
}
struct PmBuf { v4u rows[16]; v4u aw; unsigned e; u32x2_t xv; };
__device__ __forceinline__ void pm_rows(Frame& F, int t, int sl, int lane, const i32x4_t (&idv)[4], PmBuf& b) {
    const int n = lane & 15, g = lane >> 4;
    const unsigned char* WU = F.ws + WS_W4U + (size_t)sl * SLICE_BYTES;
    const unsigned lo16 = 16u * (unsigned)(lane & 7);
#pragma unroll
    for (int j = 0; j < 16; ++j) b.rows[j] = *(const GAS v4u*)(WU + (size_t)(((unsigned)idv[j >> 2][j & 3] << 7) + lo16));
    const unsigned char* cf4 = F.ws + WS_CF4 + (size_t)t * 160;
    b.aw = *(const GAS v4u*)(cf4 + 64 * (n & 1) + 16 * g); b.e = *(const GAS unsigned*)(cf4 + 128 + 4 * g);
    b.xv = *(const GAS u32x2_t*)(WSP(const bf16, WS_X1B) + (size_t)t * D + 256 * sl + 4 * lane);
}
__device__ __forceinline__ void pm_compute(Frame& F, int t, int sl, int lane, const PmBuf& b) {
    const int n = lane & 15, g = lane >> 4;
    LAS unsigned char* tile = F.lds + RING_OFF + F.wave * 16384;
    LAS float* obuf = (LAS float*)(F.lds + OBUF_OFF + F.wave * 1024);
    { LAS unsigned char* wp = tile + (lane >> 3) * 2048; const int cc = lane & 7;
#pragma unroll
      for (int j = 0; j < 16; ++j) { const v4u w = b.rows[j]; *(LAS v4u*)(wp + j * 128 + ((cc ^ (j >> 1)) << 4)) = (j & 1) ? (v4u){w.z, w.w, w.x, w.y} : w; } }
    const LAS unsigned char* rp = tile + (32 * g + n) * 128;
    const bool arow = n < 2;
    const i32x8_t afr = (i32x8_t){arow ? (int)b.aw.x : 0, arow ? (int)b.aw.y : 0, arow ? (int)b.aw.z : 0, arow ? (int)b.aw.w : 0, 0, 0, 0, 0};
    const unsigned sca = n == 0 ? b.e : n == 1 ? b.e - 0x03030303u : 0x7F7F7F7Fu;
    LAS float* const wdst = g == 0 ? obuf + n : (LAS float*)(F.lds + ODUMP_OFF + F.wave * 256) + lane; const int wstep = g == 0 ? 16 : 0;
#pragma unroll
    for (int h = 0; h < 2; ++h) {
        v2i32_t b0[8], b1[8];
#pragma unroll
        for (int q = 0; q < 8; ++q) { const int off = (((8 * h + q) ^ n) << 3); b0[q] = __builtin_amdgcn_ds_read_tr4_b64_v2i32((LAS v2i32_t*)(rp + off)); b1[q] = __builtin_amdgcn_ds_read_tr4_b64_v2i32((LAS v2i32_t*)(rp + 2048 + off)); }
        f32x4 c[8];
#pragma unroll
        for (int q = 0; q < 8; ++q) c[q] = __builtin_amdgcn_mfma_scale_f32_16x16x128_f8f6f4(afr, (i32x8_t){b0[q].x, b0[q].y, b1[q].x, b1[q].y, 0, 0, 0, 0}, (f32x4){0.f, 0.f, 0.f, 0.f}, 4, 4, 0, (int)sca, 0, 0x7F7F7F7F);
#pragma unroll
        for (int q = 0; q < 8; ++q) wdst[(8 * h + q) * wstep] = c[q][0] + c[q][1];
    }
    *(GAS f32x4*)(F.out + (size_t)t * D + 256 * sl + 4 * lane) = (f32x4){bflo(b.xv.x), bfhi(b.xv.x), bflo(b.xv.y), bfhi(b.xv.y)} + *(const LAS f32x4*)(obuf + 4 * lane);
}
__device__ __forceinline__ void peer_up_pass_mfma(Frame& F, const PeerDeal& d) {
    const int lane = F.lane;
    const int N = d.ns * d.cnt; if (N <= 0) return;
    i32x4_t I0[4], I1[4]; PmBuf B0, B1;
    int t0, s0, t1, s1, t2, s2, t3, s3;
    pd_item(0, d, t0, s0); pd_idx(F, t0, lane, I0);
    pd_item(1, d, t1, s1); pd_idx(F, t1, lane, I1);
    pm_rows(F, t0, s0, lane, I0, B0);
#pragma unroll 1
    for (int n = 0; n < N; n += 2) {
        pd_item(n + 2, d, t2, s2); pd_idx(F, t2, lane, I0);
        __builtin_amdgcn_sched_barrier(0);
        pm_rows(F, t1, s1, lane, I1, B1);
        __builtin_amdgcn_sched_barrier(0);
        pm_compute(F, t0, s0, lane, B0);
        __builtin_amdgcn_sched_barrier(0);
        pd_item(n + 3, d, t3, s3); pd_idx(F, t3, lane, I1);
        __builtin_amdgcn_sched_barrier(0);
        pm_rows(F, t2, s2, lane, I0, B0);
        __builtin_amdgcn_sched_barrier(0);
        pm_compute(F, t1, s1, lane, B1);
        __builtin_amdgcn_sched_barrier(0);
        t0 = t2; s0 = s2; t1 = t3; s1 = s3;
    }
}
typedef _Float16 h2_t __attribute__((ext_vector_type(2)));
#define FP4H2(w, b) __builtin_bit_cast(h2_t, __builtin_amdgcn_cvt_scalef32_pk_f16_fp4((w), 1.0f, (b)))
__device__ __forceinline__ void pu_idx(Frame& F, int t, int lane, i32x4_t (&idv)[8], f32x4 (&cfv)[8]) {
    const GAS i32x4_t* ip = (const GAS i32x4_t*)(WSP(const int, WS_IDX) + (size_t)t * 128 + (lane >> 4) * 32); const GAS f32x4* cp = (const GAS f32x4*)(WSP(const float, WS_GATE) + (size_t)t * 128 + (lane >> 4) * 32);
#pragma unroll
    for (int a = 0; a < 8; ++a) { idv[a] = ip[a]; cfv[a] = cp[a]; }
}
template <int H> __device__ __forceinline__ void pu_rows(Frame& F, int sl, int lane, const i32x4_t (&idv)[8], u32x2_t (&rows)[16]) {
    const unsigned char* WU = F.ws + WS_W4U + (size_t)sl * SLICE_BYTES + (lane & 15) * 8;
#pragma unroll
    for (int i = 0; i < 16; ++i) rows[i] = *(const GAS u32x2_t*)(WU + (size_t)idv[4 * H + (i >> 2)][i & 3] * 128);
}
template <int H> __device__ __forceinline__ void pu_compute(const u32x2_t (&rows)[16], const f32x4 (&cfv)[8], h2_t (&acc)[8]) {
#pragma unroll
    for (int i = 0; i < 16; ++i) { const float c = cfv[4 * H + (i >> 2)][i & 3] * 256.0f; const h2_t cc = __builtin_bit_cast(h2_t, __builtin_amdgcn_cvt_pkrtz(c, c));
#pragma unroll
        for (int k = 0; k < 2; ++k) { const unsigned w = rows[i][k];
            acc[4 * k + 0] = FP4H2(w, 0) * cc + acc[4 * k + 0]; acc[4 * k + 1] = FP4H2(w, 1) * cc + acc[4 * k + 1]; acc[4 * k + 2] = FP4H2(w, 2) * cc + acc[4 * k + 2]; acc[4 * k + 3] = FP4H2(w, 3) * cc + acc[4 * k + 3]; } }
}
__device__ __forceinline__ void pu_finish(Frame& F, int t, int sl, int lane, h2_t (&acc)[8]) {
    const int eg = lane >> 4, q = lane & 15;
#pragma unroll
    for (int a = 0; a < 8; ++a) {
        acc[a] = acc[a] + __builtin_bit_cast(h2_t, __shfl_xor(__builtin_bit_cast(unsigned, acc[a]), 16)); acc[a] = acc[a] + __builtin_bit_cast(h2_t, __shfl_xor(__builtin_bit_cast(unsigned, acc[a]), 32)); }
    const h2_t o01 = eg == 0 ? acc[0] : eg == 1 ? acc[2] : eg == 2 ? acc[4] : acc[6], o23 = eg == 0 ? acc[1] : eg == 1 ? acc[3] : eg == 2 ? acc[5] : acc[7];
    GAS f32x4* op = (GAS f32x4*)(F.out + (size_t)t * D + 256 * sl + 16 * q + 4 * eg);
    f32x4 o; { const u32x2_t w = *(const GAS u32x2_t*)(WSP(const bf16, WS_X1B) + (size_t)t * D + 256 * sl + 16 * q + 4 * eg); o = (f32x4){bflo(w.x), bfhi(w.x), bflo(w.y), bfhi(w.y)}; }
    *op = (f32x4){o[0] + (float)o01.x * (1.0f / 256.0f), o[1] + (float)o01.y * (1.0f / 256.0f), o[2] + (float)o23.x * (1.0f / 256.0f), o[3] + (float)o23.y * (1.0f / 256.0f)};
#pragma unroll
    for (int a = 0; a < 8; ++a) acc[a] = (h2_t){(_Float16)0.f, (_Float16)0.f};
}
__device__ __forceinline__ void peer_up_pass(Frame& F, const PeerDeal& d) {
    const int lane = F.lane;
    const int N = d.ns * d.cnt; if (N <= 0) return;
    i32x4_t IA[8], IB[8]; f32x4 CA[8], CB[8]; u32x2_t Ra[16], Rb[16]; h2_t acc[8];
#pragma unroll
    for (int a = 0; a < 8; ++a) acc[a] = (h2_t){(_Float16)0.f, (_Float16)0.f};
    int ta, sa, tb, sb, tc, sc;
    pd_item(0, d, ta, sa); pu_idx(F, ta, lane, IA, CA);
    pd_item(1, d, tb, sb); pu_idx(F, tb, lane, IB, CB);
    pu_rows<0>(F, sa, lane, IA, Ra);
#pragma unroll 1
    for (int n = 0; n < N; n += 2) {
        pu_rows<1>(F, sa, lane, IA, Rb);
        pu_compute<0>(Ra, CA, acc);
        pu_rows<0>(F, sb, lane, IB, Ra);
        pu_compute<1>(Rb, CA, acc);
        pu_finish(F, ta, sa, lane, acc);
        pd_item(n + 2, d, tc, sc); pu_idx(F, tc, lane, IA, CA);
        if (n + 1 < N) {
            pu_rows<1>(F, sb, lane, IB, Rb);
            pu_compute<0>(Ra, CB, acc);
            pu_rows<0>(F, sc, lane, IA, Ra);
            pu_compute<1>(Rb, CB, acc);
            pu_finish(F, tb, sb, lane, acc);
        }
        pd_item(n + 3, d, tb, sb); pu_idx(F, tb, lane, IB, CB);
        ta = tc; sa = sc;
    }
}
struct Args { const float* in[15]; float* out; unsigned char* ws; int ph_lo, ph_hi, pad0, pad1; };
__global__ void __launch_bounds__(NWAVES * 64, 2) skel_fwd(Args args) {
    extern __shared__ __attribute__((aligned(16))) unsigned char lds[];
    Frame F;
    F.lds = (LAS unsigned char*)lds;
    F.MISC = (volatile LAS unsigned*)(F.lds + MISC_OFF);
    F.tid = threadIdx.x; F.lane = F.tid & 63; F.wave = __builtin_amdgcn_readfirstlane(F.tid >> 6);
    F.G = gridDim.x; { const int bx = blockIdx.x; F.vcu = (F.G % 8 == 0) ? (bx % 8) * (F.G / 8) + bx / 8 : bx; }
    F.ws = args.ws; F.ctl = (gu32*)(args.ws + WS_CTL);
    F.x = args.in[0]; F.g1 = args.in[1]; F.w_in = args.in[2]; F.gq = args.in[3]; F.gk = args.in[4]; F.sink = args.in[5]; F.conv_w = args.in[6]; F.w_oa = args.in[7];
    F.w_oc = args.in[8]; F.w_out = args.in[9]; F.g2 = args.in[10]; F.w_qp = args.in[11]; F.subk = args.in[12]; F.w_down = args.in[13]; F.w_up = args.in[14]; F.out = args.out;
    for (int u = F.tid; u < (LDS_BYTES - LDSCTL_OFF) / 4; u += NWAVES * 64) ((LAS unsigned*)(F.lds + LDSCTL_OFF))[u] = 0u;
    __syncthreads();
    XcdBarrier bar; bar.bar = (unsigned*)(F.ctl + CW_BAR); bar.x = 0; bar.st = nullptr;
    if (MK_ONE_LAUNCH) bar = xcd_barrier_post((unsigned*)(F.ctl + CW_BAR), F.MISC + 8);
    if (MK_ONE_LAUNCH && F.tid == 0) { const unsigned xcc = xb_xcc_id(); F.MISC[10] = xcc; F.MISC[11] = __hip_atomic_fetch_add((unsigned*)(F.ctl + CW_XRANK) + 64 * xcc, 1u, RLX_AGENT); }
    if (F.wave == 0) { const bool ok = tr4_selfcheck(F.lds + RING_OFF, F.lane); if (F.lane == 0) F.MISC[15] = ok ? 1u : 0u; }
    __syncthreads();
    const bool tr4_ok = F.MISC[15] != 0u;
    const int lo = args.ph_lo, hi = args.ph_hi;
#ifndef PHASE_MASK
#define PHASE_MASK 0xfff
#endif
#define IN(k) (((PHASE_MASK >> (k)) & 1) && lo <= (k) && (k) < hi)
#ifndef DUP_MASK
#define DUP_MASK 0
#endif
#define REP(k) _Pragma("unroll") for (int rep_ = 0; rep_ < 1 + ((DUP_MASK >> (k)) & 1); ++rep_)
#define SEAM(k) do { if (MK_ONE_LAUNCH && IN(k) && IN((k) + 1)) xcd_barrier(bar); } while (0)
    const int gw = F.vcu * NWAVES + F.wave, NGW = F.G * NWAVES;

    if (IN(0)) REP(0) { p0_prologue(F); } SEAM(0);

    if (IN(1)) REP(1) { quant_w8(F); } SEAM(1);

    if (IN(2)) REP(2) {
        bf16* const pQ = WSP(bf16, WS_Q); bf16* const pK = WSP(bf16, WS_K); bf16* const pV = WSP(bf16, WS_V); bf16* const pH = WSP(bf16, WS_H); bf16* const pB = WSP(bf16, WS_B); bf16* const pC = WSP(bf16, WS_C);
        bf16* const pGA = WSP(bf16, WS_GA); bf16* const pGC = WSP(bf16, WS_GC);
        {   pg8::Gemm g{(const bf16*)(F.ws + WS_XN8), (const bf16*)(F.ws + WS_W8), M, INW, D / 2};
            pg8::RangeOrder S; S.so.init(M, I8_TILES * 256, F.G, (int)blockIdx.x); S.base = 0; S.cut = I8_CUT; S.skip = I8_SKIP;
            pg8::EpiProj<true> E{pQ, pK, pV, pH, pB, pC, pGA, pGC, WSP(const float, WS_SX), WSP(const float, WS_SW)};
            pg8::gemm_phase<pg8::EpiProj<true>, pg8::RangeOrder, PG8_ALIGN, PG8_SP2, true>(F.lds + RING_OFF, g, S, E); }
        {   pg8::Gemm g{WSP(const bf16, WS_XN), WSP(const bf16, WS_WIN), M, INW, D};
            pg8::RangeOrder S; S.so.init(M, BF_TILES * 256, F.G, (int)blockIdx.x); S.base = BF_BASE; S.cut = 68; S.skip = 0;
            pg8::EpiProj<false> E{pQ, pK, pV, pH, pB, pC, pGA, pGC, nullptr, nullptr};
            pg8::gemm_phase<pg8::EpiProj<false>, pg8::RangeOrder, PG8_ALIGN, PG8_SP2, false>(F.lds + RING_OFF, g, S, E); }
    } SEAM(2);

    if (IN(3)) REP(3) {
        for (int U = F.vcu * 4; U < BATCH * 32 * NKV * 2; U += F.G * 4)
            for (int i = 0; i < 4; ++i) attn_unit<0>(F, U + i);
#ifdef ATTN_PROBE
        for (int U = F.vcu * 4; U < BATCH * 32 * NKV * 2; U += F.G * 4)
            for (int i = 0; i < 4; ++i) attn_unit<ATTN_PROBE>(F, U + i);
#endif
        conv_phase(F);
#ifdef CONV_DUP
        conv_phase(F);
#endif
        if (DUP_MASK) __syncthreads();
    } SEAM(3);

    if (IN(4)) REP(4) {
        pg8::Gemm g{WSP(const bf16, WS_AB), WSP(const bf16, WS_WO), 2 * M, 2 * D, QW}; pg8::PairOrder S; S.so.init(M, D, F.G, (int)blockIdx.x);
        pg8::EpiMerge E{WSP(const bf16, WS_GA), WSP(const bf16, WS_GC), WSP(bf16, WS_T), WSP(bf16, WS_XN)};
        pg8::gemm_phase<pg8::EpiMerge, pg8::PairOrder, PG8_ALIGN, PG8_SP2>(F.lds + RING_OFF, g, S, E);
    } SEAM(4);

    if (IN(5)) REP(5) {
        pg8::Gemm g{WSP(const bf16, WS_XN), WSP(const bf16, WS_WOUT), M, D, D}; pg8::StaticOrder S; S.init(M, D, F.G, (int)blockIdx.x);
        pg8::EpiRes E{F.x, WSP(bf16, WS_X1B)};
        pg8::gemm_phase<pg8::EpiRes, pg8::StaticOrder, PG8_ALIGN, PG8_SP2>(F.lds + RING_OFF, g, S, E);
    } SEAM(5);

    if (IN(6)) REP(6) {
        for (int m = gw; m < M; m += NGW) rms2_row(WSP(const bf16, WS_X1B) + (size_t)m * D, F.g2, F.ws + WS_X2I8 + (size_t)m * D, WSP(float, WS_SX2) + m, F.ws + WS_X2N8 + (size_t)m * 256, F.lane);
    } SEAM(6);

    if (IN(7)) REP(7) {
        pg8::Gemm g{(const bf16*)(F.ws + WS_X2I8), (const bf16*)(F.ws + WS_W8QP), M, PQW, D / 2}; pg8::StaticOrder S; S.init(M, PQW, F.G, (int)blockIdx.x);
        pg8::EpiStoreI8 E{WSP(bf16, WS_QP), PQW, WSP(const float, WS_SX2), WSP(const float, WS_SWQ)};
        pg8::gemm_phase<pg8::EpiStoreI8, pg8::StaticOrder, PG8_ALIGN, PG8_SP2, true>(F.lds + RING_OFF, g, S, E);
    } SEAM(7);

    if (IN(8)) REP(8) {
        const int h = F.vcu & 7;
        { const bf16* SK = WSP(const bf16, WS_SK) + (size_t)h * (2 * NKEYS * 128);
#pragma unroll
          for (int i = 0; i < 8; ++i) { const int q = F.tid + 512 * i, row = q >> 4, ch = q & 15; *(LAS v4u*)(F.lds + RING_OFF + off_b(row, ch)) = *(const GAS v4u*)(SK + (size_t)row * 128 + ch * 8); } }
        __syncthreads();
        for (int tg = (F.vcu >> 3) * NWAVES + F.wave; tg < M / 16; tg += (F.G >> 3) * NWAVES) route_task(F, tg, h);
        if (DUP_MASK) __syncthreads();
    } SEAM(8);

    PeerDeal deal;
    if (IN(9) || IN(11)) {
        if (MK_ONE_LAUNCH) {
            if (F.tid == 0) { const unsigned xcc = F.MISC[10]; unsigned nloc = 0, ox = 0, nx = 0;
                for (unsigned j = 0; j < 16; ++j) { const unsigned c = __hip_atomic_load((unsigned*)(F.ctl + CW_XRANK) + 64 * j, RLX_AGENT); if (c) { ++nx; if (j < xcc) ++ox; } if (j == xcc) nloc = c; }
                F.MISC[12] = nloc; F.MISC[13] = ox; F.MISC[14] = nx; }
            __syncthreads();
            const int nloc = (int)F.MISC[12], rank = (int)F.MISC[11];
            deal.ox = (int)F.MISC[13]; deal.nx = (int)F.MISC[14]; deal.t0 = rank * NWAVES + F.wave; deal.stride = nloc * NWAVES;
        } else { const int nper = F.G >> 3; deal.ox = F.vcu / nper; deal.nx = 8; deal.t0 = (F.vcu % nper) * NWAVES + F.wave; deal.stride = nper * NWAVES; }
        deal.cnt = deal.t0 < M ? (M - deal.t0 + deal.stride - 1) / deal.stride : 0; deal.ns = deal.ox < 16 ? (16 - deal.ox + deal.nx - 1) / deal.nx : 0;
    }
    if (IN(9)) {
        peer_down_pass(F, deal);
    } SEAM(9);
    if (IN(10)) {
        for (int t = gw; t < M; t += NGW) peer_combine_token(F, t);
    } SEAM(10);
    if (IN(11)) {
        if (tr4_ok) peer_up_pass_mfma(F, deal); else peer_up_pass(F, deal);
    }
#undef IN
#undef SEAM
}

extern "C" void kernel_launch(void* const* d_in, const int* in_sizes, int n_in, void* d_out, int out_size, void* d_ws, size_t ws_size, hipStream_t stream) {
    static int grid = 0;
    if (grid == 0) {
        if (n_in != 15 || in_sizes[0] != M * D || out_size != M * D || ws_size < WS_END) { fprintf(stderr, "kernel_launch: built for 15 inputs, x and out of %d floats, >= %zu bytes of workspace; got n_in %d, in0 %d, out %d, ws %zu; nothing launched\n", M * D, (size_t)WS_END, n_in, n_in > 0 ? in_sizes[0] : -1, out_size, ws_size); grid = -1; return; }
        int dev = 0, cus = 0, per_cu = 0;
        if (hipGetDevice(&dev) != hipSuccess || hipDeviceGetAttribute(&cus, hipDeviceAttributeMultiprocessorCount, dev) != hipSuccess) { fprintf(stderr, "kernel_launch: hipGetDevice / hipDeviceGetAttribute failed; nothing launched\n"); grid = -1; return; }
        if (hipFuncSetAttribute((const void*)skel_fwd, hipFuncAttributeMaxDynamicSharedMemorySize, LDS_BYTES) != hipSuccess) { fprintf(stderr, "kernel_launch: hipFuncSetAttribute failed; nothing launched\n"); grid = -1; return; }
        if (hipOccupancyMaxActiveBlocksPerMultiprocessor(&per_cu, (const void*)skel_fwd, NWAVES * 64, LDS_BYTES) != hipSuccess || per_cu < 1)
            fprintf(stderr, "kernel_launch: note: the occupancy query reports %d workgroups per CU\n", per_cu);
        (void)hipGetLastError();
        grid = cus;
        if (grid % 8 != 0) { fprintf(stderr, "kernel_launch: %d CUs: this kernel deals work in groups of 8 workgroups; nothing launched\n", grid); grid = -1; return; }
    }
    if (grid < 0) return;
    if (hipMemsetAsync((char*)d_ws + WS_CTL, 0, CTL_ZERO_BYTES, stream) != hipSuccess) { fprintf(stderr, "kernel_launch: hipMemsetAsync of the control words failed; nothing launched\n"); return; }
    Args a{};
    for (int i = 0; i < 15; ++i) a.in[i] = (const float*)d_in[i];
    a.out = (float*)d_out; a.ws = (unsigned char*)d_ws;
#if MK_ONE_LAUNCH
    a.ph_lo = 0; a.ph_hi = N_PHASES;
    hipLaunchKernelGGL(skel_fwd, dim3(grid), dim3(NWAVES * 64), LDS_BYTES, stream, a);
    { const hipError_t le = hipPeekAtLastError(); if (le != hipSuccess) fprintf(stderr, "kernel_launch: launch failed: %s\n", hipGetErrorName(le)); }
#else
    for (int p = 0; p < N_PHASES; ++p) {
        a.ph_lo = p; a.ph_hi = p + 1;
        hipLaunchKernelGGL(skel_fwd, dim3(grid), dim3(NWAVES * 64), LDS_BYTES, stream, a);
        const hipError_t le = hipPeekAtLastError();
        if (le != hipSuccess) { fprintf(stderr, "kernel_launch: launch %d failed: %s\n", p, hipGetErrorName(le)); break; }
    }
#endif
}
```

```cpp
#include <hip/hip_runtime.h>
#include <cstdio>
#include <cstdint>
#include <cmath>
namespace pg8 {
#define PG8_LAS __attribute__((address_space(3)))
typedef unsigned short bf16_t;
typedef short bf16x8 __attribute__((ext_vector_type(8)));
typedef float f32x4 __attribute__((ext_vector_type(4)));
typedef unsigned u32x4 __attribute__((ext_vector_type(4)));
typedef int i32x4 __attribute__((ext_vector_type(4)));
constexpr int BM = 256, BK = 64, HALF = 128, HTB = HALF * BK * 2  , STAGE_BYTES = 8 * HTB, NXCD = 8, WGM = 8;

__host__ __device__ __forceinline__ int lds_byte(int r, int c) { const int st = (r >> 4) * 2 + (c >> 5), rr = r & 15, cc = c & 31, ob = rr * 64 + cc * 2; return st * 1024 + (ob ^ (((ob >> 9) & 1) << 5)); }
__host__ __device__ __forceinline__ void stage_rc(int b, int& R, int& C) { const int st = b / 1024, sb = b % 1024, swz = sb ^ (((sb >> 9) & 1) << 5); R = (st >> 1) * 16 + swz / 64; C = (st & 1) * 32 + (swz % 64) / 2; }
__host__ __device__ __forceinline__ int perm32(int rho) { const int n = rho >> 4, i = rho & 15; return 8 * (i >> 2) + 4 * n + (i & 3); }

struct Unit { int pm, pn; };
struct Gemm { const bf16_t* A; const bf16_t* Bt; int M, N, K; };

struct StaticOrder {
    int nM, nN, nwg, G, c;
    __host__ __device__ void init(int M, int N, int G_, int c_) { nM = M / BM; nN = N / BM; nwg = nM * nN; G = G_; c = c_; }
    __host__ __device__ bool next(int i, Unit& u) const {
        const long L = (long)i * G + c; if (L >= nwg) return false;
        int wgid = (int)L; { const int q = nwg / NXCD, r = nwg % NXCD, xcd = wgid % NXCD, off = wgid / NXCD; wgid = (xcd < r ? xcd * (q + 1) : r * (q + 1) + (xcd - r) * q) + off; }
        const int nig = WGM * nN, gid = wgid / nig, fm = gid * WGM, gsz = (nM - fm) < WGM ? (nM - fm) : WGM;
        u.pm = fm + ((wgid % nig) % gsz); u.pn = (wgid % nig) / gsz; return true;
    }
    __device__ __forceinline__ void a_ready(const Unit&) const {}
    __device__ __forceinline__ void done(const Unit&) const {}
};
__device__ __forceinline__ unsigned cvt_pk_bf16(float lo, float hi) { unsigned r; asm volatile("v_cvt_pk_bf16_f32 %0, %1, %2" : "=v"(r) : "v"(lo), "v"(hi)); return r; }
typedef unsigned u32x2 __attribute__((ext_vector_type(2)));
__device__ __forceinline__ float sigm(float v) { return __builtin_amdgcn_rcpf(1.0f + __builtin_amdgcn_exp2f(-1.4426950408889634f * v)); }
__device__ __forceinline__ u32x4 pack8(const f32x4 a, const f32x4 b) { u32x4 w; w.x = cvt_pk_bf16(a[0], a[1]); w.y = cvt_pk_bf16(a[2], a[3]); w.z = cvt_pk_bf16(b[0], b[1]); w.w = cvt_pk_bf16(b[2], b[3]); return w; }
__device__ __forceinline__ void unpack8(const u32x4 w, f32x4& a, f32x4& b) {
    a[0] = __uint_as_float(w.x << 16); a[1] = __uint_as_float(w.x & 0xffff0000u); a[2] = __uint_as_float(w.y << 16); a[3] = __uint_as_float(w.y & 0xffff0000u);
    b[0] = __uint_as_float(w.z << 16); b[1] = __uint_as_float(w.z & 0xffff0000u); b[2] = __uint_as_float(w.w << 16); b[3] = __uint_as_float(w.w & 0xffff0000u);
}
template <bool I8> struct EpiProj {
    static constexpr bool PERM = true, AFTER_DRAIN = false;
    bf16_t *Q, *K, *V, *H, *Bg, *Cg, *GA, *GC; const float *sx, *sw;
    __device__ __forceinline__ void operator()(const f32x4 (&acc)[2][2][4][2], const Unit& u, int wr, int wc, int fr, int fq) const {
        const int pn = u.pn; bf16_t* base; int ldc, ct; bool sg = false;
        if (pn < 8) { base = Q; ldc = 2048; ct = pn; } else if (pn < 10) { base = K; ldc = 512; ct = pn - 8; } else if (pn < 12) { base = V; ldc = 512; ct = pn - 10; }
        else if (pn < 20) { base = H; ldc = 2048; ct = pn - 12; } else if (pn < 28) { base = Bg; ldc = 2048; ct = pn - 20; } else if (pn < 36) { base = Cg; ldc = 2048; ct = pn - 28; }
        else if (pn < 52) { base = GA; ldc = 4096; ct = pn - 36; sg = true; } else { base = GC; ldc = 4096; ct = pn - 52; sg = true; }
        const int row0 = u.pm * BM + wr * 64 + fr, col0 = ct * BM + wc * 32 + 8 * fq;
        f32x4 cs[2][2];
        if constexpr (I8) {
#pragma unroll
            for (int bj = 0; bj < 2; ++bj)
#pragma unroll
                for (int n = 0; n < 2; ++n) cs[bj][n] = *(const f32x4*)(sw + pn * BM + bj * HALF + wc * 32 + 8 * fq + 4 * n);
        }
#pragma unroll
        for (int ai = 0; ai < 2; ++ai)
#pragma unroll
            for (int m = 0; m < 4; ++m) { const int row = row0 + ai * HALF + m * 16; bf16_t* rowp = base + (size_t)row * ldc + col0;
                float rs = 1.f; if constexpr (I8) rs = sx[row];
#pragma unroll
                for (int bj = 0; bj < 2; ++bj) { f32x4 v0 = acc[ai][bj][m][0], v1 = acc[ai][bj][m][1];
                    if constexpr (I8) { v0 = __builtin_convertvector(__builtin_bit_cast(i32x4, v0), f32x4) * (cs[bj][0] * rs); v1 = __builtin_convertvector(__builtin_bit_cast(i32x4, v1), f32x4) * (cs[bj][1] * rs); }
                    if (sg) {
#pragma unroll
                        for (int e = 0; e < 4; ++e) { v0[e] = sigm(v0[e]); v1[e] = sigm(v1[e]); } }
                    *(u32x4*)(rowp + bj * HALF) = pack8(v0, v1); } }
    }
};
struct EpiMerge {
    static constexpr bool PERM = true, AFTER_DRAIN = false;
    const bf16_t *GA, *GC; bf16_t *T, *Mg;
    __device__ __forceinline__ void operator()(const f32x4 (&acc)[2][2][4][2], const Unit& u, int wr, int wc, int fr, int fq) const {
        const int which = u.pm >> 6, pm = u.pm & 63, pn = u.pn & 15;
        const bf16_t* G = which ? GC : GA;
        const int row0 = pm * BM + wr * 64 + fr, col0 = pn * BM + wc * 32 + 8 * fq;
#pragma unroll
        for (int ai = 0; ai < 2; ++ai)
#pragma unroll
            for (int m = 0; m < 4; ++m) { const size_t off = (size_t)(row0 + ai * HALF + m * 16) * 4096 + col0;
#pragma unroll
                for (int bj = 0; bj < 2; ++bj) { const size_t o = off + bj * HALF; f32x4 g0, g1; unpack8(*(const u32x4*)(G + o), g0, g1);
                    f32x4 v0 = acc[ai][bj][m][0] * g0, v1 = acc[ai][bj][m][1] * g1;
                    if (which == 0) { *(u32x4*)(T + o) = pack8(v0, v1); }
                    else { f32x4 t0, t1; unpack8(*(const u32x4*)(T + o), t0, t1); *(u32x4*)(Mg + o) = pack8(v0 + t0, v1 + t1); } } }
    }
};
struct EpiRes {
    static constexpr bool PERM = true, AFTER_DRAIN = false;
    const float* X; bf16_t* O;
    __device__ __forceinline__ void operator()(const f32x4 (&acc)[2][2][4][2], const Unit& u, int wr, int wc, int fr, int fq) const {
        const int row0 = u.pm * BM + wr * 64 + fr, col0 = u.pn * BM + wc * 32 + 8 * fq;
#pragma unroll
        for (int ai = 0; ai < 2; ++ai)
#pragma unroll
            for (int m = 0; m < 4; ++m) { const size_t off = (size_t)(row0 + ai * HALF + m * 16) * 4096 + col0;
#pragma unroll
                for (int bj = 0; bj < 2; ++bj) { const size_t o = off + bj * HALF; const f32x4 x0 = *(const f32x4*)(X + o), x1 = *(const f32x4*)(X + o + 4);
                    *(u32x4*)(O + o) = pack8(x0 + acc[ai][bj][m][0], x1 + acc[ai][bj][m][1]); } }
    }
};
struct EpiStoreI8 {
    static constexpr bool PERM = true, AFTER_DRAIN = false;
    bf16_t* O; int ldc; const float *sx, *sw;
    __device__ __forceinline__ void operator()(const f32x4 (&acc)[2][2][4][2], const Unit& u, int wr, int wc, int fr, int fq) const {
        const int row0 = u.pm * BM + wr * 64 + fr, col0 = u.pn * BM + wc * 32 + 8 * fq;
        f32x4 cs[2][2];
#pragma unroll
        for (int bj = 0; bj < 2; ++bj)
#pragma unroll
            for (int n = 0; n < 2; ++n) cs[bj][n] = *(const f32x4*)(sw + col0 + bj * HALF + 4 * n);
#pragma unroll
        for (int ai = 0; ai < 2; ++ai)
#pragma unroll
            for (int m = 0; m < 4; ++m) { const int row = row0 + ai * HALF + m * 16; bf16_t* rowp = O + (size_t)row * ldc + col0; const float rs = sx[row];
#pragma unroll
                for (int bj = 0; bj < 2; ++bj) *(u32x4*)(rowp + bj * HALF) = pack8(__builtin_convertvector(__builtin_bit_cast(i32x4, acc[ai][bj][m][0]), f32x4) * (cs[bj][0] * rs), __builtin_convertvector(__builtin_bit_cast(i32x4, acc[ai][bj][m][1]), f32x4) * (cs[bj][1] * rs)); }
    }
};
struct EpiStore {
    static constexpr bool PERM = true, AFTER_DRAIN = false;
    bf16_t* O; int ldc;
    __device__ __forceinline__ void operator()(const f32x4 (&acc)[2][2][4][2], const Unit& u, int wr, int wc, int fr, int fq) const {
        const int row0 = u.pm * BM + wr * 64 + fr, col0 = u.pn * BM + wc * 32 + 8 * fq;
#pragma unroll
        for (int ai = 0; ai < 2; ++ai)
#pragma unroll
            for (int m = 0; m < 4; ++m) { bf16_t* rowp = O + (size_t)(row0 + ai * HALF + m * 16) * ldc + col0;
#pragma unroll
                for (int bj = 0; bj < 2; ++bj) *(u32x4*)(rowp + bj * HALF) = pack8(acc[ai][bj][m][0], acc[ai][bj][m][1]); }
    }
};
struct PairOrder {
    StaticOrder so;
    __device__ bool next(int i, Unit& u) const { Unit t; if (!so.next(i >> 1, t)) return false; const int w = i & 1; u.pm = t.pm + 64 * w; u.pn = t.pn + 16 * w; return true; }
    __device__ __forceinline__ void a_ready(const Unit&) const {}
    __device__ __forceinline__ void done(const Unit&) const {}
};
struct RangeOrder {
    StaticOrder so; int base, cut, skip;
    __device__ bool next(int i, Unit& u) const { if (!so.next(i, u)) return false; u.pn = base + (u.pn < cut ? u.pn : u.pn + skip); return true; }
    __device__ __forceinline__ void a_ready(const Unit&) const {}
    __device__ __forceinline__ void done(const Unit&) const {}
};
template <class Epi, class Sched, bool ALIGN_EPI = false, bool SP2 = false, bool I8 = false>
__device__ __forceinline__ void gemm_phase(PG8_LAS unsigned char* lds, const Gemm g, const Sched& S, const Epi& E) {
    const int tid = threadIdx.x, wid = __builtin_amdgcn_readfirstlane(tid >> 6), lane = tid & 63, wr = wid >> 2, wc = wid & 3, fr = lane & 15, fq = lane >> 4;
    const int K = g.K, nt = K / BK;
    unsigned voffA[2], voffB[2];
#pragma unroll
    for (int i = 0; i < 2; ++i) { int R, C; stage_rc(tid * 16 + i * 8192, R, C); const int Rb = Epi::PERM ? ((R & ~31) + perm32(R & 31)) : R;
        voffA[i] = (unsigned)(R * K + C) * 2u; voffB[i] = (unsigned)(Rb * K + C) * 2u; }
    const size_t kstep = (size_t)(BK * 2);
    const size_t hstep = (size_t)HALF * K * 2;
    const size_t tstep = 2 * hstep;
    const unsigned ldsw = (unsigned)wid * 1024u;
    const int aoff = lds_byte(wr * 64 + fr, fq * 8), boff = lds_byte(wc * 32 + fr, fq * 8);
#define PG8_SA(b, h) (((b) * 2 + (h)) * HTB)
#define PG8_SB(b, h) ((4 + (b) * 2 + (h)) * HTB)
#define PG8_STAGE(bufoff, gbase, voff) do { _Pragma("unroll") for (int _i = 0; _i < 2; ++_i) \
        __builtin_amdgcn_global_load_lds((const unsigned*)((const char*)(gbase) + (voff)[_i]), (PG8_LAS unsigned*)(lds + (bufoff) + ldsw + _i * 8192), 16, 0, 0); } while (0)
#define PG8_LDA(dst, b, h) do { _Pragma("unroll") for (int m = 0; m < 4; ++m) _Pragma("unroll") for (int k = 0; k < 2; ++k) dst[m][k] = *(const PG8_LAS bf16x8*)(lds + PG8_SA(b, h) + aoff + m * 2048 + k * 1024); } while (0)
#define PG8_LDB(dst, b, h) do { _Pragma("unroll") for (int n = 0; n < 2; ++n) _Pragma("unroll") for (int k = 0; k < 2; ++k) dst[n][k] = *(const PG8_LAS bf16x8*)(lds + PG8_SB(b, h) + boff + n * 2048 + k * 1024); } while (0)
#define PG8_MMA(ai, bj, At, Bt) do { __builtin_amdgcn_s_setprio(1); _Pragma("unroll") for (int m = 0; m < 4; ++m) _Pragma("unroll") for (int n = 0; n < 2; ++n) _Pragma("unroll") for (int k = 0; k < 2; ++k) \
        { if constexpr (I8) acc[ai][bj][m][n] = __builtin_bit_cast(f32x4, __builtin_amdgcn_mfma_i32_16x16x64_i8(__builtin_bit_cast(i32x4, Bt[n][k]), __builtin_bit_cast(i32x4, At[m][k]), __builtin_bit_cast(i32x4, acc[ai][bj][m][n]), 0, 0, 0)); \
          else acc[ai][bj][m][n] = __builtin_amdgcn_mfma_f32_16x16x32_bf16(Bt[n][k], At[m][k], acc[ai][bj][m][n], 0, 0, 0); } __builtin_amdgcn_s_setprio(0); } while (0)
#define PG8_WAIT_V(n) asm volatile("s_waitcnt vmcnt(" #n ")" ::: "memory")
#define PG8_WAIT_L(n) asm volatile("s_waitcnt lgkmcnt(" #n ")" ::: "memory")
#define PG8_BAR __builtin_amdgcn_s_barrier()
#define PG8_SCHED __builtin_amdgcn_sched_barrier(0)
    Unit cur, nxt; int ui = 0;
    if (!S.next(0, cur)) return;
    f32x4 acc[2][2][4][2];
#pragma unroll
    for (int a = 0; a < 2; ++a)
#pragma unroll
        for (int b = 0; b < 2; ++b)
#pragma unroll
            for (int m = 0; m < 4; ++m)
#pragma unroll
                for (int n = 0; n < 2; ++n) acc[a][b][m][n] = (f32x4){0.f, 0.f, 0.f, 0.f};
    bf16x8 At[4][2], B0[2][2], B1[2][2];
    const char* cA = (const char*)g.A + (size_t)cur.pm * tstep; const char* cB = (const char*)g.Bt + (size_t)cur.pn * tstep;
    S.a_ready(cur);
    if constexpr (SP2) {
        PG8_STAGE(PG8_SB(0, 0), cB, voffB); PG8_STAGE(PG8_SB(0, 1), cB + hstep, voffB); PG8_STAGE(PG8_SA(0, 0), cA, voffA); PG8_STAGE(PG8_SA(0, 1), cA + hstep, voffA);
        if (wr == 1) PG8_BAR;
        PG8_WAIT_V(2); PG8_BAR;
        PG8_STAGE(PG8_SB(1, 0), cB + kstep, voffB); PG8_STAGE(PG8_SA(1, 0), cA + kstep, voffA); PG8_STAGE(PG8_SB(1, 1), cB + hstep + kstep, voffB);
        PG8_WAIT_V(6); PG8_BAR;
    } else {
        PG8_STAGE(PG8_SB(0, 0), cB, voffB); PG8_STAGE(PG8_SA(0, 0), cA, voffA); PG8_STAGE(PG8_SB(0, 1), cB + hstep, voffB); PG8_STAGE(PG8_SA(0, 1), cA + hstep, voffA);
        if (wr == 1) PG8_BAR;
        PG8_WAIT_V(4); PG8_BAR;
        PG8_STAGE(PG8_SB(1, 0), cB + kstep, voffB); PG8_STAGE(PG8_SA(1, 0), cA + kstep, voffA); PG8_STAGE(PG8_SB(1, 1), cB + hstep + kstep, voffB);
        PG8_WAIT_V(6); PG8_BAR;
    }
    for (;;) {
        const bool has_next = S.next(ui + 1, nxt);
        const char* nA = has_next ? (const char*)g.A + (size_t)nxt.pm * tstep : cA; const char* nB = has_next ? (const char*)g.Bt + (size_t)nxt.pn * tstep : cB;
        for (int t = 0; t < nt; t += 2) {
            const bool last = (t == nt - 2);
            const char* a1 = cA + (size_t)(t + 1) * kstep;
            const char* a2 = last ? nA : cA + (size_t)(t + 2) * kstep; const char* b2 = last ? nB : cB + (size_t)(t + 2) * kstep;
            const char* a3 = a2 + kstep; const char* b3 = b2 + kstep;
            if (last && has_next) S.a_ready(nxt);
            if constexpr (SP2) {
            PG8_LDB(B0, 0, 0); PG8_LDB(B1, 0, 1); PG8_SCHED; PG8_LDA(At, 0, 0); PG8_STAGE(PG8_SA(1, 1), a1 + hstep, voffA);
            PG8_WAIT_V(8); PG8_WAIT_L(0); PG8_BAR; PG8_MMA(0, 0, At, B0); PG8_MMA(0, 1, At, B1); PG8_BAR; PG8_SCHED;
            PG8_LDA(At, 0, 1); PG8_STAGE(PG8_SB(0, 0), b2, voffB); PG8_STAGE(PG8_SB(0, 1), b2 + hstep, voffB); PG8_STAGE(PG8_SA(0, 0), a2, voffA);
            PG8_WAIT_V(8); PG8_WAIT_L(0); PG8_BAR; PG8_MMA(1, 0, At, B0); PG8_MMA(1, 1, At, B1); PG8_BAR; PG8_SCHED;
            PG8_LDB(B0, 1, 0); PG8_LDB(B1, 1, 1); PG8_SCHED; PG8_LDA(At, 1, 0); PG8_STAGE(PG8_SA(0, 1), a2 + hstep, voffA);
            PG8_WAIT_V(8); PG8_WAIT_L(0); PG8_BAR; PG8_MMA(0, 0, At, B0); PG8_MMA(0, 1, At, B1); PG8_BAR; PG8_SCHED;
            PG8_LDA(At, 1, 1); PG8_STAGE(PG8_SB(1, 0), b3, voffB); PG8_STAGE(PG8_SB(1, 1), b3 + hstep, voffB); PG8_STAGE(PG8_SA(1, 0), a3, voffA);
            PG8_WAIT_V(8); PG8_WAIT_L(0); PG8_BAR; PG8_MMA(1, 0, At, B0); PG8_MMA(1, 1, At, B1); PG8_BAR; PG8_SCHED;
            } else {
            PG8_LDB(B0, 0, 0); PG8_SCHED; PG8_LDA(At, 0, 0); PG8_STAGE(PG8_SA(1, 1), a1 + hstep, voffA);
            PG8_WAIT_L(8); PG8_BAR; PG8_WAIT_L(0); PG8_MMA(0, 0, At, B0); PG8_BAR; PG8_SCHED;
            PG8_LDB(B1, 0, 1); PG8_STAGE(PG8_SB(0, 0), b2, voffB);
            PG8_BAR; PG8_WAIT_L(0); PG8_MMA(0, 1, At, B1); PG8_BAR;
            PG8_LDA(At, 0, 1); PG8_STAGE(PG8_SA(0, 0), a2, voffA);
            PG8_BAR; PG8_WAIT_L(0); PG8_MMA(1, 0, At, B0); PG8_BAR; PG8_SCHED;
            PG8_STAGE(PG8_SB(0, 1), b2 + hstep, voffB);
            PG8_WAIT_V(6); PG8_BAR; PG8_MMA(1, 1, At, B1); PG8_BAR;
            PG8_LDB(B0, 1, 0); PG8_SCHED; PG8_LDA(At, 1, 0); PG8_STAGE(PG8_SA(0, 1), a2 + hstep, voffA);
            PG8_WAIT_L(8); PG8_BAR; PG8_WAIT_L(0); PG8_MMA(0, 0, At, B0); PG8_BAR; PG8_SCHED;
            PG8_LDB(B1, 1, 1); PG8_STAGE(PG8_SB(1, 0), b3, voffB);
            PG8_BAR; PG8_WAIT_L(0); PG8_MMA(0, 1, At, B1); PG8_BAR;
            PG8_LDA(At, 1, 1); PG8_STAGE(PG8_SA(1, 0), a3, voffA);
            PG8_BAR; PG8_WAIT_L(0); PG8_MMA(1, 0, At, B0); PG8_BAR; PG8_SCHED;
            PG8_STAGE(PG8_SB(1, 1), b3 + hstep, voffB);
            PG8_WAIT_V(6); PG8_BAR; PG8_MMA(1, 1, At, B1); PG8_BAR;
            }
        }
        if constexpr (ALIGN_EPI) { if (wr == 0) PG8_BAR; }
        if constexpr (!Epi::AFTER_DRAIN) { E(acc, cur, wr, wc, fr, fq); S.done(cur); }
        if (!has_next) break;
#pragma unroll
        for (int a = 0; a < 2; ++a)
#pragma unroll
            for (int b = 0; b < 2; ++b)
#pragma unroll
                for (int m = 0; m < 4; ++m)
#pragma unroll
                    for (int n = 0; n < 2; ++n) acc[a][b][m][n] = (f32x4){0.f, 0.f, 0.f, 0.f};
        cur = nxt; cA = nA; cB = nB; ++ui;
        if constexpr (ALIGN_EPI) { if (wr == 1) PG8_BAR; }
    }
    PG8_WAIT_V(0);
    if constexpr (!ALIGN_EPI) { if (wr == 0) PG8_BAR; }
    PG8_BAR;
    if constexpr (Epi::AFTER_DRAIN) { E.fused(acc, cur, wr, wc, fr, fq, lds, wid, lane); S.done(cur); }
#undef PG8_SA
#undef PG8_SB
#undef PG8_STAGE
#undef PG8_LDA
#undef PG8_LDB
#undef PG8_MMA
#undef PG8_WAIT_V
#undef PG8_WAIT_L
#undef PG8_BAR
#undef PG8_SCHED
}
}
#ifndef PG8_SP2
#define PG8_SP2 true
#endif
#ifndef PG8_ALIGN
#define PG8_ALIGN true
#endif
constexpr int NWAVES = 8;
#ifndef MK_ONE_LAUNCH
#define MK_ONE_LAUNCH 1
#endif
constexpr int N_PHASES = 12;
#ifndef NIBBLE_SWAP_DOWN
#define NIBBLE_SWAP_DOWN 0
#endif
#ifndef I8_CFG
#define I8_CFG 1
#endif
#if I8_CFG == 0
constexpr int I8_TILES = 44, I8_CUT = 12, I8_SKIP = 24, BF_BASE = 12, BF_TILES = 24;
#elif I8_CFG == 1
constexpr int I8_TILES = 60, I8_CUT = 12, I8_SKIP = 8, BF_BASE = 12, BF_TILES = 8;
#else
constexpr int I8_TILES = 68, I8_CUT = 68, I8_SKIP = 0, BF_BASE = 12, BF_TILES = 0;
#endif

constexpr int BATCH = 4, SEQ = 4096, D = 4096, M = BATCH * SEQ;
constexpr int HD = 128, NH = 16, NKV = 4, QW = NH * HD, KVW = NKV * HD, CW = 2048, INW = 17408;
constexpr int PH = 8, NKEYS = 128, TOPK = 16, NEXP = NKEYS * NKEYS, PQW = PH * 2 * 128;
constexpr float EPS = 1e-6f;
constexpr size_t SLICE_BYTES = (size_t)NEXP * 128;
constexpr float LOG2E = 1.4426950408889634f;

constexpr size_t MiB = 1u << 20;
constexpr size_t WS_CTL = 0, CTL_ZERO_BYTES = 1 * MiB;
constexpr size_t WS_WIN = 2 * MiB;
constexpr size_t WS_WO = 138 * MiB;
constexpr size_t WS_WOUT = 170 * MiB;
constexpr size_t WS_WQP = 202 * MiB;
constexpr size_t WS_SK = 218 * MiB;
constexpr size_t WS_IDX = 220 * MiB, WS_GATE = 228 * MiB;
constexpr size_t WS_XN = 236 * MiB;
constexpr size_t WS_AB = 364 * MiB;
constexpr size_t WS_Q = 492 * MiB, WS_K = 556 * MiB, WS_V = 572 * MiB, WS_H = 588 * MiB, WS_B = 652 * MiB, WS_C = 716 * MiB;
constexpr size_t WS_GA = 780 * MiB, WS_GC = 908 * MiB;
constexpr size_t WS_T = 492 * MiB;
constexpr size_t WS_X1B = 620 * MiB;
constexpr size_t WS_X2N = 620 * MiB;
constexpr size_t WS_PART = 236 * MiB;
constexpr size_t WS_X2N8 = 492 * MiB;
constexpr size_t WS_CF4 = 780 * MiB;
constexpr size_t WS_QP = 780 * MiB;
constexpr size_t WS_W4D = 1036 * MiB, WS_W4U = 1068 * MiB;
constexpr size_t WS_SCD = 1100 * MiB, WS_SCU = WS_SCD + 65536;
constexpr size_t WS_SX = WS_SCD + 131072, WS_SW = WS_SCD + 262144;
constexpr size_t WS_XN8 = 364 * MiB;
constexpr size_t WS_W8 = 1101 * MiB;
constexpr size_t WS_W8QP = 1169 * MiB;
constexpr size_t WS_SWQ = WS_SCD + 393216, WS_SX2 = WS_SCD + 458752;
constexpr size_t WS_X2I8 = 364 * MiB;
constexpr size_t WS_END = 1177 * MiB;
static_assert(WS_T + (size_t)M * D * 2 <= WS_X2N && WS_X2N + (size_t)M * D * 2 <= WS_GA && WS_QP + (size_t)M * PQW * 2 <= WS_GC, "d_ws overlays");
static_assert(WS_WIN + (size_t)INW * D * 2 <= WS_WO && WS_C + (size_t)M * CW * 2 <= WS_GA && WS_GC + (size_t)M * D * 2 <= WS_END, "d_ws map");
constexpr int CW_XRANK = 8192;
constexpr int CW_BAR = 4096;

constexpr int RING_OFF = 0, RING_BYTES = 131072;
constexpr int LDSCTL_OFF = RING_BYTES, MISC_OFF = LDSCTL_OFF + 320;
constexpr int OBUF_OFF = 132096;
constexpr int ODUMP_OFF = OBUF_OFF + 8192;
constexpr int LDS_BYTES = 147456;
static_assert(MISC_OFF + 128 <= OBUF_OFF && ODUMP_OFF + 2048 <= LDS_BYTES, "LDS map");
#define GAS __attribute__((address_space(1)))
#define LAS __attribute__((address_space(3)))
typedef unsigned short bf16;
typedef unsigned v4u __attribute__((ext_vector_type(4)));
typedef float f32x4 __attribute__((ext_vector_type(4)));
typedef short bf16x8 __attribute__((ext_vector_type(8)));
typedef GAS unsigned gu32;
typedef GAS unsigned long long gu64;
#define RLX_AGENT __ATOMIC_RELAXED, __HIP_MEMORY_SCOPE_AGENT
#define LDS_WAIT() asm volatile("s_waitcnt lgkmcnt(0)" ::: "memory")
#define VM_WAIT() asm volatile("s_waitcnt vmcnt(0)" ::: "memory")
__device__ __forceinline__ unsigned long long rt() { return __builtin_amdgcn_s_memrealtime(); }
__device__ __forceinline__ unsigned f2bf(float f) { unsigned u = __builtin_bit_cast(unsigned, f); return (u + 0x7fffu + ((u >> 16) & 1u)) >> 16; }
__device__ __forceinline__ unsigned pk2(float lo, float hi) { return f2bf(lo) | (f2bf(hi) << 16); }

#define XB_TMO      128
#define XB_XCNT(j)  (256  + 64 * (j))
#define XB_XSUB(j)  (1280 + 64 * (j))
#define XB_XGEN(j)  (2304 + 64 * (j))
#define XB_TOP      3328
#define XB_TOPGEN   3392
#define XCD_BAR_WORDS 3456
#define XB_SPIN_CAP (1u << 18)

__device__ __forceinline__ unsigned xb_ld(unsigned* p)              { return __hip_atomic_load(p, __ATOMIC_RELAXED, __HIP_MEMORY_SCOPE_AGENT); }
__device__ __forceinline__ unsigned xb_add(unsigned* p, unsigned v) { return __hip_atomic_fetch_add(p, v, __ATOMIC_RELAXED, __HIP_MEMORY_SCOPE_AGENT); }
__device__ __forceinline__ unsigned xb_xcc_id() { return (unsigned)__builtin_amdgcn_s_getreg((3 << 11) | 20) & 0xFu; }
#define XB_SPIN(cond, bar) do { unsigned _sp = 0; while (cond) { __builtin_amdgcn_s_sleep(1); \
    if ((++_sp & 255u) == 0u) { if (xb_ld(&(bar)[XB_TMO])) break; if (_sp > XB_SPIN_CAP) { atomicAdd(&(bar)[XB_TMO], 1u); break; } } } } while (0)

struct XcdBarrier {
    unsigned* bar; unsigned x;
    volatile LAS unsigned* st;
};

__device__ __forceinline__ XcdBarrier xcd_barrier_post(unsigned* bar, volatile LAS unsigned* st) {
    XcdBarrier b; b.bar = bar; b.x = xb_xcc_id(); b.st = st;
    if (threadIdx.x == 0) (void)xb_add(&bar[XB_XCNT(b.x)], 1u);
    return b;
}
__device__ __forceinline__ void xcd_barrier_complete(unsigned* bar, unsigned x, unsigned& nloc, unsigned& nx) {
    const unsigned G = gridDim.x * gridDim.y * gridDim.z;
    unsigned sum, cnt, mine, sp = 0u;
    for (;;) {
        sum = 0u; cnt = 0u; mine = 0u;
#pragma unroll
        for (unsigned j = 0; j < 16; ++j) { const unsigned c = xb_ld(&bar[XB_XCNT(j)]); sum += c; cnt += (c > 0u) ? 1u : 0u; mine = (j == x) ? c : mine; }
        if (sum == G) break;
        __builtin_amdgcn_s_sleep(1);
        if ((++sp & 255u) == 0u) { if (xb_ld(&bar[XB_TMO])) break; if (sp > XB_SPIN_CAP) { atomicAdd(&bar[XB_TMO], 1u); break; } }
    }
    nloc = mine > 0u ? mine : 1u; nx = cnt > 0u ? cnt : 1u;
}

__device__ __forceinline__ void xcd_barrier(const XcdBarrier& b) {
    asm volatile("s_waitcnt vmcnt(0)" ::: "memory");
    __syncthreads();
    if (threadIdx.x == 0) {
        unsigned* bar = b.bar;
        __builtin_amdgcn_s_waitcnt(0);
        unsigned nloc = b.st[0], nx = b.st[1];
        if (nloc == 0u) { xcd_barrier_complete(bar, b.x, nloc, nx); b.st[0] = nloc; b.st[1] = nx; }
        const unsigned old = xb_add(&bar[XB_XSUB(b.x)], 1u);
        const unsigned gen = old / nloc;
        if (old + 1u == (gen + 1u) * nloc) {
            __builtin_amdgcn_fence(__ATOMIC_RELEASE, "agent");
            asm volatile("s_waitcnt vmcnt(0)" ::: "memory");
            const unsigned og = xb_add(&bar[XB_TOP], 1u);
            const unsigned tg = og / nx;
            if (og + 1u == (tg + 1u) * nx) xb_add(&bar[XB_TOPGEN], 1u);
            else XB_SPIN(xb_ld(&bar[XB_TOPGEN]) == tg, bar);
            __builtin_amdgcn_fence(__ATOMIC_ACQUIRE, "agent");
            xb_add(&bar[XB_XGEN(b.x)], 1u);
            asm volatile("s_waitcnt vmcnt(0)" ::: "memory");
        } else {
            XB_SPIN(xb_ld(&bar[XB_XGEN(b.x)]) == gen, bar);
            __builtin_amdgcn_fence(__ATOMIC_ACQUIRE, "agent");
            asm volatile("s_waitcnt vmcnt(0)" ::: "memory");
        }
    }
    __syncthreads();
}
typedef unsigned u32x2_t __attribute__((ext_vector_type(2)));
typedef short v4i16_t __attribute__((ext_vector_type(4)));
typedef unsigned long long u64;
typedef float f32x2_t __attribute__((ext_vector_type(2)));
typedef int i32x4_t __attribute__((ext_vector_type(4)));
struct Frame {
    LAS unsigned char* lds;
    volatile LAS unsigned* MISC;
    gu32* ctl;
    unsigned char* ws;
    int tid, lane, wave;
    int vcu, G;
    const float *x, *g1, *w_in, *gq, *gk, *sink, *conv_w, *w_oa, *w_oc, *w_out, *g2, *w_qp, *subk, *w_down, *w_up;
    float* out;
};
#define WSP(type, off) ((type*)(F.ws + (off)))
using pg8::cvt_pk_bf16; using pg8::pack8; using pg8::unpack8;

__device__ __forceinline__ float wave_sum(float v) {
#pragma unroll
    for (int o = 1; o < 64; o <<= 1) v += __shfl_xor(v, o);
    return v;
}
__device__ __forceinline__ float dot4(const f32x4 a, const f32x4 b) { return (a[0] * b[0] + a[1] * b[1]) + (a[2] * b[2] + a[3] * b[3]); }
__device__ __forceinline__ float bflo(unsigned w) { return __uint_as_float(w << 16); }
__device__ __forceinline__ float bfhi(unsigned w) { return __uint_as_float(w & 0xffff0000u); }

typedef int v2i32_t __attribute__((ext_vector_type(2)));
__device__ __forceinline__ bool tr4_selfcheck(LAS unsigned char* tp, int lane) {
    const int g = lane >> 4, j = lane & 15;
    unsigned lo = 0u, hi = 0u;
#pragma unroll
    for (int c = 0; c < 8; ++c) { lo |= (unsigned)((j * 5 + c * 3 + g + 1) & 15) << (4 * c); hi |= (unsigned)((j * 5 + (c + 8) * 3 + g + 1) & 15) << (4 * c); }
    *(LAS u32x2_t*)(tp + lane * 8) = (u32x2_t){lo, hi};
    LDS_WAIT(); asm volatile("" ::: "memory");
    const v2i32_t rv = __builtin_amdgcn_ds_read_tr4_b64_v2i32((LAS v2i32_t*)(tp + lane * 8));
    bool ok = true;
#pragma unroll
    for (int e = 0; e < 8; ++e) { ok = ok && ((((unsigned)rv.x >> (4 * e)) & 15u) == (unsigned)((e * 5 + j * 3 + g + 1) & 15)) && ((((unsigned)rv.y >> (4 * e)) & 15u) == (unsigned)(((e + 8) * 5 + j * 3 + g + 1) & 15)); }
    return __all(ok);
}

__device__ __forceinline__ void p0_transpose_item(const float* W, int K, int N, bf16* WT, int row_off, LAS float* scr, int item, int lane) {
    const int nblk = N / 32, kb = item / nblk, nb = item % nblk, k0 = 64 * kb, n0 = 32 * nb;
#pragma unroll 8
    for (int i = 0; i < 32; ++i) { const int kk = 2 * i + (lane >> 5); scr[kk * 33 + (lane & 31)] = W[(size_t)(k0 + kk) * N + n0 + (lane & 31)]; }
    LDS_WAIT(); asm volatile("" ::: "memory");
    const int c = lane & 7;
#pragma unroll
    for (int j = 0; j < 4; ++j) { const int n = (lane >> 3) + 8 * j; const LAS float* s = scr + (8 * c) * 33 + n;
        v4u o; o.x = cvt_pk_bf16(s[0 * 33], s[1 * 33]); o.y = cvt_pk_bf16(s[2 * 33], s[3 * 33]); o.z = cvt_pk_bf16(s[4 * 33], s[5 * 33]); o.w = cvt_pk_bf16(s[6 * 33], s[7 * 33]);
        *(GAS v4u*)(WT + (size_t)(row_off + n0 + n) * K + k0 + 8 * c) = o; }
    LDS_WAIT(); asm volatile("" ::: "memory");
}
template <int QMODE  > __device__ __forceinline__ void rms_row_to_bf16(const float* xrow, const float* g, bf16* orow, unsigned* q8row, float* sxp, int lane) {
    const GAS f32x4* xr = (const GAS f32x4*)xrow + lane; const GAS f32x4* gr = (const GAS f32x4*)g + lane;
    f32x4 v[16]; float s = 0.f;
#pragma unroll
    for (int j = 0; j < 16; ++j) { v[j] = xr[64 * j]; s += dot4(v[j], v[j]); }
    const float r = rsqrtf(wave_sum(s) * (1.f / D) + EPS);
    GAS u32x2_t* o8 = (GAS u32x2_t*)orow + lane; float am = 0.f;
#pragma unroll
    for (int j = 0; j < 16; ++j) { v[j] = v[j] * r * gr[64 * j]; u32x2_t w; w.x = cvt_pk_bf16(v[j][0], v[j][1]); w.y = cvt_pk_bf16(v[j][2], v[j][3]); o8[64 * j] = w;
        am = fmaxf(am, fmaxf(fmaxf(fabsf(v[j][0]), fabsf(v[j][1])), fmaxf(fabsf(v[j][2]), fabsf(v[j][3])))); }
    if constexpr (QMODE == 2) {
#pragma unroll
        for (int j = 0; j < 16; ++j) { int p = 0; p = __builtin_amdgcn_cvt_pk_fp8_f32(v[j][0], v[j][1], p, false); p = __builtin_amdgcn_cvt_pk_fp8_f32(v[j][2], v[j][3], p, true); ((GAS unsigned*)q8row)[64 * j + lane] = (unsigned)p; }
    }
    if constexpr (QMODE == 1) {
#pragma unroll
        for (int o = 1; o < 64; o <<= 1) am = fmaxf(am, __shfl_xor(am, o));
        const float qs = am > 0.f ? 127.0f / am : 0.f;
#pragma unroll
        for (int j = 0; j < 16; ++j) { const int q0 = (int)__builtin_rintf(v[j][0] * qs), q1 = (int)__builtin_rintf(v[j][1] * qs), q2 = (int)__builtin_rintf(v[j][2] * qs), q3 = (int)__builtin_rintf(v[j][3] * qs);
            ((GAS unsigned*)q8row)[64 * j + lane] = (unsigned)(q0 & 255) | ((unsigned)(q1 & 255) << 8) | ((unsigned)(q2 & 255) << 16) | ((unsigned)q3 << 24); }
        if (lane == 0) *sxp = am * (1.0f / 127.0f);
    }
}
__device__ __forceinline__ void rms2_row(const bf16* xrow, const float* g, unsigned char* q8row, float* sxp, unsigned char* x4row, int lane) {
    const GAS v4u* xr = (const GAS v4u*)xrow + lane; const GAS f32x4* gr = (const GAS f32x4*)g + 2 * lane;
    f32x4 v[8][2]; float s = 0.f;
#pragma unroll
    for (int j = 0; j < 8; ++j) { unpack8(xr[64 * j], v[j][0], v[j][1]); s += dot4(v[j][0], v[j][0]) + dot4(v[j][1], v[j][1]); }
    const float r = rsqrtf(wave_sum(s) * (1.f / D) + EPS);
    float am = 0.f;
#pragma unroll
    for (int j = 0; j < 8; ++j) { v[j][0] = v[j][0] * r * gr[128 * j]; v[j][1] = v[j][1] * r * gr[128 * j + 1];
#pragma unroll
        for (int e = 0; e < 4; ++e) am = fmaxf(am, fmaxf(fabsf(v[j][0][e]), fabsf(v[j][1][e]))); }
#pragma unroll
    for (int o = 1; o < 64; o <<= 1) am = fmaxf(am, __shfl_xor(am, o));
    const float qs = am > 0.f ? 127.0f / am : 0.f;
    if (lane == 0) *sxp = am * (1.0f / 127.0f);
#pragma unroll
    for (int j = 0; j < 8; ++j) {
        const f32x4 y0 = v[j][0], y1 = v[j][1];
        { u32x2_t w;
          w.x = (unsigned)((int)__builtin_rintf(y0[0] * qs) & 255) | ((unsigned)((int)__builtin_rintf(y0[1] * qs) & 255) << 8) | ((unsigned)((int)__builtin_rintf(y0[2] * qs) & 255) << 16) | ((unsigned)(int)__builtin_rintf(y0[3] * qs) << 24);
          w.y = (unsigned)((int)__builtin_rintf(y1[0] * qs) & 255) | ((unsigned)((int)__builtin_rintf(y1[1] * qs) & 255) << 8) | ((unsigned)((int)__builtin_rintf(y1[2] * qs) & 255) << 16) | ((unsigned)(int)__builtin_rintf(y1[3] * qs) << 24);
          ((GAS u32x2_t*)q8row)[64 * j + lane] = w; }
        unsigned hi = 0u, lo = 0u;
        hi = __builtin_amdgcn_cvt_scalef32_pk_fp4_f32(hi, y0[0], y0[1], 1.0f, 0); hi = __builtin_amdgcn_cvt_scalef32_pk_fp4_f32(hi, y0[2], y0[3], 1.0f, 1);
        hi = __builtin_amdgcn_cvt_scalef32_pk_fp4_f32(hi, y1[0], y1[1], 1.0f, 2); hi = __builtin_amdgcn_cvt_scalef32_pk_fp4_f32(hi, y1[2], y1[3], 1.0f, 3);
        const f32x2_t d0 = __builtin_amdgcn_cvt_scalef32_pk_f32_fp4(hi, 1.0f, 0), d1 = __builtin_amdgcn_cvt_scalef32_pk_f32_fp4(hi, 1.0f, 1), d2 = __builtin_amdgcn_cvt_scalef32_pk_f32_fp4(hi, 1.0f, 2), d3 = __builtin_amdgcn_cvt_scalef32_pk_f32_fp4(hi, 1.0f, 3);
        lo = __builtin_amdgcn_cvt_scalef32_pk_fp4_f32(lo, (y0[0] - d0.x) * 8.f, (y0[1] - d0.y) * 8.f, 1.0f, 0); lo = __builtin_amdgcn_cvt_scalef32_pk_fp4_f32(lo, (y0[2] - d1.x) * 8.f, (y0[3] - d1.y) * 8.f, 1.0f, 1);
        lo = __builtin_amdgcn_cvt_scalef32_pk_fp4_f32(lo, (y1[0] - d2.x) * 8.f, (y1[1] - d2.y) * 8.f, 1.0f, 2); lo = __builtin_amdgcn_cvt_scalef32_pk_fp4_f32(lo, (y1[2] - d3.x) * 8.f, (y1[3] - d3.y) * 8.f, 1.0f, 3);
        unsigned char* const xd = x4row + (size_t)(2 * j + (lane >> 5)) * ((size_t)M * 256) + (lane & 31) * 4;
        *(GAS unsigned*)xd = hi; *(GAS unsigned*)(xd + 128) = lo;
    }
}
__device__ __forceinline__ void quant_w8(Frame& F) {
    const int gw = F.vcu * NWAVES + F.wave, NGW = F.G * NWAVES, lane = F.lane;
    for (int nn = gw; nn < INW + PQW; nn += NGW) {
        const bool qp = nn >= INW; const int n = qp ? nn - INW : nn;
        if (!qp && n >= BF_BASE * 256 && n < (BF_BASE + BF_TILES) * 256) continue;
        const GAS v4u* src = (const GAS v4u*)((qp ? WSP(const bf16, WS_WQP) : WSP(const bf16, WS_WIN)) + (size_t)n * D) + lane;
        f32x4 lo[8], hi[8]; float am = 0.f;
#pragma unroll
        for (int j = 0; j < 8; ++j) { unpack8(src[64 * j], lo[j], hi[j]);
            am = fmaxf(am, fmaxf(fmaxf(fmaxf(fabsf(lo[j][0]), fabsf(lo[j][1])), fmaxf(fabsf(lo[j][2]), fabsf(lo[j][3]))), fmaxf(fmaxf(fabsf(hi[j][0]), fabsf(hi[j][1])), fmaxf(fabsf(hi[j][2]), fabsf(hi[j][3]))))); }
#pragma unroll
        for (int o = 1; o < 64; o <<= 1) am = fmaxf(am, __shfl_xor(am, o));
        const float qs = am > 0.f ? 127.0f / am : 0.f;
        GAS u32x2_t* dst = (GAS u32x2_t*)(F.ws + (qp ? WS_W8QP : WS_W8) + (size_t)n * D) + lane;
#pragma unroll
        for (int j = 0; j < 8; ++j) { u32x2_t w;
            w.x = (unsigned)((int)__builtin_rintf(lo[j][0] * qs) & 255) | ((unsigned)((int)__builtin_rintf(lo[j][1] * qs) & 255) << 8) | ((unsigned)((int)__builtin_rintf(lo[j][2] * qs) & 255) << 16) | ((unsigned)(int)__builtin_rintf(lo[j][3] * qs) << 24);
            w.y = (unsigned)((int)__builtin_rintf(hi[j][0] * qs) & 255) | ((unsigned)((int)__builtin_rintf(hi[j][1] * qs) & 255) << 8) | ((unsigned)((int)__builtin_rintf(hi[j][2] * qs) & 255) << 16) | ((unsigned)(int)__builtin_rintf(hi[j][3] * qs) << 24);
            dst[64 * j] = w; }
        if (lane == 0) (qp ? WSP(float, WS_SWQ) : WSP(float, WS_SW))[n] = am * (1.0f / 127.0f);
    }
}
__device__ __forceinline__ void p0_prologue(Frame& F) {
    LAS float* scr = (LAS float*)(F.lds + RING_OFF + F.wave * 16384);
    const int gw = F.vcu * NWAVES + F.wave, NGW = F.G * NWAVES;
    constexpr int I_IN = (D / 64) * (INW / 32), I_OA = (QW / 64) * (D / 32), I_OC = (CW / 64) * (D / 32), I_OUT = (D / 64) * (D / 32), I_QP = (D / 64) * (PQW / 32);
    constexpr int NITEMS = I_IN + I_OA + I_OC + I_OUT + I_QP;
    bf16* Win_t = WSP(bf16, WS_WIN); bf16* Wo_t = WSP(bf16, WS_WO); bf16* Wout_t = WSP(bf16, WS_WOUT); bf16* Wqp_t = WSP(bf16, WS_WQP);
    for (int it = gw; it < NITEMS; it += NGW) {
        int r = it;
        if (r < I_IN) { p0_transpose_item(F.w_in, D, INW, Win_t, 0, scr, r, F.lane); continue; } r -= I_IN;
        if (r < I_OA) { p0_transpose_item(F.w_oa, QW, D, Wo_t, 0, scr, r, F.lane); continue; } r -= I_OA;
        if (r < I_OC) { p0_transpose_item(F.w_oc, CW, D, Wo_t, D, scr, r, F.lane); continue; } r -= I_OC;
        if (r < I_OUT) { p0_transpose_item(F.w_out, D, D, Wout_t, 0, scr, r, F.lane); continue; } r -= I_OUT;
        p0_transpose_item(F.w_qp, D, PQW, Wqp_t, 0, scr, r, F.lane);
    }
    {
        bf16* SK = WSP(bf16, WS_SK); const int nth = F.G * NWAVES * 64, gt = gw * 64 + F.lane;
        for (int i = gt; i < PH * 2 * NKEYS * 128 / 4; i += nth) { const f32x4 v = ((const GAS f32x4*)F.subk)[i]; u32x2_t w; w.x = cvt_pk_bf16(v[0], v[1]); w.y = cvt_pk_bf16(v[2], v[3]); ((GAS u32x2_t*)SK)[i] = w; }
    }
    bf16* XN = WSP(bf16, WS_XN);
    for (int m = gw; m < M; m += NGW) rms_row_to_bf16<1>(F.x + (size_t)m * D, F.g1, XN + (size_t)m * D, (unsigned*)(F.ws + WS_XN8 + (size_t)m * D), WSP(float, WS_SX) + m, F.lane);
    for (int r = gw; r < 2 * NEXP; r += NGW) {
        const bool up = r >= NEXP; const int rr = up ? r - NEXP : r;
        const GAS f32x4* src = (const GAS f32x4*)((up ? F.w_up : F.w_down) + (size_t)rr * D) + 2 * F.lane;
        f32x4 v[16]; float am = 0.f;
#pragma unroll
        for (int i = 0; i < 8; ++i) { v[2 * i] = src[128 * i]; v[2 * i + 1] = src[128 * i + 1]; }
#pragma unroll
        for (int i = 0; i < 16; ++i) am = fmaxf(am, fmaxf(fmaxf(fabsf(v[i][0]), fabsf(v[i][1])), fmaxf(fabsf(v[i][2]), fabsf(v[i][3]))));
#pragma unroll
        for (int o = 1; o < 64; o <<= 1) am = fmaxf(am, __shfl_xor(am, o));
        const float sc = am > 0.f ? 6.0f / am : 1.0f;
        unsigned char* const dstb = F.ws + (up ? WS_W4U : WS_W4D) + (size_t)rr * 128 + (size_t)(F.lane >> 5) * SLICE_BYTES + (F.lane & 31) * 4;
#pragma unroll
        for (int i = 0; i < 8; ++i) { unsigned p = 0u;
            if (NIBBLE_SWAP_DOWN && !up) {
            p = __builtin_amdgcn_cvt_scalef32_pk_fp4_f32(p, v[2 * i][1] * sc, v[2 * i][0] * sc, 1.0f, 0); p = __builtin_amdgcn_cvt_scalef32_pk_fp4_f32(p, v[2 * i][3] * sc, v[2 * i][2] * sc, 1.0f, 1);
            p = __builtin_amdgcn_cvt_scalef32_pk_fp4_f32(p, v[2 * i + 1][1] * sc, v[2 * i + 1][0] * sc, 1.0f, 2); p = __builtin_amdgcn_cvt_scalef32_pk_fp4_f32(p, v[2 * i + 1][3] * sc, v[2 * i + 1][2] * sc, 1.0f, 3);
            } else {
            p = __builtin_amdgcn_cvt_scalef32_pk_fp4_f32(p, v[2 * i][0] * sc, v[2 * i][1] * sc, 1.0f, 0); p = __builtin_amdgcn_cvt_scalef32_pk_fp4_f32(p, v[2 * i][2] * sc, v[2 * i][3] * sc, 1.0f, 1);
            p = __builtin_amdgcn_cvt_scalef32_pk_fp4_f32(p, v[2 * i + 1][0] * sc, v[2 * i + 1][1] * sc, 1.0f, 2); p = __builtin_amdgcn_cvt_scalef32_pk_fp4_f32(p, v[2 * i + 1][2] * sc, v[2 * i + 1][3] * sc, 1.0f, 3);
            }
            *(GAS unsigned*)(dstb + (size_t)(2 * i) * SLICE_BYTES) = p; }
        if (F.lane == 0) WSP(float, up ? WS_SCU : WS_SCD)[rr] = am > 0.f ? am * (1.0f / 6.0f) : 1.0f;
    }
}

__device__ __forceinline__ unsigned off_b(unsigned row, unsigned ch) { return 256u * row + 16u * (ch ^ (((row & 3u) << 2) | ((row >> 2) & 3u))); }
__device__ __forceinline__ unsigned tr_addr16(unsigned lane, unsigned c, unsigned ks, unsigned t) {
    const unsigned g = lane >> 4, q = (lane & 15u) >> 2, p = lane & 3u;
    return off_b(32u * ks + 8u * g + 4u * t + q, 2u * c + (p >> 1)) + 8u * (p & 1u);
}
__device__ __forceinline__ v4i16_t tr_read(LAS unsigned char* p) { return __builtin_amdgcn_ds_read_tr16_b64_v4i16((LAS v4i16_t*)p); }
#define MFMA16(a, b, c) __builtin_amdgcn_mfma_f32_16x16x32_bf16((a), (b), (c), 0, 0, 0)

template <int PROBE> __device__ __forceinline__ void attn_unit(Frame& F, const int U) {
    const int lane = F.lane, wave = F.wave, c = lane & 15, hg = lane >> 4, tid = F.tid;
    const int hp = U & 1, kvh = (U >> 1) & 3, nblk = (U >> 3) & 31, b = U >> 8;
    const int hq = kvh * 4 + hp * 2 + (wave >> 2), i0 = (wave & 3) * 32;
    const size_t tok0 = (size_t)b * SEQ + (size_t)nblk * 128;
    const bf16* QB = WSP(const bf16, WS_Q); const bf16* KB = WSP(const bf16, WS_K); const bf16* VB = WSP(const bf16, WS_V); bf16* OB = PROBE ? WSP(bf16, WS_XN) : WSP(bf16, WS_AB);
    bf16x8 qf[2][4];
    {
        float g[4][8];
#pragma unroll
        for (int ks = 0; ks < 4; ++ks) { const f32x4 a = *(const GAS f32x4*)(F.gq + 32 * ks + 8 * hg), bb = *(const GAS f32x4*)(F.gq + 32 * ks + 8 * hg + 4);
#pragma unroll
            for (int e = 0; e < 4; ++e) { g[ks][e] = a[e]; g[ks][4 + e] = bb[e]; } }
#pragma unroll
        for (int qt = 0; qt < 2; ++qt) {
            const bf16* qrow = QB + (tok0 + i0 + 16 * qt + c) * QW + hq * HD + 8 * hg;
            f32x4 lo[4], hi[4]; float ss = 0.f;
#pragma unroll
            for (int ks = 0; ks < 4; ++ks) { unpack8(*(const GAS v4u*)(qrow + 32 * ks), lo[ks], hi[ks]); ss += dot4(lo[ks], lo[ks]) + dot4(hi[ks], hi[ks]); }
            ss += __shfl_xor(ss, 16); ss += __shfl_xor(ss, 32);
            const float r = rsqrtf(ss * (1.f / HD) + EPS) * (0.08838834764831845f * LOG2E);
#pragma unroll
            for (int ks = 0; ks < 4; ++ks) { f32x4 a, bb;
#pragma unroll
                for (int e = 0; e < 4; ++e) { a[e] = lo[ks][e] * r * g[ks][e]; bb[e] = hi[ks][e] * r * g[ks][4 + e]; }
                qf[qt][ks] = __builtin_bit_cast(bf16x8, pack8(a, bb)); }
        }
    }
    const float slope2 = __builtin_amdgcn_exp2f(-0.5f * (float)(hq + 1)) * LOG2E;
    const float sink2 = F.sink[hq] * LOG2E;
    float mrun[2] = {sink2, sink2}, lrun[2]; lrun[0] = lrun[1] = (hg == 0) ? 1.f : 0.f;
    f32x4 acc[8][2];
#pragma unroll
    for (int dt = 0; dt < 8; ++dt) { acc[dt][0] = (f32x4){0.f, 0.f, 0.f, 0.f}; acc[dt][1] = (f32x4){0.f, 0.f, 0.f, 0.f}; }
    const f32x4 gk0 = *(const GAS f32x4*)(F.gk + (tid & 15) * 8), gk1 = *(const GAS f32x4*)(F.gk + (tid & 15) * 8 + 4);
    __syncthreads();
    int bufi = 0;
#pragma unroll 1
    for (int kbi = -1; kbi <= 1; ++kbi) {
        const int kb = nblk + kbi; if (kb < 0 || kb >= SEQ / 128) continue;
        LAS unsigned char* Kl = F.lds + RING_OFF + bufi * 65536; LAS unsigned char* Vl = Kl + 32768; bufi ^= 1;
#pragma unroll
        for (int it = 0; it < (PROBE == 3 ? 0 : 4); ++it) {
            const int row = (tid >> 4) + 32 * it, ch = tid & 15;
            const size_t src = ((size_t)b * SEQ + (size_t)kb * 128 + row) * KVW + kvh * HD + ch * 8;
            f32x4 k0, k1; unpack8(*(const GAS v4u*)(KB + src), k0, k1);
            float ss = dot4(k0, k0) + dot4(k1, k1);
            ss += __shfl_xor(ss, 1); ss += __shfl_xor(ss, 2); ss += __shfl_xor(ss, 4); ss += __shfl_xor(ss, 8);
            const float r = rsqrtf(ss * (1.f / HD) + EPS);
            *(LAS v4u*)(Kl + off_b(row, ch)) = pack8(k0 * r * gk0, k1 * r * gk1);
            *(LAS v4u*)(Vl + off_b(row, ch)) = *(const GAS v4u*)(VB + src);
        }
        __syncthreads();
        const int ks_lo = kbi < 0 ? (i0 >> 5) : 0, ks_hi = kbi > 0 ? (i0 >> 5) + 1 : 4;
#pragma unroll 2
        for (int ks32 = (PROBE == 2 ? ks_hi : ks_lo); ks32 < ks_hi; ++ks32) {
            f32x4 sa[2], sb[2];
            sa[0] = sa[1] = sb[0] = sb[1] = (f32x4){0.f, 0.f, 0.f, 0.f};
            const unsigned krow = 32u * ks32 + 8u * (c >> 2) + (c & 3);
#pragma unroll
            for (int ks = 0; ks < 4; ++ks) {
                const bf16x8 ka = *(const LAS bf16x8*)(Kl + off_b(krow, 4 * ks + hg)), kb2 = *(const LAS bf16x8*)(Kl + off_b(krow + 4, 4 * ks + hg));
#pragma unroll
                for (int qt = 0; qt < 2; ++qt) { sa[qt] = MFMA16(ka, qf[qt][ks], sa[qt]); sb[qt] = MFMA16(kb2, qf[qt][ks], sb[qt]); }
            }
            bf16x8 pf[2];
#pragma unroll
            for (int qt = 0; qt < 2; ++qt) {
                float s[8] = {sa[qt][0], sa[qt][1], sa[qt][2], sa[qt][3], sb[qt][0], sb[qt][1], sb[qt][2], sb[qt][3]};
                const int rel0 = kbi * 128 + 32 * ks32 + 8 * hg - (i0 + 16 * qt + c);
                float mx = -INFINITY;
#pragma unroll
                for (int j = 0; j < 8; ++j) { const int rel = rel0 + j, dist = rel < 0 ? -rel : rel; const float sv = s[j] - slope2 * (float)dist; s[j] = (dist <= 128) ? sv : -INFINITY; mx = fmaxf(mx, s[j]); }
                mx = fmaxf(mx, __shfl_xor(mx, 16)); mx = fmaxf(mx, __shfl_xor(mx, 32));
                const float mn = fmaxf(mrun[qt], mx), alpha = __builtin_amdgcn_exp2f(mrun[qt] - mn); mrun[qt] = mn;
                float ps = 0.f;
#pragma unroll
                for (int j = 0; j < 8; ++j) { s[j] = __builtin_amdgcn_exp2f(s[j] - mn); ps += s[j]; }
                lrun[qt] = lrun[qt] * alpha + ps;
                pf[qt] = __builtin_bit_cast(bf16x8, pack8((f32x4){s[0], s[1], s[2], s[3]}, (f32x4){s[4], s[5], s[6], s[7]}));
#pragma unroll
                for (int dt = 0; dt < 8; ++dt) acc[dt][qt] = acc[dt][qt] * alpha;
            }
#pragma unroll
            for (int dt = 0; dt < 8; ++dt) {
                const v4i16_t vlo = tr_read(Vl + tr_addr16(lane, dt, ks32, 0)), vhi = tr_read(Vl + tr_addr16(lane, dt, ks32, 1));
                const bf16x8 vf = {vlo[0], vlo[1], vlo[2], vlo[3], vhi[0], vhi[1], vhi[2], vhi[3]};
#pragma unroll
                for (int qt = 0; qt < 2; ++qt) acc[dt][qt] = MFMA16(vf, pf[qt], acc[dt][qt]);
            }
        }
    }
#pragma unroll
    for (int qt = 0; qt < 2; ++qt) {
        float l = lrun[qt]; l += __shfl_xor(l, 16); l += __shfl_xor(l, 32);
        const float inv = 1.0f / l;
        bf16* orow = OB + (tok0 + i0 + 16 * qt + c) * QW + hq * HD + 4 * hg;
#pragma unroll
        for (int dt = 0; dt < 8; ++dt) { const f32x4 o = acc[dt][qt] * inv; u32x2_t w; w.x = cvt_pk_bf16(o[0], o[1]); w.y = cvt_pk_bf16(o[2], o[3]); *(GAS u32x2_t*)(orow + 16 * dt) = w; }
    }
}
__device__ __forceinline__ int attn_i0(int wave) { return ((wave & 4) ? 3 - (wave & 3) : (wave & 3)) * 32; }
__device__ __forceinline__ int attn_unit_of(const Frame& F, int un) { const int U = (F.vcu + (un >> 2) * F.G) * 4 + (un & 3); return U < BATCH * 32 * NKV * 2 ? U : -1; }
__device__ __forceinline__ bool attn_next(const Frame& F, int& un, int& kbi) {
    for (;;) {
        ++kbi; if (kbi > 1) { ++un; kbi = -1; }
        const int U = attn_unit_of(F, un); if (U < 0) return false;
        const int kb = ((U >> 3) & 31) + kbi; if (kb >= 0 && kb < SEQ / 128) return true;
    }
}
__device__ __forceinline__ void attn_kv_issue(Frame& F, int U, int kbi, LAS unsigned char* Kl) {
    const int lane = F.lane, kvh = (U >> 1) & 3, nblk = (U >> 3) & 31, b = U >> 8, kb = nblk + kbi;
    const bf16* KB = WSP(const bf16, WS_K); const bf16* VB = WSP(const bf16, WS_V);
    const size_t base = ((size_t)b * SEQ + (size_t)kb * 128) * KVW + kvh * HD;
    const unsigned sw = ((unsigned)(lane >> 4) << 2) | ((unsigned)F.wave & 3u), ch = ((unsigned)lane & 15u) ^ sw;
#pragma unroll
    for (int it = 0; it < 4; ++it) { const int blk = F.wave + 8 * it, row = 4 * blk + (lane >> 4); const size_t src = base + (size_t)row * KVW + ch * 8;
        __builtin_amdgcn_global_load_lds((const unsigned*)(KB + src), (LAS unsigned*)(Kl + blk * 1024), 16, 0, 0);
        __builtin_amdgcn_global_load_lds((const unsigned*)(VB + src), (LAS unsigned*)(Kl + 32768 + blk * 1024), 16, 0, 0); }
}
__device__ __forceinline__ void attn_k_norm(Frame& F, LAS unsigned char* Kl, const LAS float* gkl) {
    const int lane = F.lane;
    const unsigned sw = ((unsigned)(lane >> 4) << 2) | ((unsigned)F.wave & 3u), ch = ((unsigned)lane & 15u) ^ sw;
    const f32x4 gk0 = *(const LAS f32x4*)(gkl + ch * 8), gk1 = *(const LAS f32x4*)(gkl + ch * 8 + 4);
    v4u kr[4];
#pragma unroll
    for (int it = 0; it < 4; ++it) kr[it] = *(const LAS v4u*)(Kl + (F.wave + 8 * it) * 1024 + lane * 16);
#pragma unroll
    for (int it = 0; it < 4; ++it) {
        f32x4 k0, k1; unpack8(kr[it], k0, k1);
        float ss = dot4(k0, k0) + dot4(k1, k1);
        ss += __shfl_xor(ss, 1); ss += __shfl_xor(ss, 2); ss += __shfl_xor(ss, 4); ss += __shfl_xor(ss, 8);
        const float r = rsqrtf(ss * (1.f / HD) + EPS);
        *(LAS v4u*)(Kl + (F.wave + 8 * it) * 1024 + lane * 16) = pack8(k0 * r * gk0, k1 * r * gk1); }
}
__device__ __forceinline__ void attn_q_issue(Frame& F, int U, v4u (&qr)[2][4]) {
    const int lane = F.lane, wave = F.wave, c = lane & 15, hg = lane >> 4;
    const int hp = U & 1, kvh = (U >> 1) & 3, nblk = (U >> 3) & 31, b = U >> 8, hq = kvh * 4 + hp * 2 + (wave >> 2), i0 = attn_i0(wave);
    const size_t tok0 = (size_t)b * SEQ + (size_t)nblk * 128;
    const bf16* QB = WSP(const bf16, WS_Q);
#pragma unroll
    for (int qt = 0; qt < 2; ++qt) { const bf16* qrow = QB + (tok0 + i0 + 16 * qt + c) * QW + hq * HD + 8 * hg;
#pragma unroll
        for (int ks = 0; ks < 4; ++ks) qr[qt][ks] = *(const GAS v4u*)(qrow + 32 * ks); }
}
__device__ __forceinline__ void attn_block(Frame& F, const LAS unsigned char* Kl, int kbi, const bf16x8 (&qf)[2][4], float slope2, float (&mrun)[2], float (&lrun)[2], f32x4 (&acc)[8][2]) {
    const int lane = F.lane, c = lane & 15, hg = lane >> 4, i0 = attn_i0(F.wave);
    const LAS unsigned char* Vl = Kl + 32768;
    const int ks_lo = kbi < 0 ? (i0 >> 5) : 0, ks_hi = kbi > 0 ? (i0 >> 5) + 1 : 4;
#pragma unroll 1
    for (int ks32 = ks_lo; ks32 < ks_hi; ++ks32) {
        f32x4 sa[2], sb[2];
        sa[0] = sa[1] = sb[0] = sb[1] = (f32x4){0.f, 0.f, 0.f, 0.f};
        const unsigned krow = 32u * ks32 + 8u * (c >> 2) + (c & 3);
#pragma unroll
        for (int ks = 0; ks < 4; ++ks) {
            const bf16x8 ka = *(const LAS bf16x8*)(Kl + off_b(krow, 4 * ks + hg)), kb2 = *(const LAS bf16x8*)(Kl + off_b(krow + 4, 4 * ks + hg));
#pragma unroll
            for (int qt = 0; qt < 2; ++qt) { sa[qt] = MFMA16(ka, qf[qt][ks], sa[qt]); sb[qt] = MFMA16(kb2, qf[qt][ks], sb[qt]); }
        }
        bf16x8 pf[2];
#pragma unroll
        for (int qt = 0; qt < 2; ++qt) {
            float sv8[8] = {sa[qt][0], sa[qt][1], sa[qt][2], sa[qt][3], sb[qt][0], sb[qt][1], sb[qt][2], sb[qt][3]};
            const int rel0 = kbi * 128 + 32 * ks32 + 8 * hg - (i0 + 16 * qt + c);
            float mx = -INFINITY;
#pragma unroll
            for (int j = 0; j < 8; ++j) { const int rel = rel0 + j, dist = rel < 0 ? -rel : rel; const float sv = sv8[j] - slope2 * (float)dist; sv8[j] = (dist <= 128) ? sv : -INFINITY; mx = fmaxf(mx, sv8[j]); }
            mx = fmaxf(mx, __shfl_xor(mx, 16)); mx = fmaxf(mx, __shfl_xor(mx, 32));
            const float mn = fmaxf(mrun[qt], mx), alpha = __builtin_amdgcn_exp2f(mrun[qt] - mn); mrun[qt] = mn;
            float ps = 0.f;
#pragma unroll
            for (int j = 0; j < 8; ++j) { sv8[j] = __builtin_amdgcn_exp2f(sv8[j] - mn); ps += sv8[j]; }
            lrun[qt] = lrun[qt] * alpha + ps;
            pf[qt] = __builtin_bit_cast(bf16x8, pack8((f32x4){sv8[0], sv8[1], sv8[2], sv8[3]}, (f32x4){sv8[4], sv8[5], sv8[6], sv8[7]}));
#pragma unroll
            for (int dt = 0; dt < 8; ++dt) acc[dt][qt] = acc[dt][qt] * alpha;
        }
#pragma unroll
        for (int h = 0; h < 2; ++h) {
            v4i16_t vlo[4], vhi[4];
#pragma unroll
            for (int d = 0; d < 4; ++d) {
                asm volatile("ds_read_b64_tr_b16 %0, %1" : "=v"(vlo[d]) : "v"((unsigned)(size_t)Vl + tr_addr16(lane, 4 * h + d, ks32, 0)));
                asm volatile("ds_read_b64_tr_b16 %0, %1" : "=v"(vhi[d]) : "v"((unsigned)(size_t)Vl + tr_addr16(lane, 4 * h + d, ks32, 1))); }
            asm volatile("s_waitcnt lgkmcnt(0)" : "+v"(vlo[0]), "+v"(vhi[0]), "+v"(vlo[1]), "+v"(vhi[1]), "+v"(vlo[2]), "+v"(vhi[2]), "+v"(vlo[3]), "+v"(vhi[3]) :: "memory");
#pragma unroll
            for (int d = 0; d < 4; ++d) { const bf16x8 vf = {vlo[d][0], vlo[d][1], vlo[d][2], vlo[d][3], vhi[d][0], vhi[d][1], vhi[d][2], vhi[d][3]};
#pragma unroll
                for (int qt = 0; qt < 2; ++qt) acc[4 * h + d][qt] = MFMA16(vf, pf[qt], acc[4 * h + d][qt]); }
        }
    }
}
__device__ __forceinline__ void attn_phase(Frame& F) {
    const int lane = F.lane, wave = F.wave, c = lane & 15, hg = lane >> 4, tid = F.tid, i0 = attn_i0(wave);
    LAS float* gql = (LAS float*)(F.lds + OBUF_OFF);
    LAS float* gkl = gql + 128;
    if (tid < 128) gql[tid] = F.gq[tid]; else if (tid < 256) gql[tid] = F.gk[tid - 128]; else if (tid < 256 + NH) gql[tid] = F.sink[tid - 256];
    int un = 0, kbi = -2;
    if (!attn_next(F, un, kbi)) return;
    v4u qr[2][4];
    attn_q_issue(F, attn_unit_of(F, un), qr);
    attn_kv_issue(F, attn_unit_of(F, un), kbi, F.lds + RING_OFF);
    __syncthreads();
    asm volatile("s_waitcnt vmcnt(0)" ::: "memory");
    attn_k_norm(F, F.lds + RING_OFF, gkl);
    asm volatile("s_waitcnt lgkmcnt(0)" ::: "memory"); __builtin_amdgcn_s_barrier(); asm volatile("" ::: "memory");
    int bufi = 0; bool first = true;
    bf16x8 qf[2][4]; float slope2 = 0.f, mrun[2] = {0.f, 0.f}, lrun[2] = {0.f, 0.f}; f32x4 acc[8][2];
#pragma unroll 1
    for (;;) {
        const int U = attn_unit_of(F, un);
        int nun = un, nkbi = kbi; const bool has_next = attn_next(F, nun, nkbi);
        if (first) {
            const int hp = U & 1, kvh = (U >> 1) & 3, hq = kvh * 4 + hp * 2 + (wave >> 2);
#pragma unroll
            for (int qt = 0; qt < 2; ++qt) {
                f32x4 lo[4], hi[4]; float ss = 0.f;
#pragma unroll
                for (int ks = 0; ks < 4; ++ks) { unpack8(qr[qt][ks], lo[ks], hi[ks]); ss += dot4(lo[ks], lo[ks]) + dot4(hi[ks], hi[ks]); }
                ss += __shfl_xor(ss, 16); ss += __shfl_xor(ss, 32);
                const float r = rsqrtf(ss * (1.f / HD) + EPS) * (0.08838834764831845f * LOG2E);
#pragma unroll
                for (int ks = 0; ks < 4; ++ks) { const f32x4 ga = *(const LAS f32x4*)(gql + 32 * ks + 8 * hg), gb = *(const LAS f32x4*)(gql + 32 * ks + 8 * hg + 4);
                    qf[qt][ks] = __builtin_bit_cast(bf16x8, pack8(lo[ks] * r * ga, hi[ks] * r * gb)); }
            }
            slope2 = __builtin_amdgcn_exp2f(-0.5f * (float)(hq + 1)) * LOG2E;
            const float sink2 = gql[256 + hq] * LOG2E;
            mrun[0] = mrun[1] = sink2; lrun[0] = lrun[1] = (hg == 0) ? 1.f : 0.f;
#pragma unroll
            for (int dt = 0; dt < 8; ++dt) { acc[dt][0] = (f32x4){0.f, 0.f, 0.f, 0.f}; acc[dt][1] = (f32x4){0.f, 0.f, 0.f, 0.f}; }
        }
        __builtin_amdgcn_sched_barrier(0);
        attn_kv_issue(F, attn_unit_of(F, has_next ? nun : un), has_next ? nkbi : kbi, F.lds + RING_OFF + (bufi ^ 1) * 65536);
        const bool last = !has_next || nun != un;
        __builtin_amdgcn_sched_barrier(0);
        attn_block(F, F.lds + RING_OFF + bufi * 65536, kbi, qf, slope2, mrun, lrun, acc);
        __builtin_amdgcn_sched_barrier(0);
        if (last) {
            if (has_next) attn_q_issue(F, attn_unit_of(F, nun), qr);
            __builtin_amdgcn_sched_barrier(0);
            const int hp = U & 1, kvh = (U >> 1) & 3, nblk = (U >> 3) & 31, b = U >> 8, hq = kvh * 4 + hp * 2 + (wave >> 2);
            const size_t tok0 = (size_t)b * SEQ + (size_t)nblk * 128;
            bf16* OB = WSP(bf16, WS_AB);
#pragma unroll
            for (int qt = 0; qt < 2; ++qt) {
                float l = lrun[qt]; l += __shfl_xor(l, 16); l += __shfl_xor(l, 32);
                const float inv = 1.0f / l;
                bf16* orow = OB + (tok0 + i0 + 16 * qt + c) * QW + hq * HD + 4 * hg;
#pragma unroll
                for (int dt = 0; dt < 8; ++dt) { const f32x4 o = acc[dt][qt] * inv; u32x2_t w; w.x = cvt_pk_bf16(o[0], o[1]); w.y = cvt_pk_bf16(o[2], o[3]); *(GAS u32x2_t*)(orow + 16 * dt) = w; }
            }
        }
        if (!has_next) { asm volatile("s_waitcnt vmcnt(0)" ::: "memory"); break; }
        __builtin_amdgcn_sched_barrier(0);
        if (last) asm volatile("s_waitcnt vmcnt(24)" ::: "memory"); else asm volatile("s_waitcnt vmcnt(0)" ::: "memory");
        __builtin_amdgcn_sched_barrier(0);
        attn_k_norm(F, F.lds + RING_OFF + (bufi ^ 1) * 65536, gkl);
        asm volatile("s_waitcnt lgkmcnt(0)" ::: "memory"); __builtin_amdgcn_s_barrier(); asm volatile("" ::: "memory");
        bufi ^= 1; first = last; un = nun; kbi = nkbi;
    }
    __syncthreads();
}
constexpr int CONV_T = 8;
__device__ __forceinline__ void conv_phase(Frame& F) {
    const bf16* HB = WSP(const bf16, WS_H); const bf16* BB = WSP(const bf16, WS_B); const bf16* CB = WSP(const bf16, WS_C); bf16* OC = WSP(bf16, WS_AB) + (size_t)M * CW;
    const unsigned nitem = (unsigned)(M / CONV_T) * (CW / 8);
    for (unsigned e = (unsigned)F.vcu * 512u + (unsigned)F.tid; e < nitem; e += (unsigned)F.G * 512u) {
        const int t0 = (int)(e >> 8) * CONV_T, cc = (int)(e & 255u) * 8, tl0 = t0 & (SEQ - 1);
        const size_t o = (size_t)t0 * CW + cc;
        const bool has_prev = tl0 > 0, has_next = tl0 + CONV_T < SEQ;
        v4u hw[CONV_T + 2], cw[CONV_T + 2], bw[CONV_T];
        hw[0] = cw[0] = hw[CONV_T + 1] = cw[CONV_T + 1] = (v4u){0u, 0u, 0u, 0u};
        if (has_prev) { hw[0] = *(const GAS v4u*)(HB + o - CW); cw[0] = *(const GAS v4u*)(CB + o - CW); }
#pragma unroll
        for (int k = 0; k < CONV_T; ++k) { hw[k + 1] = *(const GAS v4u*)(HB + o + (size_t)k * CW); cw[k + 1] = *(const GAS v4u*)(CB + o + (size_t)k * CW); bw[k] = *(const GAS v4u*)(BB + o + (size_t)k * CW); }
        if (has_next) { hw[CONV_T + 1] = *(const GAS v4u*)(HB + o + (size_t)CONV_T * CW); cw[CONV_T + 1] = *(const GAS v4u*)(CB + o + (size_t)CONV_T * CW); }
        const GAS f32x4* w = (const GAS f32x4*)(F.conv_w + cc);
        const f32x4 w00 = w[0], w01 = w[1], w10 = w[CW / 4], w11 = w[CW / 4 + 1], w20 = w[2 * CW / 4], w21 = w[2 * CW / 4 + 1];
        f32x4 up0, up1, uc0, uc1;
        { f32x4 h0, h1, c0, c1; unpack8(hw[0], h0, h1); unpack8(cw[0], c0, c1); up0 = h0 * c0; up1 = h1 * c1; unpack8(hw[1], h0, h1); unpack8(cw[1], c0, c1); uc0 = h0 * c0; uc1 = h1 * c1; }
#pragma unroll
        for (int k = 0; k < CONV_T; ++k) {
            f32x4 h0, h1, c0, c1, b0, b1; unpack8(hw[k + 2], h0, h1); unpack8(cw[k + 2], c0, c1); unpack8(bw[k], b0, b1);
            const f32x4 un0 = h0 * c0, un1 = h1 * c1;
            const f32x4 y0 = w00 * up0 + w10 * uc0 + w20 * un0, y1 = w01 * up1 + w11 * uc1 + w21 * un1;
            *(GAS v4u*)(OC + o + (size_t)k * CW) = pack8(b0 * y0, b1 * y1);
            up0 = uc0; up1 = uc1; uc0 = un0; uc1 = un1;
        }
    }
}

__device__ __forceinline__ unsigned ordf(float f) { const unsigned u = __float_as_uint(f); return u ^ ((u >> 31) ? 0xFFFFFFFFu : 0x80000000u); }
__device__ __forceinline__ float unordf(unsigned k) { return __uint_as_float((k & 0x80000000u) ? (k ^ 0x80000000u) : ~k); }
__device__ __forceinline__ u64 shfl64_xor(u64 v, int m) { const unsigned lo = __shfl_xor((unsigned)v, m), hi = __shfl_xor((unsigned)(v >> 32), m); return ((u64)hi << 32) | lo; }
template <int N> __device__ __forceinline__ void bitonic_merge_desc(unsigned (&a)[N]) {
#pragma unroll
    for (int j = N >> 1; j > 0; j >>= 1)
#pragma unroll
        for (int i = 0; i < N; ++i) { const int l = i ^ j; if (l > i) { const unsigned hi = a[i] > a[l] ? a[i] : a[l], lo = a[i] > a[l] ? a[l] : a[i]; a[i] = hi; a[l] = lo; } }
}
template <int N> __device__ __forceinline__ void bitonic_sort_desc(unsigned (&a)[N]) {
#pragma unroll
    for (int k = 2; k <= N; k <<= 1)
#pragma unroll
        for (int j = k >> 1; j > 0; j >>= 1)
#pragma unroll
            for (int i = 0; i < N; ++i) { const int l = i ^ j; if (l > i) { const unsigned hi = a[i] > a[l] ? a[i] : a[l], lo = a[i] > a[l] ? a[l] : a[i]; const bool desc = ((i & k) == 0); a[i] = desc ? hi : lo; a[l] = desc ? lo : hi; } }
}
__device__ __forceinline__ void xlane_top16(unsigned (&t)[16], const int mask) {
    unsigned m[16];
#pragma unroll
    for (int i = 0; i < 16; ++i) { const unsigned p = __shfl_xor(t[15 - i], mask); m[i] = t[i] > p ? t[i] : p; }
    bitonic_merge_desc<16>(m);
#pragma unroll
    for (int i = 0; i < 16; ++i) t[i] = m[i];
}
struct Stair { int i[52], j[52]; };
constexpr Stair make_stair() { Stair s{}; int n = 0; for (int a = 0; a < 16; ++a) for (int b = 0; b < 16; ++b) if ((a + 1) * (b + 1) <= 16) { s.i[n] = a; s.j[n] = b; ++n; } for (; n < 52; ++n) { s.i[n] = -1; s.j[n] = -1; } return s; }
constexpr Stair STAIR = make_stair();
template <int P> __device__ __forceinline__ unsigned cand1(const float (&v1)[16], const float (&v2)[16]) {
    constexpr int i = STAIR.i[P], j = STAIR.j[P];
    if constexpr (i < 0) return 0u;
    else return (ordf(v1[i] + v2[j]) & ~255u) | (unsigned)(16 * i + j);
}
template <int S> __device__ __forceinline__ void cand_fill(unsigned (&ck)[16], const float (&v1)[16], const float (&v2)[16], int hg) {
    const unsigned k0 = cand1<4 * S + 0>(v1, v2), k1 = cand1<4 * S + 1>(v1, v2), k2 = cand1<4 * S + 2>(v1, v2), k3 = cand1<4 * S + 3>(v1, v2);
    ck[S] = hg == 0 ? k0 : hg == 1 ? k1 : hg == 2 ? k2 : k3;
    if constexpr (S + 1 < 13) cand_fill<S + 1>(ck, v1, v2, hg);
}
__device__ __forceinline__ void route_task(Frame& F, const int tg, const int h) {
    const int lane = F.lane, c = lane & 15, hg = lane >> 4;
    const int tok = tg * 16 + c;
    const bf16* QP = WSP(const bf16, WS_QP); LAS unsigned char* SKl = F.lds + RING_OFF;
    unsigned sel[2][16];
#pragma unroll
    for (int half = 0; half < 2; ++half) {
        bf16x8 bq[4];
#pragma unroll
        for (int ks = 0; ks < 4; ++ks) bq[ks] = *(const GAS bf16x8*)(QP + (size_t)tok * PQW + h * 256 + half * 128 + 32 * ks + 8 * hg);
        unsigned k[32];
#pragma unroll
        for (int tile = 0; tile < 8; ++tile) {
            f32x4 s = (f32x4){0.f, 0.f, 0.f, 0.f};
#pragma unroll
            for (int ks = 0; ks < 4; ++ks) { const bf16x8 a = *(const LAS bf16x8*)(SKl + off_b(half * 128 + 16 * tile + c, 4 * ks + hg)); s = MFMA16(a, bq[ks], s); }
#pragma unroll
            for (int r = 0; r < 4; ++r) k[tile * 4 + r] = (ordf(s[r]) & ~127u) | (unsigned)(16 * tile + 4 * hg + r);
            if (tile & 1) asm volatile("" ::: "memory");
        }
        bitonic_sort_desc<32>(k);
        unsigned t[16];
#pragma unroll
        for (int i = 0; i < 16; ++i) t[i] = k[i];
        xlane_top16(t, 16); xlane_top16(t, 32);
#pragma unroll
        for (int i = 0; i < 16; ++i) sel[half][i] = t[i];
        asm volatile("" ::: "memory");
    }
    float v1[16], v2[16]; unsigned n1[16], n2[16];
#pragma unroll
    for (int i = 0; i < 16; ++i) { v1[i] = unordf(sel[0][i] & ~127u); n1[i] = sel[0][i] & 127u; v2[i] = unordf(sel[1][i] & ~127u); n2[i] = sel[1][i] & 127u; }
    LAS unsigned char* scr = F.lds + RING_OFF + 65536 + F.wave * 4096 + c * 256;
    if (hg == 0) {
#pragma unroll
        for (int q4 = 0; q4 < 4; ++q4) { *(LAS f32x4*)(scr + 16 * q4) = (f32x4){v1[4 * q4], v1[4 * q4 + 1], v1[4 * q4 + 2], v1[4 * q4 + 3]}; *(LAS f32x4*)(scr + 64 + 16 * q4) = (f32x4){v2[4 * q4], v2[4 * q4 + 1], v2[4 * q4 + 2], v2[4 * q4 + 3]};
            *(LAS v4u*)(scr + 128 + 16 * q4) = (v4u){n1[4 * q4], n1[4 * q4 + 1], n1[4 * q4 + 2], n1[4 * q4 + 3]}; *(LAS v4u*)(scr + 192 + 16 * q4) = (v4u){n2[4 * q4], n2[4 * q4 + 1], n2[4 * q4 + 2], n2[4 * q4 + 3]}; } }
    unsigned ck[16];
    cand_fill<0>(ck, v1, v2, hg); ck[13] = ck[14] = ck[15] = 0u;
    bitonic_sort_desc<16>(ck);
    xlane_top16(ck, 16); xlane_top16(ck, 32);
    int oi[4]; float sc[4]; float mx = -INFINITY;
#pragma unroll
    for (int jj = 0; jj < 4; ++jj) {
        const unsigned w = hg == 0 ? ck[jj] : hg == 1 ? ck[4 + jj] : hg == 2 ? ck[8 + jj] : ck[12 + jj];
        const unsigned i4 = (w >> 2) & 0x3Cu, j4 = (w & 15u) << 2;
        sc[jj] = *(const LAS float*)(scr + i4) + *(const LAS float*)(scr + 64 + j4);
        oi[jj] = (int)(*(const LAS unsigned*)(scr + 128 + i4) * (unsigned)NKEYS + *(const LAS unsigned*)(scr + 192 + j4));
        mx = fmaxf(mx, sc[jj]);
    }
    mx = fmaxf(mx, __shfl_xor(mx, 16)); mx = fmaxf(mx, __shfl_xor(mx, 32));
    float ev[4], sum = 0.f;
#pragma unroll
    for (int jj = 0; jj < 4; ++jj) { ev[jj] = __builtin_amdgcn_exp2f((sc[jj] - mx) * LOG2E); sum += ev[jj]; }
    sum += __shfl_xor(sum, 16); sum += __shfl_xor(sum, 32);
    const float inv = 1.0f / sum;
    const size_t o = ((size_t)tok * PH + h) * TOPK + 4 * hg;
    *(GAS i32x4_t*)(WSP(int, WS_IDX) + o) = (i32x4_t){oi[0], oi[1], oi[2], oi[3]};
    *(GAS f32x4*)(WSP(float, WS_GATE) + o) = (f32x4){ev[0] * inv, ev[1] * inv, ev[2] * inv, ev[3] * inv};
}

__device__ __forceinline__ float gelu_erf(float v) { return 0.5f * v * (1.0f + erff(v * 0.70710678118654752f)); }
typedef int i32x8_t __attribute__((ext_vector_type(8)));
#define FP4X2(w, b) __builtin_amdgcn_cvt_scalef32_pk_f32_fp4((w), 1.0f, (b))
__device__ __forceinline__ void fmac(float& acc, float a, float b) { asm("v_fmac_f32 %0, %1, %2" : "+v"(acc) : "v"(a), "v"(b)); }
struct PeerDeal { int ox, nx, t0, stride, cnt, ns; };
__device__ __forceinline__ void pd_item(int n, const PeerDeal& d, int& t, int& sl) { const int N = d.ns * d.cnt, nn = n < N ? n : N - 1, j = nn / d.cnt; sl = d.ox + j * d.nx; t = d.t0 + (nn - j * d.cnt) * d.stride; }
__device__ __forceinline__ void pd_idx(Frame& F, int t, int lane, i32x4_t (&idv)[4]) {
    const GAS i32x4_t* ip = (const GAS i32x4_t*)(WSP(const int, WS_IDX) + (size_t)t * 128 + (lane >> 3) * 16);
#pragma unroll
    for (int a = 0; a < 4; ++a) idv[a] = ip[a];
}
__device__ __forceinline__ void pd_rows(Frame& F, int t, int sl, int lane, const i32x4_t (&idv)[4], v4u (&rows)[16], v4u (&xw)[2]) {
    const unsigned char* xr = F.ws + WS_X2N8 + ((size_t)sl * M + t) * 256 + 16 * (lane >> 4) + ((lane & 15) == 1 ? 128 : 0);
#pragma unroll
    for (int ks = 0; ks < 2; ++ks) xw[ks] = *(const GAS v4u*)(xr + 64 * ks);
    const unsigned char* WD = F.ws + WS_W4D + (size_t)sl * SLICE_BYTES;
    const unsigned lo16 = 16u * (unsigned)(lane & 7);
#pragma unroll
    for (int j = 0; j < 16; ++j) rows[j] = *(const GAS v4u*)(WD + (size_t)(((unsigned)idv[j >> 2][j & 3] << 7) + lo16));
}
__device__ __forceinline__ float dpp_swap1(float v) { return __builtin_bit_cast(float, __builtin_amdgcn_update_dpp(0, __builtin_bit_cast(int, v), 0xB1  , 0xF, 0xF, true)); }
__device__ __forceinline__ void pd_compute(Frame& F, int t, int sl, int lane, const v4u (&rows)[16], const v4u (&xw)[2]) {
    const int r = lane & 15, g = lane >> 4;
    LAS unsigned char* tile = F.lds + RING_OFF + F.wave * 16384;
    { LAS unsigned char* wp = tile + (lane >> 3) * 2048;
#pragma unroll
      for (int j = 0; j < 16; ++j) *(LAS v4u*)(wp + j * 128 + (((lane & 7) ^ ((j >> 1) & 7)) << 4)) = rows[j]; }
    float* pp = WSP(float, WS_PART) + ((size_t)sl * M + t) * 128 + 4 * g;
    const int scb = (r == 1) ? 0x7C7C7C7C   : 0x7F7F7F7F;
    i32x8_t xb[2];
#pragma unroll
    for (int ks = 0; ks < 2; ++ks) xb[ks] = (i32x8_t){(int)xw[ks].x, (int)xw[ks].y, (int)xw[ks].z, (int)xw[ks].w, 0, 0, 0, 0};
    const LAS unsigned char* rp = tile + r * 128; const int fr = (r >> 1) & 7;
    v4u a[8][2];
#pragma unroll
    for (int i = 0; i < 8; ++i)
#pragma unroll
        for (int ks = 0; ks < 2; ++ks) a[i][ks] = *(const LAS v4u*)(rp + i * 2048 + (((4 * ks + g) ^ fr) << 4));
    f32x4 c[8];
#pragma unroll
    for (int i = 0; i < 8; ++i) { const v4u w = a[i][0]; c[i] = __builtin_amdgcn_mfma_scale_f32_16x16x128_f8f6f4((i32x8_t){(int)w.x, (int)w.y, (int)w.z, (int)w.w, 0, 0, 0, 0}, xb[0], (f32x4){0.f, 0.f, 0.f, 0.f}, 4  , 4  , 0, 0x7F7F7F7F, 0, scb); }
#pragma unroll
    for (int i = 0; i < 8; ++i) { const v4u w = a[i][1]; c[i] = __builtin_amdgcn_mfma_scale_f32_16x16x128_f8f6f4((i32x8_t){(int)w.x, (int)w.y, (int)w.z, (int)w.w, 0, 0, 0, 0}, xb[1], c[i], 4, 4, 0, 0x7F7F7F7F, 0, scb); }
#pragma unroll
    for (int i = 0; i < 8; ++i)
#pragma unroll
        for (int e = 0; e < 4; ++e) c[i][e] += dpp_swap1(c[i][e]);
    if (r == 0) {
#pragma unroll
        for (int i = 0; i < 8; ++i) *(GAS f32x4*)(pp + 16 * i) = c[i]; }
}
__device__ __forceinline__ void peer_down_pass(Frame& F, const PeerDeal& d) {
    const int lane = F.lane;
    const int N = d.ns * d.cnt; if (N <= 0) return;
    i32x4_t I0[4], I1[4]; v4u R0[16], R1[16], X0[2], X1[2];
    int t0, s0, t1, s1, t2, s2, t3, s3;
    pd_item(0, d, t0, s0); pd_idx(F, t0, lane, I0);
    pd_item(1, d, t1, s1); pd_idx(F, t1, lane, I1);
    pd_rows(F, t0, s0, lane, I0, R0, X0);
#pragma unroll 1
    for (int n = 0; n < N; n += 2) {
        pd_item(n + 2, d, t2, s2); pd_idx(F, t2, lane, I0);
        __builtin_amdgcn_sched_barrier(0);
        pd_rows(F, t1, s1, lane, I1, R1, X1);
        __builtin_amdgcn_sched_barrier(0);
        pd_compute(F, t0, s0, lane, R0, X0);
        __builtin_amdgcn_sched_barrier(0);
        pd_item(n + 3, d, t3, s3); pd_idx(F, t3, lane, I1);
        __builtin_amdgcn_sched_barrier(0);
        pd_rows(F, t2, s2, lane, I0, R0, X0);
        __builtin_amdgcn_sched_barrier(0);
        pd_compute(F, t1, s1, lane, R1, X1);
        __builtin_amdgcn_sched_barrier(0);
        t0 = t2; s0 = s2; t1 = t3; s1 = s3;
    }
}
__device__ __forceinline__ void peer_combine_token(Frame& F, const int t) {
    const int lane = F.lane;
    const float* PART = WSP(const float, WS_PART) + (size_t)t * 128 + 2 * lane; float* GATEP = WSP(float, WS_GATE) + (size_t)t * 128 + 2 * lane;
    f32x2_t a = (f32x2_t){0.f, 0.f};
#pragma unroll
    for (int sl = 0; sl < 16; ++sl) a += *(const GAS f32x2_t*)(PART + (size_t)sl * M * 128);
    const int id0 = WSP(const int, WS_IDX)[(size_t)t * 128 + 2 * lane], id1 = WSP(const int, WS_IDX)[(size_t)t * 128 + 2 * lane + 1];
    const f32x2_t gt = *(const GAS f32x2_t*)GATEP;
    const float c0 = gt.x * gelu_erf(a.x * WSP(const float, WS_SCD)[id0]) * WSP(const float, WS_SCU)[id0], c1 = gt.y * gelu_erf(a.y * WSP(const float, WS_SCD)[id1]) * WSP(const float, WS_SCU)[id1];
    *(GAS f32x2_t*)GATEP = (f32x2_t){c0, c1};
    float bm = fmaxf(fabsf(c0), fabsf(c1));
    bm = fmaxf(bm, __shfl_xor(bm, 1)); bm = fmaxf(bm, __shfl_xor(bm, 2)); bm = fmaxf(bm, __shfl_xor(bm, 4)); bm = fmaxf(bm, __shfl_xor(bm, 8));
    int eb = (int)((__float_as_uint(bm) >> 23) & 255u) - 1;
    eb = eb < 3 ? 3 : eb > 250 ? 250 : eb;
    const float inv = __uint_as_float((unsigned)(254 - eb) << 23);
    const float s0 = c0 * inv, s1 = c1 * inv;
    const unsigned hi = __builtin_amdgcn_cvt_scalef32_pk_fp4_f32(0u, s0, s1, 1.0f, 0);
    const f32x2_t dq = __builtin_amdgcn_cvt_scalef32_pk_f32_fp4(hi, 1.0f, 0);
    const unsigned lo = __builtin_amdgcn_cvt_scalef32_pk_fp4_f32(0u, (s0 - dq.x) * 8.f, (s1 - dq.y) * 8.f, 1.0f, 0);
    unsigned char* cf4 = F.ws + WS_CF4 + (size_t)t * 160;
    ((GAS unsigned char*)cf4)[lane] = (unsigned char)hi; ((GAS unsigned char*)cf4)[64 + lane] = (unsigned char)lo;
    if ((lane & 15) == 0) ((GAS unsigned*)(cf4 + 128))[lane >> 4] = (unsigned)eb * 0x01010101u;
}
struct PmBuf { v4u rows[16]; v4u aw; unsigned e; u32x2_t xv; };
__device__ __forceinline__ void pm_rows(Frame& F, int t, int sl, int lane, const i32x4_t (&idv)[4], PmBuf& b) {
    const int n = lane & 15, g = lane >> 4;
    const unsigned char* WU = F.ws + WS_W4U + (size_t)sl * SLICE_BYTES;
    const unsigned lo16 = 16u * (unsigned)(lane & 7);
#pragma unroll
    for (int j = 0; j < 16; ++j) b.rows[j] = *(const GAS v4u*)(WU + (size_t)(((unsigned)idv[j >> 2][j & 3] << 7) + lo16));
    const unsigned char* cf4 = F.ws + WS_CF4 + (size_t)t * 160;
    b.aw = *(const GAS v4u*)(cf4 + 64 * (n & 1) + 16 * g); b.e = *(const GAS unsigned*)(cf4 + 128 + 4 * g);
    b.xv = *(const GAS u32x2_t*)(WSP(const bf16, WS_X1B) + (size_t)t * D + 256 * sl + 4 * lane);
}
__device__ __forceinline__ void pm_compute(Frame& F, int t, int sl, int lane, const PmBuf& b) {
    const int n = lane & 15, g = lane >> 4;
    LAS unsigned char* tile = F.lds + RING_OFF + F.wave * 16384;
    LAS float* obuf = (LAS float*)(F.lds + OBUF_OFF + F.wave * 1024);
    { LAS unsigned char* wp = tile + (lane >> 3) * 2048; const int cc = lane & 7;
#pragma unroll
      for (int j = 0; j < 16; ++j) { const v4u w = b.rows[j]; *(LAS v4u*)(wp + j * 128 + ((cc ^ (j >> 1)) << 4)) = (j & 1) ? (v4u){w.z, w.w, w.x, w.y} : w; } }
    const LAS unsigned char* rp = tile + (32 * g + n) * 128;
    const bool arow = n < 2;
    const i32x8_t afr = (i32x8_t){arow ? (int)b.aw.x : 0, arow ? (int)b.aw.y : 0, arow ? (int)b.aw.z : 0, arow ? (int)b.aw.w : 0, 0, 0, 0, 0};
    const unsigned sca = n == 0 ? b.e : n == 1 ? b.e - 0x03030303u : 0x7F7F7F7Fu;
    LAS float* const wdst = g == 0 ? obuf + n : (LAS float*)(F.lds + ODUMP_OFF + F.wave * 256) + lane; const int wstep = g == 0 ? 16 : 0;
#pragma unroll
    for (int h = 0; h < 2; ++h) {
        v2i32_t b0[8], b1[8];
#pragma unroll
        for (int q = 0; q < 8; ++q) { const int off = (((8 * h + q) ^ n) << 3); b0[q] = __builtin_amdgcn_ds_read_tr4_b64_v2i32((LAS v2i32_t*)(rp + off)); b1[q] = __builtin_amdgcn_ds_read_tr4_b64_v2i32((LAS v2i32_t*)(rp + 2048 + off)); }
        f32x4 c[8];
#pragma unroll
        for (int q = 0; q < 8; ++q) c[q] = __builtin_amdgcn_mfma_scale_f32_16x16x128_f8f6f4(afr, (i32x8_t){b0[q].x, b0[q].y, b1[q].x, b1[q].y, 0, 0, 0, 0}, (f32x4){0.f, 0.f, 0.f, 0.f}, 4, 4, 0, (int)sca, 0, 0x7F7F7F7F);
#pragma unroll
        for (int q = 0; q < 8; ++q) wdst[(8 * h + q) * wstep] = c[q][0] + c[q][1];
    }
    *(GAS f32x4*)(F.out + (size_t)t * D + 256 * sl + 4 * lane) = (f32x4){bflo(b.xv.x), bfhi(b.xv.x), bflo(b.xv.y), bfhi(b.xv.y)} + *(const LAS f32x4*)(obuf + 4 * lane);
}
__device__ __forceinline__ void peer_up_pass_mfma(Frame& F, const PeerDeal& d) {
    const int lane = F.lane;
    const int N = d.ns * d.cnt; if (N <= 0) return;
    i32x4_t I0[4], I1[4]; PmBuf B0, B1;
    int t0, s0, t1, s1, t2, s2, t3, s3;
    pd_item(0, d, t0, s0); pd_idx(F, t0, lane, I0);
    pd_item(1, d, t1, s1); pd_idx(F, t1, lane, I1);
    pm_rows(F, t0, s0, lane, I0, B0);
#pragma unroll 1
    for (int n = 0; n < N; n += 2) {
        pd_item(n + 2, d, t2, s2); pd_idx(F, t2, lane, I0);
        __builtin_amdgcn_sched_barrier(0);
        pm_rows(F, t1, s1, lane, I1, B1);
        __builtin_amdgcn_sched_barrier(0);
        pm_compute(F, t0, s0, lane, B0);
        __builtin_amdgcn_sched_barrier(0);
        pd_item(n + 3, d, t3, s3); pd_idx(F, t3, lane, I1);
        __builtin_amdgcn_sched_barrier(0);
        pm_rows(F, t2, s2, lane, I0, B0);
        __builtin_amdgcn_sched_barrier(0);
        pm_compute(F, t1, s1, lane, B1);
        __builtin_amdgcn_sched_barrier(0);
        t0 = t2; s0 = s2; t1 = t3; s1 = s3;
    }
}
typedef _Float16 h2_t __attribute__((ext_vector_type(2)));
#define FP4H2(w, b) __builtin_bit_cast(h2_t, __builtin_amdgcn_cvt_scalef32_pk_f16_fp4((w), 1.0f, (b)))
__device__ __forceinline__ void pu_idx(Frame& F, int t, int lane, i32x4_t (&idv)[8], f32x4 (&cfv)[8]) {
    const GAS i32x4_t* ip = (const GAS i32x4_t*)(WSP(const int, WS_IDX) + (size_t)t * 128 + (lane >> 4) * 32); const GAS f32x4* cp = (const GAS f32x4*)(WSP(const float, WS_GATE) + (size_t)t * 128 + (lane >> 4) * 32);
#pragma unroll
    for (int a = 0; a < 8; ++a) { idv[a] = ip[a]; cfv[a] = cp[a]; }
}
template <int H> __device__ __forceinline__ void pu_rows(Frame& F, int sl, int lane, const i32x4_t (&idv)[8], u32x2_t (&rows)[16]) {
    const unsigned char* WU = F.ws + WS_W4U + (size_t)sl * SLICE_BYTES + (lane & 15) * 8;
#pragma unroll
    for (int i = 0; i < 16; ++i) rows[i] = *(const GAS u32x2_t*)(WU + (size_t)idv[4 * H + (i >> 2)][i & 3] * 128);
}
template <int H> __device__ __forceinline__ void pu_compute(const u32x2_t (&rows)[16], const f32x4 (&cfv)[8], h2_t (&acc)[8]) {
#pragma unroll
    for (int i = 0; i < 16; ++i) { const float c = cfv[4 * H + (i >> 2)][i & 3] * 256.0f; const h2_t cc = __builtin_bit_cast(h2_t, __builtin_amdgcn_cvt_pkrtz(c, c));
#pragma unroll
        for (int k = 0; k < 2; ++k) { const unsigned w = rows[i][k];
            acc[4 * k + 0] = FP4H2(w, 0) * cc + acc[4 * k + 0]; acc[4 * k + 1] = FP4H2(w, 1) * cc + acc[4 * k + 1]; acc[4 * k + 2] = FP4H2(w, 2) * cc + acc[4 * k + 2]; acc[4 * k + 3] = FP4H2(w, 3) * cc + acc[4 * k + 3]; } }
}
__device__ __forceinline__ void pu_finish(Frame& F, int t, int sl, int lane, h2_t (&acc)[8]) {
    const int eg = lane >> 4, q = lane & 15;
#pragma unroll
    for (int a = 0; a < 8; ++a) {
        acc[a] = acc[a] + __builtin_bit_cast(h2_t, __shfl_xor(__builtin_bit_cast(unsigned, acc[a]), 16)); acc[a] = acc[a] + __builtin_bit_cast(h2_t, __shfl_xor(__builtin_bit_cast(unsigned, acc[a]), 32)); }
    const h2_t o01 = eg == 0 ? acc[0] : eg == 1 ? acc[2] : eg == 2 ? acc[4] : acc[6], o23 = eg == 0 ? acc[1] : eg == 1 ? acc[3] : eg == 2 ? acc[5] : acc[7];
    GAS f32x4* op = (GAS f32x4*)(F.out + (size_t)t * D + 256 * sl + 16 * q + 4 * eg);
    f32x4 o; { const u32x2_t w = *(const GAS u32x2_t*)(WSP(const bf16, WS_X1B) + (size_t)t * D + 256 * sl + 16 * q + 4 * eg); o = (f32x4){bflo(w.x), bfhi(w.x), bflo(w.y), bfhi(w.y)}; }
    *op = (f32x4){o[0] + (float)o01.x * (1.0f / 256.0f), o[1] + (float)o01.y * (1.0f / 256.0f), o[2] + (float)o23.x * (1.0f / 256.0f), o[3] + (float)o23.y * (1.0f / 256.0f)};
#pragma unroll
    for (int a = 0; a < 8; ++a) acc[a] = (h2_t){(_Float16)0.f, (_Float16)0.f};
}
__device__ __forceinline__ void peer_up_pass(Frame& F, const PeerDeal& d) {
    const int lane = F.lane;
    const int N = d.ns * d.cnt; if (N <= 0) return;
    i32x4_t IA[8], IB[8]; f32x4 CA[8], CB[8]; u32x2_t Ra[16], Rb[16]; h2_t acc[8];
#pragma unroll
    for (int a = 0; a < 8; ++a) acc[a] = (h2_t){(_Float16)0.f, (_Float16)0.f};
    int ta, sa, tb, sb, tc, sc;
    pd_item(0, d, ta, sa); pu_idx(F, ta, lane, IA, CA);
    pd_item(1, d, tb, sb); pu_idx(F, tb, lane, IB, CB);
    pu_rows<0>(F, sa, lane, IA, Ra);
#pragma unroll 1
    for (int n = 0; n < N; n += 2) {
        pu_rows<1>(F, sa, lane, IA, Rb);
        pu_compute<0>(Ra, CA, acc);
        pu_rows<0>(F, sb, lane, IB, Ra);
        pu_compute<1>(Rb, CA, acc);
        pu_finish(F, ta, sa, lane, acc);
        pd_item(n + 2, d, tc, sc); pu_idx(F, tc, lane, IA, CA);
        if (n + 1 < N) {
            pu_rows<1>(F, sb, lane, IB, Rb);
            pu_compute<0>(Ra, CB, acc);
            pu_rows<0>(F, sc, lane, IA, Ra);
            pu_compute<1>(Rb, CB, acc);
            pu_finish(F, tb, sb, lane, acc);
        }
        pd_item(n + 3, d, tb, sb); pu_idx(F, tb, lane, IB, CB);
        ta = tc; sa = sc;
    }
}
struct Args { const float* in[15]; float* out; unsigned char* ws; int ph_lo, ph_hi, pad0, pad1; };
__global__ void __launch_bounds__(NWAVES * 64, 2) skel_fwd(Args args) {
    extern __shared__ __attribute__((aligned(16))) unsigned char lds[];
    Frame F;
    F.lds = (LAS unsigned char*)lds;
    F.MISC = (volatile LAS unsigned*)(F.lds + MISC_OFF);
    F.tid = threadIdx.x; F.lane = F.tid & 63; F.wave = __builtin_amdgcn_readfirstlane(F.tid >> 6);
    F.G = gridDim.x; { const int bx = blockIdx.x; F.vcu = (F.G % 8 == 0) ? (bx % 8) * (F.G / 8) + bx / 8 : bx; }
    F.ws = args.ws; F.ctl = (gu32*)(args.ws + WS_CTL);
    F.x = args.in[0]; F.g1 = args.in[1]; F.w_in = args.in[2]; F.gq = args.in[3]; F.gk = args.in[4]; F.sink = args.in[5]; F.conv_w = args.in[6]; F.w_oa = args.in[7];
    F.w_oc = args.in[8]; F.w_out = args.in[9]; F.g2 = args.in[10]; F.w_qp = args.in[11]; F.subk = args.in[12]; F.w_down = args.in[13]; F.w_up = args.in[14]; F.out = args.out;
    for (int u = F.tid; u < (LDS_BYTES - LDSCTL_OFF) / 4; u += NWAVES * 64) ((LAS unsigned*)(F.lds + LDSCTL_OFF))[u] = 0u;
    __syncthreads();
    XcdBarrier bar; bar.bar = (unsigned*)(F.ctl + CW_BAR); bar.x = 0; bar.st = nullptr;
    if (MK_ONE_LAUNCH) bar = xcd_barrier_post((unsigned*)(F.ctl + CW_BAR), F.MISC + 8);
    if (MK_ONE_LAUNCH && F.tid == 0) { const unsigned xcc = xb_xcc_id(); F.MISC[10] = xcc; F.MISC[11] = __hip_atomic_fetch_add((unsigned*)(F.ctl + CW_XRANK) + 64 * xcc, 1u, RLX_AGENT); }
    if (F.wave == 0) { const bool ok = tr4_selfcheck(F.lds + RING_OFF, F.lane); if (F.lane == 0) F.MISC[15] = ok ? 1u : 0u; }
    __syncthreads();
    const bool tr4_ok = F.MISC[15] != 0u;
    const int lo = args.ph_lo, hi = args.ph_hi;
#ifndef PHASE_MASK
#define PHASE_MASK 0xfff
#endif
#define IN(k) (((PHASE_MASK >> (k)) & 1) && lo <= (k) && (k) < hi)
#ifndef DUP_MASK
#define DUP_MASK 0
#endif
#define REP(k) _Pragma("unroll") for (int rep_ = 0; rep_ < 1 + ((DUP_MASK >> (k)) & 1); ++rep_)
#define SEAM(k) do { if (MK_ONE_LAUNCH && IN(k) && IN((k) + 1)) xcd_barrier(bar); } while (0)
    const int gw = F.vcu * NWAVES + F.wave, NGW = F.G * NWAVES;

    if (IN(0)) REP(0) { p0_prologue(F); } SEAM(0);

    if (IN(1)) REP(1) { quant_w8(F); } SEAM(1);

    if (IN(2)) REP(2) {
        bf16* const pQ = WSP(bf16, WS_Q); bf16* const pK = WSP(bf16, WS_K); bf16* const pV = WSP(bf16, WS_V); bf16* const pH = WSP(bf16, WS_H); bf16* const pB = WSP(bf16, WS_B); bf16* const pC = WSP(bf16, WS_C);
        bf16* const pGA = WSP(bf16, WS_GA); bf16* const pGC = WSP(bf16, WS_GC);
        {   pg8::Gemm g{(const bf16*)(F.ws + WS_XN8), (const bf16*)(F.ws + WS_W8), M, INW, D / 2};
            pg8::RangeOrder S; S.so.init(M, I8_TILES * 256, F.G, (int)blockIdx.x); S.base = 0; S.cut = I8_CUT; S.skip = I8_SKIP;
            pg8::EpiProj<true> E{pQ, pK, pV, pH, pB, pC, pGA, pGC, WSP(const float, WS_SX), WSP(const float, WS_SW)};
            pg8::gemm_phase<pg8::EpiProj<true>, pg8::RangeOrder, PG8_ALIGN, PG8_SP2, true>(F.lds + RING_OFF, g, S, E); }
        {   pg8::Gemm g{WSP(const bf16, WS_XN), WSP(const bf16, WS_WIN), M, INW, D};
            pg8::RangeOrder S; S.so.init(M, BF_TILES * 256, F.G, (int)blockIdx.x); S.base = BF_BASE; S.cut = 68; S.skip = 0;
            pg8::EpiProj<false> E{pQ, pK, pV, pH, pB, pC, pGA, pGC, nullptr, nullptr};
            pg8::gemm_phase<pg8::EpiProj<false>, pg8::RangeOrder, PG8_ALIGN, PG8_SP2, false>(F.lds + RING_OFF, g, S, E); }
    } SEAM(2);

    if (IN(3)) REP(3) {
        attn_phase(F);
#ifdef ATTN_PROBE
        for (int U = F.vcu * 4; U < BATCH * 32 * NKV * 2; U += F.G * 4)
            for (int i = 0; i < 4; ++i) attn_unit<ATTN_PROBE>(F, U + i);
#endif
        conv_phase(F);
#ifdef CONV_DUP
        conv_phase(F);
#endif
        if (DUP_MASK) __syncthreads();
    } SEAM(3);

    if (IN(4)) REP(4) {
        pg8::Gemm g{WSP(const bf16, WS_AB), WSP(const bf16, WS_WO), 2 * M, 2 * D, QW}; pg8::PairOrder S; S.so.init(M, D, F.G, (int)blockIdx.x);
        pg8::EpiMerge E{WSP(const bf16, WS_GA), WSP(const bf16, WS_GC), WSP(bf16, WS_T), WSP(bf16, WS_XN)};
        pg8::gemm_phase<pg8::EpiMerge, pg8::PairOrder, PG8_ALIGN, PG8_SP2>(F.lds + RING_OFF, g, S, E);
    } SEAM(4);

    if (IN(5)) REP(5) {
        pg8::Gemm g{WSP(const bf16, WS_XN), WSP(const bf16, WS_WOUT), M, D, D}; pg8::StaticOrder S; S.init(M, D, F.G, (int)blockIdx.x);
        pg8::EpiRes E{F.x, WSP(bf16, WS_X1B)};
        pg8::gemm_phase<pg8::EpiRes, pg8::StaticOrder, PG8_ALIGN, PG8_SP2>(F.lds + RING_OFF, g, S, E);
    } SEAM(5);

    if (IN(6)) REP(6) {
        for (int m = gw; m < M; m += NGW) rms2_row(WSP(const bf16, WS_X1B) + (size_t)m * D, F.g2, F.ws + WS_X2I8 + (size_t)m * D, WSP(float, WS_SX2) + m, F.ws + WS_X2N8 + (size_t)m * 256, F.lane);
    } SEAM(6);

    if (IN(7)) REP(7) {
        pg8::Gemm g{(const bf16*)(F.ws + WS_X2I8), (const bf16*)(F.ws + WS_W8QP), M, PQW, D / 2}; pg8::StaticOrder S; S.init(M, PQW, F.G, (int)blockIdx.x);
        pg8::EpiStoreI8 E{WSP(bf16, WS_QP), PQW, WSP(const float, WS_SX2), WSP(const float, WS_SWQ)};
        pg8::gemm_phase<pg8::EpiStoreI8, pg8::StaticOrder, PG8_ALIGN, PG8_SP2, true>(F.lds + RING_OFF, g, S, E);
    } SEAM(7);

    if (IN(8)) REP(8) {
        const int h = F.vcu & 7;
        { const bf16* SK = WSP(const bf16, WS_SK) + (size_t)h * (2 * NKEYS * 128);
#pragma unroll
          for (int i = 0; i < 8; ++i) { const int q = F.tid + 512 * i, row = q >> 4, ch = q & 15; *(LAS v4u*)(F.lds + RING_OFF + off_b(row, ch)) = *(const GAS v4u*)(SK + (size_t)row * 128 + ch * 8); } }
        __syncthreads();
        for (int tg = (F.vcu >> 3) * NWAVES + F.wave; tg < M / 16; tg += (F.G >> 3) * NWAVES) route_task(F, tg, h);
        if (DUP_MASK) __syncthreads();
    } SEAM(8);

    PeerDeal deal;
    if (IN(9) || IN(11)) {
        if (MK_ONE_LAUNCH) {
            if (F.tid == 0) { const unsigned xcc = F.MISC[10]; unsigned nloc = 0, ox = 0, nx = 0;
                for (unsigned j = 0; j < 16; ++j) { const unsigned c = __hip_atomic_load((unsigned*)(F.ctl + CW_XRANK) + 64 * j, RLX_AGENT); if (c) { ++nx; if (j < xcc) ++ox; } if (j == xcc) nloc = c; }
                F.MISC[12] = nloc; F.MISC[13] = ox; F.MISC[14] = nx; }
            __syncthreads();
            const int nloc = (int)F.MISC[12], rank = (int)F.MISC[11];
            deal.ox = (int)F.MISC[13]; deal.nx = (int)F.MISC[14]; deal.t0 = rank * NWAVES + F.wave; deal.stride = nloc * NWAVES;
        } else { const int nper = F.G >> 3; deal.ox = F.vcu / nper; deal.nx = 8; deal.t0 = (F.vcu % nper) * NWAVES + F.wave; deal.stride = nper * NWAVES; }
        deal.cnt = deal.t0 < M ? (M - deal.t0 + deal.stride - 1) / deal.stride : 0; deal.ns = deal.ox < 16 ? (16 - deal.ox + deal.nx - 1) / deal.nx : 0;
    }
    if (IN(9)) {
        peer_down_pass(F, deal);
    } SEAM(9);
    if (IN(10)) {
        for (int t = gw; t < M; t += NGW) peer_combine_token(F, t);
    } SEAM(10);
    if (IN(11)) {
        if (tr4_ok) peer_up_pass_mfma(F, deal); else peer_up_pass(F, deal);
    }
#undef IN
#undef SEAM
}

extern "C" void kernel_launch(void* const* d_in, const int* in_sizes, int n_in, void* d_out, int out_size, void* d_ws, size_t ws_size, hipStream_t stream) {
    static int grid = 0;
    if (grid == 0) {
        if (n_in != 15 || in_sizes[0] != M * D || out_size != M * D || ws_size < WS_END) { fprintf(stderr, "kernel_launch: built for 15 inputs, x and out of %d floats, >= %zu bytes of workspace; got n_in %d, in0 %d, out %d, ws %zu; nothing launched\n", M * D, (size_t)WS_END, n_in, n_in > 0 ? in_sizes[0] : -1, out_size, ws_size); grid = -1; return; }
        int dev = 0, cus = 0, per_cu = 0;
        if (hipGetDevice(&dev) != hipSuccess || hipDeviceGetAttribute(&cus, hipDeviceAttributeMultiprocessorCount, dev) != hipSuccess) { fprintf(stderr, "kernel_launch: hipGetDevice / hipDeviceGetAttribute failed; nothing launched\n"); grid = -1; return; }
        if (hipFuncSetAttribute((const void*)skel_fwd, hipFuncAttributeMaxDynamicSharedMemorySize, LDS_BYTES) != hipSuccess) { fprintf(stderr, "kernel_launch: hipFuncSetAttribute failed; nothing launched\n"); grid = -1; return; }
        if (hipOccupancyMaxActiveBlocksPerMultiprocessor(&per_cu, (const void*)skel_fwd, NWAVES * 64, LDS_BYTES) != hipSuccess || per_cu < 1)
            fprintf(stderr, "kernel_launch: note: the occupancy query reports %d workgroups per CU\n", per_cu);
        (void)hipGetLastError();
        grid = cus;
        if (grid % 8 != 0) { fprintf(stderr, "kernel_launch: %d CUs: this kernel deals work in groups of 8 workgroups; nothing launched\n", grid); grid = -1; return; }
    }
    if (grid < 0) return;
    if (hipMemsetAsync((char*)d_ws + WS_CTL, 0, CTL_ZERO_BYTES, stream) != hipSuccess) { fprintf(stderr, "kernel_launch: hipMemsetAsync of the control words failed; nothing launched\n"); return; }
    Args a{};
    for (int i = 0; i < 15; ++i) a.in[i] = (const float*)d_in[i];
    a.out = (float*)d_out; a.ws = (unsigned char*)d_ws;
#if MK_ONE_LAUNCH
    a.ph_lo = 0; a.ph_hi = N_PHASES;
    hipLaunchKernelGGL(skel_fwd, dim3(grid), dim3(NWAVES * 64), LDS_BYTES, stream, a);
    { const hipError_t le = hipPeekAtLastError(); if (le != hipSuccess) fprintf(stderr, "kernel_launch: launch failed: %s\n", hipGetErrorName(le)); }
#else
    for (int p = 0; p < N_PHASES; ++p) {
        a.ph_lo = p; a.ph_hi = p + 1;
        hipLaunchKernelGGL(skel_fwd, dim3(grid), dim3(NWAVES * 64), LDS_BYTES, stream, a);
        const hipError_t le = hipPeekAtLastError();
        if (le != hipSuccess) { fprintf(stderr, "kernel_launch: launch %d failed: %s\n", p, hipGetErrorName(le)); break; }
    }
#endif
}
```

```cpp
#include <hip/hip_runtime.h>
#include <cstdio>
#include <cstdint>
#include <cmath>
namespace pg8 {
#define PG8_LAS __attribute__((address_space(3)))
typedef unsigned short bf16_t;
typedef short bf16x8 __attribute__((ext_vector_type(8)));
typedef float f32x4 __attribute__((ext_vector_type(4)));
typedef unsigned u32x4 __attribute__((ext_vector_type(4)));
typedef int i32x4 __attribute__((ext_vector_type(4)));
constexpr int BM = 256, BK = 64, HALF = 128, HTB = HALF * BK * 2  , STAGE_BYTES = 8 * HTB, NXCD = 8, WGM = 8;

__host__ __device__ __forceinline__ int lds_byte(int r, int c) { const int st = (r >> 4) * 2 + (c >> 5), rr = r & 15, cc = c & 31, ob = rr * 64 + cc * 2; return st * 1024 + (ob ^ (((ob >> 9) & 1) << 5)); }
__host__ __device__ __forceinline__ void stage_rc(int b, int& R, int& C) { const int st = b / 1024, sb = b % 1024, swz = sb ^ (((sb >> 9) & 1) << 5); R = (st >> 1) * 16 + swz / 64; C = (st & 1) * 32 + (swz % 64) / 2; }
__host__ __device__ __forceinline__ int perm32(int rho) { const int n = rho >> 4, i = rho & 15; return 8 * (i >> 2) + 4 * n + (i & 3); }

struct Unit { int pm, pn; };
struct Gemm { const bf16_t* A; const bf16_t* Bt; int M, N, K; };

struct StaticOrder {
    int nM, nN, nwg, G, c;
    __host__ __device__ void init(int M, int N, int G_, int c_) { nM = M / BM; nN = N / BM; nwg = nM * nN; G = G_; c = c_; }
    __host__ __device__ bool next(int i, Unit& u) const {
        const long L = (long)i * G + c; if (L >= nwg) return false;
        int wgid = (int)L; { const int q = nwg / NXCD, r = nwg % NXCD, xcd = wgid % NXCD, off = wgid / NXCD; wgid = (xcd < r ? xcd * (q + 1) : r * (q + 1) + (xcd - r) * q) + off; }
        const int nig = WGM * nN, gid = wgid / nig, fm = gid * WGM, gsz = (nM - fm) < WGM ? (nM - fm) : WGM;
        u.pm = fm + ((wgid % nig) % gsz); u.pn = (wgid % nig) / gsz; return true;
    }
    __device__ __forceinline__ void a_ready(const Unit&) const {}
    __device__ __forceinline__ void done(const Unit&) const {}
};
__device__ __forceinline__ unsigned cvt_pk_bf16(float lo, float hi) { unsigned r; asm volatile("v_cvt_pk_bf16_f32 %0, %1, %2" : "=v"(r) : "v"(lo), "v"(hi)); return r; }
typedef unsigned u32x2 __attribute__((ext_vector_type(2)));
__device__ __forceinline__ float sigm(float v) { return __builtin_amdgcn_rcpf(1.0f + __builtin_amdgcn_exp2f(-1.4426950408889634f * v)); }
__device__ __forceinline__ u32x4 pack8(const f32x4 a, const f32x4 b) { u32x4 w; w.x = cvt_pk_bf16(a[0], a[1]); w.y = cvt_pk_bf16(a[2], a[3]); w.z = cvt_pk_bf16(b[0], b[1]); w.w = cvt_pk_bf16(b[2], b[3]); return w; }
__device__ __forceinline__ void unpack8(const u32x4 w, f32x4& a, f32x4& b) {
    a[0] = __uint_as_float(w.x << 16); a[1] = __uint_as_float(w.x & 0xffff0000u); a[2] = __uint_as_float(w.y << 16); a[3] = __uint_as_float(w.y & 0xffff0000u);
    b[0] = __uint_as_float(w.z << 16); b[1] = __uint_as_float(w.z & 0xffff0000u); b[2] = __uint_as_float(w.w << 16); b[3] = __uint_as_float(w.w & 0xffff0000u);
}
template <bool I8> struct EpiProj {
    static constexpr bool PERM = true, AFTER_DRAIN = false;
    bf16_t *Q, *K, *V, *H, *Bg, *Cg, *GA, *GC; const float *sx, *sw;
    __device__ __forceinline__ void operator()(const f32x4 (&acc)[2][2][4][2], const Unit& u, int wr, int wc, int fr, int fq) const {
        const int pn = u.pn; bf16_t* base; int ldc, ct; bool sg = false;
        if (pn < 8) { base = Q; ldc = 2048; ct = pn; } else if (pn < 10) { base = K; ldc = 512; ct = pn - 8; } else if (pn < 12) { base = V; ldc = 512; ct = pn - 10; }
        else if (pn < 20) { base = H; ldc = 2048; ct = pn - 12; } else if (pn < 28) { base = Bg; ldc = 2048; ct = pn - 20; } else if (pn < 36) { base = Cg; ldc = 2048; ct = pn - 28; }
        else if (pn < 52) { base = GA; ldc = 4096; ct = pn - 36; sg = true; } else { base = GC; ldc = 4096; ct = pn - 52; sg = true; }
        const int row0 = u.pm * BM + wr * 64 + fr, col0 = ct * BM + wc * 32 + 8 * fq;
        f32x4 cs[2][2];
        if constexpr (I8) {
#pragma unroll
            for (int bj = 0; bj < 2; ++bj)
#pragma unroll
                for (int n = 0; n < 2; ++n) cs[bj][n] = *(const f32x4*)(sw + pn * BM + bj * HALF + wc * 32 + 8 * fq + 4 * n);
        }
#pragma unroll
        for (int ai = 0; ai < 2; ++ai)
#pragma unroll
            for (int m = 0; m < 4; ++m) { const int row = row0 + ai * HALF + m * 16; bf16_t* rowp = base + (size_t)row * ldc + col0;
                float rs = 1.f; if constexpr (I8) rs = sx[row];
#pragma unroll
                for (int bj = 0; bj < 2; ++bj) { f32x4 v0 = acc[ai][bj][m][0], v1 = acc[ai][bj][m][1];
                    if constexpr (I8) { v0 = __builtin_convertvector(__builtin_bit_cast(i32x4, v0), f32x4) * (cs[bj][0] * rs); v1 = __builtin_convertvector(__builtin_bit_cast(i32x4, v1), f32x4) * (cs[bj][1] * rs); }
                    if (sg) {
#pragma unroll
                        for (int e = 0; e < 4; ++e) { v0[e] = sigm(v0[e]); v1[e] = sigm(v1[e]); } }
                    *(u32x4*)(rowp + bj * HALF) = pack8(v0, v1); } }
    }
};
struct EpiMerge {
    static constexpr bool PERM = true, AFTER_DRAIN = false;
    const bf16_t *GA, *GC; bf16_t *T, *Mg;
    __device__ __forceinline__ void operator()(const f32x4 (&acc)[2][2][4][2], const Unit& u, int wr, int wc, int fr, int fq) const {
        const int which = u.pm >> 6, pm = u.pm & 63, pn = u.pn & 15;
        const bf16_t* G = which ? GC : GA;
        const int row0 = pm * BM + wr * 64 + fr, col0 = pn * BM + wc * 32 + 8 * fq;
#pragma unroll
        for (int ai = 0; ai < 2; ++ai)
#pragma unroll
            for (int m = 0; m < 4; ++m) { const size_t off = (size_t)(row0 + ai * HALF + m * 16) * 4096 + col0;
#pragma unroll
                for (int bj = 0; bj < 2; ++bj) { const size_t o = off + bj * HALF; f32x4 g0, g1; unpack8(*(const u32x4*)(G + o), g0, g1);
                    f32x4 v0 = acc[ai][bj][m][0] * g0, v1 = acc[ai][bj][m][1] * g1;
                    if (which == 0) { *(u32x4*)(T + o) = pack8(v0, v1); }
                    else { f32x4 t0, t1; unpack8(*(const u32x4*)(T + o), t0, t1); *(u32x4*)(Mg + o) = pack8(v0 + t0, v1 + t1); } } }
    }
};
struct EpiRes {
    static constexpr bool PERM = true, AFTER_DRAIN = false;
    const float* X; bf16_t* O;
    __device__ __forceinline__ void operator()(const f32x4 (&acc)[2][2][4][2], const Unit& u, int wr, int wc, int fr, int fq) const {
        const int row0 = u.pm * BM + wr * 64 + fr, col0 = u.pn * BM + wc * 32 + 8 * fq;
#pragma unroll
        for (int ai = 0; ai < 2; ++ai)
#pragma unroll
            for (int m = 0; m < 4; ++m) { const size_t off = (size_t)(row0 + ai * HALF + m * 16) * 4096 + col0;
#pragma unroll
                for (int bj = 0; bj < 2; ++bj) { const size_t o = off + bj * HALF; const f32x4 x0 = *(const f32x4*)(X + o), x1 = *(const f32x4*)(X + o + 4);
                    *(u32x4*)(O + o) = pack8(x0 + acc[ai][bj][m][0], x1 + acc[ai][bj][m][1]); } }
    }
};
struct EpiResI8 {
    static constexpr bool PERM = true, AFTER_DRAIN = false;
    const float* X; bf16_t* O; const float *sx, *sw;
    __device__ __forceinline__ void operator()(const f32x4 (&acc)[2][2][4][2], const Unit& u, int wr, int wc, int fr, int fq) const {
        const int row0 = u.pm * BM + wr * 64 + fr, col0 = u.pn * BM + wc * 32 + 8 * fq;
        f32x4 cs[2][2];
#pragma unroll
        for (int bj = 0; bj < 2; ++bj)
#pragma unroll
            for (int n = 0; n < 2; ++n) cs[bj][n] = *(const f32x4*)(sw + col0 + bj * HALF + 4 * n);
#pragma unroll
        for (int ai = 0; ai < 2; ++ai)
#pragma unroll
            for (int m = 0; m < 4; ++m) { const int row = row0 + ai * HALF + m * 16; const size_t off = (size_t)row * 4096 + col0; const float rs = sx[row];
#pragma unroll
                for (int bj = 0; bj < 2; ++bj) { const size_t o = off + bj * HALF; const f32x4 x0 = *(const f32x4*)(X + o), x1 = *(const f32x4*)(X + o + 4);
                    *(u32x4*)(O + o) = pack8(x0 + __builtin_convertvector(__builtin_bit_cast(i32x4, acc[ai][bj][m][0]), f32x4) * (cs[bj][0] * rs), x1 + __builtin_convertvector(__builtin_bit_cast(i32x4, acc[ai][bj][m][1]), f32x4) * (cs[bj][1] * rs)); } }
    }
};
struct EpiStoreI8 {
    static constexpr bool PERM = true, AFTER_DRAIN = false;
    bf16_t* O; int ldc; const float *sx, *sw;
    __device__ __forceinline__ void operator()(const f32x4 (&acc)[2][2][4][2], const Unit& u, int wr, int wc, int fr, int fq) const {
        const int row0 = u.pm * BM + wr * 64 + fr, col0 = u.pn * BM + wc * 32 + 8 * fq;
        f32x4 cs[2][2];
#pragma unroll
        for (int bj = 0; bj < 2; ++bj)
#pragma unroll
            for (int n = 0; n < 2; ++n) cs[bj][n] = *(const f32x4*)(sw + col0 + bj * HALF + 4 * n);
#pragma unroll
        for (int ai = 0; ai < 2; ++ai)
#pragma unroll
            for (int m = 0; m < 4; ++m) { const int row = row0 + ai * HALF + m * 16; bf16_t* rowp = O + (size_t)row * ldc + col0; const float rs = sx[row];
#pragma unroll
                for (int bj = 0; bj < 2; ++bj) *(u32x4*)(rowp + bj * HALF) = pack8(__builtin_convertvector(__builtin_bit_cast(i32x4, acc[ai][bj][m][0]), f32x4) * (cs[bj][0] * rs), __builtin_convertvector(__builtin_bit_cast(i32x4, acc[ai][bj][m][1]), f32x4) * (cs[bj][1] * rs)); }
    }
};
struct EpiStore {
    static constexpr bool PERM = true, AFTER_DRAIN = false;
    bf16_t* O; int ldc;
    __device__ __forceinline__ void operator()(const f32x4 (&acc)[2][2][4][2], const Unit& u, int wr, int wc, int fr, int fq) const {
        const int row0 = u.pm * BM + wr * 64 + fr, col0 = u.pn * BM + wc * 32 + 8 * fq;
#pragma unroll
        for (int ai = 0; ai < 2; ++ai)
#pragma unroll
            for (int m = 0; m < 4; ++m) { bf16_t* rowp = O + (size_t)(row0 + ai * HALF + m * 16) * ldc + col0;
#pragma unroll
                for (int bj = 0; bj < 2; ++bj) *(u32x4*)(rowp + bj * HALF) = pack8(acc[ai][bj][m][0], acc[ai][bj][m][1]); }
    }
};
struct PairOrder {
    StaticOrder so;
    __device__ bool next(int i, Unit& u) const { Unit t; if (!so.next(i >> 1, t)) return false; const int w = i & 1; u.pm = t.pm + 64 * w; u.pn = t.pn + 16 * w; return true; }
    __device__ __forceinline__ void a_ready(const Unit&) const {}
    __device__ __forceinline__ void done(const Unit&) const {}
};
struct RangeOrder {
    StaticOrder so; int base, cut, skip;
    __device__ bool next(int i, Unit& u) const { if (!so.next(i, u)) return false; u.pn = base + (u.pn < cut ? u.pn : u.pn + skip); return true; }
    __device__ __forceinline__ void a_ready(const Unit&) const {}
    __device__ __forceinline__ void done(const Unit&) const {}
};
template <class Epi, class Sched, bool ALIGN_EPI = false, bool SP2 = false, bool I8 = false>
__device__ __forceinline__ void gemm_phase(PG8_LAS unsigned char* lds, const Gemm g, const Sched& S, const Epi& E) {
    const int tid = threadIdx.x, wid = __builtin_amdgcn_readfirstlane(tid >> 6), lane = tid & 63, wr = wid >> 2, wc = wid & 3, fr = lane & 15, fq = lane >> 4;
    const int K = g.K, nt = K / BK;
    unsigned voffA[2], voffB[2];
#pragma unroll
    for (int i = 0; i < 2; ++i) { int R, C; stage_rc(tid * 16 + i * 8192, R, C); const int Rb = Epi::PERM ? ((R & ~31) + perm32(R & 31)) : R;
        voffA[i] = (unsigned)(R * K + C) * 2u; voffB[i] = (unsigned)(Rb * K + C) * 2u; }
    const size_t kstep = (size_t)(BK * 2);
    const size_t hstep = (size_t)HALF * K * 2;
    const size_t tstep = 2 * hstep;
    const unsigned ldsw = (unsigned)wid * 1024u;
    const int aoff = lds_byte(wr * 64 + fr, fq * 8), boff = lds_byte(wc * 32 + fr, fq * 8);
#define PG8_SA(b, h) (((b) * 2 + (h)) * HTB)
#define PG8_SB(b, h) ((4 + (b) * 2 + (h)) * HTB)
#define PG8_STAGE(bufoff, gbase, voff) do { _Pragma("unroll") for (int _i = 0; _i < 2; ++_i) \
        __builtin_amdgcn_global_load_lds((const unsigned*)((const char*)(gbase) + (voff)[_i]), (PG8_LAS unsigned*)(lds + (bufoff) + ldsw + _i * 8192), 16, 0, 0); } while (0)
#define PG8_LDA(dst, b, h) do { _Pragma("unroll") for (int m = 0; m < 4; ++m) _Pragma("unroll") for (int k = 0; k < 2; ++k) dst[m][k] = *(const PG8_LAS bf16x8*)(lds + PG8_SA(b, h) + aoff + m * 2048 + k * 1024); } while (0)
#define PG8_LDB(dst, b, h) do { _Pragma("unroll") for (int n = 0; n < 2; ++n) _Pragma("unroll") for (int k = 0; k < 2; ++k) dst[n][k] = *(const PG8_LAS bf16x8*)(lds + PG8_SB(b, h) + boff + n * 2048 + k * 1024); } while (0)
#define PG8_MMA(ai, bj, At, Bt) do { __builtin_amdgcn_s_setprio(1); _Pragma("unroll") for (int m = 0; m < 4; ++m) _Pragma("unroll") for (int n = 0; n < 2; ++n) _Pragma("unroll") for (int k = 0; k < 2; ++k) \
        { if constexpr (I8) acc[ai][bj][m][n] = __builtin_bit_cast(f32x4, __builtin_amdgcn_mfma_i32_16x16x64_i8(__builtin_bit_cast(i32x4, Bt[n][k]), __builtin_bit_cast(i32x4, At[m][k]), __builtin_bit_cast(i32x4, acc[ai][bj][m][n]), 0, 0, 0)); \
          else acc[ai][bj][m][n] = __builtin_amdgcn_mfma_f32_16x16x32_bf16(Bt[n][k], At[m][k], acc[ai][bj][m][n], 0, 0, 0); } __builtin_amdgcn_s_setprio(0); } while (0)
#define PG8_WAIT_V(n) asm volatile("s_waitcnt vmcnt(" #n ")" ::: "memory")
#define PG8_WAIT_L(n) asm volatile("s_waitcnt lgkmcnt(" #n ")" ::: "memory")
#define PG8_BAR __builtin_amdgcn_s_barrier()
#define PG8_SCHED __builtin_amdgcn_sched_barrier(0)
    Unit cur, nxt; int ui = 0;
    if (!S.next(0, cur)) return;
    f32x4 acc[2][2][4][2];
#pragma unroll
    for (int a = 0; a < 2; ++a)
#pragma unroll
        for (int b = 0; b < 2; ++b)
#pragma unroll
            for (int m = 0; m < 4; ++m)
#pragma unroll
                for (int n = 0; n < 2; ++n) acc[a][b][m][n] = (f32x4){0.f, 0.f, 0.f, 0.f};
    bf16x8 At[4][2], B0[2][2], B1[2][2];
    const char* cA = (const char*)g.A + (size_t)cur.pm * tstep; const char* cB = (const char*)g.Bt + (size_t)cur.pn * tstep;
    S.a_ready(cur);
    if constexpr (SP2) {
        PG8_STAGE(PG8_SB(0, 0), cB, voffB); PG8_STAGE(PG8_SB(0, 1), cB + hstep, voffB); PG8_STAGE(PG8_SA(0, 0), cA, voffA); PG8_STAGE(PG8_SA(0, 1), cA + hstep, voffA);
        if (wr == 1) PG8_BAR;
        PG8_WAIT_V(2); PG8_BAR;
        PG8_STAGE(PG8_SB(1, 0), cB + kstep, voffB); PG8_STAGE(PG8_SA(1, 0), cA + kstep, voffA); PG8_STAGE(PG8_SB(1, 1), cB + hstep + kstep, voffB);
        PG8_WAIT_V(6); PG8_BAR;
    } else {
        PG8_STAGE(PG8_SB(0, 0), cB, voffB); PG8_STAGE(PG8_SA(0, 0), cA, voffA); PG8_STAGE(PG8_SB(0, 1), cB + hstep, voffB); PG8_STAGE(PG8_SA(0, 1), cA + hstep, voffA);
        if (wr == 1) PG8_BAR;
        PG8_WAIT_V(4); PG8_BAR;
        PG8_STAGE(PG8_SB(1, 0), cB + kstep, voffB); PG8_STAGE(PG8_SA(1, 0), cA + kstep, voffA); PG8_STAGE(PG8_SB(1, 1), cB + hstep + kstep, voffB);
        PG8_WAIT_V(6); PG8_BAR;
    }
    for (;;) {
        const bool has_next = S.next(ui + 1, nxt);
        const char* nA = has_next ? (const char*)g.A + (size_t)nxt.pm * tstep : cA; const char* nB = has_next ? (const char*)g.Bt + (size_t)nxt.pn * tstep : cB;
        for (int t = 0; t < nt; t += 2) {
            const bool last = (t == nt - 2);
            const char* a1 = cA + (size_t)(t + 1) * kstep;
            const char* a2 = last ? nA : cA + (size_t)(t + 2) * kstep; const char* b2 = last ? nB : cB + (size_t)(t + 2) * kstep;
            const char* a3 = a2 + kstep; const char* b3 = b2 + kstep;
            if (last && has_next) S.a_ready(nxt);
            if constexpr (SP2) {
            PG8_LDB(B0, 0, 0); PG8_LDB(B1, 0, 1); PG8_SCHED; PG8_LDA(At, 0, 0); PG8_STAGE(PG8_SA(1, 1), a1 + hstep, voffA);
            PG8_WAIT_V(8); PG8_WAIT_L(0); PG8_BAR; PG8_MMA(0, 0, At, B0); PG8_MMA(0, 1, At, B1); PG8_BAR; PG8_SCHED;
            PG8_LDA(At, 0, 1); PG8_STAGE(PG8_SB(0, 0), b2, voffB); PG8_STAGE(PG8_SB(0, 1), b2 + hstep, voffB); PG8_STAGE(PG8_SA(0, 0), a2, voffA);
            PG8_WAIT_V(8); PG8_WAIT_L(0); PG8_BAR; PG8_MMA(1, 0, At, B0); PG8_MMA(1, 1, At, B1); PG8_BAR; PG8_SCHED;
            PG8_LDB(B0, 1, 0); PG8_LDB(B1, 1, 1); PG8_SCHED; PG8_LDA(At, 1, 0); PG8_STAGE(PG8_SA(0, 1), a2 + hstep, voffA);
            PG8_WAIT_V(8); PG8_WAIT_L(0); PG8_BAR; PG8_MMA(0, 0, At, B0); PG8_MMA(0, 1, At, B1); PG8_BAR; PG8_SCHED;
            PG8_LDA(At, 1, 1); PG8_STAGE(PG8_SB(1, 0), b3, voffB); PG8_STAGE(PG8_SB(1, 1), b3 + hstep, voffB); PG8_STAGE(PG8_SA(1, 0), a3, voffA);
            PG8_WAIT_V(8); PG8_WAIT_L(0); PG8_BAR; PG8_MMA(1, 0, At, B0); PG8_MMA(1, 1, At, B1); PG8_BAR; PG8_SCHED;
            } else {
            PG8_LDB(B0, 0, 0); PG8_SCHED; PG8_LDA(At, 0, 0); PG8_STAGE(PG8_SA(1, 1), a1 + hstep, voffA);
            PG8_WAIT_L(8); PG8_BAR; PG8_WAIT_L(0); PG8_MMA(0, 0, At, B0); PG8_BAR; PG8_SCHED;
            PG8_LDB(B1, 0, 1); PG8_STAGE(PG8_SB(0, 0), b2, voffB);
            PG8_BAR; PG8_WAIT_L(0); PG8_MMA(0, 1, At, B1); PG8_BAR;
            PG8_LDA(At, 0, 1); PG8_STAGE(PG8_SA(0, 0), a2, voffA);
            PG8_BAR; PG8_WAIT_L(0); PG8_MMA(1, 0, At, B0); PG8_BAR; PG8_SCHED;
            PG8_STAGE(PG8_SB(0, 1), b2 + hstep, voffB);
            PG8_WAIT_V(6); PG8_BAR; PG8_MMA(1, 1, At, B1); PG8_BAR;
            PG8_LDB(B0, 1, 0); PG8_SCHED; PG8_LDA(At, 1, 0); PG8_STAGE(PG8_SA(0, 1), a2 + hstep, voffA);
            PG8_WAIT_L(8); PG8_BAR; PG8_WAIT_L(0); PG8_MMA(0, 0, At, B0); PG8_BAR; PG8_SCHED;
            PG8_LDB(B1, 1, 1); PG8_STAGE(PG8_SB(1, 0), b3, voffB);
            PG8_BAR; PG8_WAIT_L(0); PG8_MMA(0, 1, At, B1); PG8_BAR;
            PG8_LDA(At, 1, 1); PG8_STAGE(PG8_SA(1, 0), a3, voffA);
            PG8_BAR; PG8_WAIT_L(0); PG8_MMA(1, 0, At, B0); PG8_BAR; PG8_SCHED;
            PG8_STAGE(PG8_SB(1, 1), b3 + hstep, voffB);
            PG8_WAIT_V(6); PG8_BAR; PG8_MMA(1, 1, At, B1); PG8_BAR;
            }
        }
        if constexpr (ALIGN_EPI) { if (wr == 0) PG8_BAR; }
        if constexpr (!Epi::AFTER_DRAIN) { E(acc, cur, wr, wc, fr, fq); S.done(cur); }
        if (!has_next) break;
#pragma unroll
        for (int a = 0; a < 2; ++a)
#pragma unroll
            for (int b = 0; b < 2; ++b)
#pragma unroll
                for (int m = 0; m < 4; ++m)
#pragma unroll
                    for (int n = 0; n < 2; ++n) acc[a][b][m][n] = (f32x4){0.f, 0.f, 0.f, 0.f};
        cur = nxt; cA = nA; cB = nB; ++ui;
        if constexpr (ALIGN_EPI) { if (wr == 1) PG8_BAR; }
    }
    PG8_WAIT_V(0);
    if constexpr (!ALIGN_EPI) { if (wr == 0) PG8_BAR; }
    PG8_BAR;
    if constexpr (Epi::AFTER_DRAIN) { E.fused(acc, cur, wr, wc, fr, fq, lds, wid, lane); S.done(cur); }
#undef PG8_SA
#undef PG8_SB
#undef PG8_STAGE
#undef PG8_LDA
#undef PG8_LDB
#undef PG8_MMA
#undef PG8_WAIT_V
#undef PG8_WAIT_L
#undef PG8_BAR
#undef PG8_SCHED
}
}
#ifndef PG8_SP2
#define PG8_SP2 true
#endif
#ifndef PG8_ALIGN
#define PG8_ALIGN true
#endif
constexpr int NWAVES = 8;
#ifndef MK_ONE_LAUNCH
#define MK_ONE_LAUNCH 1
#endif
constexpr int N_PHASES = 12;
#ifndef NIBBLE_SWAP_DOWN
#define NIBBLE_SWAP_DOWN 0
#endif
#ifndef I8_CFG
#define I8_CFG 1
#endif
#ifndef P5_I8
#define P5_I8 1
#endif
#if I8_CFG == 0
constexpr int I8_TILES = 44, I8_CUT = 12, I8_SKIP = 24, BF_BASE = 12, BF_TILES = 24;
#elif I8_CFG == 1
constexpr int I8_TILES = 60, I8_CUT = 12, I8_SKIP = 8, BF_BASE = 12, BF_TILES = 8;
#else
constexpr int I8_TILES = 68, I8_CUT = 68, I8_SKIP = 0, BF_BASE = 12, BF_TILES = 0;
#endif

constexpr int BATCH = 4, SEQ = 4096, D = 4096, M = BATCH * SEQ;
constexpr int HD = 128, NH = 16, NKV = 4, QW = NH * HD, KVW = NKV * HD, CW = 2048, INW = 17408;
constexpr int PH = 8, NKEYS = 128, TOPK = 16, NEXP = NKEYS * NKEYS, PQW = PH * 2 * 128;
constexpr float EPS = 1e-6f;
constexpr size_t SLICE_BYTES = (size_t)NEXP * 128;
constexpr float LOG2E = 1.4426950408889634f;

constexpr size_t MiB = 1u << 20;
constexpr size_t WS_CTL = 0, CTL_ZERO_BYTES = 1 * MiB;
constexpr size_t WS_WIN = 2 * MiB;
constexpr size_t WS_WO = 138 * MiB;
constexpr size_t WS_WOUT = 170 * MiB;
constexpr size_t WS_WQP = 202 * MiB;
constexpr size_t WS_SK = 218 * MiB;
constexpr size_t WS_IDX = 220 * MiB, WS_GATE = 228 * MiB;
constexpr size_t WS_XN = 236 * MiB;
constexpr size_t WS_AB = 364 * MiB;
constexpr size_t WS_Q = 492 * MiB, WS_K = 556 * MiB, WS_V = 572 * MiB, WS_H = 588 * MiB, WS_B = 652 * MiB, WS_C = 716 * MiB;
constexpr size_t WS_GA = 780 * MiB, WS_GC = 908 * MiB;
constexpr size_t WS_T = 492 * MiB;
constexpr size_t WS_X1B = 620 * MiB;
constexpr size_t WS_X2N = 620 * MiB;
constexpr size_t WS_PART = 236 * MiB;
constexpr size_t WS_X2N8 = 492 * MiB;
constexpr size_t WS_CF4 = 780 * MiB;
constexpr size_t WS_QP = 780 * MiB;
constexpr size_t WS_W4D = 1036 * MiB, WS_W4U = 1068 * MiB;
constexpr size_t WS_SCD = 1100 * MiB, WS_SCU = WS_SCD + 65536;
constexpr size_t WS_SX = WS_SCD + 131072, WS_SW = WS_SCD + 262144;
constexpr size_t WS_XN8 = 364 * MiB;
constexpr size_t WS_W8 = 1101 * MiB;
constexpr size_t WS_W8QP = 1169 * MiB;
constexpr size_t WS_SWQ = WS_SCD + 393216, WS_SX2 = WS_SCD + 458752;
constexpr size_t WS_X2I8 = 364 * MiB;
constexpr size_t WS_W8OUT = 1177 * MiB;
constexpr size_t WS_SWO = WS_SCD + 524288, WS_SXM = WS_SCD + 589824;
constexpr size_t WS_MI8 = 364 * MiB;
constexpr size_t WS_END = 1193 * MiB;
static_assert(WS_T + (size_t)M * D * 2 <= WS_X2N && WS_X2N + (size_t)M * D * 2 <= WS_GA && WS_QP + (size_t)M * PQW * 2 <= WS_GC, "d_ws overlays");
static_assert(WS_WIN + (size_t)INW * D * 2 <= WS_WO && WS_C + (size_t)M * CW * 2 <= WS_GA && WS_GC + (size_t)M * D * 2 <= WS_END, "d_ws map");
constexpr int CW_XRANK = 8192;
constexpr int CW_BAR = 4096;

constexpr int RING_OFF = 0, RING_BYTES = 131072;
constexpr int LDSCTL_OFF = RING_BYTES, MISC_OFF = LDSCTL_OFF + 320;
constexpr int OBUF_OFF = 132096;
constexpr int ODUMP_OFF = OBUF_OFF + 8192;
constexpr int LDS_BYTES = 147456;
static_assert(MISC_OFF + 128 <= OBUF_OFF && ODUMP_OFF + 2048 <= LDS_BYTES, "LDS map");
#define GAS __attribute__((address_space(1)))
#define LAS __attribute__((address_space(3)))
typedef unsigned short bf16;
typedef unsigned v4u __attribute__((ext_vector_type(4)));
typedef float f32x4 __attribute__((ext_vector_type(4)));
typedef short bf16x8 __attribute__((ext_vector_type(8)));
typedef GAS unsigned gu32;
typedef GAS unsigned long long gu64;
#define RLX_AGENT __ATOMIC_RELAXED, __HIP_MEMORY_SCOPE_AGENT
#define LDS_WAIT() asm volatile("s_waitcnt lgkmcnt(0)" ::: "memory")
#define VM_WAIT() asm volatile("s_waitcnt vmcnt(0)" ::: "memory")
__device__ __forceinline__ unsigned long long rt() { return __builtin_amdgcn_s_memrealtime(); }
__device__ __forceinline__ unsigned f2bf(float f) { unsigned u = __builtin_bit_cast(unsigned, f); return (u + 0x7fffu + ((u >> 16) & 1u)) >> 16; }
__device__ __forceinline__ unsigned pk2(float lo, float hi) { return f2bf(lo) | (f2bf(hi) << 16); }

#define XB_TMO      128
#define XB_XCNT(j)  (256  + 64 * (j))
#define XB_XSUB(j)  (1280 + 64 * (j))
#define XB_XGEN(j)  (2304 + 64 * (j))
#define XB_TOP      3328
#define XB_TOPGEN   3392
#define XCD_BAR_WORDS 3456
#define XB_SPIN_CAP (1u << 18)

__device__ __forceinline__ unsigned xb_ld(unsigned* p)              { return __hip_atomic_load(p, __ATOMIC_RELAXED, __HIP_MEMORY_SCOPE_AGENT); }
__device__ __forceinline__ unsigned xb_add(unsigned* p, unsigned v) { return __hip_atomic_fetch_add(p, v, __ATOMIC_RELAXED, __HIP_MEMORY_SCOPE_AGENT); }
__device__ __forceinline__ unsigned xb_xcc_id() { return (unsigned)__builtin_amdgcn_s_getreg((3 << 11) | 20) & 0xFu; }
#define XB_SPIN(cond, bar) do { unsigned _sp = 0; while (cond) { __builtin_amdgcn_s_sleep(1); \
    if ((++_sp & 255u) == 0u) { if (xb_ld(&(bar)[XB_TMO])) break; if (_sp > XB_SPIN_CAP) { atomicAdd(&(bar)[XB_TMO], 1u); break; } } } } while (0)

struct XcdBarrier {
    unsigned* bar; unsigned x;
    volatile LAS unsigned* st;
};

__device__ __forceinline__ XcdBarrier xcd_barrier_post(unsigned* bar, volatile LAS unsigned* st) {
    XcdBarrier b; b.bar = bar; b.x = xb_xcc_id(); b.st = st;
    if (threadIdx.x == 0) (void)xb_add(&bar[XB_XCNT(b.x)], 1u);
    return b;
}
__device__ __forceinline__ void xcd_barrier_complete(unsigned* bar, unsigned x, unsigned& nloc, unsigned& nx) {
    const unsigned G = gridDim.x * gridDim.y * gridDim.z;
    unsigned sum, cnt, mine, sp = 0u;
    for (;;) {
        sum = 0u; cnt = 0u; mine = 0u;
#pragma unroll
        for (unsigned j = 0; j < 16; ++j) { const unsigned c = xb_ld(&bar[XB_XCNT(j)]); sum += c; cnt += (c > 0u) ? 1u : 0u; mine = (j == x) ? c : mine; }
        if (sum == G) break;
        __builtin_amdgcn_s_sleep(1);
        if ((++sp & 255u) == 0u) { if (xb_ld(&bar[XB_TMO])) break; if (sp > XB_SPIN_CAP) { atomicAdd(&bar[XB_TMO], 1u); break; } }
    }
    nloc = mine > 0u ? mine : 1u; nx = cnt > 0u ? cnt : 1u;
}

__device__ __forceinline__ void xcd_barrier(const XcdBarrier& b) {
    asm volatile("s_waitcnt vmcnt(0)" ::: "memory");
    __syncthreads();
    if (threadIdx.x == 0) {
        unsigned* bar = b.bar;
        __builtin_amdgcn_s_waitcnt(0);
        unsigned nloc = b.st[0], nx = b.st[1];
        if (nloc == 0u) { xcd_barrier_complete(bar, b.x, nloc, nx); b.st[0] = nloc; b.st[1] = nx; }
        const unsigned old = xb_add(&bar[XB_XSUB(b.x)], 1u);
        const unsigned gen = old / nloc;
        if (old + 1u == (gen + 1u) * nloc) {
            __builtin_amdgcn_fence(__ATOMIC_RELEASE, "agent");
            asm volatile("s_waitcnt vmcnt(0)" ::: "memory");
            const unsigned og = xb_add(&bar[XB_TOP], 1u);
            const unsigned tg = og / nx;
            if (og + 1u == (tg + 1u) * nx) xb_add(&bar[XB_TOPGEN], 1u);
            else XB_SPIN(xb_ld(&bar[XB_TOPGEN]) == tg, bar);
            __builtin_amdgcn_fence(__ATOMIC_ACQUIRE, "agent");
            xb_add(&bar[XB_XGEN(b.x)], 1u);
            asm volatile("s_waitcnt vmcnt(0)" ::: "memory");
        } else {
            XB_SPIN(xb_ld(&bar[XB_XGEN(b.x)]) == gen, bar);
            __builtin_amdgcn_fence(__ATOMIC_ACQUIRE, "agent");
            asm volatile("s_waitcnt vmcnt(0)" ::: "memory");
        }
    }
    __syncthreads();
}
typedef unsigned u32x2_t __attribute__((ext_vector_type(2)));
typedef short v4i16_t __attribute__((ext_vector_type(4)));
typedef unsigned long long u64;
typedef float f32x2_t __attribute__((ext_vector_type(2)));
typedef int i32x4_t __attribute__((ext_vector_type(4)));
struct Frame {
    LAS unsigned char* lds;
    volatile LAS unsigned* MISC;
    gu32* ctl;
    unsigned char* ws;
    int tid, lane, wave;
    int vcu, G;
    const float *x, *g1, *w_in, *gq, *gk, *sink, *conv_w, *w_oa, *w_oc, *w_out, *g2, *w_qp, *subk, *w_down, *w_up;
    float* out;
};
#define WSP(type, off) ((type*)(F.ws + (off)))
using pg8::cvt_pk_bf16; using pg8::pack8; using pg8::unpack8;

__device__ __forceinline__ float wave_sum(float v) {
#pragma unroll
    for (int o = 1; o < 64; o <<= 1) v += __shfl_xor(v, o);
    return v;
}
__device__ __forceinline__ float dot4(const f32x4 a, const f32x4 b) { return (a[0] * b[0] + a[1] * b[1]) + (a[2] * b[2] + a[3] * b[3]); }
__device__ __forceinline__ float bflo(unsigned w) { return __uint_as_float(w << 16); }
__device__ __forceinline__ float bfhi(unsigned w) { return __uint_as_float(w & 0xffff0000u); }

typedef int v2i32_t __attribute__((ext_vector_type(2)));
__device__ __forceinline__ bool tr4_selfcheck(LAS unsigned char* tp, int lane) {
    const int g = lane >> 4, j = lane & 15;
    unsigned lo = 0u, hi = 0u;
#pragma unroll
    for (int c = 0; c < 8; ++c) { lo |= (unsigned)((j * 5 + c * 3 + g + 1) & 15) << (4 * c); hi |= (unsigned)((j * 5 + (c + 8) * 3 + g + 1) & 15) << (4 * c); }
    *(LAS u32x2_t*)(tp + lane * 8) = (u32x2_t){lo, hi};
    LDS_WAIT(); asm volatile("" ::: "memory");
    const v2i32_t rv = __builtin_amdgcn_ds_read_tr4_b64_v2i32((LAS v2i32_t*)(tp + lane * 8));
    bool ok = true;
#pragma unroll
    for (int e = 0; e < 8; ++e) { ok = ok && ((((unsigned)rv.x >> (4 * e)) & 15u) == (unsigned)((e * 5 + j * 3 + g + 1) & 15)) && ((((unsigned)rv.y >> (4 * e)) & 15u) == (unsigned)(((e + 8) * 5 + j * 3 + g + 1) & 15)); }
    return __all(ok);
}

__device__ __forceinline__ void p0_transpose_item(const float* W, int K, int N, bf16* WT, int row_off, LAS float* scr, int item, int lane) {
    const int nblk = N / 32, kb = item / nblk, nb = item % nblk, k0 = 64 * kb, n0 = 32 * nb;
#pragma unroll 8
    for (int i = 0; i < 32; ++i) { const int kk = 2 * i + (lane >> 5); scr[kk * 33 + (lane & 31)] = W[(size_t)(k0 + kk) * N + n0 + (lane & 31)]; }
    LDS_WAIT(); asm volatile("" ::: "memory");
    const int c = lane & 7;
#pragma unroll
    for (int j = 0; j < 4; ++j) { const int n = (lane >> 3) + 8 * j; const LAS float* s = scr + (8 * c) * 33 + n;
        v4u o; o.x = cvt_pk_bf16(s[0 * 33], s[1 * 33]); o.y = cvt_pk_bf16(s[2 * 33], s[3 * 33]); o.z = cvt_pk_bf16(s[4 * 33], s[5 * 33]); o.w = cvt_pk_bf16(s[6 * 33], s[7 * 33]);
        *(GAS v4u*)(WT + (size_t)(row_off + n0 + n) * K + k0 + 8 * c) = o; }
    LDS_WAIT(); asm volatile("" ::: "memory");
}
template <int QMODE  > __device__ __forceinline__ void rms_row_to_bf16(const float* xrow, const float* g, bf16* orow, unsigned* q8row, float* sxp, int lane) {
    const GAS f32x4* xr = (const GAS f32x4*)xrow + lane; const GAS f32x4* gr = (const GAS f32x4*)g + lane;
    f32x4 v[16]; float s = 0.f;
#pragma unroll
    for (int j = 0; j < 16; ++j) { v[j] = xr[64 * j]; s += dot4(v[j], v[j]); }
    const float r = rsqrtf(wave_sum(s) * (1.f / D) + EPS);
    GAS u32x2_t* o8 = (GAS u32x2_t*)orow + lane; float am = 0.f;
#pragma unroll
    for (int j = 0; j < 16; ++j) { v[j] = v[j] * r * gr[64 * j]; u32x2_t w; w.x = cvt_pk_bf16(v[j][0], v[j][1]); w.y = cvt_pk_bf16(v[j][2], v[j][3]); o8[64 * j] = w;
        am = fmaxf(am, fmaxf(fmaxf(fabsf(v[j][0]), fabsf(v[j][1])), fmaxf(fabsf(v[j][2]), fabsf(v[j][3])))); }
    if constexpr (QMODE == 2) {
#pragma unroll
        for (int j = 0; j < 16; ++j) { int p = 0; p = __builtin_amdgcn_cvt_pk_fp8_f32(v[j][0], v[j][1], p, false); p = __builtin_amdgcn_cvt_pk_fp8_f32(v[j][2], v[j][3], p, true); ((GAS unsigned*)q8row)[64 * j + lane] = (unsigned)p; }
    }
    if constexpr (QMODE == 1) {
#pragma unroll
        for (int o = 1; o < 64; o <<= 1) am = fmaxf(am, __shfl_xor(am, o));
        const float qs = am > 0.f ? 127.0f / am : 0.f;
#pragma unroll
        for (int j = 0; j < 16; ++j) { const int q0 = (int)__builtin_rintf(v[j][0] * qs), q1 = (int)__builtin_rintf(v[j][1] * qs), q2 = (int)__builtin_rintf(v[j][2] * qs), q3 = (int)__builtin_rintf(v[j][3] * qs);
            ((GAS unsigned*)q8row)[64 * j + lane] = (unsigned)(q0 & 255) | ((unsigned)(q1 & 255) << 8) | ((unsigned)(q2 & 255) << 16) | ((unsigned)q3 << 24); }
        if (lane == 0) *sxp = am * (1.0f / 127.0f);
    }
}
__device__ __forceinline__ void rms2_row(const bf16* xrow, const float* g, unsigned char* q8row, float* sxp, unsigned char* x4row, int lane) {
    const GAS v4u* xr = (const GAS v4u*)xrow + lane; const GAS f32x4* gr = (const GAS f32x4*)g + 2 * lane;
    f32x4 v[8][2]; float s = 0.f;
#pragma unroll
    for (int j = 0; j < 8; ++j) { unpack8(xr[64 * j], v[j][0], v[j][1]); s += dot4(v[j][0], v[j][0]) + dot4(v[j][1], v[j][1]); }
    const float r = rsqrtf(wave_sum(s) * (1.f / D) + EPS);
    float am = 0.f;
#pragma unroll
    for (int j = 0; j < 8; ++j) { v[j][0] = v[j][0] * r * gr[128 * j]; v[j][1] = v[j][1] * r * gr[128 * j + 1];
#pragma unroll
        for (int e = 0; e < 4; ++e) am = fmaxf(am, fmaxf(fabsf(v[j][0][e]), fabsf(v[j][1][e]))); }
#pragma unroll
    for (int o = 1; o < 64; o <<= 1) am = fmaxf(am, __shfl_xor(am, o));
    const float qs = am > 0.f ? 127.0f / am : 0.f;
    if (lane == 0) *sxp = am * (1.0f / 127.0f);
#pragma unroll
    for (int j = 0; j < 8; ++j) {
        const f32x4 y0 = v[j][0], y1 = v[j][1];
        { u32x2_t w;
          w.x = (unsigned)((int)__builtin_rintf(y0[0] * qs) & 255) | ((unsigned)((int)__builtin_rintf(y0[1] * qs) & 255) << 8) | ((unsigned)((int)__builtin_rintf(y0[2] * qs) & 255) << 16) | ((unsigned)(int)__builtin_rintf(y0[3] * qs) << 24);
          w.y = (unsigned)((int)__builtin_rintf(y1[0] * qs) & 255) | ((unsigned)((int)__builtin_rintf(y1[1] * qs) & 255) << 8) | ((unsigned)((int)__builtin_rintf(y1[2] * qs) & 255) << 16) | ((unsigned)(int)__builtin_rintf(y1[3] * qs) << 24);
          ((GAS u32x2_t*)q8row)[64 * j + lane] = w; }
        unsigned hi = 0u, lo = 0u;
        hi = __builtin_amdgcn_cvt_scalef32_pk_fp4_f32(hi, y0[0], y0[1], 1.0f, 0); hi = __builtin_amdgcn_cvt_scalef32_pk_fp4_f32(hi, y0[2], y0[3], 1.0f, 1);
        hi = __builtin_amdgcn_cvt_scalef32_pk_fp4_f32(hi, y1[0], y1[1], 1.0f, 2); hi = __builtin_amdgcn_cvt_scalef32_pk_fp4_f32(hi, y1[2], y1[3], 1.0f, 3);
        const f32x2_t d0 = __builtin_amdgcn_cvt_scalef32_pk_f32_fp4(hi, 1.0f, 0), d1 = __builtin_amdgcn_cvt_scalef32_pk_f32_fp4(hi, 1.0f, 1), d2 = __builtin_amdgcn_cvt_scalef32_pk_f32_fp4(hi, 1.0f, 2), d3 = __builtin_amdgcn_cvt_scalef32_pk_f32_fp4(hi, 1.0f, 3);
        lo = __builtin_amdgcn_cvt_scalef32_pk_fp4_f32(lo, (y0[0] - d0.x) * 8.f, (y0[1] - d0.y) * 8.f, 1.0f, 0); lo = __builtin_amdgcn_cvt_scalef32_pk_fp4_f32(lo, (y0[2] - d1.x) * 8.f, (y0[3] - d1.y) * 8.f, 1.0f, 1);
        lo = __builtin_amdgcn_cvt_scalef32_pk_fp4_f32(lo, (y1[0] - d2.x) * 8.f, (y1[1] - d2.y) * 8.f, 1.0f, 2); lo = __builtin_amdgcn_cvt_scalef32_pk_fp4_f32(lo, (y1[2] - d3.x) * 8.f, (y1[3] - d3.y) * 8.f, 1.0f, 3);
        unsigned char* const xd = x4row + (size_t)(2 * j + (lane >> 5)) * ((size_t)M * 256) + (lane & 31) * 4;
        *(GAS unsigned*)xd = hi; *(GAS unsigned*)(xd + 128) = lo;
    }
}
__device__ __forceinline__ void quant_w8(Frame& F) {
    const int gw = F.vcu * NWAVES + F.wave, NGW = F.G * NWAVES, lane = F.lane;
    for (int nn = gw; nn < INW + PQW + (P5_I8 ? D : 0); nn += NGW) {
        const int seg = nn >= INW + PQW ? 2 : nn >= INW ? 1 : 0; const bool qp = seg != 0; const int n = seg == 2 ? nn - INW - PQW : seg == 1 ? nn - INW : nn;
        if (!qp && n >= BF_BASE * 256 && n < (BF_BASE + BF_TILES) * 256) continue;
        const GAS v4u* src = (const GAS v4u*)((seg == 2 ? WSP(const bf16, WS_WOUT) : seg == 1 ? WSP(const bf16, WS_WQP) : WSP(const bf16, WS_WIN)) + (size_t)n * D) + lane;
        f32x4 lo[8], hi[8]; float am = 0.f;
#pragma unroll
        for (int j = 0; j < 8; ++j) { unpack8(src[64 * j], lo[j], hi[j]);
            am = fmaxf(am, fmaxf(fmaxf(fmaxf(fabsf(lo[j][0]), fabsf(lo[j][1])), fmaxf(fabsf(lo[j][2]), fabsf(lo[j][3]))), fmaxf(fmaxf(fabsf(hi[j][0]), fabsf(hi[j][1])), fmaxf(fabsf(hi[j][2]), fabsf(hi[j][3]))))); }
#pragma unroll
        for (int o = 1; o < 64; o <<= 1) am = fmaxf(am, __shfl_xor(am, o));
        const float qs = am > 0.f ? 127.0f / am : 0.f;
        GAS u32x2_t* dst = (GAS u32x2_t*)(F.ws + (seg == 2 ? WS_W8OUT : seg == 1 ? WS_W8QP : WS_W8) + (size_t)n * D) + lane;
#pragma unroll
        for (int j = 0; j < 8; ++j) { u32x2_t w;
            w.x = (unsigned)((int)__builtin_rintf(lo[j][0] * qs) & 255) | ((unsigned)((int)__builtin_rintf(lo[j][1] * qs) & 255) << 8) | ((unsigned)((int)__builtin_rintf(lo[j][2] * qs) & 255) << 16) | ((unsigned)(int)__builtin_rintf(lo[j][3] * qs) << 24);
            w.y = (unsigned)((int)__builtin_rintf(hi[j][0] * qs) & 255) | ((unsigned)((int)__builtin_rintf(hi[j][1] * qs) & 255) << 8) | ((unsigned)((int)__builtin_rintf(hi[j][2] * qs) & 255) << 16) | ((unsigned)(int)__builtin_rintf(hi[j][3] * qs) << 24);
            dst[64 * j] = w; }
        if (lane == 0) (seg == 2 ? WSP(float, WS_SWO) : seg == 1 ? WSP(float, WS_SWQ) : WSP(float, WS_SW))[n] = am * (1.0f / 127.0f);
    }
}
__device__ __forceinline__ void quant_row_i8(const bf16* xrow, unsigned char* q8row, float* sxp, int lane) {
    const GAS v4u* xr = (const GAS v4u*)xrow + lane;
    v4u w[8]; f32x4 v[8][2]; float am = 0.f;
#pragma unroll
    for (int j = 0; j < 8; ++j) w[j] = xr[64 * j];
#pragma unroll
    for (int j = 0; j < 8; ++j) { unpack8(w[j], v[j][0], v[j][1]);
#pragma unroll
        for (int e = 0; e < 4; ++e) am = fmaxf(am, fmaxf(fabsf(v[j][0][e]), fabsf(v[j][1][e]))); }
#pragma unroll
    for (int o = 1; o < 64; o <<= 1) am = fmaxf(am, __shfl_xor(am, o));
    const float qs = am > 0.f ? 127.0f / am : 0.f;
    if (lane == 0) *sxp = am * (1.0f / 127.0f);
#pragma unroll
    for (int j = 0; j < 8; ++j) { const f32x4 y0 = v[j][0], y1 = v[j][1]; u32x2_t q;
        q.x = (unsigned)((int)__builtin_rintf(y0[0] * qs) & 255) | ((unsigned)((int)__builtin_rintf(y0[1] * qs) & 255) << 8) | ((unsigned)((int)__builtin_rintf(y0[2] * qs) & 255) << 16) | ((unsigned)(int)__builtin_rintf(y0[3] * qs) << 24);
        q.y = (unsigned)((int)__builtin_rintf(y1[0] * qs) & 255) | ((unsigned)((int)__builtin_rintf(y1[1] * qs) & 255) << 8) | ((unsigned)((int)__builtin_rintf(y1[2] * qs) & 255) << 16) | ((unsigned)(int)__builtin_rintf(y1[3] * qs) << 24);
        ((GAS u32x2_t*)q8row)[64 * j + lane] = q; }
}
__device__ __forceinline__ void p0_prologue(Frame& F) {
    LAS float* scr = (LAS float*)(F.lds + RING_OFF + F.wave * 16384);
    const int gw = F.vcu * NWAVES + F.wave, NGW = F.G * NWAVES;
    constexpr int I_IN = (D / 64) * (INW / 32), I_OA = (QW / 64) * (D / 32), I_OC = (CW / 64) * (D / 32), I_OUT = (D / 64) * (D / 32), I_QP = (D / 64) * (PQW / 32);
    constexpr int NITEMS = I_IN + I_OA + I_OC + I_OUT + I_QP;
    bf16* Win_t = WSP(bf16, WS_WIN); bf16* Wo_t = WSP(bf16, WS_WO); bf16* Wout_t = WSP(bf16, WS_WOUT); bf16* Wqp_t = WSP(bf16, WS_WQP);
    for (int it = gw; it < NITEMS; it += NGW) {
        int r = it;
        if (r < I_IN) { p0_transpose_item(F.w_in, D, INW, Win_t, 0, scr, r, F.lane); continue; } r -= I_IN;
        if (r < I_OA) { p0_transpose_item(F.w_oa, QW, D, Wo_t, 0, scr, r, F.lane); continue; } r -= I_OA;
        if (r < I_OC) { p0_transpose_item(F.w_oc, CW, D, Wo_t, D, scr, r, F.lane); continue; } r -= I_OC;
        if (r < I_OUT) { p0_transpose_item(F.w_out, D, D, Wout_t, 0, scr, r, F.lane); continue; } r -= I_OUT;
        p0_transpose_item(F.w_qp, D, PQW, Wqp_t, 0, scr, r, F.lane);
    }
    {
        bf16* SK = WSP(bf16, WS_SK); const int nth = F.G * NWAVES * 64, gt = gw * 64 + F.lane;
        for (int i = gt; i < PH * 2 * NKEYS * 128 / 4; i += nth) { const f32x4 v = ((const GAS f32x4*)F.subk)[i]; u32x2_t w; w.x = cvt_pk_bf16(v[0], v[1]); w.y = cvt_pk_bf16(v[2], v[3]); ((GAS u32x2_t*)SK)[i] = w; }
    }
    bf16* XN = WSP(bf16, WS_XN);
    for (int m = gw; m < M; m += NGW) rms_row_to_bf16<1>(F.x + (size_t)m * D, F.g1, XN + (size_t)m * D, (unsigned*)(F.ws + WS_XN8 + (size_t)m * D), WSP(float, WS_SX) + m, F.lane);
    for (int r = gw; r < 2 * NEXP; r += NGW) {
        const bool up = r >= NEXP; const int rr = up ? r - NEXP : r;
        const GAS f32x4* src = (const GAS f32x4*)((up ? F.w_up : F.w_down) + (size_t)rr * D) + 2 * F.lane;
        f32x4 v[16]; float am = 0.f;
#pragma unroll
        for (int i = 0; i < 8; ++i) { v[2 * i] = src[128 * i]; v[2 * i + 1] = src[128 * i + 1]; }
#pragma unroll
        for (int i = 0; i < 16; ++i) am = fmaxf(am, fmaxf(fmaxf(fabsf(v[i][0]), fabsf(v[i][1])), fmaxf(fabsf(v[i][2]), fabsf(v[i][3]))));
#pragma unroll
        for (int o = 1; o < 64; o <<= 1) am = fmaxf(am, __shfl_xor(am, o));
        const float sc = am > 0.f ? 6.0f / am : 1.0f;
        unsigned char* const dstb = F.ws + (up ? WS_W4U : WS_W4D) + (size_t)rr * 128 + (size_t)(F.lane >> 5) * SLICE_BYTES + (F.lane & 31) * 4;
#pragma unroll
        for (int i = 0; i < 8; ++i) { unsigned p = 0u;
            if (NIBBLE_SWAP_DOWN && !up) {
            p = __builtin_amdgcn_cvt_scalef32_pk_fp4_f32(p, v[2 * i][1] * sc, v[2 * i][0] * sc, 1.0f, 0); p = __builtin_amdgcn_cvt_scalef32_pk_fp4_f32(p, v[2 * i][3] * sc, v[2 * i][2] * sc, 1.0f, 1);
            p = __builtin_amdgcn_cvt_scalef32_pk_fp4_f32(p, v[2 * i + 1][1] * sc, v[2 * i + 1][0] * sc, 1.0f, 2); p = __builtin_amdgcn_cvt_scalef32_pk_fp4_f32(p, v[2 * i + 1][3] * sc, v[2 * i + 1][2] * sc, 1.0f, 3);
            } else {
            p = __builtin_amdgcn_cvt_scalef32_pk_fp4_f32(p, v[2 * i][0] * sc, v[2 * i][1] * sc, 1.0f, 0); p = __builtin_amdgcn_cvt_scalef32_pk_fp4_f32(p, v[2 * i][2] * sc, v[2 * i][3] * sc, 1.0f, 1);
            p = __builtin_amdgcn_cvt_scalef32_pk_fp4_f32(p, v[2 * i + 1][0] * sc, v[2 * i + 1][1] * sc, 1.0f, 2); p = __builtin_amdgcn_cvt_scalef32_pk_fp4_f32(p, v[2 * i + 1][2] * sc, v[2 * i + 1][3] * sc, 1.0f, 3);
            }
            *(GAS unsigned*)(dstb + (size_t)(2 * i) * SLICE_BYTES) = p; }
        if (F.lane == 0) WSP(float, up ? WS_SCU : WS_SCD)[rr] = am > 0.f ? am * (1.0f / 6.0f) : 1.0f;
    }
}

__device__ __forceinline__ unsigned off_b(unsigned row, unsigned ch) { return 256u * row + 16u * (ch ^ (((row & 3u) << 2) | ((row >> 2) & 3u))); }
__device__ __forceinline__ unsigned tr_addr16(unsigned lane, unsigned c, unsigned ks, unsigned t) {
    const unsigned g = lane >> 4, q = (lane & 15u) >> 2, p = lane & 3u;
    return off_b(32u * ks + 8u * g + 4u * t + q, 2u * c + (p >> 1)) + 8u * (p & 1u);
}
__device__ __forceinline__ v4i16_t tr_read(LAS unsigned char* p) { return __builtin_amdgcn_ds_read_tr16_b64_v4i16((LAS v4i16_t*)p); }
#define MFMA16(a, b, c) __builtin_amdgcn_mfma_f32_16x16x32_bf16((a), (b), (c), 0, 0, 0)

template <int PROBE> __device__ __forceinline__ void attn_unit(Frame& F, const int U) {
    const int lane = F.lane, wave = F.wave, c = lane & 15, hg = lane >> 4, tid = F.tid;
    const int hp = U & 1, kvh = (U >> 1) & 3, nblk = (U >> 3) & 31, b = U >> 8;
    const int hq = kvh * 4 + hp * 2 + (wave >> 2), i0 = (wave & 3) * 32;
    const size_t tok0 = (size_t)b * SEQ + (size_t)nblk * 128;
    const bf16* QB = WSP(const bf16, WS_Q); const bf16* KB = WSP(const bf16, WS_K); const bf16* VB = WSP(const bf16, WS_V); bf16* OB = PROBE ? WSP(bf16, WS_XN) : WSP(bf16, WS_AB);
    bf16x8 qf[2][4];
    {
        float g[4][8];
#pragma unroll
        for (int ks = 0; ks < 4; ++ks) { const f32x4 a = *(const GAS f32x4*)(F.gq + 32 * ks + 8 * hg), bb = *(const GAS f32x4*)(F.gq + 32 * ks + 8 * hg + 4);
#pragma unroll
            for (int e = 0; e < 4; ++e) { g[ks][e] = a[e]; g[ks][4 + e] = bb[e]; } }
#pragma unroll
        for (int qt = 0; qt < 2; ++qt) {
            const bf16* qrow = QB + (tok0 + i0 + 16 * qt + c) * QW + hq * HD + 8 * hg;
            f32x4 lo[4], hi[4]; float ss = 0.f;
#pragma unroll
            for (int ks = 0; ks < 4; ++ks) { unpack8(*(const GAS v4u*)(qrow + 32 * ks), lo[ks], hi[ks]); ss += dot4(lo[ks], lo[ks]) + dot4(hi[ks], hi[ks]); }
            ss += __shfl_xor(ss, 16); ss += __shfl_xor(ss, 32);
            const float r = rsqrtf(ss * (1.f / HD) + EPS) * (0.08838834764831845f * LOG2E);
#pragma unroll
            for (int ks = 0; ks < 4; ++ks) { f32x4 a, bb;
#pragma unroll
                for (int e = 0; e < 4; ++e) { a[e] = lo[ks][e] * r * g[ks][e]; bb[e] = hi[ks][e] * r * g[ks][4 + e]; }
                qf[qt][ks] = __builtin_bit_cast(bf16x8, pack8(a, bb)); }
        }
    }
    const float slope2 = __builtin_amdgcn_exp2f(-0.5f * (float)(hq + 1)) * LOG2E;
    const float sink2 = F.sink[hq] * LOG2E;
    float mrun[2] = {sink2, sink2}, lrun[2]; lrun[0] = lrun[1] = (hg == 0) ? 1.f : 0.f;
    f32x4 acc[8][2];
#pragma unroll
    for (int dt = 0; dt < 8; ++dt) { acc[dt][0] = (f32x4){0.f, 0.f, 0.f, 0.f}; acc[dt][1] = (f32x4){0.f, 0.f, 0.f, 0.f}; }
    const f32x4 gk0 = *(const GAS f32x4*)(F.gk + (tid & 15) * 8), gk1 = *(const GAS f32x4*)(F.gk + (tid & 15) * 8 + 4);
    __syncthreads();
    int bufi = 0;
#pragma unroll 1
    for (int kbi = -1; kbi <= 1; ++kbi) {
        const int kb = nblk + kbi; if (kb < 0 || kb >= SEQ / 128) continue;
        LAS unsigned char* Kl = F.lds + RING_OFF + bufi * 65536; LAS unsigned char* Vl = Kl + 32768; bufi ^= 1;
#pragma unroll
        for (int it = 0; it < (PROBE == 3 ? 0 : 4); ++it) {
            const int row = (tid >> 4) + 32 * it, ch = tid & 15;
            const size_t src = ((size_t)b * SEQ + (size_t)kb * 128 + row) * KVW + kvh * HD + ch * 8;
            f32x4 k0, k1; unpack8(*(const GAS v4u*)(KB + src), k0, k1);
            float ss = dot4(k0, k0) + dot4(k1, k1);
            ss += __shfl_xor(ss, 1); ss += __shfl_xor(ss, 2); ss += __shfl_xor(ss, 4); ss += __shfl_xor(ss, 8);
            const float r = rsqrtf(ss * (1.f / HD) + EPS);
            *(LAS v4u*)(Kl + off_b(row, ch)) = pack8(k0 * r * gk0, k1 * r * gk1);
            *(LAS v4u*)(Vl + off_b(row, ch)) = *(const GAS v4u*)(VB + src);
        }
        __syncthreads();
        const int ks_lo = kbi < 0 ? (i0 >> 5) : 0, ks_hi = kbi > 0 ? (i0 >> 5) + 1 : 4;
#pragma unroll 2
        for (int ks32 = (PROBE == 2 ? ks_hi : ks_lo); ks32 < ks_hi; ++ks32) {
            f32x4 sa[2], sb[2];
            sa[0] = sa[1] = sb[0] = sb[1] = (f32x4){0.f, 0.f, 0.f, 0.f};
            const unsigned krow = 32u * ks32 + 8u * (c >> 2) + (c & 3);
#pragma unroll
            for (int ks = 0; ks < 4; ++ks) {
                const bf16x8 ka = *(const LAS bf16x8*)(Kl + off_b(krow, 4 * ks + hg)), kb2 = *(const LAS bf16x8*)(Kl + off_b(krow + 4, 4 * ks + hg));
#pragma unroll
                for (int qt = 0; qt < 2; ++qt) { sa[qt] = MFMA16(ka, qf[qt][ks], sa[qt]); sb[qt] = MFMA16(kb2, qf[qt][ks], sb[qt]); }
            }
            bf16x8 pf[2];
#pragma unroll
            for (int qt = 0; qt < 2; ++qt) {
                float s[8] = {sa[qt][0], sa[qt][1], sa[qt][2], sa[qt][3], sb[qt][0], sb[qt][1], sb[qt][2], sb[qt][3]};
                const int rel0 = kbi * 128 + 32 * ks32 + 8 * hg - (i0 + 16 * qt + c);
                float mx = -INFINITY;
#pragma unroll
                for (int j = 0; j < 8; ++j) { const int rel = rel0 + j, dist = rel < 0 ? -rel : rel; const float sv = s[j] - slope2 * (float)dist; s[j] = (dist <= 128) ? sv : -INFINITY; mx = fmaxf(mx, s[j]); }
                mx = fmaxf(mx, __shfl_xor(mx, 16)); mx = fmaxf(mx, __shfl_xor(mx, 32));
                const float mn = fmaxf(mrun[qt], mx), alpha = __builtin_amdgcn_exp2f(mrun[qt] - mn); mrun[qt] = mn;
                float ps = 0.f;
#pragma unroll
                for (int j = 0; j < 8; ++j) { s[j] = __builtin_amdgcn_exp2f(s[j] - mn); ps += s[j]; }
                lrun[qt] = lrun[qt] * alpha + ps;
                pf[qt] = __builtin_bit_cast(bf16x8, pack8((f32x4){s[0], s[1], s[2], s[3]}, (f32x4){s[4], s[5], s[6], s[7]}));
#pragma unroll
                for (int dt = 0; dt < 8; ++dt) acc[dt][qt] = acc[dt][qt] * alpha;
            }
#pragma unroll
            for (int dt = 0; dt < 8; ++dt) {
                const v4i16_t vlo = tr_read(Vl + tr_addr16(lane, dt, ks32, 0)), vhi = tr_read(Vl + tr_addr16(lane, dt, ks32, 1));
                const bf16x8 vf = {vlo[0], vlo[1], vlo[2], vlo[3], vhi[0], vhi[1], vhi[2], vhi[3]};
#pragma unroll
                for (int qt = 0; qt < 2; ++qt) acc[dt][qt] = MFMA16(vf, pf[qt], acc[dt][qt]);
            }
        }
    }
#pragma unroll
    for (int qt = 0; qt < 2; ++qt) {
        float l = lrun[qt]; l += __shfl_xor(l, 16); l += __shfl_xor(l, 32);
        const float inv = 1.0f / l;
        bf16* orow = OB + (tok0 + i0 + 16 * qt + c) * QW + hq * HD + 4 * hg;
#pragma unroll
        for (int dt = 0; dt < 8; ++dt) { const f32x4 o = acc[dt][qt] * inv; u32x2_t w; w.x = cvt_pk_bf16(o[0], o[1]); w.y = cvt_pk_bf16(o[2], o[3]); *(GAS u32x2_t*)(orow + 16 * dt) = w; }
    }
}
__device__ __forceinline__ int attn_i0(int wave) { return ((wave & 4) ? 3 - (wave & 3) : (wave & 3)) * 32; }
__device__ __forceinline__ int attn_unit_of(const Frame& F, int un) { const int U = (F.vcu + (un >> 2) * F.G) * 4 + (un & 3); return U < BATCH * 32 * NKV * 2 ? U : -1; }
__device__ __forceinline__ bool attn_next(const Frame& F, int& un, int& kbi) {
    for (;;) {
        ++kbi; if (kbi > 1) { ++un; kbi = -1; }
        const int U = attn_unit_of(F, un); if (U < 0) return false;
        const int kb = ((U >> 3) & 31) + kbi; if (kb >= 0 && kb < SEQ / 128) return true;
    }
}
__device__ __forceinline__ void attn_kv_issue(Frame& F, int U, int kbi, LAS unsigned char* Kl) {
    const int lane = F.lane, kvh = (U >> 1) & 3, nblk = (U >> 3) & 31, b = U >> 8, kb = nblk + kbi;
    const bf16* KB = WSP(const bf16, WS_K); const bf16* VB = WSP(const bf16, WS_V);
    const size_t base = ((size_t)b * SEQ + (size_t)kb * 128) * KVW + kvh * HD;
    const unsigned sw = ((unsigned)(lane >> 4) << 2) | ((unsigned)F.wave & 3u), ch = ((unsigned)lane & 15u) ^ sw;
#pragma unroll
    for (int it = 0; it < 4; ++it) { const int blk = F.wave + 8 * it, row = 4 * blk + (lane >> 4); const size_t src = base + (size_t)row * KVW + ch * 8;
        __builtin_amdgcn_global_load_lds((const unsigned*)(KB + src), (LAS unsigned*)(Kl + blk * 1024), 16, 0, 0);
        __builtin_amdgcn_global_load_lds((const unsigned*)(VB + src), (LAS unsigned*)(Kl + 32768 + blk * 1024), 16, 0, 0); }
}
__device__ __forceinline__ void attn_k_norm(Frame& F, LAS unsigned char* Kl, const LAS float* gkl) {
    const int lane = F.lane;
    const unsigned sw = ((unsigned)(lane >> 4) << 2) | ((unsigned)F.wave & 3u), ch = ((unsigned)lane & 15u) ^ sw;
    const f32x4 gk0 = *(const LAS f32x4*)(gkl + ch * 8), gk1 = *(const LAS f32x4*)(gkl + ch * 8 + 4);
    v4u kr[4];
#pragma unroll
    for (int it = 0; it < 4; ++it) kr[it] = *(const LAS v4u*)(Kl + (F.wave + 8 * it) * 1024 + lane * 16);
#pragma unroll
    for (int it = 0; it < 4; ++it) {
        f32x4 k0, k1; unpack8(kr[it], k0, k1);
        float ss = dot4(k0, k0) + dot4(k1, k1);
        ss += __shfl_xor(ss, 1); ss += __shfl_xor(ss, 2); ss += __shfl_xor(ss, 4); ss += __shfl_xor(ss, 8);
        const float r = rsqrtf(ss * (1.f / HD) + EPS);
        *(LAS v4u*)(Kl + (F.wave + 8 * it) * 1024 + lane * 16) = pack8(k0 * r * gk0, k1 * r * gk1); }
}
__device__ __forceinline__ void attn_q_issue(Frame& F, int U, v4u (&qr)[2][4]) {
    const int lane = F.lane, wave = F.wave, c = lane & 15, hg = lane >> 4;
    const int hp = U & 1, kvh = (U >> 1) & 3, nblk = (U >> 3) & 31, b = U >> 8, hq = kvh * 4 + hp * 2 + (wave >> 2), i0 = attn_i0(wave);
    const size_t tok0 = (size_t)b * SEQ + (size_t)nblk * 128;
    const bf16* QB = WSP(const bf16, WS_Q);
#pragma unroll
    for (int qt = 0; qt < 2; ++qt) { const bf16* qrow = QB + (tok0 + i0 + 16 * qt + c) * QW + hq * HD + 8 * hg;
#pragma unroll
        for (int ks = 0; ks < 4; ++ks) qr[qt][ks] = *(const GAS v4u*)(qrow + 32 * ks); }
}
__device__ __forceinline__ void attn_block(Frame& F, const LAS unsigned char* Kl, int kbi, const bf16x8 (&qf)[2][4], float slope2, float (&mrun)[2], float (&lrun)[2], f32x4 (&acc)[8][2]) {
    const int lane = F.lane, c = lane & 15, hg = lane >> 4, i0 = attn_i0(F.wave);
    const LAS unsigned char* Vl = Kl + 32768;
    const int ks_lo = kbi < 0 ? (i0 >> 5) : 0, ks_hi = kbi > 0 ? (i0 >> 5) + 1 : 4;
#pragma unroll 1
    for (int ks32 = ks_lo; ks32 < ks_hi; ++ks32) {
        f32x4 sa[2], sb[2];
        sa[0] = sa[1] = sb[0] = sb[1] = (f32x4){0.f, 0.f, 0.f, 0.f};
        const unsigned krow = 32u * ks32 + 8u * (c >> 2) + (c & 3);
#pragma unroll
        for (int ks = 0; ks < 4; ++ks) {
            const bf16x8 ka = *(const LAS bf16x8*)(Kl + off_b(krow, 4 * ks + hg)), kb2 = *(const LAS bf16x8*)(Kl + off_b(krow + 4, 4 * ks + hg));
#pragma unroll
            for (int qt = 0; qt < 2; ++qt) { sa[qt] = MFMA16(ka, qf[qt][ks], sa[qt]); sb[qt] = MFMA16(kb2, qf[qt][ks], sb[qt]); }
        }
        bf16x8 pf[2];
#pragma unroll
        for (int qt = 0; qt < 2; ++qt) {
            float sv8[8] = {sa[qt][0], sa[qt][1], sa[qt][2], sa[qt][3], sb[qt][0], sb[qt][1], sb[qt][2], sb[qt][3]};
            const int rel0 = kbi * 128 + 32 * ks32 + 8 * hg - (i0 + 16 * qt + c);
            float mx = -INFINITY;
#pragma unroll
            for (int j = 0; j < 8; ++j) { const int rel = rel0 + j, dist = rel < 0 ? -rel : rel; const float sv = sv8[j] - slope2 * (float)dist; sv8[j] = (dist <= 128) ? sv : -INFINITY; mx = fmaxf(mx, sv8[j]); }
            mx = fmaxf(mx, __shfl_xor(mx, 16)); mx = fmaxf(mx, __shfl_xor(mx, 32));
            const float mn = fmaxf(mrun[qt], mx), alpha = __builtin_amdgcn_exp2f(mrun[qt] - mn); mrun[qt] = mn;
            float ps = 0.f;
#pragma unroll
            for (int j = 0; j < 8; ++j) { sv8[j] = __builtin_amdgcn_exp2f(sv8[j] - mn); ps += sv8[j]; }
            lrun[qt] = lrun[qt] * alpha + ps;
            pf[qt] = __builtin_bit_cast(bf16x8, pack8((f32x4){sv8[0], sv8[1], sv8[2], sv8[3]}, (f32x4){sv8[4], sv8[5], sv8[6], sv8[7]}));
#pragma unroll
            for (int dt = 0; dt < 8; ++dt) acc[dt][qt] = acc[dt][qt] * alpha;
        }
#pragma unroll
        for (int h = 0; h < 2; ++h) {
            v4i16_t vlo[4], vhi[4];
#pragma unroll
            for (int d = 0; d < 4; ++d) {
                asm volatile("ds_read_b64_tr_b16 %0, %1" : "=v"(vlo[d]) : "v"((unsigned)(size_t)Vl + tr_addr16(lane, 4 * h + d, ks32, 0)));
                asm volatile("ds_read_b64_tr_b16 %0, %1" : "=v"(vhi[d]) : "v"((unsigned)(size_t)Vl + tr_addr16(lane, 4 * h + d, ks32, 1))); }
            asm volatile("s_waitcnt lgkmcnt(0)" : "+v"(vlo[0]), "+v"(vhi[0]), "+v"(vlo[1]), "+v"(vhi[1]), "+v"(vlo[2]), "+v"(vhi[2]), "+v"(vlo[3]), "+v"(vhi[3]) :: "memory");
#pragma unroll
            for (int d = 0; d < 4; ++d) { const bf16x8 vf = {vlo[d][0], vlo[d][1], vlo[d][2], vlo[d][3], vhi[d][0], vhi[d][1], vhi[d][2], vhi[d][3]};
#pragma unroll
                for (int qt = 0; qt < 2; ++qt) acc[4 * h + d][qt] = MFMA16(vf, pf[qt], acc[4 * h + d][qt]); }
        }
    }
}
__device__ __forceinline__ void attn_phase(Frame& F) {
    const int lane = F.lane, wave = F.wave, c = lane & 15, hg = lane >> 4, tid = F.tid, i0 = attn_i0(wave);
    LAS float* gql = (LAS float*)(F.lds + OBUF_OFF);
    LAS float* gkl = gql + 128;
    if (tid < 128) gql[tid] = F.gq[tid]; else if (tid < 256) gql[tid] = F.gk[tid - 128]; else if (tid < 256 + NH) gql[tid] = F.sink[tid - 256];
    int un = 0, kbi = -2;
    if (!attn_next(F, un, kbi)) return;
    v4u qr[2][4];
    attn_q_issue(F, attn_unit_of(F, un), qr);
    attn_kv_issue(F, attn_unit_of(F, un), kbi, F.lds + RING_OFF);
    __syncthreads();
    asm volatile("s_waitcnt vmcnt(0)" ::: "memory");
    attn_k_norm(F, F.lds + RING_OFF, gkl);
    asm volatile("s_waitcnt lgkmcnt(0)" ::: "memory"); __builtin_amdgcn_s_barrier(); asm volatile("" ::: "memory");
    int bufi = 0; bool first = true;
    bf16x8 qf[2][4]; float slope2 = 0.f, mrun[2] = {0.f, 0.f}, lrun[2] = {0.f, 0.f}; f32x4 acc[8][2];
#pragma unroll 1
    for (;;) {
        const int U = attn_unit_of(F, un);
        int nun = un, nkbi = kbi; const bool has_next = attn_next(F, nun, nkbi);
        if (first) {
            const int hp = U & 1, kvh = (U >> 1) & 3, hq = kvh * 4 + hp * 2 + (wave >> 2);
#pragma unroll
            for (int qt = 0; qt < 2; ++qt) {
                f32x4 lo[4], hi[4]; float ss = 0.f;
#pragma unroll
                for (int ks = 0; ks < 4; ++ks) { unpack8(qr[qt][ks], lo[ks], hi[ks]); ss += dot4(lo[ks], lo[ks]) + dot4(hi[ks], hi[ks]); }
                ss += __shfl_xor(ss, 16); ss += __shfl_xor(ss, 32);
                const float r = rsqrtf(ss * (1.f / HD) + EPS) * (0.08838834764831845f * LOG2E);
#pragma unroll
                for (int ks = 0; ks < 4; ++ks) { const f32x4 ga = *(const LAS f32x4*)(gql + 32 * ks + 8 * hg), gb = *(const LAS f32x4*)(gql + 32 * ks + 8 * hg + 4);
                    qf[qt][ks] = __builtin_bit_cast(bf16x8, pack8(lo[ks] * r * ga, hi[ks] * r * gb)); }
            }
            slope2 = __builtin_amdgcn_exp2f(-0.5f * (float)(hq + 1)) * LOG2E;
            const float sink2 = gql[256 + hq] * LOG2E;
            mrun[0] = mrun[1] = sink2; lrun[0] = lrun[1] = (hg == 0) ? 1.f : 0.f;
#pragma unroll
            for (int dt = 0; dt < 8; ++dt) { acc[dt][0] = (f32x4){0.f, 0.f, 0.f, 0.f}; acc[dt][1] = (f32x4){0.f, 0.f, 0.f, 0.f}; }
        }
        __builtin_amdgcn_sched_barrier(0);
        attn_kv_issue(F, attn_unit_of(F, has_next ? nun : un), has_next ? nkbi : kbi, F.lds + RING_OFF + (bufi ^ 1) * 65536);
        const bool last = !has_next || nun != un;
        __builtin_amdgcn_sched_barrier(0);
        attn_block(F, F.lds + RING_OFF + bufi * 65536, kbi, qf, slope2, mrun, lrun, acc);
        __builtin_amdgcn_sched_barrier(0);
        if (last) {
            if (has_next) attn_q_issue(F, attn_unit_of(F, nun), qr);
            __builtin_amdgcn_sched_barrier(0);
            const int hp = U & 1, kvh = (U >> 1) & 3, nblk = (U >> 3) & 31, b = U >> 8, hq = kvh * 4 + hp * 2 + (wave >> 2);
            const size_t tok0 = (size_t)b * SEQ + (size_t)nblk * 128;
            bf16* OB = WSP(bf16, WS_AB);
#pragma unroll
            for (int qt = 0; qt < 2; ++qt) {
                float l = lrun[qt]; l += __shfl_xor(l, 16); l += __shfl_xor(l, 32);
                const float inv = 1.0f / l;
                bf16* orow = OB + (tok0 + i0 + 16 * qt + c) * QW + hq * HD + 4 * hg;
#pragma unroll
                for (int dt = 0; dt < 8; ++dt) { const f32x4 o = acc[dt][qt] * inv; u32x2_t w; w.x = cvt_pk_bf16(o[0], o[1]); w.y = cvt_pk_bf16(o[2], o[3]); *(GAS u32x2_t*)(orow + 16 * dt) = w; }
            }
        }
        if (!has_next) { asm volatile("s_waitcnt vmcnt(0)" ::: "memory"); break; }
        __builtin_amdgcn_sched_barrier(0);
        if (last) asm volatile("s_waitcnt vmcnt(24)" ::: "memory"); else asm volatile("s_waitcnt vmcnt(0)" ::: "memory");
        __builtin_amdgcn_sched_barrier(0);
        attn_k_norm(F, F.lds + RING_OFF + (bufi ^ 1) * 65536, gkl);
        asm volatile("s_waitcnt lgkmcnt(0)" ::: "memory"); __builtin_amdgcn_s_barrier(); asm volatile("" ::: "memory");
        bufi ^= 1; first = last; un = nun; kbi = nkbi;
    }
    __syncthreads();
}
constexpr int CONV_T = 8;
__device__ __forceinline__ void conv_phase(Frame& F) {
    const bf16* HB = WSP(const bf16, WS_H); const bf16* BB = WSP(const bf16, WS_B); const bf16* CB = WSP(const bf16, WS_C); bf16* OC = WSP(bf16, WS_AB) + (size_t)M * CW;
    const unsigned nitem = (unsigned)(M / CONV_T) * (CW / 8);
    for (unsigned e = (unsigned)F.vcu * 512u + (unsigned)F.tid; e < nitem; e += (unsigned)F.G * 512u) {
        const int t0 = (int)(e >> 8) * CONV_T, cc = (int)(e & 255u) * 8, tl0 = t0 & (SEQ - 1);
        const size_t o = (size_t)t0 * CW + cc;
        const bool has_prev = tl0 > 0, has_next = tl0 + CONV_T < SEQ;
        v4u hw[CONV_T + 2], cw[CONV_T + 2], bw[CONV_T];
        hw[0] = cw[0] = hw[CONV_T + 1] = cw[CONV_T + 1] = (v4u){0u, 0u, 0u, 0u};
        if (has_prev) { hw[0] = *(const GAS v4u*)(HB + o - CW); cw[0] = *(const GAS v4u*)(CB + o - CW); }
#pragma unroll
        for (int k = 0; k < CONV_T; ++k) { hw[k + 1] = *(const GAS v4u*)(HB + o + (size_t)k * CW); cw[k + 1] = *(const GAS v4u*)(CB + o + (size_t)k * CW); bw[k] = *(const GAS v4u*)(BB + o + (size_t)k * CW); }
        if (has_next) { hw[CONV_T + 1] = *(const GAS v4u*)(HB + o + (size_t)CONV_T * CW); cw[CONV_T + 1] = *(const GAS v4u*)(CB + o + (size_t)CONV_T * CW); }
        const GAS f32x4* w = (const GAS f32x4*)(F.conv_w + cc);
        const f32x4 w00 = w[0], w01 = w[1], w10 = w[CW / 4], w11 = w[CW / 4 + 1], w20 = w[2 * CW / 4], w21 = w[2 * CW / 4 + 1];
        f32x4 up0, up1, uc0, uc1;
        { f32x4 h0, h1, c0, c1; unpack8(hw[0], h0, h1); unpack8(cw[0], c0, c1); up0 = h0 * c0; up1 = h1 * c1; unpack8(hw[1], h0, h1); unpack8(cw[1], c0, c1); uc0 = h0 * c0; uc1 = h1 * c1; }
#pragma unroll
        for (int k = 0; k < CONV_T; ++k) {
            f32x4 h0, h1, c0, c1, b0, b1; unpack8(hw[k + 2], h0, h1); unpack8(cw[k + 2], c0, c1); unpack8(bw[k], b0, b1);
            const f32x4 un0 = h0 * c0, un1 = h1 * c1;
            const f32x4 y0 = w00 * up0 + w10 * uc0 + w20 * un0, y1 = w01 * up1 + w11 * uc1 + w21 * un1;
            *(GAS v4u*)(OC + o + (size_t)k * CW) = pack8(b0 * y0, b1 * y1);
            up0 = uc0; up1 = uc1; uc0 = un0; uc1 = un1;
        }
    }
}

__device__ __forceinline__ unsigned ordf(float f) { const unsigned u = __float_as_uint(f); return u ^ ((u >> 31) ? 0xFFFFFFFFu : 0x80000000u); }
__device__ __forceinline__ float unordf(unsigned k) { return __uint_as_float((k & 0x80000000u) ? (k ^ 0x80000000u) : ~k); }
__device__ __forceinline__ u64 shfl64_xor(u64 v, int m) { const unsigned lo = __shfl_xor((unsigned)v, m), hi = __shfl_xor((unsigned)(v >> 32), m); return ((u64)hi << 32) | lo; }
template <int N> __device__ __forceinline__ void bitonic_merge_desc(unsigned (&a)[N]) {
#pragma unroll
    for (int j = N >> 1; j > 0; j >>= 1)
#pragma unroll
        for (int i = 0; i < N; ++i) { const int l = i ^ j; if (l > i) { const unsigned hi = a[i] > a[l] ? a[i] : a[l], lo = a[i] > a[l] ? a[l] : a[i]; a[i] = hi; a[l] = lo; } }
}
template <int N> __device__ __forceinline__ void bitonic_sort_desc(unsigned (&a)[N]) {
#pragma unroll
    for (int k = 2; k <= N; k <<= 1)
#pragma unroll
        for (int j = k >> 1; j > 0; j >>= 1)
#pragma unroll
            for (int i = 0; i < N; ++i) { const int l = i ^ j; if (l > i) { const unsigned hi = a[i] > a[l] ? a[i] : a[l], lo = a[i] > a[l] ? a[l] : a[i]; const bool desc = ((i & k) == 0); a[i] = desc ? hi : lo; a[l] = desc ? lo : hi; } }
}
__device__ __forceinline__ void xlane_top16(unsigned (&t)[16], const int mask) {
    unsigned m[16];
#pragma unroll
    for (int i = 0; i < 16; ++i) { const unsigned p = __shfl_xor(t[15 - i], mask); m[i] = t[i] > p ? t[i] : p; }
    bitonic_merge_desc<16>(m);
#pragma unroll
    for (int i = 0; i < 16; ++i) t[i] = m[i];
}
struct Stair { int i[52], j[52]; };
constexpr Stair make_stair() { Stair s{}; int n = 0; for (int a = 0; a < 16; ++a) for (int b = 0; b < 16; ++b) if ((a + 1) * (b + 1) <= 16) { s.i[n] = a; s.j[n] = b; ++n; } for (; n < 52; ++n) { s.i[n] = -1; s.j[n] = -1; } return s; }
constexpr Stair STAIR = make_stair();
template <int P> __device__ __forceinline__ unsigned cand1(const float (&v1)[16], const float (&v2)[16]) {
    constexpr int i = STAIR.i[P], j = STAIR.j[P];
    if constexpr (i < 0) return 0u;
    else return (ordf(v1[i] + v2[j]) & ~255u) | (unsigned)(16 * i + j);
}
template <int S> __device__ __forceinline__ void cand_fill(unsigned (&ck)[16], const float (&v1)[16], const float (&v2)[16], int hg) {
    const unsigned k0 = cand1<4 * S + 0>(v1, v2), k1 = cand1<4 * S + 1>(v1, v2), k2 = cand1<4 * S + 2>(v1, v2), k3 = cand1<4 * S + 3>(v1, v2);
    ck[S] = hg == 0 ? k0 : hg == 1 ? k1 : hg == 2 ? k2 : k3;
    if constexpr (S + 1 < 13) cand_fill<S + 1>(ck, v1, v2, hg);
}
__device__ __forceinline__ void route_task(Frame& F, const int tg, const int h) {
    const int lane = F.lane, c = lane & 15, hg = lane >> 4;
    const int tok = tg * 16 + c;
    const bf16* QP = WSP(const bf16, WS_QP); LAS unsigned char* SKl = F.lds + RING_OFF;
    unsigned sel[2][16];
#pragma unroll
    for (int half = 0; half < 2; ++half) {
        bf16x8 bq[4];
#pragma unroll
        for (int ks = 0; ks < 4; ++ks) bq[ks] = *(const GAS bf16x8*)(QP + (size_t)tok * PQW + h * 256 + half * 128 + 32 * ks + 8 * hg);
        unsigned k[32];
#pragma unroll
        for (int tile = 0; tile < 8; ++tile) {
            f32x4 s = (f32x4){0.f, 0.f, 0.f, 0.f};
#pragma unroll
            for (int ks = 0; ks < 4; ++ks) { const bf16x8 a = *(const LAS bf16x8*)(SKl + off_b(half * 128 + 16 * tile + c, 4 * ks + hg)); s = MFMA16(a, bq[ks], s); }
#pragma unroll
            for (int r = 0; r < 4; ++r) k[tile * 4 + r] = (ordf(s[r]) & ~127u) | (unsigned)(16 * tile + 4 * hg + r);
            if (tile & 1) asm volatile("" ::: "memory");
        }
        bitonic_sort_desc<32>(k);
        unsigned t[16];
#pragma unroll
        for (int i = 0; i < 16; ++i) t[i] = k[i];
        xlane_top16(t, 16); xlane_top16(t, 32);
#pragma unroll
        for (int i = 0; i < 16; ++i) sel[half][i] = t[i];
        asm volatile("" ::: "memory");
    }
    float v1[16], v2[16]; unsigned n1[16], n2[16];
#pragma unroll
    for (int i = 0; i < 16; ++i) { v1[i] = unordf(sel[0][i] & ~127u); n1[i] = sel[0][i] & 127u; v2[i] = unordf(sel[1][i] & ~127u); n2[i] = sel[1][i] & 127u; }
    LAS unsigned char* scr = F.lds + RING_OFF + 65536 + F.wave * 4096 + c * 256;
    if (hg == 0) {
#pragma unroll
        for (int q4 = 0; q4 < 4; ++q4) { *(LAS f32x4*)(scr + 16 * q4) = (f32x4){v1[4 * q4], v1[4 * q4 + 1], v1[4 * q4 + 2], v1[4 * q4 + 3]}; *(LAS f32x4*)(scr + 64 + 16 * q4) = (f32x4){v2[4 * q4], v2[4 * q4 + 1], v2[4 * q4 + 2], v2[4 * q4 + 3]};
            *(LAS v4u*)(scr + 128 + 16 * q4) = (v4u){n1[4 * q4], n1[4 * q4 + 1], n1[4 * q4 + 2], n1[4 * q4 + 3]}; *(LAS v4u*)(scr + 192 + 16 * q4) = (v4u){n2[4 * q4], n2[4 * q4 + 1], n2[4 * q4 + 2], n2[4 * q4 + 3]}; } }
    unsigned ck[16];
    cand_fill<0>(ck, v1, v2, hg); ck[13] = ck[14] = ck[15] = 0u;
    bitonic_sort_desc<16>(ck);
    xlane_top16(ck, 16); xlane_top16(ck, 32);
    int oi[4]; float sc[4]; float mx = -INFINITY;
#pragma unroll
    for (int jj = 0; jj < 4; ++jj) {
        const unsigned w = hg == 0 ? ck[jj] : hg == 1 ? ck[4 + jj] : hg == 2 ? ck[8 + jj] : ck[12 + jj];
        const unsigned i4 = (w >> 2) & 0x3Cu, j4 = (w & 15u) << 2;
        sc[jj] = *(const LAS float*)(scr + i4) + *(const LAS float*)(scr + 64 + j4);
        oi[jj] = (int)(*(const LAS unsigned*)(scr + 128 + i4) * (unsigned)NKEYS + *(const LAS unsigned*)(scr + 192 + j4));
        mx = fmaxf(mx, sc[jj]);
    }
    mx = fmaxf(mx, __shfl_xor(mx, 16)); mx = fmaxf(mx, __shfl_xor(mx, 32));
    float ev[4], sum = 0.f;
#pragma unroll
    for (int jj = 0; jj < 4; ++jj) { ev[jj] = __builtin_amdgcn_exp2f((sc[jj] - mx) * LOG2E); sum += ev[jj]; }
    sum += __shfl_xor(sum, 16); sum += __shfl_xor(sum, 32);
    const float inv = 1.0f / sum;
    const size_t o = ((size_t)tok * PH + h) * TOPK + 4 * hg;
    *(GAS i32x4_t*)(WSP(int, WS_IDX) + o) = (i32x4_t){oi[0], oi[1], oi[2], oi[3]};
    *(GAS f32x4*)(WSP(float, WS_GATE) + o) = (f32x4){ev[0] * inv, ev[1] * inv, ev[2] * inv, ev[3] * inv};
}

__device__ __forceinline__ float gelu_erf(float v) { return 0.5f * v * (1.0f + erff(v * 0.70710678118654752f)); }
typedef int i32x8_t __attribute__((ext_vector_type(8)));
#define FP4X2(w, b) __builtin_amdgcn_cvt_scalef32_pk_f32_fp4((w), 1.0f, (b))
__device__ __forceinline__ void fmac(float& acc, float a, float b) { asm("v_fmac_f32 %0, %1, %2" : "+v"(acc) : "v"(a), "v"(b)); }
struct PeerDeal { int ox, nx, t0, stride, cnt, ns; };
__device__ __forceinline__ void pd_item(int n, const PeerDeal& d, int& t, int& sl) { const int N = d.ns * d.cnt, nn = n < N ? n : N - 1, j = nn / d.cnt; sl = d.ox + j * d.nx; t = d.t0 + (nn - j * d.cnt) * d.stride; }
__device__ __forceinline__ void pd_idx(Frame& F, int t, int lane, i32x4_t (&idv)[4]) {
    const GAS i32x4_t* ip = (const GAS i32x4_t*)(WSP(const int, WS_IDX) + (size_t)t * 128 + (lane >> 3) * 16);
#pragma unroll
    for (int a = 0; a < 4; ++a) idv[a] = ip[a];
}
__device__ __forceinline__ void pd_rows(Frame& F, int t, int sl, int lane, const i32x4_t (&idv)[4], v4u (&rows)[16], v4u (&xw)[2]) {
    const unsigned char* xr = F.ws + WS_X2N8 + ((size_t)sl * M + t) * 256 + 16 * (lane >> 4) + ((lane & 15) == 1 ? 128 : 0);
#pragma unroll
    for (int ks = 0; ks < 2; ++ks) xw[ks] = *(const GAS v4u*)(xr + 64 * ks);
    const unsigned char* WD = F.ws + WS_W4D + (size_t)sl * SLICE_BYTES;
    const unsigned lo16 = 16u * (unsigned)(lane & 7);
#pragma unroll
    for (int j = 0; j < 16; ++j) rows[j] = *(const GAS v4u*)(WD + (size_t)(((unsigned)idv[j >> 2][j & 3] << 7) + lo16));
}
__device__ __forceinline__ float dpp_swap1(float v) { return __builtin_bit_cast(float, __builtin_amdgcn_update_dpp(0, __builtin_bit_cast(int, v), 0xB1  , 0xF, 0xF, true)); }
__device__ __forceinline__ void pd_compute(Frame& F, int t, int sl, int lane, const v4u (&rows)[16], const v4u (&xw)[2]) {
    const int r = lane & 15, g = lane >> 4;
    LAS unsigned char* tile = F.lds + RING_OFF + F.wave * 16384;
    { LAS unsigned char* wp = tile + (lane >> 3) * 2048;
#pragma unroll
      for (int j = 0; j < 16; ++j) *(LAS v4u*)(wp + j * 128 + (((lane & 7) ^ ((j >> 1) & 7)) << 4)) = rows[j]; }
    float* pp = WSP(float, WS_PART) + ((size_t)sl * M + t) * 128 + 4 * g;
    const int scb = (r == 1) ? 0x7C7C7C7C   : 0x7F7F7F7F;
    i32x8_t xb[2];
#pragma unroll
    for (int ks = 0; ks < 2; ++ks) xb[ks] = (i32x8_t){(int)xw[ks].x, (int)xw[ks].y, (int)xw[ks].z, (int)xw[ks].w, 0, 0, 0, 0};
    const LAS unsigned char* rp = tile + r * 128; const int fr = (r >> 1) & 7;
    v4u a[8][2];
#pragma unroll
    for (int i = 0; i < 8; ++i)
#pragma unroll
        for (int ks = 0; ks < 2; ++ks) a[i][ks] = *(const LAS v4u*)(rp + i * 2048 + (((4 * ks + g) ^ fr) << 4));
    f32x4 c[8];
#pragma unroll
    for (int i = 0; i < 8; ++i) { const v4u w = a[i][0]; c[i] = __builtin_amdgcn_mfma_scale_f32_16x16x128_f8f6f4((i32x8_t){(int)w.x, (int)w.y, (int)w.z, (int)w.w, 0, 0, 0, 0}, xb[0], (f32x4){0.f, 0.f, 0.f, 0.f}, 4  , 4  , 0, 0x7F7F7F7F, 0, scb); }
#pragma unroll
    for (int i = 0; i < 8; ++i) { const v4u w = a[i][1]; c[i] = __builtin_amdgcn_mfma_scale_f32_16x16x128_f8f6f4((i32x8_t){(int)w.x, (int)w.y, (int)w.z, (int)w.w, 0, 0, 0, 0}, xb[1], c[i], 4, 4, 0, 0x7F7F7F7F, 0, scb); }
#pragma unroll
    for (int i = 0; i < 8; ++i)
#pragma unroll
        for (int e = 0; e < 4; ++e) c[i][e] += dpp_swap1(c[i][e]);
    if (r == 0) {
#pragma unroll
        for (int i = 0; i < 8; ++i) *(GAS f32x4*)(pp + 16 * i) = c[i]; }
}
__device__ __forceinline__ void peer_down_pass(Frame& F, const PeerDeal& d) {
    const int lane = F.lane;
    const int N = d.ns * d.cnt; if (N <= 0) return;
    i32x4_t I0[4], I1[4]; v4u R0[16], R1[16], X0[2], X1[2];
    int t0, s0, t1, s1, t2, s2, t3, s3;
    pd_item(0, d, t0, s0); pd_idx(F, t0, lane, I0);
    pd_item(1, d, t1, s1); pd_idx(F, t1, lane, I1);
    pd_rows(F, t0, s0, lane, I0, R0, X0);
#pragma unroll 1
    for (int n = 0; n < N; n += 2) {
        pd_item(n + 2, d, t2, s2); pd_idx(F, t2, lane, I0);
        __builtin_amdgcn_sched_barrier(0);
        pd_rows(F, t1, s1, lane, I1, R1, X1);
        __builtin_amdgcn_sched_barrier(0);
        pd_compute(F, t0, s0, lane, R0, X0);
        __builtin_amdgcn_sched_barrier(0);
        pd_item(n + 3, d, t3, s3); pd_idx(F, t3, lane, I1);
        __builtin_amdgcn_sched_barrier(0);
        pd_rows(F, t2, s2, lane, I0, R0, X0);
        __builtin_amdgcn_sched_barrier(0);
        pd_compute(F, t1, s1, lane, R1, X1);
        __builtin_amdgcn_sched_barrier(0);
        t0 = t2; s0 = s2; t1 = t3; s1 = s3;
    }
}
__device__ __forceinline__ void peer_combine_token(Frame& F, const int t) {
    const int lane = F.lane;
    const float* PART = WSP(const float, WS_PART) + (size_t)t * 128 + 2 * lane; float* GATEP = WSP(float, WS_GATE) + (size_t)t * 128 + 2 * lane;
    f32x2_t a = (f32x2_t){0.f, 0.f};
#pragma unroll
    for (int sl = 0; sl < 16; ++sl) a += *(const GAS f32x2_t*)(PART + (size_t)sl * M * 128);
    const int id0 = WSP(const int, WS_IDX)[(size_t)t * 128 + 2 * lane], id1 = WSP(const int, WS_IDX)[(size_t)t * 128 + 2 * lane + 1];
    const f32x2_t gt = *(const GAS f32x2_t*)GATEP;
    const float c0 = gt.x * gelu_erf(a.x * WSP(const float, WS_SCD)[id0]) * WSP(const float, WS_SCU)[id0], c1 = gt.y * gelu_erf(a.y * WSP(const float, WS_SCD)[id1]) * WSP(const float, WS_SCU)[id1];
    *(GAS f32x2_t*)GATEP = (f32x2_t){c0, c1};
    float bm = fmaxf(fabsf(c0), fabsf(c1));
    bm = fmaxf(bm, __shfl_xor(bm, 1)); bm = fmaxf(bm, __shfl_xor(bm, 2)); bm = fmaxf(bm, __shfl_xor(bm, 4)); bm = fmaxf(bm, __shfl_xor(bm, 8));
    int eb = (int)((__float_as_uint(bm) >> 23) & 255u) - 1;
    eb = eb < 3 ? 3 : eb > 250 ? 250 : eb;
    const float inv = __uint_as_float((unsigned)(254 - eb) << 23);
    const float s0 = c0 * inv, s1 = c1 * inv;
    const unsigned hi = __builtin_amdgcn_cvt_scalef32_pk_fp4_f32(0u, s0, s1, 1.0f, 0);
    const f32x2_t dq = __builtin_amdgcn_cvt_scalef32_pk_f32_fp4(hi, 1.0f, 0);
    const unsigned lo = __builtin_amdgcn_cvt_scalef32_pk_fp4_f32(0u, (s0 - dq.x) * 8.f, (s1 - dq.y) * 8.f, 1.0f, 0);
    unsigned char* cf4 = F.ws + WS_CF4 + (size_t)t * 160;
    ((GAS unsigned char*)cf4)[lane] = (unsigned char)hi; ((GAS unsigned char*)cf4)[64 + lane] = (unsigned char)lo;
    if ((lane & 15) == 0) ((GAS unsigned*)(cf4 + 128))[lane >> 4] = (unsigned)eb * 0x01010101u;
}
struct PmBuf { v4u rows[16]; v4u aw; unsigned e; u32x2_t xv; };
__device__ __forceinline__ void pm_rows(Frame& F, int t, int sl, int lane, const i32x4_t (&idv)[4], PmBuf& b) {
    const int n = lane & 15, g = lane >> 4;
    const unsigned char* WU = F.ws + WS_W4U + (size_t)sl * SLICE_BYTES;
    const unsigned lo16 = 16u * (unsigned)(lane & 7);
#pragma unroll
    for (int j = 0; j < 16; ++j) b.rows[j] = *(const GAS v4u*)(WU + (size_t)(((unsigned)idv[j >> 2][j & 3] << 7) + lo16));
    const unsigned char* cf4 = F.ws + WS_CF4 + (size_t)t * 160;
    b.aw = *(const GAS v4u*)(cf4 + 64 * (n & 1) + 16 * g); b.e = *(const GAS unsigned*)(cf4 + 128 + 4 * g);
    b.xv = *(const GAS u32x2_t*)(WSP(const bf16, WS_X1B) + (size_t)t * D + 256 * sl + 4 * lane);
}
__device__ __forceinline__ void pm_compute(Frame& F, int t, int sl, int lane, const PmBuf& b) {
    const int n = lane & 15, g = lane >> 4;
    LAS unsigned char* tile = F.lds + RING_OFF + F.wave * 16384;
    LAS float* obuf = (LAS float*)(F.lds + OBUF_OFF + F.wave * 1024);
    { LAS unsigned char* wp = tile + (lane >> 3) * 2048; const int cc = lane & 7;
#pragma unroll
      for (int j = 0; j < 16; ++j) { const v4u w = b.rows[j]; *(LAS v4u*)(wp + j * 128 + ((cc ^ (j >> 1)) << 4)) = (j & 1) ? (v4u){w.z, w.w, w.x, w.y} : w; } }
    const LAS unsigned char* rp = tile + (32 * g + n) * 128;
    const bool arow = n < 2;
    const i32x8_t afr = (i32x8_t){arow ? (int)b.aw.x : 0, arow ? (int)b.aw.y : 0, arow ? (int)b.aw.z : 0, arow ? (int)b.aw.w : 0, 0, 0, 0, 0};
    const unsigned sca = n == 0 ? b.e : n == 1 ? b.e - 0x03030303u : 0x7F7F7F7Fu;
    LAS float* const wdst = g == 0 ? obuf + n : (LAS float*)(F.lds + ODUMP_OFF + F.wave * 256) + lane; const int wstep = g == 0 ? 16 : 0;
#pragma unroll
    for (int h = 0; h < 2; ++h) {
        v2i32_t b0[8], b1[8];
#pragma unroll
        for (int q = 0; q < 8; ++q) { const int off = (((8 * h + q) ^ n) << 3); b0[q] = __builtin_amdgcn_ds_read_tr4_b64_v2i32((LAS v2i32_t*)(rp + off)); b1[q] = __builtin_amdgcn_ds_read_tr4_b64_v2i32((LAS v2i32_t*)(rp + 2048 + off)); }
        f32x4 c[8];
#pragma unroll
        for (int q = 0; q < 8; ++q) c[q] = __builtin_amdgcn_mfma_scale_f32_16x16x128_f8f6f4(afr, (i32x8_t){b0[q].x, b0[q].y, b1[q].x, b1[q].y, 0, 0, 0, 0}, (f32x4){0.f, 0.f, 0.f, 0.f}, 4, 4, 0, (int)sca, 0, 0x7F7F7F7F);
#pragma unroll
        for (int q = 0; q < 8; ++q) wdst[(8 * h + q) * wstep] = c[q][0] + c[q][1];
    }
    *(GAS f32x4*)(F.out + (size_t)t * D + 256 * sl + 4 * lane) = (f32x4){bflo(b.xv.x), bfhi(b.xv.x), bflo(b.xv.y), bfhi(b.xv.y)} + *(const LAS f32x4*)(obuf + 4 * lane);
}
__device__ __forceinline__ void peer_up_pass_mfma(Frame& F, const PeerDeal& d) {
    const int lane = F.lane;
    const int N = d.ns * d.cnt; if (N <= 0) return;
    i32x4_t I0[4], I1[4]; PmBuf B0, B1;
    int t0, s0, t1, s1, t2, s2, t3, s3;
    pd_item(0, d, t0, s0); pd_idx(F, t0, lane, I0);
    pd_item(1, d, t1, s1); pd_idx(F, t1, lane, I1);
    pm_rows(F, t0, s0, lane, I0, B0);
#pragma unroll 1
    for (int n = 0; n < N; n += 2) {
        pd_item(n + 2, d, t2, s2); pd_idx(F, t2, lane, I0);
        __builtin_amdgcn_sched_barrier(0);
        pm_rows(F, t1, s1, lane, I1, B1);
        __builtin_amdgcn_sched_barrier(0);
        pm_compute(F, t0, s0, lane, B0);
        __builtin_amdgcn_sched_barrier(0);
        pd_item(n + 3, d, t3, s3); pd_idx(F, t3, lane, I1);
        __builtin_amdgcn_sched_barrier(0);
        pm_rows(F, t2, s2, lane, I0, B0);
        __builtin_amdgcn_sched_barrier(0);
        pm_compute(F, t1, s1, lane, B1);
        __builtin_amdgcn_sched_barrier(0);
        t0 = t2; s0 = s2; t1 = t3; s1 = s3;
    }
}
typedef _Float16 h2_t __attribute__((ext_vector_type(2)));
#define FP4H2(w, b) __builtin_bit_cast(h2_t, __builtin_amdgcn_cvt_scalef32_pk_f16_fp4((w), 1.0f, (b)))
__device__ __forceinline__ void pu_idx(Frame& F, int t, int lane, i32x4_t (&idv)[8], f32x4 (&cfv)[8]) {
    const GAS i32x4_t* ip = (const GAS i32x4_t*)(WSP(const int, WS_IDX) + (size_t)t * 128 + (lane >> 4) * 32); const GAS f32x4* cp = (const GAS f32x4*)(WSP(const float, WS_GATE) + (size_t)t * 128 + (lane >> 4) * 32);
#pragma unroll
    for (int a = 0; a < 8; ++a) { idv[a] = ip[a]; cfv[a] = cp[a]; }
}
template <int H> __device__ __forceinline__ void pu_rows(Frame& F, int sl, int lane, const i32x4_t (&idv)[8], u32x2_t (&rows)[16]) {
    const unsigned char* WU = F.ws + WS_W4U + (size_t)sl * SLICE_BYTES + (lane & 15) * 8;
#pragma unroll
    for (int i = 0; i < 16; ++i) rows[i] = *(const GAS u32x2_t*)(WU + (size_t)idv[4 * H + (i >> 2)][i & 3] * 128);
}
template <int H> __device__ __forceinline__ void pu_compute(const u32x2_t (&rows)[16], const f32x4 (&cfv)[8], h2_t (&acc)[8]) {
#pragma unroll
    for (int i = 0; i < 16; ++i) { const float c = cfv[4 * H + (i >> 2)][i & 3] * 256.0f; const h2_t cc = __builtin_bit_cast(h2_t, __builtin_amdgcn_cvt_pkrtz(c, c));
#pragma unroll
        for (int k = 0; k < 2; ++k) { const unsigned w = rows[i][k];
            acc[4 * k + 0] = FP4H2(w, 0) * cc + acc[4 * k + 0]; acc[4 * k + 1] = FP4H2(w, 1) * cc + acc[4 * k + 1]; acc[4 * k + 2] = FP4H2(w, 2) * cc + acc[4 * k + 2]; acc[4 * k + 3] = FP4H2(w, 3) * cc + acc[4 * k + 3]; } }
}
__device__ __forceinline__ void pu_finish(Frame& F, int t, int sl, int lane, h2_t (&acc)[8]) {
    const int eg = lane >> 4, q = lane & 15;
#pragma unroll
    for (int a = 0; a < 8; ++a) {
        acc[a] = acc[a] + __builtin_bit_cast(h2_t, __shfl_xor(__builtin_bit_cast(unsigned, acc[a]), 16)); acc[a] = acc[a] + __builtin_bit_cast(h2_t, __shfl_xor(__builtin_bit_cast(unsigned, acc[a]), 32)); }
    const h2_t o01 = eg == 0 ? acc[0] : eg == 1 ? acc[2] : eg == 2 ? acc[4] : acc[6], o23 = eg == 0 ? acc[1] : eg == 1 ? acc[3] : eg == 2 ? acc[5] : acc[7];
    GAS f32x4* op = (GAS f32x4*)(F.out + (size_t)t * D + 256 * sl + 16 * q + 4 * eg);
    f32x4 o; { const u32x2_t w = *(const GAS u32x2_t*)(WSP(const bf16, WS_X1B) + (size_t)t * D + 256 * sl + 16 * q + 4 * eg); o = (f32x4){bflo(w.x), bfhi(w.x), bflo(w.y), bfhi(w.y)}; }
    *op = (f32x4){o[0] + (float)o01.x * (1.0f / 256.0f), o[1] + (float)o01.y * (1.0f / 256.0f), o[2] + (float)o23.x * (1.0f / 256.0f), o[3] + (float)o23.y * (1.0f / 256.0f)};
#pragma unroll
    for (int a = 0; a < 8; ++a) acc[a] = (h2_t){(_Float16)0.f, (_Float16)0.f};
}
__device__ __forceinline__ void peer_up_pass(Frame& F, const PeerDeal& d) {
    const int lane = F.lane;
    const int N = d.ns * d.cnt; if (N <= 0) return;
    i32x4_t IA[8], IB[8]; f32x4 CA[8], CB[8]; u32x2_t Ra[16], Rb[16]; h2_t acc[8];
#pragma unroll
    for (int a = 0; a < 8; ++a) acc[a] = (h2_t){(_Float16)0.f, (_Float16)0.f};
    int ta, sa, tb, sb, tc, sc;
    pd_item(0, d, ta, sa); pu_idx(F, ta, lane, IA, CA);
    pd_item(1, d, tb, sb); pu_idx(F, tb, lane, IB, CB);
    pu_rows<0>(F, sa, lane, IA, Ra);
#pragma unroll 1
    for (int n = 0; n < N; n += 2) {
        pu_rows<1>(F, sa, lane, IA, Rb);
        pu_compute<0>(Ra, CA, acc);
        pu_rows<0>(F, sb, lane, IB, Ra);
        pu_compute<1>(Rb, CA, acc);
        pu_finish(F, ta, sa, lane, acc);
        pd_item(n + 2, d, tc, sc); pu_idx(F, tc, lane, IA, CA);
        if (n + 1 < N) {
            pu_rows<1>(F, sb, lane, IB, Rb);
            pu_compute<0>(Ra, CB, acc);
            pu_rows<0>(F, sc, lane, IA, Ra);
            pu_compute<1>(Rb, CB, acc);
            pu_finish(F, tb, sb, lane, acc);
        }
        pd_item(n + 3, d, tb, sb); pu_idx(F, tb, lane, IB, CB);
        ta = tc; sa = sc;
    }
}
struct Args { const float* in[15]; float* out; unsigned char* ws; int ph_lo, ph_hi, pad0, pad1; };
__global__ void __launch_bounds__(NWAVES * 64, 2) skel_fwd(Args args) {
    extern __shared__ __attribute__((aligned(16))) unsigned char lds[];
    Frame F;
    F.lds = (LAS unsigned char*)lds;
    F.MISC = (volatile LAS unsigned*)(F.lds + MISC_OFF);
    F.tid = threadIdx.x; F.lane = F.tid & 63; F.wave = __builtin_amdgcn_readfirstlane(F.tid >> 6);
    F.G = gridDim.x; { const int bx = blockIdx.x; F.vcu = (F.G % 8 == 0) ? (bx % 8) * (F.G / 8) + bx / 8 : bx; }
    F.ws = args.ws; F.ctl = (gu32*)(args.ws + WS_CTL);
    F.x = args.in[0]; F.g1 = args.in[1]; F.w_in = args.in[2]; F.gq = args.in[3]; F.gk = args.in[4]; F.sink = args.in[5]; F.conv_w = args.in[6]; F.w_oa = args.in[7];
    F.w_oc = args.in[8]; F.w_out = args.in[9]; F.g2 = args.in[10]; F.w_qp = args.in[11]; F.subk = args.in[12]; F.w_down = args.in[13]; F.w_up = args.in[14]; F.out = args.out;
    for (int u = F.tid; u < (LDS_BYTES - LDSCTL_OFF) / 4; u += NWAVES * 64) ((LAS unsigned*)(F.lds + LDSCTL_OFF))[u] = 0u;
    __syncthreads();
    XcdBarrier bar; bar.bar = (unsigned*)(F.ctl + CW_BAR); bar.x = 0; bar.st = nullptr;
    if (MK_ONE_LAUNCH) bar = xcd_barrier_post((unsigned*)(F.ctl + CW_BAR), F.MISC + 8);
    if (MK_ONE_LAUNCH && F.tid == 0) { const unsigned xcc = xb_xcc_id(); F.MISC[10] = xcc; F.MISC[11] = __hip_atomic_fetch_add((unsigned*)(F.ctl + CW_XRANK) + 64 * xcc, 1u, RLX_AGENT); }
    if (F.wave == 0) { const bool ok = tr4_selfcheck(F.lds + RING_OFF, F.lane); if (F.lane == 0) F.MISC[15] = ok ? 1u : 0u; }
    __syncthreads();
    const bool tr4_ok = F.MISC[15] != 0u;
    const int lo = args.ph_lo, hi = args.ph_hi;
#ifndef PHASE_MASK
#define PHASE_MASK 0xfff
#endif
#define IN(k) (((PHASE_MASK >> (k)) & 1) && lo <= (k) && (k) < hi)
#ifndef DUP_MASK
#define DUP_MASK 0
#endif
#define REP(k) _Pragma("unroll") for (int rep_ = 0; rep_ < 1 + ((DUP_MASK >> (k)) & 1); ++rep_)
#define SEAM(k) do { if (MK_ONE_LAUNCH && IN(k) && IN((k) + 1)) xcd_barrier(bar); } while (0)
    const int gw = F.vcu * NWAVES + F.wave, NGW = F.G * NWAVES;

    if (IN(0)) REP(0) { p0_prologue(F); } SEAM(0);

    if (IN(1)) REP(1) { quant_w8(F); } SEAM(1);

    if (IN(2)) REP(2) {
        bf16* const pQ = WSP(bf16, WS_Q); bf16* const pK = WSP(bf16, WS_K); bf16* const pV = WSP(bf16, WS_V); bf16* const pH = WSP(bf16, WS_H); bf16* const pB = WSP(bf16, WS_B); bf16* const pC = WSP(bf16, WS_C);
        bf16* const pGA = WSP(bf16, WS_GA); bf16* const pGC = WSP(bf16, WS_GC);
        {   pg8::Gemm g{(const bf16*)(F.ws + WS_XN8), (const bf16*)(F.ws + WS_W8), M, INW, D / 2};
            pg8::RangeOrder S; S.so.init(M, I8_TILES * 256, F.G, (int)blockIdx.x); S.base = 0; S.cut = I8_CUT; S.skip = I8_SKIP;
            pg8::EpiProj<true> E{pQ, pK, pV, pH, pB, pC, pGA, pGC, WSP(const float, WS_SX), WSP(const float, WS_SW)};
            pg8::gemm_phase<pg8::EpiProj<true>, pg8::RangeOrder, PG8_ALIGN, PG8_SP2, true>(F.lds + RING_OFF, g, S, E); }
        {   pg8::Gemm g{WSP(const bf16, WS_XN), WSP(const bf16, WS_WIN), M, INW, D};
            pg8::RangeOrder S; S.so.init(M, BF_TILES * 256, F.G, (int)blockIdx.x); S.base = BF_BASE; S.cut = 68; S.skip = 0;
            pg8::EpiProj<false> E{pQ, pK, pV, pH, pB, pC, pGA, pGC, nullptr, nullptr};
            pg8::gemm_phase<pg8::EpiProj<false>, pg8::RangeOrder, PG8_ALIGN, PG8_SP2, false>(F.lds + RING_OFF, g, S, E); }
    } SEAM(2);

    if (IN(3)) REP(3) {
        attn_phase(F);
#ifdef ATTN_PROBE
        for (int U = F.vcu * 4; U < BATCH * 32 * NKV * 2; U += F.G * 4)
            for (int i = 0; i < 4; ++i) attn_unit<ATTN_PROBE>(F, U + i);
#endif
        conv_phase(F);
#ifdef CONV_DUP
        conv_phase(F);
#endif
        if (DUP_MASK) __syncthreads();
    } SEAM(3);

    if (IN(4)) REP(4) {
        pg8::Gemm g{WSP(const bf16, WS_AB), WSP(const bf16, WS_WO), 2 * M, 2 * D, QW}; pg8::PairOrder S; S.so.init(M, D, F.G, (int)blockIdx.x);
        pg8::EpiMerge E{WSP(const bf16, WS_GA), WSP(const bf16, WS_GC), WSP(bf16, WS_T), WSP(bf16, WS_XN)};
        pg8::gemm_phase<pg8::EpiMerge, pg8::PairOrder, PG8_ALIGN, PG8_SP2>(F.lds + RING_OFF, g, S, E);
    } SEAM(4);

    if (IN(5)) REP(5) {
#if P5_I8
        for (int m = gw; m < M; m += NGW) quant_row_i8(WSP(const bf16, WS_XN) + (size_t)m * D, F.ws + WS_MI8 + (size_t)m * D, WSP(float, WS_SXM) + m, F.lane);
        if (MK_ONE_LAUNCH) xcd_barrier(bar);
        pg8::Gemm g{(const bf16*)(F.ws + WS_MI8), (const bf16*)(F.ws + WS_W8OUT), M, D, D / 2}; pg8::StaticOrder S; S.init(M, D, F.G, (int)blockIdx.x);
        pg8::EpiResI8 E{F.x, WSP(bf16, WS_X1B), WSP(const float, WS_SXM), WSP(const float, WS_SWO)};
        pg8::gemm_phase<pg8::EpiResI8, pg8::StaticOrder, PG8_ALIGN, PG8_SP2, true>(F.lds + RING_OFF, g, S, E);
#else
        pg8::Gemm g{WSP(const bf16, WS_XN), WSP(const bf16, WS_WOUT), M, D, D}; pg8::StaticOrder S; S.init(M, D, F.G, (int)blockIdx.x);
        pg8::EpiRes E{F.x, WSP(bf16, WS_X1B)};
        pg8::gemm_phase<pg8::EpiRes, pg8::StaticOrder, PG8_ALIGN, PG8_SP2>(F.lds + RING_OFF, g, S, E);
#endif
    } SEAM(5);

    if (IN(6)) REP(6) {
        for (int m = gw; m < M; m += NGW) rms2_row(WSP(const bf16, WS_X1B) + (size_t)m * D, F.g2, F.ws + WS_X2I8 + (size_t)m * D, WSP(float, WS_SX2) + m, F.ws + WS_X2N8 + (size_t)m * 256, F.lane);
    } SEAM(6);

    if (IN(7)) REP(7) {
        pg8::Gemm g{(const bf16*)(F.ws + WS_X2I8), (const bf16*)(F.ws + WS_W8QP), M, PQW, D / 2}; pg8::StaticOrder S; S.init(M, PQW, F.G, (int)blockIdx.x);
        pg8::EpiStoreI8 E{WSP(bf16, WS_QP), PQW, WSP(const float, WS_SX2), WSP(const float, WS_SWQ)};
        pg8::gemm_phase<pg8::EpiStoreI8, pg8::StaticOrder, PG8_ALIGN, PG8_SP2, true>(F.lds + RING_OFF, g, S, E);
    } SEAM(7);

    if (IN(8)) REP(8) {
        const int h = F.vcu & 7;
        { const bf16* SK = WSP(const bf16, WS_SK) + (size_t)h * (2 * NKEYS * 128);
#pragma unroll
          for (int i = 0; i < 8; ++i) { const int q = F.tid + 512 * i, row = q >> 4, ch = q & 15; *(LAS v4u*)(F.lds + RING_OFF + off_b(row, ch)) = *(const GAS v4u*)(SK + (size_t)row * 128 + ch * 8); } }
        __syncthreads();
        for (int tg = (F.vcu >> 3) * NWAVES + F.wave; tg < M / 16; tg += (F.G >> 3) * NWAVES) route_task(F, tg, h);
        if (DUP_MASK) __syncthreads();
    } SEAM(8);

    PeerDeal deal;
    if (IN(9) || IN(11)) {
        if (MK_ONE_LAUNCH) {
            if (F.tid == 0) { const unsigned xcc = F.MISC[10]; unsigned nloc = 0, ox = 0, nx = 0;
                for (unsigned j = 0; j < 16; ++j) { const unsigned c = __hip_atomic_load((unsigned*)(F.ctl + CW_XRANK) + 64 * j, RLX_AGENT); if (c) { ++nx; if (j < xcc) ++ox; } if (j == xcc) nloc = c; }
                F.MISC[12] = nloc; F.MISC[13] = ox; F.MISC[14] = nx; }
            __syncthreads();
            const int nloc = (int)F.MISC[12], rank = (int)F.MISC[11];
            deal.ox = (int)F.MISC[13]; deal.nx = (int)F.MISC[14]; deal.t0 = rank * NWAVES + F.wave; deal.stride = nloc * NWAVES;
        } else { const int nper = F.G >> 3; deal.ox = F.vcu / nper; deal.nx = 8; deal.t0 = (F.vcu % nper) * NWAVES + F.wave; deal.stride = nper * NWAVES; }
        deal.cnt = deal.t0 < M ? (M - deal.t0 + deal.stride - 1) / deal.stride : 0; deal.ns = deal.ox < 16 ? (16 - deal.ox + deal.nx - 1) / deal.nx : 0;
    }
    if (IN(9)) {
        peer_down_pass(F, deal);
    } SEAM(9);
    if (IN(10)) {
        for (int t = gw; t < M; t += NGW) peer_combine_token(F, t);
    } SEAM(10);
    if (IN(11)) {
        if (tr4_ok) peer_up_pass_mfma(F, deal); else peer_up_pass(F, deal);
    }
#undef IN
#undef SEAM
}

extern "C" void kernel_launch(void* const* d_in, const int* in_sizes, int n_in, void* d_out, int out_size, void* d_ws, size_t ws_size, hipStream_t stream) {
    static int grid = 0;
    if (grid == 0) {
        if (n_in != 15 || in_sizes[0] != M * D || out_size != M * D || ws_size < WS_END) { fprintf(stderr, "kernel_launch: built for 15 inputs, x and out of %d floats, >= %zu bytes of workspace; got n_in %d, in0 %d, out %d, ws %zu; nothing launched\n", M * D, (size_t)WS_END, n_in, n_in > 0 ? in_sizes[0] : -1, out_size, ws_size); grid = -1; return; }
        int dev = 0, cus = 0, per_cu = 0;
        if (hipGetDevice(&dev) != hipSuccess || hipDeviceGetAttribute(&cus, hipDeviceAttributeMultiprocessorCount, dev) != hipSuccess) { fprintf(stderr, "kernel_launch: hipGetDevice / hipDeviceGetAttribute failed; nothing launched\n"); grid = -1; return; }
        if (hipFuncSetAttribute((const void*)skel_fwd, hipFuncAttributeMaxDynamicSharedMemorySize, LDS_BYTES) != hipSuccess) { fprintf(stderr, "kernel_launch: hipFuncSetAttribute failed; nothing launched\n"); grid = -1; return; }
        if (hipOccupancyMaxActiveBlocksPerMultiprocessor(&per_cu, (const void*)skel_fwd, NWAVES * 64, LDS_BYTES) != hipSuccess || per_cu < 1)
            fprintf(stderr, "kernel_launch: note: the occupancy query reports %d workgroups per CU\n", per_cu);
        (void)hipGetLastError();
        grid = cus;
        if (grid % 8 != 0) { fprintf(stderr, "kernel_launch: %d CUs: this kernel deals work in groups of 8 workgroups; nothing launched\n", grid); grid = -1; return; }
    }
    if (grid < 0) return;
    if (hipMemsetAsync((char*)d_ws + WS_CTL, 0, CTL_ZERO_BYTES, stream) != hipSuccess) { fprintf(stderr, "kernel_launch: hipMemsetAsync of the control words failed; nothing launched\n"); return; }
    Args a{};
    for (int i = 0; i < 15; ++i) a.in[i] = (const float*)d_in[i];
    a.out = (float*)d_out; a.ws = (unsigned char*)d_ws;
#if MK_ONE_LAUNCH
    a.ph_lo = 0; a.ph_hi = N_PHASES;
    hipLaunchKernelGGL(skel_fwd, dim3(grid), dim3(NWAVES * 64), LDS_BYTES, stream, a);
    { const hipError_t le = hipPeekAtLastError(); if (le != hipSuccess) fprintf(stderr, "kernel_launch: launch failed: %s\n", hipGetErrorName(le)); }
#else
    for (int p = 0; p < N_PHASES; ++p) {
        a.ph_lo = p; a.ph_hi = p + 1;
        hipLaunchKernelGGL(skel_fwd, dim3(grid), dim3(NWAVES * 64), LDS_BYTES, stream, a);
        const hipError_t le = hipPeekAtLastError();
        if (le != hipSuccess) { fprintf(stderr, "kernel_launch: launch %d failed: %s\n", p, hipGetErrorName(le)); break; }
    }
#endif
}
```

```cpp
#include <hip/hip_runtime.h>
#include <cstdio>
#include <cstdint>
#include <cmath>
namespace pg8 {
#define PG8_LAS __attribute__((address_space(3)))
typedef unsigned short bf16_t;
typedef short bf16x8 __attribute__((ext_vector_type(8)));
typedef float f32x4 __attribute__((ext_vector_type(4)));
typedef unsigned u32x4 __attribute__((ext_vector_type(4)));
typedef int i32x4 __attribute__((ext_vector_type(4)));
constexpr int BM = 256, BK = 64, HALF = 128, HTB = HALF * BK * 2  , STAGE_BYTES = 8 * HTB, NXCD = 8, WGM = 8;

__host__ __device__ __forceinline__ int lds_byte(int r, int c) { const int st = (r >> 4) * 2 + (c >> 5), rr = r & 15, cc = c & 31, ob = rr * 64 + cc * 2; return st * 1024 + (ob ^ (((ob >> 9) & 1) << 5)); }
__host__ __device__ __forceinline__ void stage_rc(int b, int& R, int& C) { const int st = b / 1024, sb = b % 1024, swz = sb ^ (((sb >> 9) & 1) << 5); R = (st >> 1) * 16 + swz / 64; C = (st & 1) * 32 + (swz % 64) / 2; }
__host__ __device__ __forceinline__ int perm32(int rho) { const int n = rho >> 4, i = rho & 15; return 8 * (i >> 2) + 4 * n + (i & 3); }

struct Unit { int pm, pn; };
struct Gemm { const bf16_t* A; const bf16_t* Bt; int M, N, K; };

struct StaticOrder {
    int nM, nN, nwg, G, c;
    __host__ __device__ void init(int M, int N, int G_, int c_) { nM = M / BM; nN = N / BM; nwg = nM * nN; G = G_; c = c_; }
    __host__ __device__ bool next(int i, Unit& u) const {
        const long L = (long)i * G + c; if (L >= nwg) return false;
        int wgid = (int)L; { const int q = nwg / NXCD, r = nwg % NXCD, xcd = wgid % NXCD, off = wgid / NXCD; wgid = (xcd < r ? xcd * (q + 1) : r * (q + 1) + (xcd - r) * q) + off; }
        const int nig = WGM * nN, gid = wgid / nig, fm = gid * WGM, gsz = (nM - fm) < WGM ? (nM - fm) : WGM;
        u.pm = fm + ((wgid % nig) % gsz); u.pn = (wgid % nig) / gsz; return true;
    }
    __device__ __forceinline__ void a_ready(const Unit&) const {}
    __device__ __forceinline__ void done(const Unit&) const {}
};
__device__ __forceinline__ unsigned cvt_pk_bf16(float lo, float hi) { unsigned r; asm volatile("v_cvt_pk_bf16_f32 %0, %1, %2" : "=v"(r) : "v"(lo), "v"(hi)); return r; }
typedef unsigned u32x2 __attribute__((ext_vector_type(2)));
__device__ __forceinline__ float sigm(float v) { return __builtin_amdgcn_rcpf(1.0f + __builtin_amdgcn_exp2f(-1.4426950408889634f * v)); }
__device__ __forceinline__ u32x4 pack8(const f32x4 a, const f32x4 b) { u32x4 w; w.x = cvt_pk_bf16(a[0], a[1]); w.y = cvt_pk_bf16(a[2], a[3]); w.z = cvt_pk_bf16(b[0], b[1]); w.w = cvt_pk_bf16(b[2], b[3]); return w; }
__device__ __forceinline__ void unpack8(const u32x4 w, f32x4& a, f32x4& b) {
    a[0] = __uint_as_float(w.x << 16); a[1] = __uint_as_float(w.x & 0xffff0000u); a[2] = __uint_as_float(w.y << 16); a[3] = __uint_as_float(w.y & 0xffff0000u);
    b[0] = __uint_as_float(w.z << 16); b[1] = __uint_as_float(w.z & 0xffff0000u); b[2] = __uint_as_float(w.w << 16); b[3] = __uint_as_float(w.w & 0xffff0000u);
}
template <bool I8> struct EpiProj {
    static constexpr bool PERM = true, AFTER_DRAIN = false;
    bf16_t *Q, *K, *V, *H, *Bg, *Cg, *GA, *GC; const float *sx, *sw;
    __device__ __forceinline__ void operator()(const f32x4 (&acc)[2][2][4][2], const Unit& u, int wr, int wc, int fr, int fq) const {
        const int pn = u.pn; bf16_t* base; int ldc, ct; bool sg = false;
        if (pn < 8) { base = Q; ldc = 2048; ct = pn; } else if (pn < 10) { base = K; ldc = 512; ct = pn - 8; } else if (pn < 12) { base = V; ldc = 512; ct = pn - 10; }
        else if (pn < 20) { base = H; ldc = 2048; ct = pn - 12; } else if (pn < 28) { base = Bg; ldc = 2048; ct = pn - 20; } else if (pn < 36) { base = Cg; ldc = 2048; ct = pn - 28; }
        else if (pn < 52) { base = GA; ldc = 4096; ct = pn - 36; sg = true; } else { base = GC; ldc = 4096; ct = pn - 52; sg = true; }
        const int row0 = u.pm * BM + wr * 64 + fr, col0 = ct * BM + wc * 32 + 8 * fq;
        f32x4 cs[2][2];
        if constexpr (I8) {
#pragma unroll
            for (int bj = 0; bj < 2; ++bj)
#pragma unroll
                for (int n = 0; n < 2; ++n) cs[bj][n] = *(const f32x4*)(sw + pn * BM + bj * HALF + wc * 32 + 8 * fq + 4 * n);
        }
#pragma unroll
        for (int ai = 0; ai < 2; ++ai)
#pragma unroll
            for (int m = 0; m < 4; ++m) { const int row = row0 + ai * HALF + m * 16; bf16_t* rowp = base + (size_t)row * ldc + col0;
                float rs = 1.f; if constexpr (I8) rs = sx[row];
#pragma unroll
                for (int bj = 0; bj < 2; ++bj) { f32x4 v0 = acc[ai][bj][m][0], v1 = acc[ai][bj][m][1];
                    if constexpr (I8) { v0 = __builtin_convertvector(__builtin_bit_cast(i32x4, v0), f32x4) * (cs[bj][0] * rs); v1 = __builtin_convertvector(__builtin_bit_cast(i32x4, v1), f32x4) * (cs[bj][1] * rs); }
                    if (sg) {
#pragma unroll
                        for (int e = 0; e < 4; ++e) { v0[e] = sigm(v0[e]); v1[e] = sigm(v1[e]); } }
                    *(u32x4*)(rowp + bj * HALF) = pack8(v0, v1); } }
    }
};
struct EpiMerge {
    static constexpr bool PERM = true, AFTER_DRAIN = false;
    const bf16_t *GA, *GC; bf16_t *T, *Mg;
    __device__ __forceinline__ void operator()(const f32x4 (&acc)[2][2][4][2], const Unit& u, int wr, int wc, int fr, int fq) const {
        const int which = u.pm >> 6, pm = u.pm & 63, pn = u.pn & 15;
        const bf16_t* G = which ? GC : GA;
        const int row0 = pm * BM + wr * 64 + fr, col0 = pn * BM + wc * 32 + 8 * fq;
#pragma unroll
        for (int ai = 0; ai < 2; ++ai)
#pragma unroll
            for (int m = 0; m < 4; ++m) { const size_t off = (size_t)(row0 + ai * HALF + m * 16) * 4096 + col0;
#pragma unroll
                for (int bj = 0; bj < 2; ++bj) { const size_t o = off + bj * HALF; f32x4 g0, g1; unpack8(*(const u32x4*)(G + o), g0, g1);
                    f32x4 v0 = acc[ai][bj][m][0] * g0, v1 = acc[ai][bj][m][1] * g1;
                    if (which == 0) { *(u32x4*)(T + o) = pack8(v0, v1); }
                    else { f32x4 t0, t1; unpack8(*(const u32x4*)(T + o), t0, t1); *(u32x4*)(Mg + o) = pack8(v0 + t0, v1 + t1); } } }
    }
};
struct EpiRes {
    static constexpr bool PERM = true, AFTER_DRAIN = false;
    const float* X; bf16_t* O;
    __device__ __forceinline__ void operator()(const f32x4 (&acc)[2][2][4][2], const Unit& u, int wr, int wc, int fr, int fq) const {
        const int row0 = u.pm * BM + wr * 64 + fr, col0 = u.pn * BM + wc * 32 + 8 * fq;
#pragma unroll
        for (int ai = 0; ai < 2; ++ai)
#pragma unroll
            for (int m = 0; m < 4; ++m) { const size_t off = (size_t)(row0 + ai * HALF + m * 16) * 4096 + col0;
#pragma unroll
                for (int bj = 0; bj < 2; ++bj) { const size_t o = off + bj * HALF; const f32x4 x0 = *(const f32x4*)(X + o), x1 = *(const f32x4*)(X + o + 4);
                    *(u32x4*)(O + o) = pack8(x0 + acc[ai][bj][m][0], x1 + acc[ai][bj][m][1]); } }
    }
};
struct EpiMergeA8 {
    static constexpr bool PERM = true, AFTER_DRAIN = false;
    const bf16_t* GA; bf16_t* T; const float *sx, *sw;
    __device__ __forceinline__ void operator()(const f32x4 (&acc)[2][2][4][2], const Unit& u, int wr, int wc, int fr, int fq) const {
        const int row0 = u.pm * BM + wr * 64 + fr, col0 = u.pn * BM + wc * 32 + 8 * fq;
        f32x4 cs[2][2];
#pragma unroll
        for (int bj = 0; bj < 2; ++bj)
#pragma unroll
            for (int n = 0; n < 2; ++n) cs[bj][n] = *(const f32x4*)(sw + col0 + bj * HALF + 4 * n);
#pragma unroll
        for (int ai = 0; ai < 2; ++ai)
#pragma unroll
            for (int m = 0; m < 4; ++m) { const int row = row0 + ai * HALF + m * 16; const size_t off = (size_t)row * 4096 + col0; const float rs = sx[row];
#pragma unroll
                for (int bj = 0; bj < 2; ++bj) { const size_t o = off + bj * HALF; f32x4 g0, g1; unpack8(*(const u32x4*)(GA + o), g0, g1);
                    *(u32x4*)(T + o) = pack8(__builtin_convertvector(__builtin_bit_cast(i32x4, acc[ai][bj][m][0]), f32x4) * (cs[bj][0] * rs) * g0, __builtin_convertvector(__builtin_bit_cast(i32x4, acc[ai][bj][m][1]), f32x4) * (cs[bj][1] * rs) * g1); } }
    }
};
struct EpiMergeC {
    static constexpr bool PERM = true, AFTER_DRAIN = false;
    const bf16_t *GC, *T; bf16_t* Mg;
    __device__ __forceinline__ void operator()(const f32x4 (&acc)[2][2][4][2], const Unit& u, int wr, int wc, int fr, int fq) const {
        const int row0 = u.pm * BM + wr * 64 + fr, col0 = u.pn * BM + wc * 32 + 8 * fq;
#pragma unroll
        for (int ai = 0; ai < 2; ++ai)
#pragma unroll
            for (int m = 0; m < 4; ++m) { const size_t off = (size_t)(row0 + ai * HALF + m * 16) * 4096 + col0;
#pragma unroll
                for (int bj = 0; bj < 2; ++bj) { const size_t o = off + bj * HALF; f32x4 g0, g1, t0, t1; unpack8(*(const u32x4*)(GC + o), g0, g1); unpack8(*(const u32x4*)(T + o), t0, t1);
                    *(u32x4*)(Mg + o) = pack8(acc[ai][bj][m][0] * g0 + t0, acc[ai][bj][m][1] * g1 + t1); } }
    }
};
struct EpiResI8 {
    static constexpr bool PERM = true, AFTER_DRAIN = false;
    const float* X; bf16_t* O; const float *sx, *sw;
    __device__ __forceinline__ void operator()(const f32x4 (&acc)[2][2][4][2], const Unit& u, int wr, int wc, int fr, int fq) const {
        const int row0 = u.pm * BM + wr * 64 + fr, col0 = u.pn * BM + wc * 32 + 8 * fq;
        f32x4 cs[2][2];
#pragma unroll
        for (int bj = 0; bj < 2; ++bj)
#pragma unroll
            for (int n = 0; n < 2; ++n) cs[bj][n] = *(const f32x4*)(sw + col0 + bj * HALF + 4 * n);
#pragma unroll
        for (int ai = 0; ai < 2; ++ai)
#pragma unroll
            for (int m = 0; m < 4; ++m) { const int row = row0 + ai * HALF + m * 16; const size_t off = (size_t)row * 4096 + col0; const float rs = sx[row];
#pragma unroll
                for (int bj = 0; bj < 2; ++bj) { const size_t o = off + bj * HALF; const f32x4 x0 = *(const f32x4*)(X + o), x1 = *(const f32x4*)(X + o + 4);
                    *(u32x4*)(O + o) = pack8(x0 + __builtin_convertvector(__builtin_bit_cast(i32x4, acc[ai][bj][m][0]), f32x4) * (cs[bj][0] * rs), x1 + __builtin_convertvector(__builtin_bit_cast(i32x4, acc[ai][bj][m][1]), f32x4) * (cs[bj][1] * rs)); } }
    }
};
struct EpiStoreI8 {
    static constexpr bool PERM = true, AFTER_DRAIN = false;
    bf16_t* O; int ldc; const float *sx, *sw;
    __device__ __forceinline__ void operator()(const f32x4 (&acc)[2][2][4][2], const Unit& u, int wr, int wc, int fr, int fq) const {
        const int row0 = u.pm * BM + wr * 64 + fr, col0 = u.pn * BM + wc * 32 + 8 * fq;
        f32x4 cs[2][2];
#pragma unroll
        for (int bj = 0; bj < 2; ++bj)
#pragma unroll
            for (int n = 0; n < 2; ++n) cs[bj][n] = *(const f32x4*)(sw + col0 + bj * HALF + 4 * n);
#pragma unroll
        for (int ai = 0; ai < 2; ++ai)
#pragma unroll
            for (int m = 0; m < 4; ++m) { const int row = row0 + ai * HALF + m * 16; bf16_t* rowp = O + (size_t)row * ldc + col0; const float rs = sx[row];
#pragma unroll
                for (int bj = 0; bj < 2; ++bj) *(u32x4*)(rowp + bj * HALF) = pack8(__builtin_convertvector(__builtin_bit_cast(i32x4, acc[ai][bj][m][0]), f32x4) * (cs[bj][0] * rs), __builtin_convertvector(__builtin_bit_cast(i32x4, acc[ai][bj][m][1]), f32x4) * (cs[bj][1] * rs)); }
    }
};
struct EpiStore {
    static constexpr bool PERM = true, AFTER_DRAIN = false;
    bf16_t* O; int ldc;
    __device__ __forceinline__ void operator()(const f32x4 (&acc)[2][2][4][2], const Unit& u, int wr, int wc, int fr, int fq) const {
        const int row0 = u.pm * BM + wr * 64 + fr, col0 = u.pn * BM + wc * 32 + 8 * fq;
#pragma unroll
        for (int ai = 0; ai < 2; ++ai)
#pragma unroll
            for (int m = 0; m < 4; ++m) { bf16_t* rowp = O + (size_t)(row0 + ai * HALF + m * 16) * ldc + col0;
#pragma unroll
                for (int bj = 0; bj < 2; ++bj) *(u32x4*)(rowp + bj * HALF) = pack8(acc[ai][bj][m][0], acc[ai][bj][m][1]); }
    }
};
struct PairOrder {
    StaticOrder so;
    __device__ bool next(int i, Unit& u) const { Unit t; if (!so.next(i >> 1, t)) return false; const int w = i & 1; u.pm = t.pm + 64 * w; u.pn = t.pn + 16 * w; return true; }
    __device__ __forceinline__ void a_ready(const Unit&) const {}
    __device__ __forceinline__ void done(const Unit&) const {}
};
struct RangeOrder {
    StaticOrder so; int base, cut, skip;
    __device__ bool next(int i, Unit& u) const { if (!so.next(i, u)) return false; u.pn = base + (u.pn < cut ? u.pn : u.pn + skip); return true; }
    __device__ __forceinline__ void a_ready(const Unit&) const {}
    __device__ __forceinline__ void done(const Unit&) const {}
};
template <class Epi, class Sched, bool ALIGN_EPI = false, bool SP2 = false, bool I8 = false>
__device__ __forceinline__ void gemm_phase(PG8_LAS unsigned char* lds, const Gemm g, const Sched& S, const Epi& E) {
    const int tid = threadIdx.x, wid = __builtin_amdgcn_readfirstlane(tid >> 6), lane = tid & 63, wr = wid >> 2, wc = wid & 3, fr = lane & 15, fq = lane >> 4;
    const int K = g.K, nt = K / BK;
    unsigned voffA[2], voffB[2];
#pragma unroll
    for (int i = 0; i < 2; ++i) { int R, C; stage_rc(tid * 16 + i * 8192, R, C); const int Rb = Epi::PERM ? ((R & ~31) + perm32(R & 31)) : R;
        voffA[i] = (unsigned)(R * K + C) * 2u; voffB[i] = (unsigned)(Rb * K + C) * 2u; }
    const size_t kstep = (size_t)(BK * 2);
    const size_t hstep = (size_t)HALF * K * 2;
    const size_t tstep = 2 * hstep;
    const unsigned ldsw = (unsigned)wid * 1024u;
    const int aoff = lds_byte(wr * 64 + fr, fq * 8), boff = lds_byte(wc * 32 + fr, fq * 8);
#define PG8_SA(b, h) (((b) * 2 + (h)) * HTB)
#define PG8_SB(b, h) ((4 + (b) * 2 + (h)) * HTB)
#define PG8_STAGE(bufoff, gbase, voff) do { _Pragma("unroll") for (int _i = 0; _i < 2; ++_i) \
        __builtin_amdgcn_global_load_lds((const unsigned*)((const char*)(gbase) + (voff)[_i]), (PG8_LAS unsigned*)(lds + (bufoff) + ldsw + _i * 8192), 16, 0, 0); } while (0)
#define PG8_LDA(dst, b, h) do { _Pragma("unroll") for (int m = 0; m < 4; ++m) _Pragma("unroll") for (int k = 0; k < 2; ++k) dst[m][k] = *(const PG8_LAS bf16x8*)(lds + PG8_SA(b, h) + aoff + m * 2048 + k * 1024); } while (0)
#define PG8_LDB(dst, b, h) do { _Pragma("unroll") for (int n = 0; n < 2; ++n) _Pragma("unroll") for (int k = 0; k < 2; ++k) dst[n][k] = *(const PG8_LAS bf16x8*)(lds + PG8_SB(b, h) + boff + n * 2048 + k * 1024); } while (0)
#define PG8_MMA(ai, bj, At, Bt) do { __builtin_amdgcn_s_setprio(1); _Pragma("unroll") for (int m = 0; m < 4; ++m) _Pragma("unroll") for (int n = 0; n < 2; ++n) _Pragma("unroll") for (int k = 0; k < 2; ++k) \
        { if constexpr (I8) acc[ai][bj][m][n] = __builtin_bit_cast(f32x4, __builtin_amdgcn_mfma_i32_16x16x64_i8(__builtin_bit_cast(i32x4, Bt[n][k]), __builtin_bit_cast(i32x4, At[m][k]), __builtin_bit_cast(i32x4, acc[ai][bj][m][n]), 0, 0, 0)); \
          else acc[ai][bj][m][n] = __builtin_amdgcn_mfma_f32_16x16x32_bf16(Bt[n][k], At[m][k], acc[ai][bj][m][n], 0, 0, 0); } __builtin_amdgcn_s_setprio(0); } while (0)
#define PG8_WAIT_V(n) asm volatile("s_waitcnt vmcnt(" #n ")" ::: "memory")
#define PG8_WAIT_L(n) asm volatile("s_waitcnt lgkmcnt(" #n ")" ::: "memory")
#define PG8_BAR __builtin_amdgcn_s_barrier()
#define PG8_SCHED __builtin_amdgcn_sched_barrier(0)
    Unit cur, nxt; int ui = 0;
    if (!S.next(0, cur)) return;
    f32x4 acc[2][2][4][2];
#pragma unroll
    for (int a = 0; a < 2; ++a)
#pragma unroll
        for (int b = 0; b < 2; ++b)
#pragma unroll
            for (int m = 0; m < 4; ++m)
#pragma unroll
                for (int n = 0; n < 2; ++n) acc[a][b][m][n] = (f32x4){0.f, 0.f, 0.f, 0.f};
    bf16x8 At[4][2], B0[2][2], B1[2][2];
    const char* cA = (const char*)g.A + (size_t)cur.pm * tstep; const char* cB = (const char*)g.Bt + (size_t)cur.pn * tstep;
    S.a_ready(cur);
    if constexpr (SP2) {
        PG8_STAGE(PG8_SB(0, 0), cB, voffB); PG8_STAGE(PG8_SB(0, 1), cB + hstep, voffB); PG8_STAGE(PG8_SA(0, 0), cA, voffA); PG8_STAGE(PG8_SA(0, 1), cA + hstep, voffA);
        if (wr == 1) PG8_BAR;
        PG8_WAIT_V(2); PG8_BAR;
        PG8_STAGE(PG8_SB(1, 0), cB + kstep, voffB); PG8_STAGE(PG8_SA(1, 0), cA + kstep, voffA); PG8_STAGE(PG8_SB(1, 1), cB + hstep + kstep, voffB);
        PG8_WAIT_V(6); PG8_BAR;
    } else {
        PG8_STAGE(PG8_SB(0, 0), cB, voffB); PG8_STAGE(PG8_SA(0, 0), cA, voffA); PG8_STAGE(PG8_SB(0, 1), cB + hstep, voffB); PG8_STAGE(PG8_SA(0, 1), cA + hstep, voffA);
        if (wr == 1) PG8_BAR;
        PG8_WAIT_V(4); PG8_BAR;
        PG8_STAGE(PG8_SB(1, 0), cB + kstep, voffB); PG8_STAGE(PG8_SA(1, 0), cA + kstep, voffA); PG8_STAGE(PG8_SB(1, 1), cB + hstep + kstep, voffB);
        PG8_WAIT_V(6); PG8_BAR;
    }
    for (;;) {
        const bool has_next = S.next(ui + 1, nxt);
        const char* nA = has_next ? (const char*)g.A + (size_t)nxt.pm * tstep : cA; const char* nB = has_next ? (const char*)g.Bt + (size_t)nxt.pn * tstep : cB;
        for (int t = 0; t < nt; t += 2) {
            const bool last = (t == nt - 2);
            const char* a1 = cA + (size_t)(t + 1) * kstep;
            const char* a2 = last ? nA : cA + (size_t)(t + 2) * kstep; const char* b2 = last ? nB : cB + (size_t)(t + 2) * kstep;
            const char* a3 = a2 + kstep; const char* b3 = b2 + kstep;
            if (last && has_next) S.a_ready(nxt);
            if constexpr (SP2) {
            PG8_LDB(B0, 0, 0); PG8_LDB(B1, 0, 1); PG8_SCHED; PG8_LDA(At, 0, 0); PG8_STAGE(PG8_SA(1, 1), a1 + hstep, voffA);
            PG8_WAIT_V(8); PG8_WAIT_L(0); PG8_BAR; PG8_MMA(0, 0, At, B0); PG8_MMA(0, 1, At, B1); PG8_BAR; PG8_SCHED;
            PG8_LDA(At, 0, 1); PG8_STAGE(PG8_SB(0, 0), b2, voffB); PG8_STAGE(PG8_SB(0, 1), b2 + hstep, voffB); PG8_STAGE(PG8_SA(0, 0), a2, voffA);
            PG8_WAIT_V(8); PG8_WAIT_L(0); PG8_BAR; PG8_MMA(1, 0, At, B0); PG8_MMA(1, 1, At, B1); PG8_BAR; PG8_SCHED;
            PG8_LDB(B0, 1, 0); PG8_LDB(B1, 1, 1); PG8_SCHED; PG8_LDA(At, 1, 0); PG8_STAGE(PG8_SA(0, 1), a2 + hstep, voffA);
            PG8_WAIT_V(8); PG8_WAIT_L(0); PG8_BAR; PG8_MMA(0, 0, At, B0); PG8_MMA(0, 1, At, B1); PG8_BAR; PG8_SCHED;
            PG8_LDA(At, 1, 1); PG8_STAGE(PG8_SB(1, 0), b3, voffB); PG8_STAGE(PG8_SB(1, 1), b3 + hstep, voffB); PG8_STAGE(PG8_SA(1, 0), a3, voffA);
            PG8_WAIT_V(8); PG8_WAIT_L(0); PG8_BAR; PG8_MMA(1, 0, At, B0); PG8_MMA(1, 1, At, B1); PG8_BAR; PG8_SCHED;
            } else {
            PG8_LDB(B0, 0, 0); PG8_SCHED; PG8_LDA(At, 0, 0); PG8_STAGE(PG8_SA(1, 1), a1 + hstep, voffA);
            PG8_WAIT_L(8); PG8_BAR; PG8_WAIT_L(0); PG8_MMA(0, 0, At, B0); PG8_BAR; PG8_SCHED;
            PG8_LDB(B1, 0, 1); PG8_STAGE(PG8_SB(0, 0), b2, voffB);
            PG8_BAR; PG8_WAIT_L(0); PG8_MMA(0, 1, At, B1); PG8_BAR;
            PG8_LDA(At, 0, 1); PG8_STAGE(PG8_SA(0, 0), a2, voffA);
            PG8_BAR; PG8_WAIT_L(0); PG8_MMA(1, 0, At, B0); PG8_BAR; PG8_SCHED;
            PG8_STAGE(PG8_SB(0, 1), b2 + hstep, voffB);
            PG8_WAIT_V(6); PG8_BAR; PG8_MMA(1, 1, At, B1); PG8_BAR;
            PG8_LDB(B0, 1, 0); PG8_SCHED; PG8_LDA(At, 1, 0); PG8_STAGE(PG8_SA(0, 1), a2 + hstep, voffA);
            PG8_WAIT_L(8); PG8_BAR; PG8_WAIT_L(0); PG8_MMA(0, 0, At, B0); PG8_BAR; PG8_SCHED;
            PG8_LDB(B1, 1, 1); PG8_STAGE(PG8_SB(1, 0), b3, voffB);
            PG8_BAR; PG8_WAIT_L(0); PG8_MMA(0, 1, At, B1); PG8_BAR;
            PG8_LDA(At, 1, 1); PG8_STAGE(PG8_SA(1, 0), a3, voffA);
            PG8_BAR; PG8_WAIT_L(0); PG8_MMA(1, 0, At, B0); PG8_BAR; PG8_SCHED;
            PG8_STAGE(PG8_SB(1, 1), b3 + hstep, voffB);
            PG8_WAIT_V(6); PG8_BAR; PG8_MMA(1, 1, At, B1); PG8_BAR;
            }
        }
        if constexpr (ALIGN_EPI) { if (wr == 0) PG8_BAR; }
        if constexpr (!Epi::AFTER_DRAIN) { E(acc, cur, wr, wc, fr, fq); S.done(cur); }
        if (!has_next) break;
#pragma unroll
        for (int a = 0; a < 2; ++a)
#pragma unroll
            for (int b = 0; b < 2; ++b)
#pragma unroll
                for (int m = 0; m < 4; ++m)
#pragma unroll
                    for (int n = 0; n < 2; ++n) acc[a][b][m][n] = (f32x4){0.f, 0.f, 0.f, 0.f};
        cur = nxt; cA = nA; cB = nB; ++ui;
        if constexpr (ALIGN_EPI) { if (wr == 1) PG8_BAR; }
    }
    PG8_WAIT_V(0);
    if constexpr (!ALIGN_EPI) { if (wr == 0) PG8_BAR; }
    PG8_BAR;
    if constexpr (Epi::AFTER_DRAIN) { E.fused(acc, cur, wr, wc, fr, fq, lds, wid, lane); S.done(cur); }
#undef PG8_SA
#undef PG8_SB
#undef PG8_STAGE
#undef PG8_LDA
#undef PG8_LDB
#undef PG8_MMA
#undef PG8_WAIT_V
#undef PG8_WAIT_L
#undef PG8_BAR
#undef PG8_SCHED
}
}
#ifndef PG8_SP2
#define PG8_SP2 true
#endif
#ifndef PG8_ALIGN
#define PG8_ALIGN true
#endif
constexpr int NWAVES = 8;
#ifndef MK_ONE_LAUNCH
#define MK_ONE_LAUNCH 1
#endif
constexpr int N_PHASES = 12;
#ifndef NIBBLE_SWAP_DOWN
#define NIBBLE_SWAP_DOWN 0
#endif
#ifndef I8_CFG
#define I8_CFG 1
#endif
#ifndef P4A_I8
#define P4A_I8 1
#endif
#ifndef P5_I8
#define P5_I8 1
#endif
#if I8_CFG == 0
constexpr int I8_TILES = 44, I8_CUT = 12, I8_SKIP = 24, BF_BASE = 12, BF_TILES = 24;
#elif I8_CFG == 1
constexpr int I8_TILES = 60, I8_CUT = 12, I8_SKIP = 8, BF_BASE = 12, BF_TILES = 8;
#else
constexpr int I8_TILES = 68, I8_CUT = 68, I8_SKIP = 0, BF_BASE = 12, BF_TILES = 0;
#endif

constexpr int BATCH = 4, SEQ = 4096, D = 4096, M = BATCH * SEQ;
constexpr int HD = 128, NH = 16, NKV = 4, QW = NH * HD, KVW = NKV * HD, CW = 2048, INW = 17408;
constexpr int PH = 8, NKEYS = 128, TOPK = 16, NEXP = NKEYS * NKEYS, PQW = PH * 2 * 128;
constexpr float EPS = 1e-6f;
constexpr size_t SLICE_BYTES = (size_t)NEXP * 128;
constexpr float LOG2E = 1.4426950408889634f;

constexpr size_t MiB = 1u << 20;
constexpr size_t WS_CTL = 0, CTL_ZERO_BYTES = 1 * MiB;
constexpr size_t WS_WIN = 2 * MiB;
constexpr size_t WS_WO = 138 * MiB;
constexpr size_t WS_WOUT = 170 * MiB;
constexpr size_t WS_WQP = 202 * MiB;
constexpr size_t WS_SK = 218 * MiB;
constexpr size_t WS_IDX = 220 * MiB, WS_GATE = 228 * MiB;
constexpr size_t WS_XN = 236 * MiB;
constexpr size_t WS_AB = 364 * MiB;
constexpr size_t WS_Q = 492 * MiB, WS_K = 556 * MiB, WS_V = 572 * MiB, WS_H = 588 * MiB, WS_B = 652 * MiB, WS_C = 716 * MiB;
constexpr size_t WS_GA = 780 * MiB, WS_GC = 908 * MiB;
constexpr size_t WS_T = 492 * MiB;
constexpr size_t WS_X1B = 620 * MiB;
constexpr size_t WS_X2N = 620 * MiB;
constexpr size_t WS_PART = 236 * MiB;
constexpr size_t WS_X2N8 = 492 * MiB;
constexpr size_t WS_CF4 = 780 * MiB;
constexpr size_t WS_QP = 780 * MiB;
constexpr size_t WS_W4D = 1036 * MiB, WS_W4U = 1068 * MiB;
constexpr size_t WS_SCD = 1100 * MiB, WS_SCU = WS_SCD + 65536;
constexpr size_t WS_SX = WS_SCD + 131072, WS_SW = WS_SCD + 262144;
constexpr size_t WS_XN8 = 364 * MiB;
constexpr size_t WS_W8 = 1101 * MiB;
constexpr size_t WS_W8QP = 1169 * MiB;
constexpr size_t WS_SWQ = WS_SCD + 393216, WS_SX2 = WS_SCD + 458752;
constexpr size_t WS_X2I8 = 364 * MiB;
constexpr size_t WS_W8OUT = 1177 * MiB;
constexpr size_t WS_SWO = WS_SCD + 524288, WS_SXM = WS_SCD + 589824;
constexpr size_t WS_MI8 = 364 * MiB;
constexpr size_t WS_W8OA = 1193 * MiB;
constexpr size_t WS_SWA = WS_SCD + 655360, WS_SXA = WS_SCD + 671744;
constexpr size_t WS_AI8 = 748 * MiB;
constexpr size_t WS_END = 1201 * MiB;
static_assert(WS_T + (size_t)M * D * 2 <= WS_X2N && WS_X2N + (size_t)M * D * 2 <= WS_GA && WS_QP + (size_t)M * PQW * 2 <= WS_GC, "d_ws overlays");
static_assert(WS_WIN + (size_t)INW * D * 2 <= WS_WO && WS_C + (size_t)M * CW * 2 <= WS_GA && WS_GC + (size_t)M * D * 2 <= WS_END, "d_ws map");
constexpr int CW_XRANK = 8192;
constexpr int CW_BAR = 4096;

constexpr int RING_OFF = 0, RING_BYTES = 131072;
constexpr int LDSCTL_OFF = RING_BYTES, MISC_OFF = LDSCTL_OFF + 320;
constexpr int OBUF_OFF = 132096;
constexpr int ODUMP_OFF = OBUF_OFF + 8192;
constexpr int LDS_BYTES = 147456;
static_assert(MISC_OFF + 128 <= OBUF_OFF && ODUMP_OFF + 2048 <= LDS_BYTES, "LDS map");
#define GAS __attribute__((address_space(1)))
#define LAS __attribute__((address_space(3)))
typedef unsigned short bf16;
typedef unsigned v4u __attribute__((ext_vector_type(4)));
typedef float f32x4 __attribute__((ext_vector_type(4)));
typedef short bf16x8 __attribute__((ext_vector_type(8)));
typedef GAS unsigned gu32;
typedef GAS unsigned long long gu64;
#define RLX_AGENT __ATOMIC_RELAXED, __HIP_MEMORY_SCOPE_AGENT
#define LDS_WAIT() asm volatile("s_waitcnt lgkmcnt(0)" ::: "memory")
#define VM_WAIT() asm volatile("s_waitcnt vmcnt(0)" ::: "memory")
__device__ __forceinline__ unsigned long long rt() { return __builtin_amdgcn_s_memrealtime(); }
__device__ __forceinline__ unsigned f2bf(float f) { unsigned u = __builtin_bit_cast(unsigned, f); return (u + 0x7fffu + ((u >> 16) & 1u)) >> 16; }
__device__ __forceinline__ unsigned pk2(float lo, float hi) { return f2bf(lo) | (f2bf(hi) << 16); }

#define XB_TMO      128
#define XB_XCNT(j)  (256  + 64 * (j))
#define XB_XSUB(j)  (1280 + 64 * (j))
#define XB_XGEN(j)  (2304 + 64 * (j))
#define XB_TOP      3328
#define XB_TOPGEN   3392
#define XCD_BAR_WORDS 3456
#define XB_SPIN_CAP (1u << 18)

__device__ __forceinline__ unsigned xb_ld(unsigned* p)              { return __hip_atomic_load(p, __ATOMIC_RELAXED, __HIP_MEMORY_SCOPE_AGENT); }
__device__ __forceinline__ unsigned xb_add(unsigned* p, unsigned v) { return __hip_atomic_fetch_add(p, v, __ATOMIC_RELAXED, __HIP_MEMORY_SCOPE_AGENT); }
__device__ __forceinline__ unsigned xb_xcc_id() { return (unsigned)__builtin_amdgcn_s_getreg((3 << 11) | 20) & 0xFu; }
#define XB_SPIN(cond, bar) do { unsigned _sp = 0; while (cond) { __builtin_amdgcn_s_sleep(1); \
    if ((++_sp & 255u) == 0u) { if (xb_ld(&(bar)[XB_TMO])) break; if (_sp > XB_SPIN_CAP) { atomicAdd(&(bar)[XB_TMO], 1u); break; } } } } while (0)

struct XcdBarrier {
    unsigned* bar; unsigned x;
    volatile LAS unsigned* st;
};

__device__ __forceinline__ XcdBarrier xcd_barrier_post(unsigned* bar, volatile LAS unsigned* st) {
    XcdBarrier b; b.bar = bar; b.x = xb_xcc_id(); b.st = st;
    if (threadIdx.x == 0) (void)xb_add(&bar[XB_XCNT(b.x)], 1u);
    return b;
}
__device__ __forceinline__ void xcd_barrier_complete(unsigned* bar, unsigned x, unsigned& nloc, unsigned& nx) {
    const unsigned G = gridDim.x * gridDim.y * gridDim.z;
    unsigned sum, cnt, mine, sp = 0u;
    for (;;) {
        sum = 0u; cnt = 0u; mine = 0u;
#pragma unroll
        for (unsigned j = 0; j < 16; ++j) { const unsigned c = xb_ld(&bar[XB_XCNT(j)]); sum += c; cnt += (c > 0u) ? 1u : 0u; mine = (j == x) ? c : mine; }
        if (sum == G) break;
        __builtin_amdgcn_s_sleep(1);
        if ((++sp & 255u) == 0u) { if (xb_ld(&bar[XB_TMO])) break; if (sp > XB_SPIN_CAP) { atomicAdd(&bar[XB_TMO], 1u); break; } }
    }
    nloc = mine > 0u ? mine : 1u; nx = cnt > 0u ? cnt : 1u;
}

__device__ __forceinline__ void xcd_barrier(const XcdBarrier& b) {
    asm volatile("s_waitcnt vmcnt(0)" ::: "memory");
    __syncthreads();
    if (threadIdx.x == 0) {
        unsigned* bar = b.bar;
        __builtin_amdgcn_s_waitcnt(0);
        unsigned nloc = b.st[0], nx = b.st[1];
        if (nloc == 0u) { xcd_barrier_complete(bar, b.x, nloc, nx); b.st[0] = nloc; b.st[1] = nx; }
        const unsigned old = xb_add(&bar[XB_XSUB(b.x)], 1u);
        const unsigned gen = old / nloc;
        if (old + 1u == (gen + 1u) * nloc) {
            __builtin_amdgcn_fence(__ATOMIC_RELEASE, "agent");
            asm volatile("s_waitcnt vmcnt(0)" ::: "memory");
            const unsigned og = xb_add(&bar[XB_TOP], 1u);
            const unsigned tg = og / nx;
            if (og + 1u == (tg + 1u) * nx) xb_add(&bar[XB_TOPGEN], 1u);
            else XB_SPIN(xb_ld(&bar[XB_TOPGEN]) == tg, bar);
            __builtin_amdgcn_fence(__ATOMIC_ACQUIRE, "agent");
            xb_add(&bar[XB_XGEN(b.x)], 1u);
            asm volatile("s_waitcnt vmcnt(0)" ::: "memory");
        } else {
            XB_SPIN(xb_ld(&bar[XB_XGEN(b.x)]) == gen, bar);
            __builtin_amdgcn_fence(__ATOMIC_ACQUIRE, "agent");
            asm volatile("s_waitcnt vmcnt(0)" ::: "memory");
        }
    }
    __syncthreads();
}
typedef unsigned u32x2_t __attribute__((ext_vector_type(2)));
typedef short v4i16_t __attribute__((ext_vector_type(4)));
typedef unsigned long long u64;
typedef float f32x2_t __attribute__((ext_vector_type(2)));
typedef int i32x4_t __attribute__((ext_vector_type(4)));
struct Frame {
    LAS unsigned char* lds;
    volatile LAS unsigned* MISC;
    gu32* ctl;
    unsigned char* ws;
    int tid, lane, wave;
    int vcu, G;
    const float *x, *g1, *w_in, *gq, *gk, *sink, *conv_w, *w_oa, *w_oc, *w_out, *g2, *w_qp, *subk, *w_down, *w_up;
    float* out;
};
#define WSP(type, off) ((type*)(F.ws + (off)))
using pg8::cvt_pk_bf16; using pg8::pack8; using pg8::unpack8;

__device__ __forceinline__ float wave_sum(float v) {
#pragma unroll
    for (int o = 1; o < 64; o <<= 1) v += __shfl_xor(v, o);
    return v;
}
__device__ __forceinline__ float dot4(const f32x4 a, const f32x4 b) { return (a[0] * b[0] + a[1] * b[1]) + (a[2] * b[2] + a[3] * b[3]); }
__device__ __forceinline__ float bflo(unsigned w) { return __uint_as_float(w << 16); }
__device__ __forceinline__ float bfhi(unsigned w) { return __uint_as_float(w & 0xffff0000u); }

typedef int v2i32_t __attribute__((ext_vector_type(2)));
__device__ __forceinline__ bool tr4_selfcheck(LAS unsigned char* tp, int lane) {
    const int g = lane >> 4, j = lane & 15;
    unsigned lo = 0u, hi = 0u;
#pragma unroll
    for (int c = 0; c < 8; ++c) { lo |= (unsigned)((j * 5 + c * 3 + g + 1) & 15) << (4 * c); hi |= (unsigned)((j * 5 + (c + 8) * 3 + g + 1) & 15) << (4 * c); }
    *(LAS u32x2_t*)(tp + lane * 8) = (u32x2_t){lo, hi};
    LDS_WAIT(); asm volatile("" ::: "memory");
    const v2i32_t rv = __builtin_amdgcn_ds_read_tr4_b64_v2i32((LAS v2i32_t*)(tp + lane * 8));
    bool ok = true;
#pragma unroll
    for (int e = 0; e < 8; ++e) { ok = ok && ((((unsigned)rv.x >> (4 * e)) & 15u) == (unsigned)((e * 5 + j * 3 + g + 1) & 15)) && ((((unsigned)rv.y >> (4 * e)) & 15u) == (unsigned)(((e + 8) * 5 + j * 3 + g + 1) & 15)); }
    return __all(ok);
}

__device__ __forceinline__ void p0_transpose_item(const float* W, int K, int N, bf16* WT, int row_off, LAS float* scr, int item, int lane) {
    const int nblk = N / 32, kb = item / nblk, nb = item % nblk, k0 = 64 * kb, n0 = 32 * nb;
#pragma unroll 8
    for (int i = 0; i < 32; ++i) { const int kk = 2 * i + (lane >> 5); scr[kk * 33 + (lane & 31)] = W[(size_t)(k0 + kk) * N + n0 + (lane & 31)]; }
    LDS_WAIT(); asm volatile("" ::: "memory");
    const int c = lane & 7;
#pragma unroll
    for (int j = 0; j < 4; ++j) { const int n = (lane >> 3) + 8 * j; const LAS float* s = scr + (8 * c) * 33 + n;
        v4u o; o.x = cvt_pk_bf16(s[0 * 33], s[1 * 33]); o.y = cvt_pk_bf16(s[2 * 33], s[3 * 33]); o.z = cvt_pk_bf16(s[4 * 33], s[5 * 33]); o.w = cvt_pk_bf16(s[6 * 33], s[7 * 33]);
        *(GAS v4u*)(WT + (size_t)(row_off + n0 + n) * K + k0 + 8 * c) = o; }
    LDS_WAIT(); asm volatile("" ::: "memory");
}
template <int QMODE  > __device__ __forceinline__ void rms_row_to_bf16(const float* xrow, const float* g, bf16* orow, unsigned* q8row, float* sxp, int lane) {
    const GAS f32x4* xr = (const GAS f32x4*)xrow + lane; const GAS f32x4* gr = (const GAS f32x4*)g + lane;
    f32x4 v[16]; float s = 0.f;
#pragma unroll
    for (int j = 0; j < 16; ++j) { v[j] = xr[64 * j]; s += dot4(v[j], v[j]); }
    const float r = rsqrtf(wave_sum(s) * (1.f / D) + EPS);
    GAS u32x2_t* o8 = (GAS u32x2_t*)orow + lane; float am = 0.f;
#pragma unroll
    for (int j = 0; j < 16; ++j) { v[j] = v[j] * r * gr[64 * j]; u32x2_t w; w.x = cvt_pk_bf16(v[j][0], v[j][1]); w.y = cvt_pk_bf16(v[j][2], v[j][3]); o8[64 * j] = w;
        am = fmaxf(am, fmaxf(fmaxf(fabsf(v[j][0]), fabsf(v[j][1])), fmaxf(fabsf(v[j][2]), fabsf(v[j][3])))); }
    if constexpr (QMODE == 2) {
#pragma unroll
        for (int j = 0; j < 16; ++j) { int p = 0; p = __builtin_amdgcn_cvt_pk_fp8_f32(v[j][0], v[j][1], p, false); p = __builtin_amdgcn_cvt_pk_fp8_f32(v[j][2], v[j][3], p, true); ((GAS unsigned*)q8row)[64 * j + lane] = (unsigned)p; }
    }
    if constexpr (QMODE == 1) {
#pragma unroll
        for (int o = 1; o < 64; o <<= 1) am = fmaxf(am, __shfl_xor(am, o));
        const float qs = am > 0.f ? 127.0f / am : 0.f;
#pragma unroll
        for (int j = 0; j < 16; ++j) { const int q0 = (int)__builtin_rintf(v[j][0] * qs), q1 = (int)__builtin_rintf(v[j][1] * qs), q2 = (int)__builtin_rintf(v[j][2] * qs), q3 = (int)__builtin_rintf(v[j][3] * qs);
            ((GAS unsigned*)q8row)[64 * j + lane] = (unsigned)(q0 & 255) | ((unsigned)(q1 & 255) << 8) | ((unsigned)(q2 & 255) << 16) | ((unsigned)q3 << 24); }
        if (lane == 0) *sxp = am * (1.0f / 127.0f);
    }
}
__device__ __forceinline__ void rms2_row(const bf16* xrow, const float* g, unsigned char* q8row, float* sxp, unsigned char* x4row, int lane) {
    const GAS v4u* xr = (const GAS v4u*)xrow + lane; const GAS f32x4* gr = (const GAS f32x4*)g + 2 * lane;
    f32x4 v[8][2]; float s = 0.f;
#pragma unroll
    for (int j = 0; j < 8; ++j) { unpack8(xr[64 * j], v[j][0], v[j][1]); s += dot4(v[j][0], v[j][0]) + dot4(v[j][1], v[j][1]); }
    const float r = rsqrtf(wave_sum(s) * (1.f / D) + EPS);
    float am = 0.f;
#pragma unroll
    for (int j = 0; j < 8; ++j) { v[j][0] = v[j][0] * r * gr[128 * j]; v[j][1] = v[j][1] * r * gr[128 * j + 1];
#pragma unroll
        for (int e = 0; e < 4; ++e) am = fmaxf(am, fmaxf(fabsf(v[j][0][e]), fabsf(v[j][1][e]))); }
#pragma unroll
    for (int o = 1; o < 64; o <<= 1) am = fmaxf(am, __shfl_xor(am, o));
    const float qs = am > 0.f ? 127.0f / am : 0.f;
    if (lane == 0) *sxp = am * (1.0f / 127.0f);
#pragma unroll
    for (int j = 0; j < 8; ++j) {
        const f32x4 y0 = v[j][0], y1 = v[j][1];
        { u32x2_t w;
          w.x = (unsigned)((int)__builtin_rintf(y0[0] * qs) & 255) | ((unsigned)((int)__builtin_rintf(y0[1] * qs) & 255) << 8) | ((unsigned)((int)__builtin_rintf(y0[2] * qs) & 255) << 16) | ((unsigned)(int)__builtin_rintf(y0[3] * qs) << 24);
          w.y = (unsigned)((int)__builtin_rintf(y1[0] * qs) & 255) | ((unsigned)((int)__builtin_rintf(y1[1] * qs) & 255) << 8) | ((unsigned)((int)__builtin_rintf(y1[2] * qs) & 255) << 16) | ((unsigned)(int)__builtin_rintf(y1[3] * qs) << 24);
          ((GAS u32x2_t*)q8row)[64 * j + lane] = w; }
        unsigned hi = 0u, lo = 0u;
        hi = __builtin_amdgcn_cvt_scalef32_pk_fp4_f32(hi, y0[0], y0[1], 1.0f, 0); hi = __builtin_amdgcn_cvt_scalef32_pk_fp4_f32(hi, y0[2], y0[3], 1.0f, 1);
        hi = __builtin_amdgcn_cvt_scalef32_pk_fp4_f32(hi, y1[0], y1[1], 1.0f, 2); hi = __builtin_amdgcn_cvt_scalef32_pk_fp4_f32(hi, y1[2], y1[3], 1.0f, 3);
        const f32x2_t d0 = __builtin_amdgcn_cvt_scalef32_pk_f32_fp4(hi, 1.0f, 0), d1 = __builtin_amdgcn_cvt_scalef32_pk_f32_fp4(hi, 1.0f, 1), d2 = __builtin_amdgcn_cvt_scalef32_pk_f32_fp4(hi, 1.0f, 2), d3 = __builtin_amdgcn_cvt_scalef32_pk_f32_fp4(hi, 1.0f, 3);
        lo = __builtin_amdgcn_cvt_scalef32_pk_fp4_f32(lo, (y0[0] - d0.x) * 8.f, (y0[1] - d0.y) * 8.f, 1.0f, 0); lo = __builtin_amdgcn_cvt_scalef32_pk_fp4_f32(lo, (y0[2] - d1.x) * 8.f, (y0[3] - d1.y) * 8.f, 1.0f, 1);
        lo = __builtin_amdgcn_cvt_scalef32_pk_fp4_f32(lo, (y1[0] - d2.x) * 8.f, (y1[1] - d2.y) * 8.f, 1.0f, 2); lo = __builtin_amdgcn_cvt_scalef32_pk_fp4_f32(lo, (y1[2] - d3.x) * 8.f, (y1[3] - d3.y) * 8.f, 1.0f, 3);
        unsigned char* const xd = x4row + (size_t)(2 * j + (lane >> 5)) * ((size_t)M * 256) + (lane & 31) * 4;
        *(GAS unsigned*)xd = hi; *(GAS unsigned*)(xd + 128) = lo;
    }
}
__device__ __forceinline__ void quant_w8(Frame& F) {
    const int gw = F.vcu * NWAVES + F.wave, NGW = F.G * NWAVES, lane = F.lane;
    for (int nn = gw; nn < INW + PQW + (P5_I8 ? D : 0); nn += NGW) {
        const int seg = nn >= INW + PQW ? 2 : nn >= INW ? 1 : 0; const bool qp = seg != 0; const int n = seg == 2 ? nn - INW - PQW : seg == 1 ? nn - INW : nn;
        if (!qp && n >= BF_BASE * 256 && n < (BF_BASE + BF_TILES) * 256) continue;
        const GAS v4u* src = (const GAS v4u*)((seg == 2 ? WSP(const bf16, WS_WOUT) : seg == 1 ? WSP(const bf16, WS_WQP) : WSP(const bf16, WS_WIN)) + (size_t)n * D) + lane;
        f32x4 lo[8], hi[8]; float am = 0.f;
#pragma unroll
        for (int j = 0; j < 8; ++j) { unpack8(src[64 * j], lo[j], hi[j]);
            am = fmaxf(am, fmaxf(fmaxf(fmaxf(fabsf(lo[j][0]), fabsf(lo[j][1])), fmaxf(fabsf(lo[j][2]), fabsf(lo[j][3]))), fmaxf(fmaxf(fabsf(hi[j][0]), fabsf(hi[j][1])), fmaxf(fabsf(hi[j][2]), fabsf(hi[j][3]))))); }
#pragma unroll
        for (int o = 1; o < 64; o <<= 1) am = fmaxf(am, __shfl_xor(am, o));
        const float qs = am > 0.f ? 127.0f / am : 0.f;
        GAS u32x2_t* dst = (GAS u32x2_t*)(F.ws + (seg == 2 ? WS_W8OUT : seg == 1 ? WS_W8QP : WS_W8) + (size_t)n * D) + lane;
#pragma unroll
        for (int j = 0; j < 8; ++j) { u32x2_t w;
            w.x = (unsigned)((int)__builtin_rintf(lo[j][0] * qs) & 255) | ((unsigned)((int)__builtin_rintf(lo[j][1] * qs) & 255) << 8) | ((unsigned)((int)__builtin_rintf(lo[j][2] * qs) & 255) << 16) | ((unsigned)(int)__builtin_rintf(lo[j][3] * qs) << 24);
            w.y = (unsigned)((int)__builtin_rintf(hi[j][0] * qs) & 255) | ((unsigned)((int)__builtin_rintf(hi[j][1] * qs) & 255) << 8) | ((unsigned)((int)__builtin_rintf(hi[j][2] * qs) & 255) << 16) | ((unsigned)(int)__builtin_rintf(hi[j][3] * qs) << 24);
            dst[64 * j] = w; }
        if (lane == 0) (seg == 2 ? WSP(float, WS_SWO) : seg == 1 ? WSP(float, WS_SWQ) : WSP(float, WS_SW))[n] = am * (1.0f / 127.0f);
    }
}
template <int NJ  > __device__ __forceinline__ void quant_row_i8(const bf16* xrow, unsigned char* q8row, float* sxp, int lane) {
    const GAS v4u* xr = (const GAS v4u*)xrow + lane;
    v4u w[NJ]; f32x4 v[NJ][2]; float am = 0.f;
#pragma unroll
    for (int j = 0; j < NJ; ++j) w[j] = xr[64 * j];
#pragma unroll
    for (int j = 0; j < NJ; ++j) { unpack8(w[j], v[j][0], v[j][1]);
#pragma unroll
        for (int e = 0; e < 4; ++e) am = fmaxf(am, fmaxf(fabsf(v[j][0][e]), fabsf(v[j][1][e]))); }
#pragma unroll
    for (int o = 1; o < 64; o <<= 1) am = fmaxf(am, __shfl_xor(am, o));
    const float qs = am > 0.f ? 127.0f / am : 0.f;
    if (lane == 0) *sxp = am * (1.0f / 127.0f);
#pragma unroll
    for (int j = 0; j < NJ; ++j) { const f32x4 y0 = v[j][0], y1 = v[j][1]; u32x2_t q;
        q.x = (unsigned)((int)__builtin_rintf(y0[0] * qs) & 255) | ((unsigned)((int)__builtin_rintf(y0[1] * qs) & 255) << 8) | ((unsigned)((int)__builtin_rintf(y0[2] * qs) & 255) << 16) | ((unsigned)(int)__builtin_rintf(y0[3] * qs) << 24);
        q.y = (unsigned)((int)__builtin_rintf(y1[0] * qs) & 255) | ((unsigned)((int)__builtin_rintf(y1[1] * qs) & 255) << 8) | ((unsigned)((int)__builtin_rintf(y1[2] * qs) & 255) << 16) | ((unsigned)(int)__builtin_rintf(y1[3] * qs) << 24);
        ((GAS u32x2_t*)q8row)[64 * j + lane] = q; }
}
__device__ __forceinline__ void quant_w8_oa(Frame& F) {
    const int gw = F.vcu * NWAVES + F.wave, NGW = F.G * NWAVES;
    for (int n = gw; n < D; n += NGW) quant_row_i8<4>(WSP(const bf16, WS_WO) + (size_t)n * QW, F.ws + WS_W8OA + (size_t)n * QW, WSP(float, WS_SWA) + n, F.lane);
}
__device__ __forceinline__ void p0_prologue(Frame& F) {
    LAS float* scr = (LAS float*)(F.lds + RING_OFF + F.wave * 16384);
    const int gw = F.vcu * NWAVES + F.wave, NGW = F.G * NWAVES;
    constexpr int I_IN = (D / 64) * (INW / 32), I_OA = (QW / 64) * (D / 32), I_OC = (CW / 64) * (D / 32), I_OUT = (D / 64) * (D / 32), I_QP = (D / 64) * (PQW / 32);
    constexpr int NITEMS = I_IN + I_OA + I_OC + I_OUT + I_QP;
    bf16* Win_t = WSP(bf16, WS_WIN); bf16* Wo_t = WSP(bf16, WS_WO); bf16* Wout_t = WSP(bf16, WS_WOUT); bf16* Wqp_t = WSP(bf16, WS_WQP);
    for (int it = gw; it < NITEMS; it += NGW) {
        int r = it;
        if (r < I_IN) { p0_transpose_item(F.w_in, D, INW, Win_t, 0, scr, r, F.lane); continue; } r -= I_IN;
        if (r < I_OA) { p0_transpose_item(F.w_oa, QW, D, Wo_t, 0, scr, r, F.lane); continue; } r -= I_OA;
        if (r < I_OC) { p0_transpose_item(F.w_oc, CW, D, Wo_t, D, scr, r, F.lane); continue; } r -= I_OC;
        if (r < I_OUT) { p0_transpose_item(F.w_out, D, D, Wout_t, 0, scr, r, F.lane); continue; } r -= I_OUT;
        p0_transpose_item(F.w_qp, D, PQW, Wqp_t, 0, scr, r, F.lane);
    }
    {
        bf16* SK = WSP(bf16, WS_SK); const int nth = F.G * NWAVES * 64, gt = gw * 64 + F.lane;
        for (int i = gt; i < PH * 2 * NKEYS * 128 / 4; i += nth) { const f32x4 v = ((const GAS f32x4*)F.subk)[i]; u32x2_t w; w.x = cvt_pk_bf16(v[0], v[1]); w.y = cvt_pk_bf16(v[2], v[3]); ((GAS u32x2_t*)SK)[i] = w; }
    }
    bf16* XN = WSP(bf16, WS_XN);
    for (int m = gw; m < M; m += NGW) rms_row_to_bf16<1>(F.x + (size_t)m * D, F.g1, XN + (size_t)m * D, (unsigned*)(F.ws + WS_XN8 + (size_t)m * D), WSP(float, WS_SX) + m, F.lane);
    for (int r = gw; r < 2 * NEXP; r += NGW) {
        const bool up = r >= NEXP; const int rr = up ? r - NEXP : r;
        const GAS f32x4* src = (const GAS f32x4*)((up ? F.w_up : F.w_down) + (size_t)rr * D) + 2 * F.lane;
        f32x4 v[16]; float am = 0.f;
#pragma unroll
        for (int i = 0; i < 8; ++i) { v[2 * i] = src[128 * i]; v[2 * i + 1] = src[128 * i + 1]; }
#pragma unroll
        for (int i = 0; i < 16; ++i) am = fmaxf(am, fmaxf(fmaxf(fabsf(v[i][0]), fabsf(v[i][1])), fmaxf(fabsf(v[i][2]), fabsf(v[i][3]))));
#pragma unroll
        for (int o = 1; o < 64; o <<= 1) am = fmaxf(am, __shfl_xor(am, o));
        const float sc = am > 0.f ? 6.0f / am : 1.0f;
        unsigned char* const dstb = F.ws + (up ? WS_W4U : WS_W4D) + (size_t)rr * 128 + (size_t)(F.lane >> 5) * SLICE_BYTES + (F.lane & 31) * 4;
#pragma unroll
        for (int i = 0; i < 8; ++i) { unsigned p = 0u;
            if (NIBBLE_SWAP_DOWN && !up) {
            p = __builtin_amdgcn_cvt_scalef32_pk_fp4_f32(p, v[2 * i][1] * sc, v[2 * i][0] * sc, 1.0f, 0); p = __builtin_amdgcn_cvt_scalef32_pk_fp4_f32(p, v[2 * i][3] * sc, v[2 * i][2] * sc, 1.0f, 1);
            p = __builtin_amdgcn_cvt_scalef32_pk_fp4_f32(p, v[2 * i + 1][1] * sc, v[2 * i + 1][0] * sc, 1.0f, 2); p = __builtin_amdgcn_cvt_scalef32_pk_fp4_f32(p, v[2 * i + 1][3] * sc, v[2 * i + 1][2] * sc, 1.0f, 3);
            } else {
            p = __builtin_amdgcn_cvt_scalef32_pk_fp4_f32(p, v[2 * i][0] * sc, v[2 * i][1] * sc, 1.0f, 0); p = __builtin_amdgcn_cvt_scalef32_pk_fp4_f32(p, v[2 * i][2] * sc, v[2 * i][3] * sc, 1.0f, 1);
            p = __builtin_amdgcn_cvt_scalef32_pk_fp4_f32(p, v[2 * i + 1][0] * sc, v[2 * i + 1][1] * sc, 1.0f, 2); p = __builtin_amdgcn_cvt_scalef32_pk_fp4_f32(p, v[2 * i + 1][2] * sc, v[2 * i + 1][3] * sc, 1.0f, 3);
            }
            *(GAS unsigned*)(dstb + (size_t)(2 * i) * SLICE_BYTES) = p; }
        if (F.lane == 0) WSP(float, up ? WS_SCU : WS_SCD)[rr] = am > 0.f ? am * (1.0f / 6.0f) : 1.0f;
    }
}

__device__ __forceinline__ unsigned off_b(unsigned row, unsigned ch) { return 256u * row + 16u * (ch ^ (((row & 3u) << 2) | ((row >> 2) & 3u))); }
__device__ __forceinline__ unsigned tr_addr16(unsigned lane, unsigned c, unsigned ks, unsigned t) {
    const unsigned g = lane >> 4, q = (lane & 15u) >> 2, p = lane & 3u;
    return off_b(32u * ks + 8u * g + 4u * t + q, 2u * c + (p >> 1)) + 8u * (p & 1u);
}
__device__ __forceinline__ v4i16_t tr_read(LAS unsigned char* p) { return __builtin_amdgcn_ds_read_tr16_b64_v4i16((LAS v4i16_t*)p); }
#define MFMA16(a, b, c) __builtin_amdgcn_mfma_f32_16x16x32_bf16((a), (b), (c), 0, 0, 0)

template <int PROBE> __device__ __forceinline__ void attn_unit(Frame& F, const int U) {
    const int lane = F.lane, wave = F.wave, c = lane & 15, hg = lane >> 4, tid = F.tid;
    const int hp = U & 1, kvh = (U >> 1) & 3, nblk = (U >> 3) & 31, b = U >> 8;
    const int hq = kvh * 4 + hp * 2 + (wave >> 2), i0 = (wave & 3) * 32;
    const size_t tok0 = (size_t)b * SEQ + (size_t)nblk * 128;
    const bf16* QB = WSP(const bf16, WS_Q); const bf16* KB = WSP(const bf16, WS_K); const bf16* VB = WSP(const bf16, WS_V); bf16* OB = PROBE ? WSP(bf16, WS_XN) : WSP(bf16, WS_AB);
    bf16x8 qf[2][4];
    {
        float g[4][8];
#pragma unroll
        for (int ks = 0; ks < 4; ++ks) { const f32x4 a = *(const GAS f32x4*)(F.gq + 32 * ks + 8 * hg), bb = *(const GAS f32x4*)(F.gq + 32 * ks + 8 * hg + 4);
#pragma unroll
            for (int e = 0; e < 4; ++e) { g[ks][e] = a[e]; g[ks][4 + e] = bb[e]; } }
#pragma unroll
        for (int qt = 0; qt < 2; ++qt) {
            const bf16* qrow = QB + (tok0 + i0 + 16 * qt + c) * QW + hq * HD + 8 * hg;
            f32x4 lo[4], hi[4]; float ss = 0.f;
#pragma unroll
            for (int ks = 0; ks < 4; ++ks) { unpack8(*(const GAS v4u*)(qrow + 32 * ks), lo[ks], hi[ks]); ss += dot4(lo[ks], lo[ks]) + dot4(hi[ks], hi[ks]); }
            ss += __shfl_xor(ss, 16); ss += __shfl_xor(ss, 32);
            const float r = rsqrtf(ss * (1.f / HD) + EPS) * (0.08838834764831845f * LOG2E);
#pragma unroll
            for (int ks = 0; ks < 4; ++ks) { f32x4 a, bb;
#pragma unroll
                for (int e = 0; e < 4; ++e) { a[e] = lo[ks][e] * r * g[ks][e]; bb[e] = hi[ks][e] * r * g[ks][4 + e]; }
                qf[qt][ks] = __builtin_bit_cast(bf16x8, pack8(a, bb)); }
        }
    }
    const float slope2 = __builtin_amdgcn_exp2f(-0.5f * (float)(hq + 1)) * LOG2E;
    const float sink2 = F.sink[hq] * LOG2E;
    float mrun[2] = {sink2, sink2}, lrun[2]; lrun[0] = lrun[1] = (hg == 0) ? 1.f : 0.f;
    f32x4 acc[8][2];
#pragma unroll
    for (int dt = 0; dt < 8; ++dt) { acc[dt][0] = (f32x4){0.f, 0.f, 0.f, 0.f}; acc[dt][1] = (f32x4){0.f, 0.f, 0.f, 0.f}; }
    const f32x4 gk0 = *(const GAS f32x4*)(F.gk + (tid & 15) * 8), gk1 = *(const GAS f32x4*)(F.gk + (tid & 15) * 8 + 4);
    __syncthreads();
    int bufi = 0;
#pragma unroll 1
    for (int kbi = -1; kbi <= 1; ++kbi) {
        const int kb = nblk + kbi; if (kb < 0 || kb >= SEQ / 128) continue;
        LAS unsigned char* Kl = F.lds + RING_OFF + bufi * 65536; LAS unsigned char* Vl = Kl + 32768; bufi ^= 1;
#pragma unroll
        for (int it = 0; it < (PROBE == 3 ? 0 : 4); ++it) {
            const int row = (tid >> 4) + 32 * it, ch = tid & 15;
            const size_t src = ((size_t)b * SEQ + (size_t)kb * 128 + row) * KVW + kvh * HD + ch * 8;
            f32x4 k0, k1; unpack8(*(const GAS v4u*)(KB + src), k0, k1);
            float ss = dot4(k0, k0) + dot4(k1, k1);
            ss += __shfl_xor(ss, 1); ss += __shfl_xor(ss, 2); ss += __shfl_xor(ss, 4); ss += __shfl_xor(ss, 8);
            const float r = rsqrtf(ss * (1.f / HD) + EPS);
            *(LAS v4u*)(Kl + off_b(row, ch)) = pack8(k0 * r * gk0, k1 * r * gk1);
            *(LAS v4u*)(Vl + off_b(row, ch)) = *(const GAS v4u*)(VB + src);
        }
        __syncthreads();
        const int ks_lo = kbi < 0 ? (i0 >> 5) : 0, ks_hi = kbi > 0 ? (i0 >> 5) + 1 : 4;
#pragma unroll 2
        for (int ks32 = (PROBE == 2 ? ks_hi : ks_lo); ks32 < ks_hi; ++ks32) {
            f32x4 sa[2], sb[2];
            sa[0] = sa[1] = sb[0] = sb[1] = (f32x4){0.f, 0.f, 0.f, 0.f};
            const unsigned krow = 32u * ks32 + 8u * (c >> 2) + (c & 3);
#pragma unroll
            for (int ks = 0; ks < 4; ++ks) {
                const bf16x8 ka = *(const LAS bf16x8*)(Kl + off_b(krow, 4 * ks + hg)), kb2 = *(const LAS bf16x8*)(Kl + off_b(krow + 4, 4 * ks + hg));
#pragma unroll
                for (int qt = 0; qt < 2; ++qt) { sa[qt] = MFMA16(ka, qf[qt][ks], sa[qt]); sb[qt] = MFMA16(kb2, qf[qt][ks], sb[qt]); }
            }
            bf16x8 pf[2];
#pragma unroll
            for (int qt = 0; qt < 2; ++qt) {
                float s[8] = {sa[qt][0], sa[qt][1], sa[qt][2], sa[qt][3], sb[qt][0], sb[qt][1], sb[qt][2], sb[qt][3]};
                const int rel0 = kbi * 128 + 32 * ks32 + 8 * hg - (i0 + 16 * qt + c);
                float mx = -INFINITY;
#pragma unroll
                for (int j = 0; j < 8; ++j) { const int rel = rel0 + j, dist = rel < 0 ? -rel : rel; const float sv = s[j] - slope2 * (float)dist; s[j] = (dist <= 128) ? sv : -INFINITY; mx = fmaxf(mx, s[j]); }
                mx = fmaxf(mx, __shfl_xor(mx, 16)); mx = fmaxf(mx, __shfl_xor(mx, 32));
                const float mn = fmaxf(mrun[qt], mx), alpha = __builtin_amdgcn_exp2f(mrun[qt] - mn); mrun[qt] = mn;
                float ps = 0.f;
#pragma unroll
                for (int j = 0; j < 8; ++j) { s[j] = __builtin_amdgcn_exp2f(s[j] - mn); ps += s[j]; }
                lrun[qt] = lrun[qt] * alpha + ps;
                pf[qt] = __builtin_bit_cast(bf16x8, pack8((f32x4){s[0], s[1], s[2], s[3]}, (f32x4){s[4], s[5], s[6], s[7]}));
#pragma unroll
                for (int dt = 0; dt < 8; ++dt) acc[dt][qt] = acc[dt][qt] * alpha;
            }
#pragma unroll
            for (int dt = 0; dt < 8; ++dt) {
                const v4i16_t vlo = tr_read(Vl + tr_addr16(lane, dt, ks32, 0)), vhi = tr_read(Vl + tr_addr16(lane, dt, ks32, 1));
                const bf16x8 vf = {vlo[0], vlo[1], vlo[2], vlo[3], vhi[0], vhi[1], vhi[2], vhi[3]};
#pragma unroll
                for (int qt = 0; qt < 2; ++qt) acc[dt][qt] = MFMA16(vf, pf[qt], acc[dt][qt]);
            }
        }
    }
#pragma unroll
    for (int qt = 0; qt < 2; ++qt) {
        float l = lrun[qt]; l += __shfl_xor(l, 16); l += __shfl_xor(l, 32);
        const float inv = 1.0f / l;
        bf16* orow = OB + (tok0 + i0 + 16 * qt + c) * QW + hq * HD + 4 * hg;
#pragma unroll
        for (int dt = 0; dt < 8; ++dt) { const f32x4 o = acc[dt][qt] * inv; u32x2_t w; w.x = cvt_pk_bf16(o[0], o[1]); w.y = cvt_pk_bf16(o[2], o[3]); *(GAS u32x2_t*)(orow + 16 * dt) = w; }
    }
}
__device__ __forceinline__ int attn_i0(int wave) { return ((wave & 4) ? 3 - (wave & 3) : (wave & 3)) * 32; }
__device__ __forceinline__ int attn_unit_of(const Frame& F, int un) { const int U = (F.vcu + (un >> 2) * F.G) * 4 + (un & 3); return U < BATCH * 32 * NKV * 2 ? U : -1; }
__device__ __forceinline__ bool attn_next(const Frame& F, int& un, int& kbi) {
    for (;;) {
        ++kbi; if (kbi > 1) { ++un; kbi = -1; }
        const int U = attn_unit_of(F, un); if (U < 0) return false;
        const int kb = ((U >> 3) & 31) + kbi; if (kb >= 0 && kb < SEQ / 128) return true;
    }
}
__device__ __forceinline__ void attn_kv_issue(Frame& F, int U, int kbi, LAS unsigned char* Kl) {
    const int lane = F.lane, kvh = (U >> 1) & 3, nblk = (U >> 3) & 31, b = U >> 8, kb = nblk + kbi;
    const bf16* KB = WSP(const bf16, WS_K); const bf16* VB = WSP(const bf16, WS_V);
    const size_t base = ((size_t)b * SEQ + (size_t)kb * 128) * KVW + kvh * HD;
    const unsigned sw = ((unsigned)(lane >> 4) << 2) | ((unsigned)F.wave & 3u), ch = ((unsigned)lane & 15u) ^ sw;
#pragma unroll
    for (int it = 0; it < 4; ++it) { const int blk = F.wave + 8 * it, row = 4 * blk + (lane >> 4); const size_t src = base + (size_t)row * KVW + ch * 8;
        __builtin_amdgcn_global_load_lds((const unsigned*)(KB + src), (LAS unsigned*)(Kl + blk * 1024), 16, 0, 0);
        __builtin_amdgcn_global_load_lds((const unsigned*)(VB + src), (LAS unsigned*)(Kl + 32768 + blk * 1024), 16, 0, 0); }
}
__device__ __forceinline__ void attn_k_norm(Frame& F, LAS unsigned char* Kl, const LAS float* gkl) {
    const int lane = F.lane;
    const unsigned sw = ((unsigned)(lane >> 4) << 2) | ((unsigned)F.wave & 3u), ch = ((unsigned)lane & 15u) ^ sw;
    const f32x4 gk0 = *(const LAS f32x4*)(gkl + ch * 8), gk1 = *(const LAS f32x4*)(gkl + ch * 8 + 4);
    v4u kr[4];
#pragma unroll
    for (int it = 0; it < 4; ++it) kr[it] = *(const LAS v4u*)(Kl + (F.wave + 8 * it) * 1024 + lane * 16);
#pragma unroll
    for (int it = 0; it < 4; ++it) {
        f32x4 k0, k1; unpack8(kr[it], k0, k1);
        float ss = dot4(k0, k0) + dot4(k1, k1);
        ss += __shfl_xor(ss, 1); ss += __shfl_xor(ss, 2); ss += __shfl_xor(ss, 4); ss += __shfl_xor(ss, 8);
        const float r = rsqrtf(ss * (1.f / HD) + EPS);
        *(LAS v4u*)(Kl + (F.wave + 8 * it) * 1024 + lane * 16) = pack8(k0 * r * gk0, k1 * r * gk1); }
}
__device__ __forceinline__ void attn_q_issue(Frame& F, int U, v4u (&qr)[2][4]) {
    const int lane = F.lane, wave = F.wave, c = lane & 15, hg = lane >> 4;
    const int hp = U & 1, kvh = (U >> 1) & 3, nblk = (U >> 3) & 31, b = U >> 8, hq = kvh * 4 + hp * 2 + (wave >> 2), i0 = attn_i0(wave);
    const size_t tok0 = (size_t)b * SEQ + (size_t)nblk * 128;
    const bf16* QB = WSP(const bf16, WS_Q);
#pragma unroll
    for (int qt = 0; qt < 2; ++qt) { const bf16* qrow = QB + (tok0 + i0 + 16 * qt + c) * QW + hq * HD + 8 * hg;
#pragma unroll
        for (int ks = 0; ks < 4; ++ks) qr[qt][ks] = *(const GAS v4u*)(qrow + 32 * ks); }
}
__device__ __forceinline__ void attn_block(Frame& F, const LAS unsigned char* Kl, int kbi, const bf16x8 (&qf)[2][4], float slope2, float (&mrun)[2], float (&lrun)[2], f32x4 (&acc)[8][2]) {
    const int lane = F.lane, c = lane & 15, hg = lane >> 4, i0 = attn_i0(F.wave);
    const LAS unsigned char* Vl = Kl + 32768;
    const int ks_lo = kbi < 0 ? (i0 >> 5) : 0, ks_hi = kbi > 0 ? (i0 >> 5) + 1 : 4;
#pragma unroll 1
    for (int ks32 = ks_lo; ks32 < ks_hi; ++ks32) {
        f32x4 sa[2], sb[2];
        sa[0] = sa[1] = sb[0] = sb[1] = (f32x4){0.f, 0.f, 0.f, 0.f};
        const unsigned krow = 32u * ks32 + 8u * (c >> 2) + (c & 3);
#pragma unroll
        for (int ks = 0; ks < 4; ++ks) {
            const bf16x8 ka = *(const LAS bf16x8*)(Kl + off_b(krow, 4 * ks + hg)), kb2 = *(const LAS bf16x8*)(Kl + off_b(krow + 4, 4 * ks + hg));
#pragma unroll
            for (int qt = 0; qt < 2; ++qt) { sa[qt] = MFMA16(ka, qf[qt][ks], sa[qt]); sb[qt] = MFMA16(kb2, qf[qt][ks], sb[qt]); }
        }
        bf16x8 pf[2];
#pragma unroll
        for (int qt = 0; qt < 2; ++qt) {
            float sv8[8] = {sa[qt][0], sa[qt][1], sa[qt][2], sa[qt][3], sb[qt][0], sb[qt][1], sb[qt][2], sb[qt][3]};
            const int rel0 = kbi * 128 + 32 * ks32 + 8 * hg - (i0 + 16 * qt + c);
            float mx = -INFINITY;
#pragma unroll
            for (int j = 0; j < 8; ++j) { const int rel = rel0 + j, dist = rel < 0 ? -rel : rel; const float sv = sv8[j] - slope2 * (float)dist; sv8[j] = (dist <= 128) ? sv : -INFINITY; mx = fmaxf(mx, sv8[j]); }
            mx = fmaxf(mx, __shfl_xor(mx, 16)); mx = fmaxf(mx, __shfl_xor(mx, 32));
            const float mn = fmaxf(mrun[qt], mx), alpha = __builtin_amdgcn_exp2f(mrun[qt] - mn); mrun[qt] = mn;
            float ps = 0.f;
#pragma unroll
            for (int j = 0; j < 8; ++j) { sv8[j] = __builtin_amdgcn_exp2f(sv8[j] - mn); ps += sv8[j]; }
            lrun[qt] = lrun[qt] * alpha + ps;
            pf[qt] = __builtin_bit_cast(bf16x8, pack8((f32x4){sv8[0], sv8[1], sv8[2], sv8[3]}, (f32x4){sv8[4], sv8[5], sv8[6], sv8[7]}));
#pragma unroll
            for (int dt = 0; dt < 8; ++dt) acc[dt][qt] = acc[dt][qt] * alpha;
        }
#pragma unroll
        for (int h = 0; h < 2; ++h) {
            v4i16_t vlo[4], vhi[4];
#pragma unroll
            for (int d = 0; d < 4; ++d) {
                asm volatile("ds_read_b64_tr_b16 %0, %1" : "=v"(vlo[d]) : "v"((unsigned)(size_t)Vl + tr_addr16(lane, 4 * h + d, ks32, 0)));
                asm volatile("ds_read_b64_tr_b16 %0, %1" : "=v"(vhi[d]) : "v"((unsigned)(size_t)Vl + tr_addr16(lane, 4 * h + d, ks32, 1))); }
            asm volatile("s_waitcnt lgkmcnt(0)" : "+v"(vlo[0]), "+v"(vhi[0]), "+v"(vlo[1]), "+v"(vhi[1]), "+v"(vlo[2]), "+v"(vhi[2]), "+v"(vlo[3]), "+v"(vhi[3]) :: "memory");
#pragma unroll
            for (int d = 0; d < 4; ++d) { const bf16x8 vf = {vlo[d][0], vlo[d][1], vlo[d][2], vlo[d][3], vhi[d][0], vhi[d][1], vhi[d][2], vhi[d][3]};
#pragma unroll
                for (int qt = 0; qt < 2; ++qt) acc[4 * h + d][qt] = MFMA16(vf, pf[qt], acc[4 * h + d][qt]); }
        }
    }
}
__device__ __forceinline__ void attn_phase(Frame& F) {
    const int lane = F.lane, wave = F.wave, c = lane & 15, hg = lane >> 4, tid = F.tid, i0 = attn_i0(wave);
    LAS float* gql = (LAS float*)(F.lds + OBUF_OFF);
    LAS float* gkl = gql + 128;
    if (tid < 128) gql[tid] = F.gq[tid]; else if (tid < 256) gql[tid] = F.gk[tid - 128]; else if (tid < 256 + NH) gql[tid] = F.sink[tid - 256];
    int un = 0, kbi = -2;
    if (!attn_next(F, un, kbi)) return;
    v4u qr[2][4];
    attn_q_issue(F, attn_unit_of(F, un), qr);
    attn_kv_issue(F, attn_unit_of(F, un), kbi, F.lds + RING_OFF);
    __syncthreads();
    asm volatile("s_waitcnt vmcnt(0)" ::: "memory");
    attn_k_norm(F, F.lds + RING_OFF, gkl);
    asm volatile("s_waitcnt lgkmcnt(0)" ::: "memory"); __builtin_amdgcn_s_barrier(); asm volatile("" ::: "memory");
    int bufi = 0; bool first = true;
    bf16x8 qf[2][4]; float slope2 = 0.f, mrun[2] = {0.f, 0.f}, lrun[2] = {0.f, 0.f}; f32x4 acc[8][2];
#pragma unroll 1
    for (;;) {
        const int U = attn_unit_of(F, un);
        int nun = un, nkbi = kbi; const bool has_next = attn_next(F, nun, nkbi);
        if (first) {
            const int hp = U & 1, kvh = (U >> 1) & 3, hq = kvh * 4 + hp * 2 + (wave >> 2);
#pragma unroll
            for (int qt = 0; qt < 2; ++qt) {
                f32x4 lo[4], hi[4]; float ss = 0.f;
#pragma unroll
                for (int ks = 0; ks < 4; ++ks) { unpack8(qr[qt][ks], lo[ks], hi[ks]); ss += dot4(lo[ks], lo[ks]) + dot4(hi[ks], hi[ks]); }
                ss += __shfl_xor(ss, 16); ss += __shfl_xor(ss, 32);
                const float r = rsqrtf(ss * (1.f / HD) + EPS) * (0.08838834764831845f * LOG2E);
#pragma unroll
                for (int ks = 0; ks < 4; ++ks) { const f32x4 ga = *(const LAS f32x4*)(gql + 32 * ks + 8 * hg), gb = *(const LAS f32x4*)(gql + 32 * ks + 8 * hg + 4);
                    qf[qt][ks] = __builtin_bit_cast(bf16x8, pack8(lo[ks] * r * ga, hi[ks] * r * gb)); }
            }
            slope2 = __builtin_amdgcn_exp2f(-0.5f * (float)(hq + 1)) * LOG2E;
            const float sink2 = gql[256 + hq] * LOG2E;
            mrun[0] = mrun[1] = sink2; lrun[0] = lrun[1] = (hg == 0) ? 1.f : 0.f;
#pragma unroll
            for (int dt = 0; dt < 8; ++dt) { acc[dt][0] = (f32x4){0.f, 0.f, 0.f, 0.f}; acc[dt][1] = (f32x4){0.f, 0.f, 0.f, 0.f}; }
        }
        __builtin_amdgcn_sched_barrier(0);
        attn_kv_issue(F, attn_unit_of(F, has_next ? nun : un), has_next ? nkbi : kbi, F.lds + RING_OFF + (bufi ^ 1) * 65536);
        const bool last = !has_next || nun != un;
        __builtin_amdgcn_sched_barrier(0);
        attn_block(F, F.lds + RING_OFF + bufi * 65536, kbi, qf, slope2, mrun, lrun, acc);
        __builtin_amdgcn_sched_barrier(0);
        if (last) {
            if (has_next) attn_q_issue(F, attn_unit_of(F, nun), qr);
            __builtin_amdgcn_sched_barrier(0);
            const int hp = U & 1, kvh = (U >> 1) & 3, nblk = (U >> 3) & 31, b = U >> 8, hq = kvh * 4 + hp * 2 + (wave >> 2);
            const size_t tok0 = (size_t)b * SEQ + (size_t)nblk * 128;
            bf16* OB = WSP(bf16, WS_AB);
#pragma unroll
            for (int qt = 0; qt < 2; ++qt) {
                float l = lrun[qt]; l += __shfl_xor(l, 16); l += __shfl_xor(l, 32);
                const float inv = 1.0f / l;
                bf16* orow = OB + (tok0 + i0 + 16 * qt + c) * QW + hq * HD + 4 * hg;
#pragma unroll
                for (int dt = 0; dt < 8; ++dt) { const f32x4 o = acc[dt][qt] * inv; u32x2_t w; w.x = cvt_pk_bf16(o[0], o[1]); w.y = cvt_pk_bf16(o[2], o[3]); *(GAS u32x2_t*)(orow + 16 * dt) = w; }
            }
        }
        if (!has_next) { asm volatile("s_waitcnt vmcnt(0)" ::: "memory"); break; }
        __builtin_amdgcn_sched_barrier(0);
        if (last) asm volatile("s_waitcnt vmcnt(24)" ::: "memory"); else asm volatile("s_waitcnt vmcnt(0)" ::: "memory");
        __builtin_amdgcn_sched_barrier(0);
        attn_k_norm(F, F.lds + RING_OFF + (bufi ^ 1) * 65536, gkl);
        asm volatile("s_waitcnt lgkmcnt(0)" ::: "memory"); __builtin_amdgcn_s_barrier(); asm volatile("" ::: "memory");
        bufi ^= 1; first = last; un = nun; kbi = nkbi;
    }
    __syncthreads();
}
constexpr int CONV_T = 8;
__device__ __forceinline__ void conv_phase(Frame& F) {
    const bf16* HB = WSP(const bf16, WS_H); const bf16* BB = WSP(const bf16, WS_B); const bf16* CB = WSP(const bf16, WS_C); bf16* OC = WSP(bf16, WS_AB) + (size_t)M * CW;
    const unsigned nitem = (unsigned)(M / CONV_T) * (CW / 8);
    for (unsigned e = (unsigned)F.vcu * 512u + (unsigned)F.tid; e < nitem; e += (unsigned)F.G * 512u) {
        const int t0 = (int)(e >> 8) * CONV_T, cc = (int)(e & 255u) * 8, tl0 = t0 & (SEQ - 1);
        const size_t o = (size_t)t0 * CW + cc;
        const bool has_prev = tl0 > 0, has_next = tl0 + CONV_T < SEQ;
        v4u hw[CONV_T + 2], cw[CONV_T + 2], bw[CONV_T];
        hw[0] = cw[0] = hw[CONV_T + 1] = cw[CONV_T + 1] = (v4u){0u, 0u, 0u, 0u};
        if (has_prev) { hw[0] = *(const GAS v4u*)(HB + o - CW); cw[0] = *(const GAS v4u*)(CB + o - CW); }
#pragma unroll
        for (int k = 0; k < CONV_T; ++k) { hw[k + 1] = *(const GAS v4u*)(HB + o + (size_t)k * CW); cw[k + 1] = *(const GAS v4u*)(CB + o + (size_t)k * CW); bw[k] = *(const GAS v4u*)(BB + o + (size_t)k * CW); }
        if (has_next) { hw[CONV_T + 1] = *(const GAS v4u*)(HB + o + (size_t)CONV_T * CW); cw[CONV_T + 1] = *(const GAS v4u*)(CB + o + (size_t)CONV_T * CW); }
        const GAS f32x4* w = (const GAS f32x4*)(F.conv_w + cc);
        const f32x4 w00 = w[0], w01 = w[1], w10 = w[CW / 4], w11 = w[CW / 4 + 1], w20 = w[2 * CW / 4], w21 = w[2 * CW / 4 + 1];
        f32x4 up0, up1, uc0, uc1;
        { f32x4 h0, h1, c0, c1; unpack8(hw[0], h0, h1); unpack8(cw[0], c0, c1); up0 = h0 * c0; up1 = h1 * c1; unpack8(hw[1], h0, h1); unpack8(cw[1], c0, c1); uc0 = h0 * c0; uc1 = h1 * c1; }
#pragma unroll
        for (int k = 0; k < CONV_T; ++k) {
            f32x4 h0, h1, c0, c1, b0, b1; unpack8(hw[k + 2], h0, h1); unpack8(cw[k + 2], c0, c1); unpack8(bw[k], b0, b1);
            const f32x4 un0 = h0 * c0, un1 = h1 * c1;
            const f32x4 y0 = w00 * up0 + w10 * uc0 + w20 * un0, y1 = w01 * up1 + w11 * uc1 + w21 * un1;
            *(GAS v4u*)(OC + o + (size_t)k * CW) = pack8(b0 * y0, b1 * y1);
            up0 = uc0; up1 = uc1; uc0 = un0; uc1 = un1;
        }
    }
}

__device__ __forceinline__ unsigned ordf(float f) { const unsigned u = __float_as_uint(f); return u ^ ((u >> 31) ? 0xFFFFFFFFu : 0x80000000u); }
__device__ __forceinline__ float unordf(unsigned k) { return __uint_as_float((k & 0x80000000u) ? (k ^ 0x80000000u) : ~k); }
__device__ __forceinline__ u64 shfl64_xor(u64 v, int m) { const unsigned lo = __shfl_xor((unsigned)v, m), hi = __shfl_xor((unsigned)(v >> 32), m); return ((u64)hi << 32) | lo; }
template <int N> __device__ __forceinline__ void bitonic_merge_desc(unsigned (&a)[N]) {
#pragma unroll
    for (int j = N >> 1; j > 0; j >>= 1)
#pragma unroll
        for (int i = 0; i < N; ++i) { const int l = i ^ j; if (l > i) { const unsigned hi = a[i] > a[l] ? a[i] : a[l], lo = a[i] > a[l] ? a[l] : a[i]; a[i] = hi; a[l] = lo; } }
}
template <int N> __device__ __forceinline__ void bitonic_sort_desc(unsigned (&a)[N]) {
#pragma unroll
    for (int k = 2; k <= N; k <<= 1)
#pragma unroll
        for (int j = k >> 1; j > 0; j >>= 1)
#pragma unroll
            for (int i = 0; i < N; ++i) { const int l = i ^ j; if (l > i) { const unsigned hi = a[i] > a[l] ? a[i] : a[l], lo = a[i] > a[l] ? a[l] : a[i]; const bool desc = ((i & k) == 0); a[i] = desc ? hi : lo; a[l] = desc ? lo : hi; } }
}
__device__ __forceinline__ void xlane_top16(unsigned (&t)[16], const int mask) {
    unsigned m[16];
#pragma unroll
    for (int i = 0; i < 16; ++i) { const unsigned p = __shfl_xor(t[15 - i], mask); m[i] = t[i] > p ? t[i] : p; }
    bitonic_merge_desc<16>(m);
#pragma unroll
    for (int i = 0; i < 16; ++i) t[i] = m[i];
}
struct Stair { int i[52], j[52]; };
constexpr Stair make_stair() { Stair s{}; int n = 0; for (int a = 0; a < 16; ++a) for (int b = 0; b < 16; ++b) if ((a + 1) * (b + 1) <= 16) { s.i[n] = a; s.j[n] = b; ++n; } for (; n < 52; ++n) { s.i[n] = -1; s.j[n] = -1; } return s; }
constexpr Stair STAIR = make_stair();
template <int P> __device__ __forceinline__ unsigned cand1(const float (&v1)[16], const float (&v2)[16]) {
    constexpr int i = STAIR.i[P], j = STAIR.j[P];
    if constexpr (i < 0) return 0u;
    else return (ordf(v1[i] + v2[j]) & ~255u) | (unsigned)(16 * i + j);
}
template <int S> __device__ __forceinline__ void cand_fill(unsigned (&ck)[16], const float (&v1)[16], const float (&v2)[16], int hg) {
    const unsigned k0 = cand1<4 * S + 0>(v1, v2), k1 = cand1<4 * S + 1>(v1, v2), k2 = cand1<4 * S + 2>(v1, v2), k3 = cand1<4 * S + 3>(v1, v2);
    ck[S] = hg == 0 ? k0 : hg == 1 ? k1 : hg == 2 ? k2 : k3;
    if constexpr (S + 1 < 13) cand_fill<S + 1>(ck, v1, v2, hg);
}
__device__ __forceinline__ void route_task(Frame& F, const int tg, const int h) {
    const int lane = F.lane, c = lane & 15, hg = lane >> 4;
    const int tok = tg * 16 + c;
    const bf16* QP = WSP(const bf16, WS_QP); LAS unsigned char* SKl = F.lds + RING_OFF;
    unsigned sel[2][16];
#pragma unroll
    for (int half = 0; half < 2; ++half) {
        bf16x8 bq[4];
#pragma unroll
        for (int ks = 0; ks < 4; ++ks) bq[ks] = *(const GAS bf16x8*)(QP + (size_t)tok * PQW + h * 256 + half * 128 + 32 * ks + 8 * hg);
        unsigned k[32];
#pragma unroll
        for (int tile = 0; tile < 8; ++tile) {
            f32x4 s = (f32x4){0.f, 0.f, 0.f, 0.f};
#pragma unroll
            for (int ks = 0; ks < 4; ++ks) { const bf16x8 a = *(const LAS bf16x8*)(SKl + off_b(half * 128 + 16 * tile + c, 4 * ks + hg)); s = MFMA16(a, bq[ks], s); }
#pragma unroll
            for (int r = 0; r < 4; ++r) k[tile * 4 + r] = (ordf(s[r]) & ~127u) | (unsigned)(16 * tile + 4 * hg + r);
            if (tile & 1) asm volatile("" ::: "memory");
        }
        bitonic_sort_desc<32>(k);
        unsigned t[16];
#pragma unroll
        for (int i = 0; i < 16; ++i) t[i] = k[i];
        xlane_top16(t, 16); xlane_top16(t, 32);
#pragma unroll
        for (int i = 0; i < 16; ++i) sel[half][i] = t[i];
        asm volatile("" ::: "memory");
    }
    float v1[16], v2[16]; unsigned n1[16], n2[16];
#pragma unroll
    for (int i = 0; i < 16; ++i) { v1[i] = unordf(sel[0][i] & ~127u); n1[i] = sel[0][i] & 127u; v2[i] = unordf(sel[1][i] & ~127u); n2[i] = sel[1][i] & 127u; }
    LAS unsigned char* scr = F.lds + RING_OFF + 65536 + F.wave * 4096 + c * 256;
    if (hg == 0) {
#pragma unroll
        for (int q4 = 0; q4 < 4; ++q4) { *(LAS f32x4*)(scr + 16 * q4) = (f32x4){v1[4 * q4], v1[4 * q4 + 1], v1[4 * q4 + 2], v1[4 * q4 + 3]}; *(LAS f32x4*)(scr + 64 + 16 * q4) = (f32x4){v2[4 * q4], v2[4 * q4 + 1], v2[4 * q4 + 2], v2[4 * q4 + 3]};
            *(LAS v4u*)(scr + 128 + 16 * q4) = (v4u){n1[4 * q4], n1[4 * q4 + 1], n1[4 * q4 + 2], n1[4 * q4 + 3]}; *(LAS v4u*)(scr + 192 + 16 * q4) = (v4u){n2[4 * q4], n2[4 * q4 + 1], n2[4 * q4 + 2], n2[4 * q4 + 3]}; } }
    unsigned ck[16];
    cand_fill<0>(ck, v1, v2, hg); ck[13] = ck[14] = ck[15] = 0u;
    bitonic_sort_desc<16>(ck);
    xlane_top16(ck, 16); xlane_top16(ck, 32);
    int oi[4]; float sc[4]; float mx = -INFINITY;
#pragma unroll
    for (int jj = 0; jj < 4; ++jj) {
        const unsigned w = hg == 0 ? ck[jj] : hg == 1 ? ck[4 + jj] : hg == 2 ? ck[8 + jj] : ck[12 + jj];
        const unsigned i4 = (w >> 2) & 0x3Cu, j4 = (w & 15u) << 2;
        sc[jj] = *(const LAS float*)(scr + i4) + *(const LAS float*)(scr + 64 + j4);
        oi[jj] = (int)(*(const LAS unsigned*)(scr + 128 + i4) * (unsigned)NKEYS + *(const LAS unsigned*)(scr + 192 + j4));
        mx = fmaxf(mx, sc[jj]);
    }
    mx = fmaxf(mx, __shfl_xor(mx, 16)); mx = fmaxf(mx, __shfl_xor(mx, 32));
    float ev[4], sum = 0.f;
#pragma unroll
    for (int jj = 0; jj < 4; ++jj) { ev[jj] = __builtin_amdgcn_exp2f((sc[jj] - mx) * LOG2E); sum += ev[jj]; }
    sum += __shfl_xor(sum, 16); sum += __shfl_xor(sum, 32);
    const float inv = 1.0f / sum;
    const size_t o = ((size_t)tok * PH + h) * TOPK + 4 * hg;
    *(GAS i32x4_t*)(WSP(int, WS_IDX) + o) = (i32x4_t){oi[0], oi[1], oi[2], oi[3]};
    *(GAS f32x4*)(WSP(float, WS_GATE) + o) = (f32x4){ev[0] * inv, ev[1] * inv, ev[2] * inv, ev[3] * inv};
}

__device__ __forceinline__ float gelu_erf(float v) { return 0.5f * v * (1.0f + erff(v * 0.70710678118654752f)); }
typedef int i32x8_t __attribute__((ext_vector_type(8)));
#define FP4X2(w, b) __builtin_amdgcn_cvt_scalef32_pk_f32_fp4((w), 1.0f, (b))
__device__ __forceinline__ void fmac(float& acc, float a, float b) { asm("v_fmac_f32 %0, %1, %2" : "+v"(acc) : "v"(a), "v"(b)); }
struct PeerDeal { int ox, nx, t0, stride, cnt, ns; };
__device__ __forceinline__ void pd_item(int n, const PeerDeal& d, int& t, int& sl) { const int N = d.ns * d.cnt, nn = n < N ? n : N - 1, j = nn / d.cnt; sl = d.ox + j * d.nx; t = d.t0 + (nn - j * d.cnt) * d.stride; }
__device__ __forceinline__ void pd_idx(Frame& F, int t, int lane, i32x4_t (&idv)[4]) {
    const GAS i32x4_t* ip = (const GAS i32x4_t*)(WSP(const int, WS_IDX) + (size_t)t * 128 + (lane >> 3) * 16);
#pragma unroll
    for (int a = 0; a < 4; ++a) idv[a] = ip[a];
}
__device__ __forceinline__ void pd_rows(Frame& F, int t, int sl, int lane, const i32x4_t (&idv)[4], v4u (&rows)[16], v4u (&xw)[2]) {
    const unsigned char* xr = F.ws + WS_X2N8 + ((size_t)sl * M + t) * 256 + 16 * (lane >> 4) + ((lane & 15) == 1 ? 128 : 0);
#pragma unroll
    for (int ks = 0; ks < 2; ++ks) xw[ks] = *(const GAS v4u*)(xr + 64 * ks);
    const unsigned char* WD = F.ws + WS_W4D + (size_t)sl * SLICE_BYTES;
    const unsigned lo16 = 16u * (unsigned)(lane & 7);
#pragma unroll
    for (int j = 0; j < 16; ++j) rows[j] = *(const GAS v4u*)(WD + (size_t)(((unsigned)idv[j >> 2][j & 3] << 7) + lo16));
}
__device__ __forceinline__ float dpp_swap1(float v) { return __builtin_bit_cast(float, __builtin_amdgcn_update_dpp(0, __builtin_bit_cast(int, v), 0xB1  , 0xF, 0xF, true)); }
__device__ __forceinline__ void pd_compute(Frame& F, int t, int sl, int lane, const v4u (&rows)[16], const v4u (&xw)[2]) {
    const int r = lane & 15, g = lane >> 4;
    LAS unsigned char* tile = F.lds + RING_OFF + F.wave * 16384;
    { LAS unsigned char* wp = tile + (lane >> 3) * 2048;
#pragma unroll
      for (int j = 0; j < 16; ++j) *(LAS v4u*)(wp + j * 128 + (((lane & 7) ^ ((j >> 1) & 7)) << 4)) = rows[j]; }
    float* pp = WSP(float, WS_PART) + ((size_t)sl * M + t) * 128 + 4 * g;
    const int scb = (r == 1) ? 0x7C7C7C7C   : 0x7F7F7F7F;
    i32x8_t xb[2];
#pragma unroll
    for (int ks = 0; ks < 2; ++ks) xb[ks] = (i32x8_t){(int)xw[ks].x, (int)xw[ks].y, (int)xw[ks].z, (int)xw[ks].w, 0, 0, 0, 0};
    const LAS unsigned char* rp = tile + r * 128; const int fr = (r >> 1) & 7;
    v4u a[8][2];
#pragma unroll
    for (int i = 0; i < 8; ++i)
#pragma unroll
        for (int ks = 0; ks < 2; ++ks) a[i][ks] = *(const LAS v4u*)(rp + i * 2048 + (((4 * ks + g) ^ fr) << 4));
    f32x4 c[8];
#pragma unroll
    for (int i = 0; i < 8; ++i) { const v4u w = a[i][0]; c[i] = __builtin_amdgcn_mfma_scale_f32_16x16x128_f8f6f4((i32x8_t){(int)w.x, (int)w.y, (int)w.z, (int)w.w, 0, 0, 0, 0}, xb[0], (f32x4){0.f, 0.f, 0.f, 0.f}, 4  , 4  , 0, 0x7F7F7F7F, 0, scb); }
#pragma unroll
    for (int i = 0; i < 8; ++i) { const v4u w = a[i][1]; c[i] = __builtin_amdgcn_mfma_scale_f32_16x16x128_f8f6f4((i32x8_t){(int)w.x, (int)w.y, (int)w.z, (int)w.w, 0, 0, 0, 0}, xb[1], c[i], 4, 4, 0, 0x7F7F7F7F, 0, scb); }
#pragma unroll
    for (int i = 0; i < 8; ++i)
#pragma unroll
        for (int e = 0; e < 4; ++e) c[i][e] += dpp_swap1(c[i][e]);
    if (r == 0) {
#pragma unroll
        for (int i = 0; i < 8; ++i) *(GAS f32x4*)(pp + 16 * i) = c[i]; }
}
__device__ __forceinline__ void peer_down_pass(Frame& F, const PeerDeal& d) {
    const int lane = F.lane;
    const int N = d.ns * d.cnt; if (N <= 0) return;
    i32x4_t I0[4], I1[4]; v4u R0[16], R1[16], X0[2], X1[2];
    int t0, s0, t1, s1, t2, s2, t3, s3;
    pd_item(0, d, t0, s0); pd_idx(F, t0, lane, I0);
    pd_item(1, d, t1, s1); pd_idx(F, t1, lane, I1);
    pd_rows(F, t0, s0, lane, I0, R0, X0);
#pragma unroll 1
    for (int n = 0; n < N; n += 2) {
        pd_item(n + 2, d, t2, s2); pd_idx(F, t2, lane, I0);
        __builtin_amdgcn_sched_barrier(0);
        pd_rows(F, t1, s1, lane, I1, R1, X1);
        __builtin_amdgcn_sched_barrier(0);
        pd_compute(F, t0, s0, lane, R0, X0);
        __builtin_amdgcn_sched_barrier(0);
        pd_item(n + 3, d, t3, s3); pd_idx(F, t3, lane, I1);
        __builtin_amdgcn_sched_barrier(0);
        pd_rows(F, t2, s2, lane, I0, R0, X0);
        __builtin_amdgcn_sched_barrier(0);
        pd_compute(F, t1, s1, lane, R1, X1);
        __builtin_amdgcn_sched_barrier(0);
        t0 = t2; s0 = s2; t1 = t3; s1 = s3;
    }
}
__device__ __forceinline__ void peer_combine_token(Frame& F, const int t) {
    const int lane = F.lane;
    const float* PART = WSP(const float, WS_PART) + (size_t)t * 128 + 2 * lane; float* GATEP = WSP(float, WS_GATE) + (size_t)t * 128 + 2 * lane;
    f32x2_t a = (f32x2_t){0.f, 0.f};
#pragma unroll
    for (int sl = 0; sl < 16; ++sl) a += *(const GAS f32x2_t*)(PART + (size_t)sl * M * 128);
    const int id0 = WSP(const int, WS_IDX)[(size_t)t * 128 + 2 * lane], id1 = WSP(const int, WS_IDX)[(size_t)t * 128 + 2 * lane + 1];
    const f32x2_t gt = *(const GAS f32x2_t*)GATEP;
    const float c0 = gt.x * gelu_erf(a.x * WSP(const float, WS_SCD)[id0]) * WSP(const float, WS_SCU)[id0], c1 = gt.y * gelu_erf(a.y * WSP(const float, WS_SCD)[id1]) * WSP(const float, WS_SCU)[id1];
    *(GAS f32x2_t*)GATEP = (f32x2_t){c0, c1};
    float bm = fmaxf(fabsf(c0), fabsf(c1));
    bm = fmaxf(bm, __shfl_xor(bm, 1)); bm = fmaxf(bm, __shfl_xor(bm, 2)); bm = fmaxf(bm, __shfl_xor(bm, 4)); bm = fmaxf(bm, __shfl_xor(bm, 8));
    int eb = (int)((__float_as_uint(bm) >> 23) & 255u) - 1;
    eb = eb < 3 ? 3 : eb > 250 ? 250 : eb;
    const float inv = __uint_as_float((unsigned)(254 - eb) << 23);
    const float s0 = c0 * inv, s1 = c1 * inv;
    const unsigned hi = __builtin_amdgcn_cvt_scalef32_pk_fp4_f32(0u, s0, s1, 1.0f, 0);
    const f32x2_t dq = __builtin_amdgcn_cvt_scalef32_pk_f32_fp4(hi, 1.0f, 0);
    const unsigned lo = __builtin_amdgcn_cvt_scalef32_pk_fp4_f32(0u, (s0 - dq.x) * 8.f, (s1 - dq.y) * 8.f, 1.0f, 0);
    unsigned char* cf4 = F.ws + WS_CF4 + (size_t)t * 160;
    ((GAS unsigned char*)cf4)[lane] = (unsigned char)hi; ((GAS unsigned char*)cf4)[64 + lane] = (unsigned char)lo;
    if ((lane & 15) == 0) ((GAS unsigned*)(cf4 + 128))[lane >> 4] = (unsigned)eb * 0x01010101u;
}
struct PmBuf { v4u rows[16]; v4u aw; unsigned e; u32x2_t xv; };
__device__ __forceinline__ void pm_rows(Frame& F, int t, int sl, int lane, const i32x4_t (&idv)[4], PmBuf& b) {
    const int n = lane & 15, g = lane >> 4;
    const unsigned char* WU = F.ws + WS_W4U + (size_t)sl * SLICE_BYTES;
    const unsigned lo16 = 16u * (unsigned)(lane & 7);
#pragma unroll
    for (int j = 0; j < 16; ++j) b.rows[j] = *(const GAS v4u*)(WU + (size_t)(((unsigned)idv[j >> 2][j & 3] << 7) + lo16));
    const unsigned char* cf4 = F.ws + WS_CF4 + (size_t)t * 160;
    b.aw = *(const GAS v4u*)(cf4 + 64 * (n & 1) + 16 * g); b.e = *(const GAS unsigned*)(cf4 + 128 + 4 * g);
    b.xv = *(const GAS u32x2_t*)(WSP(const bf16, WS_X1B) + (size_t)t * D + 256 * sl + 4 * lane);
}
__device__ __forceinline__ void pm_compute(Frame& F, int t, int sl, int lane, const PmBuf& b) {
    const int n = lane & 15, g = lane >> 4;
    LAS unsigned char* tile = F.lds + RING_OFF + F.wave * 16384;
    LAS float* obuf = (LAS float*)(F.lds + OBUF_OFF + F.wave * 1024);
    { LAS unsigned char* wp = tile + (lane >> 3) * 2048; const int cc = lane & 7;
#pragma unroll
      for (int j = 0; j < 16; ++j) { const v4u w = b.rows[j]; *(LAS v4u*)(wp + j * 128 + ((cc ^ (j >> 1)) << 4)) = (j & 1) ? (v4u){w.z, w.w, w.x, w.y} : w; } }
    const LAS unsigned char* rp = tile + (32 * g + n) * 128;
    const bool arow = n < 2;
    const i32x8_t afr = (i32x8_t){arow ? (int)b.aw.x : 0, arow ? (int)b.aw.y : 0, arow ? (int)b.aw.z : 0, arow ? (int)b.aw.w : 0, 0, 0, 0, 0};
    const unsigned sca = n == 0 ? b.e : n == 1 ? b.e - 0x03030303u : 0x7F7F7F7Fu;
    LAS float* const wdst = g == 0 ? obuf + n : (LAS float*)(F.lds + ODUMP_OFF + F.wave * 256) + lane; const int wstep = g == 0 ? 16 : 0;
#pragma unroll
    for (int h = 0; h < 2; ++h) {
        v2i32_t b0[8], b1[8];
#pragma unroll
        for (int q = 0; q < 8; ++q) { const int off = (((8 * h + q) ^ n) << 3); b0[q] = __builtin_amdgcn_ds_read_tr4_b64_v2i32((LAS v2i32_t*)(rp + off)); b1[q] = __builtin_amdgcn_ds_read_tr4_b64_v2i32((LAS v2i32_t*)(rp + 2048 + off)); }
        f32x4 c[8];
#pragma unroll
        for (int q = 0; q < 8; ++q) c[q] = __builtin_amdgcn_mfma_scale_f32_16x16x128_f8f6f4(afr, (i32x8_t){b0[q].x, b0[q].y, b1[q].x, b1[q].y, 0, 0, 0, 0}, (f32x4){0.f, 0.f, 0.f, 0.f}, 4, 4, 0, (int)sca, 0, 0x7F7F7F7F);
#pragma unroll
        for (int q = 0; q < 8; ++q) wdst[(8 * h + q) * wstep] = c[q][0] + c[q][1];
    }
    *(GAS f32x4*)(F.out + (size_t)t * D + 256 * sl + 4 * lane) = (f32x4){bflo(b.xv.x), bfhi(b.xv.x), bflo(b.xv.y), bfhi(b.xv.y)} + *(const LAS f32x4*)(obuf + 4 * lane);
}
__device__ __forceinline__ void peer_up_pass_mfma(Frame& F, const PeerDeal& d) {
    const int lane = F.lane;
    const int N = d.ns * d.cnt; if (N <= 0) return;
    i32x4_t I0[4], I1[4]; PmBuf B0, B1;
    int t0, s0, t1, s1, t2, s2, t3, s3;
    pd_item(0, d, t0, s0); pd_idx(F, t0, lane, I0);
    pd_item(1, d, t1, s1); pd_idx(F, t1, lane, I1);
    pm_rows(F, t0, s0, lane, I0, B0);
#pragma unroll 1
    for (int n = 0; n < N; n += 2) {
        pd_item(n + 2, d, t2, s2); pd_idx(F, t2, lane, I0);
        __builtin_amdgcn_sched_barrier(0);
        pm_rows(F, t1, s1, lane, I1, B1);
        __builtin_amdgcn_sched_barrier(0);
        pm_compute(F, t0, s0, lane, B0);
        __builtin_amdgcn_sched_barrier(0);
        pd_item(n + 3, d, t3, s3); pd_idx(F, t3, lane, I1);
        __builtin_amdgcn_sched_barrier(0);
        pm_rows(F, t2, s2, lane, I0, B0);
        __builtin_amdgcn_sched_barrier(0);
        pm_compute(F, t1, s1, lane, B1);
        __builtin_amdgcn_sched_barrier(0);
        t0 = t2; s0 = s2; t1 = t3; s1 = s3;
    }
}
typedef _Float16 h2_t __attribute__((ext_vector_type(2)));
#define FP4H2(w, b) __builtin_bit_cast(h2_t, __builtin_amdgcn_cvt_scalef32_pk_f16_fp4((w), 1.0f, (b)))
__device__ __forceinline__ void pu_idx(Frame& F, int t, int lane, i32x4_t (&idv)[8], f32x4 (&cfv)[8]) {
    const GAS i32x4_t* ip = (const GAS i32x4_t*)(WSP(const int, WS_IDX) + (size_t)t * 128 + (lane >> 4) * 32); const GAS f32x4* cp = (const GAS f32x4*)(WSP(const float, WS_GATE) + (size_t)t * 128 + (lane >> 4) * 32);
#pragma unroll
    for (int a = 0; a < 8; ++a) { idv[a] = ip[a]; cfv[a] = cp[a]; }
}
template <int H> __device__ __forceinline__ void pu_rows(Frame& F, int sl, int lane, const i32x4_t (&idv)[8], u32x2_t (&rows)[16]) {
    const unsigned char* WU = F.ws + WS_W4U + (size_t)sl * SLICE_BYTES + (lane & 15) * 8;
#pragma unroll
    for (int i = 0; i < 16; ++i) rows[i] = *(const GAS u32x2_t*)(WU + (size_t)idv[4 * H + (i >> 2)][i & 3] * 128);
}
template <int H> __device__ __forceinline__ void pu_compute(const u32x2_t (&rows)[16], const f32x4 (&cfv)[8], h2_t (&acc)[8]) {
#pragma unroll
    for (int i = 0; i < 16; ++i) { const float c = cfv[4 * H + (i >> 2)][i & 3] * 256.0f; const h2_t cc = __builtin_bit_cast(h2_t, __builtin_amdgcn_cvt_pkrtz(c, c));
#pragma unroll
        for (int k = 0; k < 2; ++k) { const unsigned w = rows[i][k];
            acc[4 * k + 0] = FP4H2(w, 0) * cc + acc[4 * k + 0]; acc[4 * k + 1] = FP4H2(w, 1) * cc + acc[4 * k + 1]; acc[4 * k + 2] = FP4H2(w, 2) * cc + acc[4 * k + 2]; acc[4 * k + 3] = FP4H2(w, 3) * cc + acc[4 * k + 3]; } }
}
__device__ __forceinline__ void pu_finish(Frame& F, int t, int sl, int lane, h2_t (&acc)[8]) {
    const int eg = lane >> 4, q = lane & 15;
#pragma unroll
    for (int a = 0; a < 8; ++a) {
        acc[a] = acc[a] + __builtin_bit_cast(h2_t, __shfl_xor(__builtin_bit_cast(unsigned, acc[a]), 16)); acc[a] = acc[a] + __builtin_bit_cast(h2_t, __shfl_xor(__builtin_bit_cast(unsigned, acc[a]), 32)); }
    const h2_t o01 = eg == 0 ? acc[0] : eg == 1 ? acc[2] : eg == 2 ? acc[4] : acc[6], o23 = eg == 0 ? acc[1] : eg == 1 ? acc[3] : eg == 2 ? acc[5] : acc[7];
    GAS f32x4* op = (GAS f32x4*)(F.out + (size_t)t * D + 256 * sl + 16 * q + 4 * eg);
    f32x4 o; { const u32x2_t w = *(const GAS u32x2_t*)(WSP(const bf16, WS_X1B) + (size_t)t * D + 256 * sl + 16 * q + 4 * eg); o = (f32x4){bflo(w.x), bfhi(w.x), bflo(w.y), bfhi(w.y)}; }
    *op = (f32x4){o[0] + (float)o01.x * (1.0f / 256.0f), o[1] + (float)o01.y * (1.0f / 256.0f), o[2] + (float)o23.x * (1.0f / 256.0f), o[3] + (float)o23.y * (1.0f / 256.0f)};
#pragma unroll
    for (int a = 0; a < 8; ++a) acc[a] = (h2_t){(_Float16)0.f, (_Float16)0.f};
}
__device__ __forceinline__ void peer_up_pass(Frame& F, const PeerDeal& d) {
    const int lane = F.lane;
    const int N = d.ns * d.cnt; if (N <= 0) return;
    i32x4_t IA[8], IB[8]; f32x4 CA[8], CB[8]; u32x2_t Ra[16], Rb[16]; h2_t acc[8];
#pragma unroll
    for (int a = 0; a < 8; ++a) acc[a] = (h2_t){(_Float16)0.f, (_Float16)0.f};
    int ta, sa, tb, sb, tc, sc;
    pd_item(0, d, ta, sa); pu_idx(F, ta, lane, IA, CA);
    pd_item(1, d, tb, sb); pu_idx(F, tb, lane, IB, CB);
    pu_rows<0>(F, sa, lane, IA, Ra);
#pragma unroll 1
    for (int n = 0; n < N; n += 2) {
        pu_rows<1>(F, sa, lane, IA, Rb);
        pu_compute<0>(Ra, CA, acc);
        pu_rows<0>(F, sb, lane, IB, Ra);
        pu_compute<1>(Rb, CA, acc);
        pu_finish(F, ta, sa, lane, acc);
        pd_item(n + 2, d, tc, sc); pu_idx(F, tc, lane, IA, CA);
        if (n + 1 < N) {
            pu_rows<1>(F, sb, lane, IB, Rb);
            pu_compute<0>(Ra, CB, acc);
            pu_rows<0>(F, sc, lane, IA, Ra);
            pu_compute<1>(Rb, CB, acc);
            pu_finish(F, tb, sb, lane, acc);
        }
        pd_item(n + 3, d, tb, sb); pu_idx(F, tb, lane, IB, CB);
        ta = tc; sa = sc;
    }
}
struct Args { const float* in[15]; float* out; unsigned char* ws; int ph_lo, ph_hi, pad0, pad1; };
__global__ void __launch_bounds__(NWAVES * 64, 2) skel_fwd(Args args) {
    extern __shared__ __attribute__((aligned(16))) unsigned char lds[];
    Frame F;
    F.lds = (LAS unsigned char*)lds;
    F.MISC = (volatile LAS unsigned*)(F.lds + MISC_OFF);
    F.tid = threadIdx.x; F.lane = F.tid & 63; F.wave = __builtin_amdgcn_readfirstlane(F.tid >> 6);
    F.G = gridDim.x; { const int bx = blockIdx.x; F.vcu = (F.G % 8 == 0) ? (bx % 8) * (F.G / 8) + bx / 8 : bx; }
    F.ws = args.ws; F.ctl = (gu32*)(args.ws + WS_CTL);
    F.x = args.in[0]; F.g1 = args.in[1]; F.w_in = args.in[2]; F.gq = args.in[3]; F.gk = args.in[4]; F.sink = args.in[5]; F.conv_w = args.in[6]; F.w_oa = args.in[7];
    F.w_oc = args.in[8]; F.w_out = args.in[9]; F.g2 = args.in[10]; F.w_qp = args.in[11]; F.subk = args.in[12]; F.w_down = args.in[13]; F.w_up = args.in[14]; F.out = args.out;
    for (int u = F.tid; u < (LDS_BYTES - LDSCTL_OFF) / 4; u += NWAVES * 64) ((LAS unsigned*)(F.lds + LDSCTL_OFF))[u] = 0u;
    __syncthreads();
    XcdBarrier bar; bar.bar = (unsigned*)(F.ctl + CW_BAR); bar.x = 0; bar.st = nullptr;
    if (MK_ONE_LAUNCH) bar = xcd_barrier_post((unsigned*)(F.ctl + CW_BAR), F.MISC + 8);
    if (MK_ONE_LAUNCH && F.tid == 0) { const unsigned xcc = xb_xcc_id(); F.MISC[10] = xcc; F.MISC[11] = __hip_atomic_fetch_add((unsigned*)(F.ctl + CW_XRANK) + 64 * xcc, 1u, RLX_AGENT); }
    if (F.wave == 0) { const bool ok = tr4_selfcheck(F.lds + RING_OFF, F.lane); if (F.lane == 0) F.MISC[15] = ok ? 1u : 0u; }
    __syncthreads();
    const bool tr4_ok = F.MISC[15] != 0u;
    const int lo = args.ph_lo, hi = args.ph_hi;
#ifndef PHASE_MASK
#define PHASE_MASK 0xfff
#endif
#define IN(k) (((PHASE_MASK >> (k)) & 1) && lo <= (k) && (k) < hi)
#ifndef DUP_MASK
#define DUP_MASK 0
#endif
#define REP(k) _Pragma("unroll") for (int rep_ = 0; rep_ < 1 + ((DUP_MASK >> (k)) & 1); ++rep_)
#define SEAM(k) do { if (MK_ONE_LAUNCH && IN(k) && IN((k) + 1)) xcd_barrier(bar); } while (0)
    const int gw = F.vcu * NWAVES + F.wave, NGW = F.G * NWAVES;

    if (IN(0)) REP(0) { p0_prologue(F); } SEAM(0);

    if (IN(1)) REP(1) { quant_w8(F); if (P4A_I8) quant_w8_oa(F); } SEAM(1);

    if (IN(2)) REP(2) {
        bf16* const pQ = WSP(bf16, WS_Q); bf16* const pK = WSP(bf16, WS_K); bf16* const pV = WSP(bf16, WS_V); bf16* const pH = WSP(bf16, WS_H); bf16* const pB = WSP(bf16, WS_B); bf16* const pC = WSP(bf16, WS_C);
        bf16* const pGA = WSP(bf16, WS_GA); bf16* const pGC = WSP(bf16, WS_GC);
        {   pg8::Gemm g{(const bf16*)(F.ws + WS_XN8), (const bf16*)(F.ws + WS_W8), M, INW, D / 2};
            pg8::RangeOrder S; S.so.init(M, I8_TILES * 256, F.G, (int)blockIdx.x); S.base = 0; S.cut = I8_CUT; S.skip = I8_SKIP;
            pg8::EpiProj<true> E{pQ, pK, pV, pH, pB, pC, pGA, pGC, WSP(const float, WS_SX), WSP(const float, WS_SW)};
            pg8::gemm_phase<pg8::EpiProj<true>, pg8::RangeOrder, PG8_ALIGN, PG8_SP2, true>(F.lds + RING_OFF, g, S, E); }
        {   pg8::Gemm g{WSP(const bf16, WS_XN), WSP(const bf16, WS_WIN), M, INW, D};
            pg8::RangeOrder S; S.so.init(M, BF_TILES * 256, F.G, (int)blockIdx.x); S.base = BF_BASE; S.cut = 68; S.skip = 0;
            pg8::EpiProj<false> E{pQ, pK, pV, pH, pB, pC, pGA, pGC, nullptr, nullptr};
            pg8::gemm_phase<pg8::EpiProj<false>, pg8::RangeOrder, PG8_ALIGN, PG8_SP2, false>(F.lds + RING_OFF, g, S, E); }
    } SEAM(2);

    if (IN(3)) REP(3) {
        attn_phase(F);
#ifdef ATTN_PROBE
        for (int U = F.vcu * 4; U < BATCH * 32 * NKV * 2; U += F.G * 4)
            for (int i = 0; i < 4; ++i) attn_unit<ATTN_PROBE>(F, U + i);
#endif
        conv_phase(F);
#ifdef CONV_DUP
        conv_phase(F);
#endif
        if (DUP_MASK) __syncthreads();
    } SEAM(3);

    if (IN(4)) REP(4) {
#if P4A_I8
        for (int m = gw; m < M; m += NGW) quant_row_i8<4>(WSP(const bf16, WS_AB) + (size_t)m * QW, F.ws + WS_AI8 + (size_t)m * QW, WSP(float, WS_SXA) + m, F.lane);
        if (MK_ONE_LAUNCH) xcd_barrier(bar);
        {   pg8::Gemm g{(const bf16*)(F.ws + WS_AI8), (const bf16*)(F.ws + WS_W8OA), M, D, QW / 2}; pg8::StaticOrder S; S.init(M, D, F.G, (int)blockIdx.x);
            pg8::EpiMergeA8 E{WSP(const bf16, WS_GA), WSP(bf16, WS_T), WSP(const float, WS_SXA), WSP(const float, WS_SWA)};
            pg8::gemm_phase<pg8::EpiMergeA8, pg8::StaticOrder, PG8_ALIGN, PG8_SP2, true>(F.lds + RING_OFF, g, S, E); }
        {   pg8::Gemm g{WSP(const bf16, WS_AB) + (size_t)M * CW, WSP(const bf16, WS_WO) + (size_t)D * QW, M, D, CW}; pg8::StaticOrder S; S.init(M, D, F.G, (int)blockIdx.x);
            pg8::EpiMergeC E{WSP(const bf16, WS_GC), WSP(const bf16, WS_T), WSP(bf16, WS_XN)};
            pg8::gemm_phase<pg8::EpiMergeC, pg8::StaticOrder, PG8_ALIGN, PG8_SP2>(F.lds + RING_OFF, g, S, E); }
#else
        pg8::Gemm g{WSP(const bf16, WS_AB), WSP(const bf16, WS_WO), 2 * M, 2 * D, QW}; pg8::PairOrder S; S.so.init(M, D, F.G, (int)blockIdx.x);
        pg8::EpiMerge E{WSP(const bf16, WS_GA), WSP(const bf16, WS_GC), WSP(bf16, WS_T), WSP(bf16, WS_XN)};
        pg8::gemm_phase<pg8::EpiMerge, pg8::PairOrder, PG8_ALIGN, PG8_SP2>(F.lds + RING_OFF, g, S, E);
#endif
    } SEAM(4);

    if (IN(5)) REP(5) {
#if P5_I8
        for (int m = gw; m < M; m += NGW) quant_row_i8<8>(WSP(const bf16, WS_XN) + (size_t)m * D, F.ws + WS_MI8 + (size_t)m * D, WSP(float, WS_SXM) + m, F.lane);
        if (MK_ONE_LAUNCH) xcd_barrier(bar);
        pg8::Gemm g{(const bf16*)(F.ws + WS_MI8), (const bf16*)(F.ws + WS_W8OUT), M, D, D / 2}; pg8::StaticOrder S; S.init(M, D, F.G, (int)blockIdx.x);
        pg8::EpiResI8 E{F.x, WSP(bf16, WS_X1B), WSP(const float, WS_SXM), WSP(const float, WS_SWO)};
        pg8::gemm_phase<pg8::EpiResI8, pg8::StaticOrder, PG8_ALIGN, PG8_SP2, true>(F.lds + RING_OFF, g, S, E);
#else
        pg8::Gemm g{WSP(const bf16, WS_XN), WSP(const bf16, WS_WOUT), M, D, D}; pg8::StaticOrder S; S.init(M, D, F.G, (int)blockIdx.x);
        pg8::EpiRes E{F.x, WSP(bf16, WS_X1B)};
        pg8::gemm_phase<pg8::EpiRes, pg8::StaticOrder, PG8_ALIGN, PG8_SP2>(F.lds + RING_OFF, g, S, E);
#endif
    } SEAM(5);

    if (IN(6)) REP(6) {
        for (int m = gw; m < M; m += NGW) rms2_row(WSP(const bf16, WS_X1B) + (size_t)m * D, F.g2, F.ws + WS_X2I8 + (size_t)m * D, WSP(float, WS_SX2) + m, F.ws + WS_X2N8 + (size_t)m * 256, F.lane);
    } SEAM(6);

    if (IN(7)) REP(7) {
        pg8::Gemm g{(const bf16*)(F.ws + WS_X2I8), (const bf16*)(F.ws + WS_W8QP), M, PQW, D / 2}; pg8::StaticOrder S; S.init(M, PQW, F.G, (int)blockIdx.x);
        pg8::EpiStoreI8 E{WSP(bf16, WS_QP), PQW, WSP(const float, WS_SX2), WSP(const float, WS_SWQ)};
        pg8::gemm_phase<pg8::EpiStoreI8, pg8::StaticOrder, PG8_ALIGN, PG8_SP2, true>(F.lds + RING_OFF, g, S, E);
    } SEAM(7);

    if (IN(8)) REP(8) {
        const int h = F.vcu & 7;
        { const bf16* SK = WSP(const bf16, WS_SK) + (size_t)h * (2 * NKEYS * 128);
#pragma unroll
          for (int i = 0; i < 8; ++i) { const int q = F.tid + 512 * i, row = q >> 4, ch = q & 15; *(LAS v4u*)(F.lds + RING_OFF + off_b(row, ch)) = *(const GAS v4u*)(SK + (size_t)row * 128 + ch * 8); } }
        __syncthreads();
        for (int tg = (F.vcu >> 3) * NWAVES + F.wave; tg < M / 16; tg += (F.G >> 3) * NWAVES) route_task(F, tg, h);
        if (DUP_MASK) __syncthreads();
    } SEAM(8);

    PeerDeal deal;
    if (IN(9) || IN(11)) {
        if (MK_ONE_LAUNCH) {
            if (F.tid == 0) { const unsigned xcc = F.MISC[10]; unsigned nloc = 0, ox = 0, nx = 0;
                for (unsigned j = 0; j < 16; ++j) { const unsigned c = __hip_atomic_load((unsigned*)(F.ctl + CW_XRANK) + 64 * j, RLX_AGENT); if (c) { ++nx; if (j < xcc) ++ox; } if (j == xcc) nloc = c; }
                F.MISC[12] = nloc; F.MISC[13] = ox; F.MISC[14] = nx; }
            __syncthreads();
            const int nloc = (int)F.MISC[12], rank = (int)F.MISC[11];
            deal.ox = (int)F.MISC[13]; deal.nx = (int)F.MISC[14]; deal.t0 = rank * NWAVES + F.wave; deal.stride = nloc * NWAVES;
        } else { const int nper = F.G >> 3; deal.ox = F.vcu / nper; deal.nx = 8; deal.t0 = (F.vcu % nper) * NWAVES + F.wave; deal.stride = nper * NWAVES; }
        deal.cnt = deal.t0 < M ? (M - deal.t0 + deal.stride - 1) / deal.stride : 0; deal.ns = deal.ox < 16 ? (16 - deal.ox + deal.nx - 1) / deal.nx : 0;
    }
    if (IN(9)) {
        peer_down_pass(F, deal);
    } SEAM(9);
    if (IN(10)) {
        for (int t = gw; t < M; t += NGW) peer_combine_token(F, t);
    } SEAM(10);
    if (IN(11)) {
        if (tr4_ok) peer_up_pass_mfma(F, deal); else peer_up_pass(F, deal);
    }
#undef IN
#undef SEAM
}

extern "C" void kernel_launch(void* const* d_in, const int* in_sizes, int n_in, void* d_out, int out_size, void* d_ws, size_t ws_size, hipStream_t stream) {
    static int grid = 0;
    if (grid == 0) {
        if (n_in != 15 || in_sizes[0] != M * D || out_size != M * D || ws_size < WS_END) { fprintf(stderr, "kernel_launch: built for 15 inputs, x and out of %d floats, >= %zu bytes of workspace; got n_in %d, in0 %d, out %d, ws %zu; nothing launched\n", M * D, (size_t)WS_END, n_in, n_in > 0 ? in_sizes[0] : -1, out_size, ws_size); grid = -1; return; }
        int dev = 0, cus = 0, per_cu = 0;
        if (hipGetDevice(&dev) != hipSuccess || hipDeviceGetAttribute(&cus, hipDeviceAttributeMultiprocessorCount, dev) != hipSuccess) { fprintf(stderr, "kernel_launch: hipGetDevice / hipDeviceGetAttribute failed; nothing launched\n"); grid = -1; return; }
        if (hipFuncSetAttribute((const void*)skel_fwd, hipFuncAttributeMaxDynamicSharedMemorySize, LDS_BYTES) != hipSuccess) { fprintf(stderr, "kernel_launch: hipFuncSetAttribute failed; nothing launched\n"); grid = -1; return; }
        if (hipOccupancyMaxActiveBlocksPerMultiprocessor(&per_cu, (const void*)skel_fwd, NWAVES * 64, LDS_BYTES) != hipSuccess || per_cu < 1)
            fprintf(stderr, "kernel_launch: note: the occupancy query reports %d workgroups per CU\n", per_cu);
        (void)hipGetLastError();
        grid = cus;
        if (grid % 8 != 0) { fprintf(stderr, "kernel_launch: %d CUs: this kernel deals work in groups of 8 workgroups; nothing launched\n", grid); grid = -1; return; }
    }
    if (grid < 0) return;
    if (hipMemsetAsync((char*)d_ws + WS_CTL, 0, CTL_ZERO_BYTES, stream) != hipSuccess) { fprintf(stderr, "kernel_launch: hipMemsetAsync of the control words failed; nothing launched\n"); return; }
    Args a{};
    for (int i = 0; i < 15; ++i) a.in[i] = (const float*)d_in[i];
    a.out = (float*)d_out; a.ws = (unsigned char*)d_ws;
#if MK_ONE_LAUNCH
    a.ph_lo = 0; a.ph_hi = N_PHASES;
    hipLaunchKernelGGL(skel_fwd, dim3(grid), dim3(NWAVES * 64), LDS_BYTES, stream, a);
    { const hipError_t le = hipPeekAtLastError(); if (le != hipSuccess) fprintf(stderr, "kernel_launch: launch failed: %s\n", hipGetErrorName(le)); }
#else
    for (int p = 0; p < N_PHASES; ++p) {
        a.ph_lo = p; a.ph_hi = p + 1;
        hipLaunchKernelGGL(skel_fwd, dim3(grid), dim3(NWAVES * 64), LDS_BYTES, stream, a);
        const hipError_t le = hipPeekAtLastError();
        if (le != hipSuccess) { fprintf(stderr, "kernel_launch: launch %d failed: %s\n", p, hipGetErrorName(le)); break; }
    }
#endif
}
```

```cpp
#include <hip/hip_runtime.h>
#include <cstdio>
#include <cstdint>
#include <cmath>
namespace pg8 {
#define PG8_LAS __attribute__((address_space(3)))
typedef unsigned short bf16_t;
typedef short bf16x8 __attribute__((ext_vector_type(8)));
typedef float f32x4 __attribute__((ext_vector_type(4)));
typedef unsigned u32x4 __attribute__((ext_vector_type(4)));
typedef int i32x4 __attribute__((ext_vector_type(4)));
constexpr int BM = 256, BK = 64, HALF = 128, HTB = HALF * BK * 2  , STAGE_BYTES = 8 * HTB, NXCD = 8, WGM = 8;

__host__ __device__ __forceinline__ int lds_byte(int r, int c) { const int st = (r >> 4) * 2 + (c >> 5), rr = r & 15, cc = c & 31, ob = rr * 64 + cc * 2; return st * 1024 + (ob ^ (((ob >> 9) & 1) << 5)); }
__host__ __device__ __forceinline__ void stage_rc(int b, int& R, int& C) { const int st = b / 1024, sb = b % 1024, swz = sb ^ (((sb >> 9) & 1) << 5); R = (st >> 1) * 16 + swz / 64; C = (st & 1) * 32 + (swz % 64) / 2; }
__host__ __device__ __forceinline__ int perm32(int rho) { const int n = rho >> 4, i = rho & 15; return 8 * (i >> 2) + 4 * n + (i & 3); }

struct Unit { int pm, pn; };
struct Gemm { const bf16_t* A; const bf16_t* Bt; int M, N, K; };

struct StaticOrder {
    int nM, nN, nwg, G, c;
    __host__ __device__ void init(int M, int N, int G_, int c_) { nM = M / BM; nN = N / BM; nwg = nM * nN; G = G_; c = c_; }
    __host__ __device__ bool next(int i, Unit& u) const {
        const long L = (long)i * G + c; if (L >= nwg) return false;
        int wgid = (int)L; { const int q = nwg / NXCD, r = nwg % NXCD, xcd = wgid % NXCD, off = wgid / NXCD; wgid = (xcd < r ? xcd * (q + 1) : r * (q + 1) + (xcd - r) * q) + off; }
        const int nig = WGM * nN, gid = wgid / nig, fm = gid * WGM, gsz = (nM - fm) < WGM ? (nM - fm) : WGM;
        u.pm = fm + ((wgid % nig) % gsz); u.pn = (wgid % nig) / gsz; return true;
    }
    __device__ __forceinline__ void a_ready(const Unit&) const {}
    __device__ __forceinline__ void done(const Unit&) const {}
};
__device__ __forceinline__ unsigned cvt_pk_bf16(float lo, float hi) { unsigned r; asm volatile("v_cvt_pk_bf16_f32 %0, %1, %2" : "=v"(r) : "v"(lo), "v"(hi)); return r; }
typedef unsigned u32x2 __attribute__((ext_vector_type(2)));
__device__ __forceinline__ float sigm(float v) { return __builtin_amdgcn_rcpf(1.0f + __builtin_amdgcn_exp2f(-1.4426950408889634f * v)); }
__device__ __forceinline__ u32x4 pack8(const f32x4 a, const f32x4 b) { u32x4 w; w.x = cvt_pk_bf16(a[0], a[1]); w.y = cvt_pk_bf16(a[2], a[3]); w.z = cvt_pk_bf16(b[0], b[1]); w.w = cvt_pk_bf16(b[2], b[3]); return w; }
__device__ __forceinline__ void unpack8(const u32x4 w, f32x4& a, f32x4& b) {
    a[0] = __uint_as_float(w.x << 16); a[1] = __uint_as_float(w.x & 0xffff0000u); a[2] = __uint_as_float(w.y << 16); a[3] = __uint_as_float(w.y & 0xffff0000u);
    b[0] = __uint_as_float(w.z << 16); b[1] = __uint_as_float(w.z & 0xffff0000u); b[2] = __uint_as_float(w.w << 16); b[3] = __uint_as_float(w.w & 0xffff0000u);
}
template <bool I8> struct EpiProj {
    static constexpr bool PERM = true, AFTER_DRAIN = false;
    bf16_t *Q, *K, *V, *H, *Bg, *Cg, *GA, *GC; const float *sx, *sw;
    __device__ __forceinline__ void operator()(const f32x4 (&acc)[2][2][4][2], const Unit& u, int wr, int wc, int fr, int fq) const {
        const int pn = u.pn; bf16_t* base; int ldc, ct; bool sg = false;
        if (pn < 8) { base = Q; ldc = 2048; ct = pn; } else if (pn < 10) { base = K; ldc = 512; ct = pn - 8; } else if (pn < 12) { base = V; ldc = 512; ct = pn - 10; }
        else if (pn < 20) { base = H; ldc = 2048; ct = pn - 12; } else if (pn < 28) { base = Bg; ldc = 2048; ct = pn - 20; } else if (pn < 36) { base = Cg; ldc = 2048; ct = pn - 28; }
        else if (pn < 52) { base = GA; ldc = 4096; ct = pn - 36; sg = true; } else { base = GC; ldc = 4096; ct = pn - 52; sg = true; }
        const int row0 = u.pm * BM + wr * 64 + fr, col0 = ct * BM + wc * 32 + 8 * fq;
        f32x4 cs[2][2];
        if constexpr (I8) {
#pragma unroll
            for (int bj = 0; bj < 2; ++bj)
#pragma unroll
                for (int n = 0; n < 2; ++n) cs[bj][n] = *(const f32x4*)(sw + pn * BM + bj * HALF + wc * 32 + 8 * fq + 4 * n);
        }
#pragma unroll
        for (int ai = 0; ai < 2; ++ai)
#pragma unroll
            for (int m = 0; m < 4; ++m) { const int row = row0 + ai * HALF + m * 16; bf16_t* rowp = base + (size_t)row * ldc + col0;
                float rs = 1.f; if constexpr (I8) rs = sx[row];
#pragma unroll
                for (int bj = 0; bj < 2; ++bj) { f32x4 v0 = acc[ai][bj][m][0], v1 = acc[ai][bj][m][1];
                    if constexpr (I8) { v0 = __builtin_convertvector(__builtin_bit_cast(i32x4, v0), f32x4) * (cs[bj][0] * rs); v1 = __builtin_convertvector(__builtin_bit_cast(i32x4, v1), f32x4) * (cs[bj][1] * rs); }
                    if (sg) {
#pragma unroll
                        for (int e = 0; e < 4; ++e) { v0[e] = sigm(v0[e]); v1[e] = sigm(v1[e]); } }
                    *(u32x4*)(rowp + bj * HALF) = pack8(v0, v1); } }
    }
};
struct EpiMerge {
    static constexpr bool PERM = true, AFTER_DRAIN = false;
    const bf16_t *GA, *GC; bf16_t *T, *Mg;
    __device__ __forceinline__ void operator()(const f32x4 (&acc)[2][2][4][2], const Unit& u, int wr, int wc, int fr, int fq) const {
        const int which = u.pm >> 6, pm = u.pm & 63, pn = u.pn & 15;
        const bf16_t* G = which ? GC : GA;
        const int row0 = pm * BM + wr * 64 + fr, col0 = pn * BM + wc * 32 + 8 * fq;
#pragma unroll
        for (int ai = 0; ai < 2; ++ai)
#pragma unroll
            for (int m = 0; m < 4; ++m) { const size_t off = (size_t)(row0 + ai * HALF + m * 16) * 4096 + col0;
#pragma unroll
                for (int bj = 0; bj < 2; ++bj) { const size_t o = off + bj * HALF; f32x4 g0, g1; unpack8(*(const u32x4*)(G + o), g0, g1);
                    f32x4 v0 = acc[ai][bj][m][0] * g0, v1 = acc[ai][bj][m][1] * g1;
                    if (which == 0) { *(u32x4*)(T + o) = pack8(v0, v1); }
                    else { f32x4 t0, t1; unpack8(*(const u32x4*)(T + o), t0, t1); *(u32x4*)(Mg + o) = pack8(v0 + t0, v1 + t1); } } }
    }
};
struct EpiRes {
    static constexpr bool PERM = true, AFTER_DRAIN = false;
    const float* X; bf16_t* O;
    __device__ __forceinline__ void operator()(const f32x4 (&acc)[2][2][4][2], const Unit& u, int wr, int wc, int fr, int fq) const {
        const int row0 = u.pm * BM + wr * 64 + fr, col0 = u.pn * BM + wc * 32 + 8 * fq;
#pragma unroll
        for (int ai = 0; ai < 2; ++ai)
#pragma unroll
            for (int m = 0; m < 4; ++m) { const size_t off = (size_t)(row0 + ai * HALF + m * 16) * 4096 + col0;
#pragma unroll
                for (int bj = 0; bj < 2; ++bj) { const size_t o = off + bj * HALF; const f32x4 x0 = *(const f32x4*)(X + o), x1 = *(const f32x4*)(X + o + 4);
                    *(u32x4*)(O + o) = pack8(x0 + acc[ai][bj][m][0], x1 + acc[ai][bj][m][1]); } }
    }
};
struct EpiMergeA8 {
    static constexpr bool PERM = true, AFTER_DRAIN = false;
    const bf16_t* GA; bf16_t* T; const float *sx, *sw;
    __device__ __forceinline__ void operator()(const f32x4 (&acc)[2][2][4][2], const Unit& u, int wr, int wc, int fr, int fq) const {
        const int row0 = u.pm * BM + wr * 64 + fr, col0 = u.pn * BM + wc * 32 + 8 * fq;
        f32x4 cs[2][2];
#pragma unroll
        for (int bj = 0; bj < 2; ++bj)
#pragma unroll
            for (int n = 0; n < 2; ++n) cs[bj][n] = *(const f32x4*)(sw + col0 + bj * HALF + 4 * n);
#pragma unroll
        for (int ai = 0; ai < 2; ++ai)
#pragma unroll
            for (int m = 0; m < 4; ++m) { const int row = row0 + ai * HALF + m * 16; const size_t off = (size_t)row * 4096 + col0; const float rs = sx[row];
#pragma unroll
                for (int bj = 0; bj < 2; ++bj) { const size_t o = off + bj * HALF; f32x4 g0, g1; unpack8(*(const u32x4*)(GA + o), g0, g1);
                    *(u32x4*)(T + o) = pack8(__builtin_convertvector(__builtin_bit_cast(i32x4, acc[ai][bj][m][0]), f32x4) * (cs[bj][0] * rs) * g0, __builtin_convertvector(__builtin_bit_cast(i32x4, acc[ai][bj][m][1]), f32x4) * (cs[bj][1] * rs) * g1); } }
    }
};
struct EpiMergeC {
    static constexpr bool PERM = true, AFTER_DRAIN = false;
    const bf16_t *GC, *T; bf16_t* Mg;
    __device__ __forceinline__ void operator()(const f32x4 (&acc)[2][2][4][2], const Unit& u, int wr, int wc, int fr, int fq) const {
        const int row0 = u.pm * BM + wr * 64 + fr, col0 = u.pn * BM + wc * 32 + 8 * fq;
#pragma unroll
        for (int ai = 0; ai < 2; ++ai)
#pragma unroll
            for (int m = 0; m < 4; ++m) { const size_t off = (size_t)(row0 + ai * HALF + m * 16) * 4096 + col0;
#pragma unroll
                for (int bj = 0; bj < 2; ++bj) { const size_t o = off + bj * HALF; f32x4 g0, g1, t0, t1; unpack8(*(const u32x4*)(GC + o), g0, g1); unpack8(*(const u32x4*)(T + o), t0, t1);
                    *(u32x4*)(Mg + o) = pack8(acc[ai][bj][m][0] * g0 + t0, acc[ai][bj][m][1] * g1 + t1); } }
    }
};
struct EpiResI8 {
    static constexpr bool PERM = true, AFTER_DRAIN = false;
    const float* X; bf16_t* O; const float *sx, *sw;
    __device__ __forceinline__ void operator()(const f32x4 (&acc)[2][2][4][2], const Unit& u, int wr, int wc, int fr, int fq) const {
        const int row0 = u.pm * BM + wr * 64 + fr, col0 = u.pn * BM + wc * 32 + 8 * fq;
        f32x4 cs[2][2];
#pragma unroll
        for (int bj = 0; bj < 2; ++bj)
#pragma unroll
            for (int n = 0; n < 2; ++n) cs[bj][n] = *(const f32x4*)(sw + col0 + bj * HALF + 4 * n);
#pragma unroll
        for (int ai = 0; ai < 2; ++ai)
#pragma unroll
            for (int m = 0; m < 4; ++m) { const int row = row0 + ai * HALF + m * 16; const size_t off = (size_t)row * 4096 + col0; const float rs = sx[row];
#pragma unroll
                for (int bj = 0; bj < 2; ++bj) { const size_t o = off + bj * HALF; const f32x4 x0 = *(const f32x4*)(X + o), x1 = *(const f32x4*)(X + o + 4);
                    *(u32x4*)(O + o) = pack8(x0 + __builtin_convertvector(__builtin_bit_cast(i32x4, acc[ai][bj][m][0]), f32x4) * (cs[bj][0] * rs), x1 + __builtin_convertvector(__builtin_bit_cast(i32x4, acc[ai][bj][m][1]), f32x4) * (cs[bj][1] * rs)); } }
    }
};
struct EpiStoreI8 {
    static constexpr bool PERM = true, AFTER_DRAIN = false;
    bf16_t* O; int ldc; const float *sx, *sw;
    __device__ __forceinline__ void operator()(const f32x4 (&acc)[2][2][4][2], const Unit& u, int wr, int wc, int fr, int fq) const {
        const int row0 = u.pm * BM + wr * 64 + fr, col0 = u.pn * BM + wc * 32 + 8 * fq;
        f32x4 cs[2][2];
#pragma unroll
        for (int bj = 0; bj < 2; ++bj)
#pragma unroll
            for (int n = 0; n < 2; ++n) cs[bj][n] = *(const f32x4*)(sw + col0 + bj * HALF + 4 * n);
#pragma unroll
        for (int ai = 0; ai < 2; ++ai)
#pragma unroll
            for (int m = 0; m < 4; ++m) { const int row = row0 + ai * HALF + m * 16; bf16_t* rowp = O + (size_t)row * ldc + col0; const float rs = sx[row];
#pragma unroll
                for (int bj = 0; bj < 2; ++bj) *(u32x4*)(rowp + bj * HALF) = pack8(__builtin_convertvector(__builtin_bit_cast(i32x4, acc[ai][bj][m][0]), f32x4) * (cs[bj][0] * rs), __builtin_convertvector(__builtin_bit_cast(i32x4, acc[ai][bj][m][1]), f32x4) * (cs[bj][1] * rs)); }
    }
};
struct EpiStore {
    static constexpr bool PERM = true, AFTER_DRAIN = false;
    bf16_t* O; int ldc;
    __device__ __forceinline__ void operator()(const f32x4 (&acc)[2][2][4][2], const Unit& u, int wr, int wc, int fr, int fq) const {
        const int row0 = u.pm * BM + wr * 64 + fr, col0 = u.pn * BM + wc * 32 + 8 * fq;
#pragma unroll
        for (int ai = 0; ai < 2; ++ai)
#pragma unroll
            for (int m = 0; m < 4; ++m) { bf16_t* rowp = O + (size_t)(row0 + ai * HALF + m * 16) * ldc + col0;
#pragma unroll
                for (int bj = 0; bj < 2; ++bj) *(u32x4*)(rowp + bj * HALF) = pack8(acc[ai][bj][m][0], acc[ai][bj][m][1]); }
    }
};
struct PairOrder {
    StaticOrder so;
    __device__ bool next(int i, Unit& u) const { Unit t; if (!so.next(i >> 1, t)) return false; const int w = i & 1; u.pm = t.pm + 64 * w; u.pn = t.pn + 16 * w; return true; }
    __device__ __forceinline__ void a_ready(const Unit&) const {}
    __device__ __forceinline__ void done(const Unit&) const {}
};
struct RangeOrder {
    StaticOrder so; int base, cut, skip;
    __device__ bool next(int i, Unit& u) const { if (!so.next(i, u)) return false; u.pn = base + (u.pn < cut ? u.pn : u.pn + skip); return true; }
    __device__ __forceinline__ void a_ready(const Unit&) const {}
    __device__ __forceinline__ void done(const Unit&) const {}
};
template <class Epi, class Sched, bool ALIGN_EPI = false, bool SP2 = false, bool I8 = false>
__device__ __forceinline__ void gemm_phase(PG8_LAS unsigned char* lds, const Gemm g, const Sched& S, const Epi& E) {
    const int tid = threadIdx.x, wid = __builtin_amdgcn_readfirstlane(tid >> 6), lane = tid & 63, wr = wid >> 2, wc = wid & 3, fr = lane & 15, fq = lane >> 4;
    const int K = g.K, nt = K / BK;
    unsigned voffA[2], voffB[2];
#pragma unroll
    for (int i = 0; i < 2; ++i) { int R, C; stage_rc(tid * 16 + i * 8192, R, C); const int Rb = Epi::PERM ? ((R & ~31) + perm32(R & 31)) : R;
        voffA[i] = (unsigned)(R * K + C) * 2u; voffB[i] = (unsigned)(Rb * K + C) * 2u; }
    const size_t kstep = (size_t)(BK * 2);
    const size_t hstep = (size_t)HALF * K * 2;
    const size_t tstep = 2 * hstep;
    const unsigned ldsw = (unsigned)wid * 1024u;
    const int aoff = lds_byte(wr * 64 + fr, fq * 8), boff = lds_byte(wc * 32 + fr, fq * 8);
#define PG8_SA(b, h) (((b) * 2 + (h)) * HTB)
#define PG8_SB(b, h) ((4 + (b) * 2 + (h)) * HTB)
#define PG8_STAGE(bufoff, gbase, voff) do { _Pragma("unroll") for (int _i = 0; _i < 2; ++_i) \
        __builtin_amdgcn_global_load_lds((const unsigned*)((const char*)(gbase) + (voff)[_i]), (PG8_LAS unsigned*)(lds + (bufoff) + ldsw + _i * 8192), 16, 0, 0); } while (0)
#define PG8_LDA(dst, b, h) do { _Pragma("unroll") for (int m = 0; m < 4; ++m) _Pragma("unroll") for (int k = 0; k < 2; ++k) dst[m][k] = *(const PG8_LAS bf16x8*)(lds + PG8_SA(b, h) + aoff + m * 2048 + k * 1024); } while (0)
#define PG8_LDB(dst, b, h) do { _Pragma("unroll") for (int n = 0; n < 2; ++n) _Pragma("unroll") for (int k = 0; k < 2; ++k) dst[n][k] = *(const PG8_LAS bf16x8*)(lds + PG8_SB(b, h) + boff + n * 2048 + k * 1024); } while (0)
#define PG8_MMA(ai, bj, At, Bt) do { __builtin_amdgcn_s_setprio(1); _Pragma("unroll") for (int m = 0; m < 4; ++m) _Pragma("unroll") for (int n = 0; n < 2; ++n) _Pragma("unroll") for (int k = 0; k < 2; ++k) \
        { if constexpr (I8) acc[ai][bj][m][n] = __builtin_bit_cast(f32x4, __builtin_amdgcn_mfma_i32_16x16x64_i8(__builtin_bit_cast(i32x4, Bt[n][k]), __builtin_bit_cast(i32x4, At[m][k]), __builtin_bit_cast(i32x4, acc[ai][bj][m][n]), 0, 0, 0)); \
          else acc[ai][bj][m][n] = __builtin_amdgcn_mfma_f32_16x16x32_bf16(Bt[n][k], At[m][k], acc[ai][bj][m][n], 0, 0, 0); } __builtin_amdgcn_s_setprio(0); } while (0)
#define PG8_WAIT_V(n) asm volatile("s_waitcnt vmcnt(" #n ")" ::: "memory")
#define PG8_WAIT_L(n) asm volatile("s_waitcnt lgkmcnt(" #n ")" ::: "memory")
#define PG8_BAR __builtin_amdgcn_s_barrier()
#define PG8_SCHED __builtin_amdgcn_sched_barrier(0)
    Unit cur, nxt; int ui = 0;
    if (!S.next(0, cur)) return;
    f32x4 acc[2][2][4][2];
#pragma unroll
    for (int a = 0; a < 2; ++a)
#pragma unroll
        for (int b = 0; b < 2; ++b)
#pragma unroll
            for (int m = 0; m < 4; ++m)
#pragma unroll
                for (int n = 0; n < 2; ++n) acc[a][b][m][n] = (f32x4){0.f, 0.f, 0.f, 0.f};
    bf16x8 At[4][2], B0[2][2], B1[2][2];
    const char* cA = (const char*)g.A + (size_t)cur.pm * tstep; const char* cB = (const char*)g.Bt + (size_t)cur.pn * tstep;
    S.a_ready(cur);
    if constexpr (SP2) {
        PG8_STAGE(PG8_SB(0, 0), cB, voffB); PG8_STAGE(PG8_SB(0, 1), cB + hstep, voffB); PG8_STAGE(PG8_SA(0, 0), cA, voffA); PG8_STAGE(PG8_SA(0, 1), cA + hstep, voffA);
        if (wr == 1) PG8_BAR;
        PG8_WAIT_V(2); PG8_BAR;
        PG8_STAGE(PG8_SB(1, 0), cB + kstep, voffB); PG8_STAGE(PG8_SA(1, 0), cA + kstep, voffA); PG8_STAGE(PG8_SB(1, 1), cB + hstep + kstep, voffB);
        PG8_WAIT_V(6); PG8_BAR;
    } else {
        PG8_STAGE(PG8_SB(0, 0), cB, voffB); PG8_STAGE(PG8_SA(0, 0), cA, voffA); PG8_STAGE(PG8_SB(0, 1), cB + hstep, voffB); PG8_STAGE(PG8_SA(0, 1), cA + hstep, voffA);
        if (wr == 1) PG8_BAR;
        PG8_WAIT_V(4); PG8_BAR;
        PG8_STAGE(PG8_SB(1, 0), cB + kstep, voffB); PG8_STAGE(PG8_SA(1, 0), cA + kstep, voffA); PG8_STAGE(PG8_SB(1, 1), cB + hstep + kstep, voffB);
        PG8_WAIT_V(6); PG8_BAR;
    }
    for (;;) {
        const bool has_next = S.next(ui + 1, nxt);
        const char* nA = has_next ? (const char*)g.A + (size_t)nxt.pm * tstep : cA; const char* nB = has_next ? (const char*)g.Bt + (size_t)nxt.pn * tstep : cB;
        for (int t = 0; t < nt; t += 2) {
            const bool last = (t == nt - 2);
            const char* a1 = cA + (size_t)(t + 1) * kstep;
            const char* a2 = last ? nA : cA + (size_t)(t + 2) * kstep; const char* b2 = last ? nB : cB + (size_t)(t + 2) * kstep;
            const char* a3 = a2 + kstep; const char* b3 = b2 + kstep;
            if (last && has_next) S.a_ready(nxt);
            if constexpr (SP2) {
            PG8_LDB(B0, 0, 0); PG8_LDB(B1, 0, 1); PG8_SCHED; PG8_LDA(At, 0, 0); PG8_STAGE(PG8_SA(1, 1), a1 + hstep, voffA);
            PG8_WAIT_V(8); PG8_WAIT_L(0); PG8_BAR; PG8_MMA(0, 0, At, B0); PG8_MMA(0, 1, At, B1); PG8_BAR; PG8_SCHED;
            PG8_LDA(At, 0, 1); PG8_STAGE(PG8_SB(0, 0), b2, voffB); PG8_STAGE(PG8_SB(0, 1), b2 + hstep, voffB); PG8_STAGE(PG8_SA(0, 0), a2, voffA);
            PG8_WAIT_V(8); PG8_WAIT_L(0); PG8_BAR; PG8_MMA(1, 0, At, B0); PG8_MMA(1, 1, At, B1); PG8_BAR; PG8_SCHED;
            PG8_LDB(B0, 1, 0); PG8_LDB(B1, 1, 1); PG8_SCHED; PG8_LDA(At, 1, 0); PG8_STAGE(PG8_SA(0, 1), a2 + hstep, voffA);
            PG8_WAIT_V(8); PG8_WAIT_L(0); PG8_BAR; PG8_MMA(0, 0, At, B0); PG8_MMA(0, 1, At, B1); PG8_BAR; PG8_SCHED;
            PG8_LDA(At, 1, 1); PG8_STAGE(PG8_SB(1, 0), b3, voffB); PG8_STAGE(PG8_SB(1, 1), b3 + hstep, voffB); PG8_STAGE(PG8_SA(1, 0), a3, voffA);
            PG8_WAIT_V(8); PG8_WAIT_L(0); PG8_BAR; PG8_MMA(1, 0, At, B0); PG8_MMA(1, 1, At, B1); PG8_BAR; PG8_SCHED;
            } else {
            PG8_LDB(B0, 0, 0); PG8_SCHED; PG8_LDA(At, 0, 0); PG8_STAGE(PG8_SA(1, 1), a1 + hstep, voffA);
            PG8_WAIT_L(8); PG8_BAR; PG8_WAIT_L(0); PG8_MMA(0, 0, At, B0); PG8_BAR; PG8_SCHED;
            PG8_LDB(B1, 0, 1); PG8_STAGE(PG8_SB(0, 0), b2, voffB);
            PG8_BAR; PG8_WAIT_L(0); PG8_MMA(0, 1, At, B1); PG8_BAR;
            PG8_LDA(At, 0, 1); PG8_STAGE(PG8_SA(0, 0), a2, voffA);
            PG8_BAR; PG8_WAIT_L(0); PG8_MMA(1, 0, At, B0); PG8_BAR; PG8_SCHED;
            PG8_STAGE(PG8_SB(0, 1), b2 + hstep, voffB);
            PG8_WAIT_V(6); PG8_BAR; PG8_MMA(1, 1, At, B1); PG8_BAR;
            PG8_LDB(B0, 1, 0); PG8_SCHED; PG8_LDA(At, 1, 0); PG8_STAGE(PG8_SA(0, 1), a2 + hstep, voffA);
            PG8_WAIT_L(8); PG8_BAR; PG8_WAIT_L(0); PG8_MMA(0, 0, At, B0); PG8_BAR; PG8_SCHED;
            PG8_LDB(B1, 1, 1); PG8_STAGE(PG8_SB(1, 0), b3, voffB);
            PG8_BAR; PG8_WAIT_L(0); PG8_MMA(0, 1, At, B1); PG8_BAR;
            PG8_LDA(At, 1, 1); PG8_STAGE(PG8_SA(1, 0), a3, voffA);
            PG8_BAR; PG8_WAIT_L(0); PG8_MMA(1, 0, At, B0); PG8_BAR; PG8_SCHED;
            PG8_STAGE(PG8_SB(1, 1), b3 + hstep, voffB);
            PG8_WAIT_V(6); PG8_BAR; PG8_MMA(1, 1, At, B1); PG8_BAR;
            }
        }
        if constexpr (ALIGN_EPI) { if (wr == 0) PG8_BAR; }
        if constexpr (!Epi::AFTER_DRAIN) { E(acc, cur, wr, wc, fr, fq); S.done(cur); }
        if (!has_next) break;
#pragma unroll
        for (int a = 0; a < 2; ++a)
#pragma unroll
            for (int b = 0; b < 2; ++b)
#pragma unroll
                for (int m = 0; m < 4; ++m)
#pragma unroll
                    for (int n = 0; n < 2; ++n) acc[a][b][m][n] = (f32x4){0.f, 0.f, 0.f, 0.f};
        cur = nxt; cA = nA; cB = nB; ++ui;
        if constexpr (ALIGN_EPI) { if (wr == 1) PG8_BAR; }
    }
    PG8_WAIT_V(0);
    if constexpr (!ALIGN_EPI) { if (wr == 0) PG8_BAR; }
    PG8_BAR;
    if constexpr (Epi::AFTER_DRAIN) { E.fused(acc, cur, wr, wc, fr, fq, lds, wid, lane); S.done(cur); }
#undef PG8_SA
#undef PG8_SB
#undef PG8_STAGE
#undef PG8_LDA
#undef PG8_LDB
#undef PG8_MMA
#undef PG8_WAIT_V
#undef PG8_WAIT_L
#undef PG8_BAR
#undef PG8_SCHED
}
}
#ifndef PG8_SP2
#define PG8_SP2 true
#endif
#ifndef PG8_ALIGN
#define PG8_ALIGN true
#endif
constexpr int NWAVES = 8;
#ifndef MK_ONE_LAUNCH
#define MK_ONE_LAUNCH 1
#endif
constexpr int N_PHASES = 12;
#ifndef NIBBLE_SWAP_DOWN
#define NIBBLE_SWAP_DOWN 0
#endif
#ifndef I8_CFG
#define I8_CFG 1
#endif
#ifndef P4A_I8
#define P4A_I8 1
#endif
#ifndef P5_I8
#define P5_I8 1
#endif
#if I8_CFG == 0
constexpr int I8_TILES = 44, I8_CUT = 12, I8_SKIP = 24, BF_BASE = 12, BF_TILES = 24;
#elif I8_CFG == 1
constexpr int I8_TILES = 60, I8_CUT = 12, I8_SKIP = 8, BF_BASE = 12, BF_TILES = 8;
#else
constexpr int I8_TILES = 68, I8_CUT = 68, I8_SKIP = 0, BF_BASE = 12, BF_TILES = 0;
#endif

constexpr int BATCH = 4, SEQ = 4096, D = 4096, M = BATCH * SEQ;
constexpr int HD = 128, NH = 16, NKV = 4, QW = NH * HD, KVW = NKV * HD, CW = 2048, INW = 17408;
constexpr int PH = 8, NKEYS = 128, TOPK = 16, NEXP = NKEYS * NKEYS, PQW = PH * 2 * 128;
constexpr float EPS = 1e-6f;
constexpr size_t SLICE_BYTES = (size_t)NEXP * 128;
constexpr float LOG2E = 1.4426950408889634f;

constexpr size_t MiB = 1u << 20;
constexpr size_t WS_CTL = 0, CTL_ZERO_BYTES = 1 * MiB;
constexpr size_t WS_WIN = 2 * MiB;
constexpr size_t WS_WO = 138 * MiB;
constexpr size_t WS_WOUT = 170 * MiB;
constexpr size_t WS_WQP = 202 * MiB;
constexpr size_t WS_SK = 218 * MiB;
constexpr size_t WS_IDX = 220 * MiB, WS_GATE = 228 * MiB;
constexpr size_t WS_XN = 236 * MiB;
constexpr size_t WS_AB = 364 * MiB;
constexpr size_t WS_Q = 492 * MiB, WS_K = 556 * MiB, WS_V = 572 * MiB, WS_H = 588 * MiB, WS_B = 652 * MiB, WS_C = 716 * MiB;
constexpr size_t WS_GA = 780 * MiB, WS_GC = 908 * MiB;
constexpr size_t WS_T = 492 * MiB;
constexpr size_t WS_X1B = 620 * MiB;
constexpr size_t WS_X2N = 620 * MiB;
constexpr size_t WS_PART = 236 * MiB;
constexpr size_t WS_X2N8 = 492 * MiB;
constexpr size_t WS_CF4 = 780 * MiB;
constexpr size_t WS_QP = 780 * MiB;
constexpr size_t WS_W4D = 1036 * MiB, WS_W4U = 1068 * MiB;
constexpr size_t WS_SCD = 1100 * MiB, WS_SCU = WS_SCD + 65536;
constexpr size_t WS_SX = WS_SCD + 131072, WS_SW = WS_SCD + 262144;
constexpr size_t WS_XN8 = 364 * MiB;
constexpr size_t WS_W8 = 1101 * MiB;
constexpr size_t WS_W8QP = 1169 * MiB;
constexpr size_t WS_SWQ = WS_SCD + 393216, WS_SX2 = WS_SCD + 458752;
constexpr size_t WS_X2I8 = 364 * MiB;
constexpr size_t WS_W8OUT = 1177 * MiB;
constexpr size_t WS_SWO = WS_SCD + 524288, WS_SXM = WS_SCD + 589824;
constexpr size_t WS_MI8 = 364 * MiB;
constexpr size_t WS_W8OA = 1193 * MiB;
constexpr size_t WS_SWA = WS_SCD + 655360, WS_SXA = WS_SCD + 671744;
constexpr size_t WS_AI8 = 748 * MiB;
constexpr size_t WS_END = 1201 * MiB;
static_assert(WS_T + (size_t)M * D * 2 <= WS_X2N && WS_X2N + (size_t)M * D * 2 <= WS_GA && WS_QP + (size_t)M * PQW * 2 <= WS_GC, "d_ws overlays");
static_assert(WS_WIN + (size_t)INW * D * 2 <= WS_WO && WS_C + (size_t)M * CW * 2 <= WS_GA && WS_GC + (size_t)M * D * 2 <= WS_END, "d_ws map");
constexpr int CW_XRANK = 8192;
constexpr int CW_BAR = 4096;

constexpr int RING_OFF = 0, RING_BYTES = 131072;
constexpr int LDSCTL_OFF = RING_BYTES, MISC_OFF = LDSCTL_OFF + 320;
constexpr int OBUF_OFF = 132096;
constexpr int ODUMP_OFF = OBUF_OFF + 8192;
constexpr int LDS_BYTES = 147456;
static_assert(MISC_OFF + 128 <= OBUF_OFF && ODUMP_OFF + 2048 <= LDS_BYTES, "LDS map");
#define GAS __attribute__((address_space(1)))
#define LAS __attribute__((address_space(3)))
typedef unsigned short bf16;
typedef unsigned v4u __attribute__((ext_vector_type(4)));
typedef float f32x4 __attribute__((ext_vector_type(4)));
typedef short bf16x8 __attribute__((ext_vector_type(8)));
typedef GAS unsigned gu32;
typedef GAS unsigned long long gu64;
#define RLX_AGENT __ATOMIC_RELAXED, __HIP_MEMORY_SCOPE_AGENT
#define LDS_WAIT() asm volatile("s_waitcnt lgkmcnt(0)" ::: "memory")
#define VM_WAIT() asm volatile("s_waitcnt vmcnt(0)" ::: "memory")
__device__ __forceinline__ unsigned long long rt() { return __builtin_amdgcn_s_memrealtime(); }
__device__ __forceinline__ unsigned f2bf(float f) { unsigned u = __builtin_bit_cast(unsigned, f); return (u + 0x7fffu + ((u >> 16) & 1u)) >> 16; }
__device__ __forceinline__ unsigned pk2(float lo, float hi) { return f2bf(lo) | (f2bf(hi) << 16); }

#define XB_TMO      128
#define XB_XCNT(j)  (256  + 64 * (j))
#define XB_XSUB(j)  (1280 + 64 * (j))
#define XB_XGEN(j)  (2304 + 64 * (j))
#define XB_TOP      3328
#define XB_TOPGEN   3392
#define XCD_BAR_WORDS 3456
#define XB_SPIN_CAP (1u << 18)

__device__ __forceinline__ unsigned xb_ld(unsigned* p)              { return __hip_atomic_load(p, __ATOMIC_RELAXED, __HIP_MEMORY_SCOPE_AGENT); }
__device__ __forceinline__ unsigned xb_add(unsigned* p, unsigned v) { return __hip_atomic_fetch_add(p, v, __ATOMIC_RELAXED, __HIP_MEMORY_SCOPE_AGENT); }
__device__ __forceinline__ unsigned xb_xcc_id() { return (unsigned)__builtin_amdgcn_s_getreg((3 << 11) | 20) & 0xFu; }
#define XB_SPIN(cond, bar) do { unsigned _sp = 0; while (cond) { __builtin_amdgcn_s_sleep(1); \
    if ((++_sp & 255u) == 0u) { if (xb_ld(&(bar)[XB_TMO])) break; if (_sp > XB_SPIN_CAP) { atomicAdd(&(bar)[XB_TMO], 1u); break; } } } } while (0)

struct XcdBarrier {
    unsigned* bar; unsigned x;
    volatile LAS unsigned* st;
};

__device__ __forceinline__ XcdBarrier xcd_barrier_post(unsigned* bar, volatile LAS unsigned* st) {
    XcdBarrier b; b.bar = bar; b.x = xb_xcc_id(); b.st = st;
    if (threadIdx.x == 0) (void)xb_add(&bar[XB_XCNT(b.x)], 1u);
    return b;
}
__device__ __forceinline__ void xcd_barrier_complete(unsigned* bar, unsigned x, unsigned& nloc, unsigned& nx) {
    const unsigned G = gridDim.x * gridDim.y * gridDim.z;
    unsigned sum, cnt, mine, sp = 0u;
    for (;;) {
        sum = 0u; cnt = 0u; mine = 0u;
#pragma unroll
        for (unsigned j = 0; j < 16; ++j) { const unsigned c = xb_ld(&bar[XB_XCNT(j)]); sum += c; cnt += (c > 0u) ? 1u : 0u; mine = (j == x) ? c : mine; }
        if (sum == G) break;
        __builtin_amdgcn_s_sleep(1);
        if ((++sp & 255u) == 0u) { if (xb_ld(&bar[XB_TMO])) break; if (sp > XB_SPIN_CAP) { atomicAdd(&bar[XB_TMO], 1u); break; } }
    }
    nloc = mine > 0u ? mine : 1u; nx = cnt > 0u ? cnt : 1u;
}

__device__ __forceinline__ void xcd_barrier(const XcdBarrier& b) {
    asm volatile("s_waitcnt vmcnt(0)" ::: "memory");
    __syncthreads();
    if (threadIdx.x == 0) {
        unsigned* bar = b.bar;
        __builtin_amdgcn_s_waitcnt(0);
        unsigned nloc = b.st[0], nx = b.st[1];
        if (nloc == 0u) { xcd_barrier_complete(bar, b.x, nloc, nx); b.st[0] = nloc; b.st[1] = nx; }
        const unsigned old = xb_add(&bar[XB_XSUB(b.x)], 1u);
        const unsigned gen = old / nloc;
        if (old + 1u == (gen + 1u) * nloc) {
            __builtin_amdgcn_fence(__ATOMIC_RELEASE, "agent");
            asm volatile("s_waitcnt vmcnt(0)" ::: "memory");
            const unsigned og = xb_add(&bar[XB_TOP], 1u);
            const unsigned tg = og / nx;
            if (og + 1u == (tg + 1u) * nx) xb_add(&bar[XB_TOPGEN], 1u);
            else XB_SPIN(xb_ld(&bar[XB_TOPGEN]) == tg, bar);
            __builtin_amdgcn_fence(__ATOMIC_ACQUIRE, "agent");
            xb_add(&bar[XB_XGEN(b.x)], 1u);
            asm volatile("s_waitcnt vmcnt(0)" ::: "memory");
        } else {
            XB_SPIN(xb_ld(&bar[XB_XGEN(b.x)]) == gen, bar);
            __builtin_amdgcn_fence(__ATOMIC_ACQUIRE, "agent");
            asm volatile("s_waitcnt vmcnt(0)" ::: "memory");
        }
    }
    __syncthreads();
}
typedef unsigned u32x2_t __attribute__((ext_vector_type(2)));
typedef short v4i16_t __attribute__((ext_vector_type(4)));
typedef unsigned long long u64;
typedef float f32x2_t __attribute__((ext_vector_type(2)));
typedef int i32x4_t __attribute__((ext_vector_type(4)));
struct Frame {
    LAS unsigned char* lds;
    volatile LAS unsigned* MISC;
    gu32* ctl;
    unsigned char* ws;
    int tid, lane, wave;
    int vcu, G;
    const float *x, *g1, *w_in, *gq, *gk, *sink, *conv_w, *w_oa, *w_oc, *w_out, *g2, *w_qp, *subk, *w_down, *w_up;
    float* out;
};
#define WSP(type, off) ((type*)(F.ws + (off)))
using pg8::cvt_pk_bf16; using pg8::pack8; using pg8::unpack8;

__device__ __forceinline__ float wave_sum(float v) {
#pragma unroll
    for (int o = 1; o < 64; o <<= 1) v += __shfl_xor(v, o);
    return v;
}
__device__ __forceinline__ float dot4(const f32x4 a, const f32x4 b) { return (a[0] * b[0] + a[1] * b[1]) + (a[2] * b[2] + a[3] * b[3]); }
__device__ __forceinline__ float bflo(unsigned w) { return __uint_as_float(w << 16); }
__device__ __forceinline__ float bfhi(unsigned w) { return __uint_as_float(w & 0xffff0000u); }

typedef int v2i32_t __attribute__((ext_vector_type(2)));
__device__ __forceinline__ bool tr4_selfcheck(LAS unsigned char* tp, int lane) {
    const int g = lane >> 4, j = lane & 15;
    unsigned lo = 0u, hi = 0u;
#pragma unroll
    for (int c = 0; c < 8; ++c) { lo |= (unsigned)((j * 5 + c * 3 + g + 1) & 15) << (4 * c); hi |= (unsigned)((j * 5 + (c + 8) * 3 + g + 1) & 15) << (4 * c); }
    *(LAS u32x2_t*)(tp + lane * 8) = (u32x2_t){lo, hi};
    LDS_WAIT(); asm volatile("" ::: "memory");
    const v2i32_t rv = __builtin_amdgcn_ds_read_tr4_b64_v2i32((LAS v2i32_t*)(tp + lane * 8));
    bool ok = true;
#pragma unroll
    for (int e = 0; e < 8; ++e) { ok = ok && ((((unsigned)rv.x >> (4 * e)) & 15u) == (unsigned)((e * 5 + j * 3 + g + 1) & 15)) && ((((unsigned)rv.y >> (4 * e)) & 15u) == (unsigned)(((e + 8) * 5 + j * 3 + g + 1) & 15)); }
    return __all(ok);
}

__device__ __forceinline__ void p0_transpose_item(const float* W, int K, int N, bf16* WT, int row_off, LAS float* scr, int item, int lane) {
    const int nblk = N / 32, kb = item / nblk, nb = item % nblk, k0 = 64 * kb, n0 = 32 * nb;
#pragma unroll 8
    for (int i = 0; i < 32; ++i) { const int kk = 2 * i + (lane >> 5); scr[kk * 33 + (lane & 31)] = W[(size_t)(k0 + kk) * N + n0 + (lane & 31)]; }
    LDS_WAIT(); asm volatile("" ::: "memory");
    const int c = lane & 7;
#pragma unroll
    for (int j = 0; j < 4; ++j) { const int n = (lane >> 3) + 8 * j; const LAS float* s = scr + (8 * c) * 33 + n;
        v4u o; o.x = cvt_pk_bf16(s[0 * 33], s[1 * 33]); o.y = cvt_pk_bf16(s[2 * 33], s[3 * 33]); o.z = cvt_pk_bf16(s[4 * 33], s[5 * 33]); o.w = cvt_pk_bf16(s[6 * 33], s[7 * 33]);
        *(GAS v4u*)(WT + (size_t)(row_off + n0 + n) * K + k0 + 8 * c) = o; }
    LDS_WAIT(); asm volatile("" ::: "memory");
}
template <int QMODE  > __device__ __forceinline__ void rms_row_to_bf16(const float* xrow, const float* g, bf16* orow, unsigned* q8row, float* sxp, int lane) {
    const GAS f32x4* xr = (const GAS f32x4*)xrow + lane; const GAS f32x4* gr = (const GAS f32x4*)g + lane;
    f32x4 v[16]; float s = 0.f;
#pragma unroll
    for (int j = 0; j < 16; ++j) { v[j] = xr[64 * j]; s += dot4(v[j], v[j]); }
    const float r = rsqrtf(wave_sum(s) * (1.f / D) + EPS);
    GAS u32x2_t* o8 = (GAS u32x2_t*)orow + lane; float am = 0.f;
#pragma unroll
    for (int j = 0; j < 16; ++j) { v[j] = v[j] * r * gr[64 * j]; u32x2_t w; w.x = cvt_pk_bf16(v[j][0], v[j][1]); w.y = cvt_pk_bf16(v[j][2], v[j][3]); o8[64 * j] = w;
        am = fmaxf(am, fmaxf(fmaxf(fabsf(v[j][0]), fabsf(v[j][1])), fmaxf(fabsf(v[j][2]), fabsf(v[j][3])))); }
    if constexpr (QMODE == 2) {
#pragma unroll
        for (int j = 0; j < 16; ++j) { int p = 0; p = __builtin_amdgcn_cvt_pk_fp8_f32(v[j][0], v[j][1], p, false); p = __builtin_amdgcn_cvt_pk_fp8_f32(v[j][2], v[j][3], p, true); ((GAS unsigned*)q8row)[64 * j + lane] = (unsigned)p; }
    }
    if constexpr (QMODE == 1) {
#pragma unroll
        for (int o = 1; o < 64; o <<= 1) am = fmaxf(am, __shfl_xor(am, o));
        const float qs = am > 0.f ? 127.0f / am : 0.f;
#pragma unroll
        for (int j = 0; j < 16; ++j) { const int q0 = (int)__builtin_rintf(v[j][0] * qs), q1 = (int)__builtin_rintf(v[j][1] * qs), q2 = (int)__builtin_rintf(v[j][2] * qs), q3 = (int)__builtin_rintf(v[j][3] * qs);
            ((GAS unsigned*)q8row)[64 * j + lane] = (unsigned)(q0 & 255) | ((unsigned)(q1 & 255) << 8) | ((unsigned)(q2 & 255) << 16) | ((unsigned)q3 << 24); }
        if (lane == 0) *sxp = am * (1.0f / 127.0f);
    }
}
__device__ __forceinline__ void rms2_row(const bf16* xrow, const float* g, unsigned char* q8row, float* sxp, unsigned char* x4row, int lane) {
    const GAS v4u* xr = (const GAS v4u*)xrow + lane; const GAS f32x4* gr = (const GAS f32x4*)g + 2 * lane;
    f32x4 v[8][2]; float s = 0.f;
#pragma unroll
    for (int j = 0; j < 8; ++j) { unpack8(xr[64 * j], v[j][0], v[j][1]); s += dot4(v[j][0], v[j][0]) + dot4(v[j][1], v[j][1]); }
    const float r = rsqrtf(wave_sum(s) * (1.f / D) + EPS);
    float am = 0.f;
#pragma unroll
    for (int j = 0; j < 8; ++j) { v[j][0] = v[j][0] * r * gr[128 * j]; v[j][1] = v[j][1] * r * gr[128 * j + 1];
#pragma unroll
        for (int e = 0; e < 4; ++e) am = fmaxf(am, fmaxf(fabsf(v[j][0][e]), fabsf(v[j][1][e]))); }
#pragma unroll
    for (int o = 1; o < 64; o <<= 1) am = fmaxf(am, __shfl_xor(am, o));
    const float qs = am > 0.f ? 127.0f / am : 0.f;
    if (lane == 0) *sxp = am * (1.0f / 127.0f);
#pragma unroll
    for (int j = 0; j < 8; ++j) {
        const f32x4 y0 = v[j][0], y1 = v[j][1];
        { u32x2_t w;
          w.x = (unsigned)((int)__builtin_rintf(y0[0] * qs) & 255) | ((unsigned)((int)__builtin_rintf(y0[1] * qs) & 255) << 8) | ((unsigned)((int)__builtin_rintf(y0[2] * qs) & 255) << 16) | ((unsigned)(int)__builtin_rintf(y0[3] * qs) << 24);
          w.y = (unsigned)((int)__builtin_rintf(y1[0] * qs) & 255) | ((unsigned)((int)__builtin_rintf(y1[1] * qs) & 255) << 8) | ((unsigned)((int)__builtin_rintf(y1[2] * qs) & 255) << 16) | ((unsigned)(int)__builtin_rintf(y1[3] * qs) << 24);
          ((GAS u32x2_t*)q8row)[64 * j + lane] = w; }
        unsigned hi = 0u, lo = 0u;
        hi = __builtin_amdgcn_cvt_scalef32_pk_fp4_f32(hi, y0[0], y0[1], 1.0f, 0); hi = __builtin_amdgcn_cvt_scalef32_pk_fp4_f32(hi, y0[2], y0[3], 1.0f, 1);
        hi = __builtin_amdgcn_cvt_scalef32_pk_fp4_f32(hi, y1[0], y1[1], 1.0f, 2); hi = __builtin_amdgcn_cvt_scalef32_pk_fp4_f32(hi, y1[2], y1[3], 1.0f, 3);
        const f32x2_t d0 = __builtin_amdgcn_cvt_scalef32_pk_f32_fp4(hi, 1.0f, 0), d1 = __builtin_amdgcn_cvt_scalef32_pk_f32_fp4(hi, 1.0f, 1), d2 = __builtin_amdgcn_cvt_scalef32_pk_f32_fp4(hi, 1.0f, 2), d3 = __builtin_amdgcn_cvt_scalef32_pk_f32_fp4(hi, 1.0f, 3);
        lo = __builtin_amdgcn_cvt_scalef32_pk_fp4_f32(lo, (y0[0] - d0.x) * 8.f, (y0[1] - d0.y) * 8.f, 1.0f, 0); lo = __builtin_amdgcn_cvt_scalef32_pk_fp4_f32(lo, (y0[2] - d1.x) * 8.f, (y0[3] - d1.y) * 8.f, 1.0f, 1);
        lo = __builtin_amdgcn_cvt_scalef32_pk_fp4_f32(lo, (y1[0] - d2.x) * 8.f, (y1[1] - d2.y) * 8.f, 1.0f, 2); lo = __builtin_amdgcn_cvt_scalef32_pk_fp4_f32(lo, (y1[2] - d3.x) * 8.f, (y1[3] - d3.y) * 8.f, 1.0f, 3);
        unsigned char* const xd = x4row + (size_t)(2 * j + (lane >> 5)) * ((size_t)M * 256) + (lane & 31) * 4;
        *(GAS unsigned*)xd = hi; *(GAS unsigned*)(xd + 128) = lo;
    }
}
__device__ __forceinline__ void quant_w8(Frame& F) {
    const int gw = F.vcu * NWAVES + F.wave, NGW = F.G * NWAVES, lane = F.lane;
    for (int nn = gw; nn < INW + PQW + (P5_I8 ? D : 0); nn += NGW) {
        const int seg = nn >= INW + PQW ? 2 : nn >= INW ? 1 : 0; const bool qp = seg != 0; const int n = seg == 2 ? nn - INW - PQW : seg == 1 ? nn - INW : nn;
        if (!qp && n >= BF_BASE * 256 && n < (BF_BASE + BF_TILES) * 256) continue;
        const GAS v4u* src = (const GAS v4u*)((seg == 2 ? WSP(const bf16, WS_WOUT) : seg == 1 ? WSP(const bf16, WS_WQP) : WSP(const bf16, WS_WIN)) + (size_t)n * D) + lane;
        f32x4 lo[8], hi[8]; float am = 0.f;
#pragma unroll
        for (int j = 0; j < 8; ++j) { unpack8(src[64 * j], lo[j], hi[j]);
            am = fmaxf(am, fmaxf(fmaxf(fmaxf(fabsf(lo[j][0]), fabsf(lo[j][1])), fmaxf(fabsf(lo[j][2]), fabsf(lo[j][3]))), fmaxf(fmaxf(fabsf(hi[j][0]), fabsf(hi[j][1])), fmaxf(fabsf(hi[j][2]), fabsf(hi[j][3]))))); }
#pragma unroll
        for (int o = 1; o < 64; o <<= 1) am = fmaxf(am, __shfl_xor(am, o));
        const float qs = am > 0.f ? 127.0f / am : 0.f;
        GAS u32x2_t* dst = (GAS u32x2_t*)(F.ws + (seg == 2 ? WS_W8OUT : seg == 1 ? WS_W8QP : WS_W8) + (size_t)n * D) + lane;
#pragma unroll
        for (int j = 0; j < 8; ++j) { u32x2_t w;
            w.x = (unsigned)((int)__builtin_rintf(lo[j][0] * qs) & 255) | ((unsigned)((int)__builtin_rintf(lo[j][1] * qs) & 255) << 8) | ((unsigned)((int)__builtin_rintf(lo[j][2] * qs) & 255) << 16) | ((unsigned)(int)__builtin_rintf(lo[j][3] * qs) << 24);
            w.y = (unsigned)((int)__builtin_rintf(hi[j][0] * qs) & 255) | ((unsigned)((int)__builtin_rintf(hi[j][1] * qs) & 255) << 8) | ((unsigned)((int)__builtin_rintf(hi[j][2] * qs) & 255) << 16) | ((unsigned)(int)__builtin_rintf(hi[j][3] * qs) << 24);
            dst[64 * j] = w; }
        if (lane == 0) (seg == 2 ? WSP(float, WS_SWO) : seg == 1 ? WSP(float, WS_SWQ) : WSP(float, WS_SW))[n] = am * (1.0f / 127.0f);
    }
}
template <int NJ  > __device__ __forceinline__ void quant_row_i8(const bf16* xrow, unsigned char* q8row, float* sxp, int lane) {
    const GAS v4u* xr = (const GAS v4u*)xrow + lane;
    v4u w[NJ]; f32x4 v[NJ][2]; float am = 0.f;
#pragma unroll
    for (int j = 0; j < NJ; ++j) w[j] = xr[64 * j];
#pragma unroll
    for (int j = 0; j < NJ; ++j) { unpack8(w[j], v[j][0], v[j][1]);
#pragma unroll
        for (int e = 0; e < 4; ++e) am = fmaxf(am, fmaxf(fabsf(v[j][0][e]), fabsf(v[j][1][e]))); }
#pragma unroll
    for (int o = 1; o < 64; o <<= 1) am = fmaxf(am, __shfl_xor(am, o));
    const float qs = am > 0.f ? 127.0f / am : 0.f;
    if (lane == 0) *sxp = am * (1.0f / 127.0f);
#pragma unroll
    for (int j = 0; j < NJ; ++j) { const f32x4 y0 = v[j][0], y1 = v[j][1]; u32x2_t q;
        q.x = (unsigned)((int)__builtin_rintf(y0[0] * qs) & 255) | ((unsigned)((int)__builtin_rintf(y0[1] * qs) & 255) << 8) | ((unsigned)((int)__builtin_rintf(y0[2] * qs) & 255) << 16) | ((unsigned)(int)__builtin_rintf(y0[3] * qs) << 24);
        q.y = (unsigned)((int)__builtin_rintf(y1[0] * qs) & 255) | ((unsigned)((int)__builtin_rintf(y1[1] * qs) & 255) << 8) | ((unsigned)((int)__builtin_rintf(y1[2] * qs) & 255) << 16) | ((unsigned)(int)__builtin_rintf(y1[3] * qs) << 24);
        ((GAS u32x2_t*)q8row)[64 * j + lane] = q; }
}
__device__ __forceinline__ void quant_w8_oa(Frame& F) {
    const int gw = F.vcu * NWAVES + F.wave, NGW = F.G * NWAVES;
    for (int n = gw; n < D; n += NGW) quant_row_i8<4>(WSP(const bf16, WS_WO) + (size_t)n * QW, F.ws + WS_W8OA + (size_t)n * QW, WSP(float, WS_SWA) + n, F.lane);
}
__device__ __forceinline__ void p0_prologue(Frame& F) {
    LAS float* scr = (LAS float*)(F.lds + RING_OFF + F.wave * 16384);
    const int gw = F.vcu * NWAVES + F.wave, NGW = F.G * NWAVES;
    constexpr int I_IN = (D / 64) * (INW / 32), I_OA = (QW / 64) * (D / 32), I_OC = (CW / 64) * (D / 32), I_OUT = (D / 64) * (D / 32), I_QP = (D / 64) * (PQW / 32);
    constexpr int NITEMS = I_IN + I_OA + I_OC + I_OUT + I_QP;
    bf16* Win_t = WSP(bf16, WS_WIN); bf16* Wo_t = WSP(bf16, WS_WO); bf16* Wout_t = WSP(bf16, WS_WOUT); bf16* Wqp_t = WSP(bf16, WS_WQP);
    for (int it = gw; it < NITEMS; it += NGW) {
        int r = it;
        if (r < I_IN) { p0_transpose_item(F.w_in, D, INW, Win_t, 0, scr, r, F.lane); continue; } r -= I_IN;
        if (r < I_OA) { p0_transpose_item(F.w_oa, QW, D, Wo_t, 0, scr, r, F.lane); continue; } r -= I_OA;
        if (r < I_OC) { p0_transpose_item(F.w_oc, CW, D, Wo_t, D, scr, r, F.lane); continue; } r -= I_OC;
        if (r < I_OUT) { p0_transpose_item(F.w_out, D, D, Wout_t, 0, scr, r, F.lane); continue; } r -= I_OUT;
        p0_transpose_item(F.w_qp, D, PQW, Wqp_t, 0, scr, r, F.lane);
    }
    {
        bf16* SK = WSP(bf16, WS_SK); const int nth = F.G * NWAVES * 64, gt = gw * 64 + F.lane;
        for (int i = gt; i < PH * 2 * NKEYS * 128 / 4; i += nth) { const f32x4 v = ((const GAS f32x4*)F.subk)[i]; u32x2_t w; w.x = cvt_pk_bf16(v[0], v[1]); w.y = cvt_pk_bf16(v[2], v[3]); ((GAS u32x2_t*)SK)[i] = w; }
    }
    bf16* XN = WSP(bf16, WS_XN);
    for (int m = gw; m < M; m += NGW) rms_row_to_bf16<1>(F.x + (size_t)m * D, F.g1, XN + (size_t)m * D, (unsigned*)(F.ws + WS_XN8 + (size_t)m * D), WSP(float, WS_SX) + m, F.lane);
    for (int r = gw; r < 2 * NEXP; r += NGW) {
        const bool up = r >= NEXP; const int rr = up ? r - NEXP : r;
        const GAS f32x4* src = (const GAS f32x4*)((up ? F.w_up : F.w_down) + (size_t)rr * D) + 2 * F.lane;
        f32x4 v[16]; float am = 0.f;
#pragma unroll
        for (int i = 0; i < 8; ++i) { v[2 * i] = src[128 * i]; v[2 * i + 1] = src[128 * i + 1]; }
#pragma unroll
        for (int i = 0; i < 16; ++i) am = fmaxf(am, fmaxf(fmaxf(fabsf(v[i][0]), fabsf(v[i][1])), fmaxf(fabsf(v[i][2]), fabsf(v[i][3]))));
#pragma unroll
        for (int o = 1; o < 64; o <<= 1) am = fmaxf(am, __shfl_xor(am, o));
        const float sc = am > 0.f ? 6.0f / am : 1.0f;
        unsigned char* const dstb = F.ws + (up ? WS_W4U : WS_W4D) + (size_t)rr * 128 + (size_t)(F.lane >> 5) * SLICE_BYTES + (F.lane & 31) * 4;
#pragma unroll
        for (int i = 0; i < 8; ++i) { unsigned p = 0u;
            if (NIBBLE_SWAP_DOWN && !up) {
            p = __builtin_amdgcn_cvt_scalef32_pk_fp4_f32(p, v[2 * i][1] * sc, v[2 * i][0] * sc, 1.0f, 0); p = __builtin_amdgcn_cvt_scalef32_pk_fp4_f32(p, v[2 * i][3] * sc, v[2 * i][2] * sc, 1.0f, 1);
            p = __builtin_amdgcn_cvt_scalef32_pk_fp4_f32(p, v[2 * i + 1][1] * sc, v[2 * i + 1][0] * sc, 1.0f, 2); p = __builtin_amdgcn_cvt_scalef32_pk_fp4_f32(p, v[2 * i + 1][3] * sc, v[2 * i + 1][2] * sc, 1.0f, 3);
            } else {
            p = __builtin_amdgcn_cvt_scalef32_pk_fp4_f32(p, v[2 * i][0] * sc, v[2 * i][1] * sc, 1.0f, 0); p = __builtin_amdgcn_cvt_scalef32_pk_fp4_f32(p, v[2 * i][2] * sc, v[2 * i][3] * sc, 1.0f, 1);
            p = __builtin_amdgcn_cvt_scalef32_pk_fp4_f32(p, v[2 * i + 1][0] * sc, v[2 * i + 1][1] * sc, 1.0f, 2); p = __builtin_amdgcn_cvt_scalef32_pk_fp4_f32(p, v[2 * i + 1][2] * sc, v[2 * i + 1][3] * sc, 1.0f, 3);
            }
            *(GAS unsigned*)(dstb + (size_t)(2 * i) * SLICE_BYTES) = p; }
        if (F.lane == 0) WSP(float, up ? WS_SCU : WS_SCD)[rr] = am > 0.f ? am * (1.0f / 6.0f) : 1.0f;
    }
}

__device__ __forceinline__ unsigned off_b(unsigned row, unsigned ch) { return 256u * row + 16u * (ch ^ (((row & 3u) << 2) | ((row >> 2) & 3u))); }
__device__ __forceinline__ unsigned tr_addr16(unsigned lane, unsigned c, unsigned ks, unsigned t) {
    const unsigned g = lane >> 4, q = (lane & 15u) >> 2, p = lane & 3u;
    return off_b(32u * ks + 8u * g + 4u * t + q, 2u * c + (p >> 1)) + 8u * (p & 1u);
}
__device__ __forceinline__ v4i16_t tr_read(LAS unsigned char* p) { return __builtin_amdgcn_ds_read_tr16_b64_v4i16((LAS v4i16_t*)p); }
#define MFMA16(a, b, c) __builtin_amdgcn_mfma_f32_16x16x32_bf16((a), (b), (c), 0, 0, 0)

template <int PROBE> __device__ __forceinline__ void attn_unit(Frame& F, const int U) {
    const int lane = F.lane, wave = F.wave, c = lane & 15, hg = lane >> 4, tid = F.tid;
    const int hp = U & 1, kvh = (U >> 1) & 3, nblk = (U >> 3) & 31, b = U >> 8;
    const int hq = kvh * 4 + hp * 2 + (wave >> 2), i0 = (wave & 3) * 32;
    const size_t tok0 = (size_t)b * SEQ + (size_t)nblk * 128;
    const bf16* QB = WSP(const bf16, WS_Q); const bf16* KB = WSP(const bf16, WS_K); const bf16* VB = WSP(const bf16, WS_V); bf16* OB = PROBE ? WSP(bf16, WS_XN) : WSP(bf16, WS_AB);
    bf16x8 qf[2][4];
    {
        float g[4][8];
#pragma unroll
        for (int ks = 0; ks < 4; ++ks) { const f32x4 a = *(const GAS f32x4*)(F.gq + 32 * ks + 8 * hg), bb = *(const GAS f32x4*)(F.gq + 32 * ks + 8 * hg + 4);
#pragma unroll
            for (int e = 0; e < 4; ++e) { g[ks][e] = a[e]; g[ks][4 + e] = bb[e]; } }
#pragma unroll
        for (int qt = 0; qt < 2; ++qt) {
            const bf16* qrow = QB + (tok0 + i0 + 16 * qt + c) * QW + hq * HD + 8 * hg;
            f32x4 lo[4], hi[4]; float ss = 0.f;
#pragma unroll
            for (int ks = 0; ks < 4; ++ks) { unpack8(*(const GAS v4u*)(qrow + 32 * ks), lo[ks], hi[ks]); ss += dot4(lo[ks], lo[ks]) + dot4(hi[ks], hi[ks]); }
            ss += __shfl_xor(ss, 16); ss += __shfl_xor(ss, 32);
            const float r = rsqrtf(ss * (1.f / HD) + EPS) * (0.08838834764831845f * LOG2E);
#pragma unroll
            for (int ks = 0; ks < 4; ++ks) { f32x4 a, bb;
#pragma unroll
                for (int e = 0; e < 4; ++e) { a[e] = lo[ks][e] * r * g[ks][e]; bb[e] = hi[ks][e] * r * g[ks][4 + e]; }
                qf[qt][ks] = __builtin_bit_cast(bf16x8, pack8(a, bb)); }
        }
    }
    const float slope2 = __builtin_amdgcn_exp2f(-0.5f * (float)(hq + 1)) * LOG2E;
    const float sink2 = F.sink[hq] * LOG2E;
    float mrun[2] = {sink2, sink2}, lrun[2]; lrun[0] = lrun[1] = (hg == 0) ? 1.f : 0.f;
    f32x4 acc[8][2];
#pragma unroll
    for (int dt = 0; dt < 8; ++dt) { acc[dt][0] = (f32x4){0.f, 0.f, 0.f, 0.f}; acc[dt][1] = (f32x4){0.f, 0.f, 0.f, 0.f}; }
    const f32x4 gk0 = *(const GAS f32x4*)(F.gk + (tid & 15) * 8), gk1 = *(const GAS f32x4*)(F.gk + (tid & 15) * 8 + 4);
    __syncthreads();
    int bufi = 0;
#pragma unroll 1
    for (int kbi = -1; kbi <= 1; ++kbi) {
        const int kb = nblk + kbi; if (kb < 0 || kb >= SEQ / 128) continue;
        LAS unsigned char* Kl = F.lds + RING_OFF + bufi * 65536; LAS unsigned char* Vl = Kl + 32768; bufi ^= 1;
#pragma unroll
        for (int it = 0; it < (PROBE == 3 ? 0 : 4); ++it) {
            const int row = (tid >> 4) + 32 * it, ch = tid & 15;
            const size_t src = ((size_t)b * SEQ + (size_t)kb * 128 + row) * KVW + kvh * HD + ch * 8;
            f32x4 k0, k1; unpack8(*(const GAS v4u*)(KB + src), k0, k1);
            float ss = dot4(k0, k0) + dot4(k1, k1);
            ss += __shfl_xor(ss, 1); ss += __shfl_xor(ss, 2); ss += __shfl_xor(ss, 4); ss += __shfl_xor(ss, 8);
            const float r = rsqrtf(ss * (1.f / HD) + EPS);
            *(LAS v4u*)(Kl + off_b(row, ch)) = pack8(k0 * r * gk0, k1 * r * gk1);
            *(LAS v4u*)(Vl + off_b(row, ch)) = *(const GAS v4u*)(VB + src);
        }
        __syncthreads();
        const int ks_lo = kbi < 0 ? (i0 >> 5) : 0, ks_hi = kbi > 0 ? (i0 >> 5) + 1 : 4;
#pragma unroll 2
        for (int ks32 = (PROBE == 2 ? ks_hi : ks_lo); ks32 < ks_hi; ++ks32) {
            f32x4 sa[2], sb[2];
            sa[0] = sa[1] = sb[0] = sb[1] = (f32x4){0.f, 0.f, 0.f, 0.f};
            const unsigned krow = 32u * ks32 + 8u * (c >> 2) + (c & 3);
#pragma unroll
            for (int ks = 0; ks < 4; ++ks) {
                const bf16x8 ka = *(const LAS bf16x8*)(Kl + off_b(krow, 4 * ks + hg)), kb2 = *(const LAS bf16x8*)(Kl + off_b(krow + 4, 4 * ks + hg));
#pragma unroll
                for (int qt = 0; qt < 2; ++qt) { sa[qt] = MFMA16(ka, qf[qt][ks], sa[qt]); sb[qt] = MFMA16(kb2, qf[qt][ks], sb[qt]); }
            }
            bf16x8 pf[2];
#pragma unroll
            for (int qt = 0; qt < 2; ++qt) {
                float s[8] = {sa[qt][0], sa[qt][1], sa[qt][2], sa[qt][3], sb[qt][0], sb[qt][1], sb[qt][2], sb[qt][3]};
                const int rel0 = kbi * 128 + 32 * ks32 + 8 * hg - (i0 + 16 * qt + c);
                float mx = -INFINITY;
#pragma unroll
                for (int j = 0; j < 8; ++j) { const int rel = rel0 + j, dist = rel < 0 ? -rel : rel; const float sv = s[j] - slope2 * (float)dist; s[j] = (dist <= 128) ? sv : -INFINITY; mx = fmaxf(mx, s[j]); }
                mx = fmaxf(mx, __shfl_xor(mx, 16)); mx = fmaxf(mx, __shfl_xor(mx, 32));
                const float mn = fmaxf(mrun[qt], mx), alpha = __builtin_amdgcn_exp2f(mrun[qt] - mn); mrun[qt] = mn;
                float ps = 0.f;
#pragma unroll
                for (int j = 0; j < 8; ++j) { s[j] = __builtin_amdgcn_exp2f(s[j] - mn); ps += s[j]; }
                lrun[qt] = lrun[qt] * alpha + ps;
                pf[qt] = __builtin_bit_cast(bf16x8, pack8((f32x4){s[0], s[1], s[2], s[3]}, (f32x4){s[4], s[5], s[6], s[7]}));
#pragma unroll
                for (int dt = 0; dt < 8; ++dt) acc[dt][qt] = acc[dt][qt] * alpha;
            }
#pragma unroll
            for (int dt = 0; dt < 8; ++dt) {
                const v4i16_t vlo = tr_read(Vl + tr_addr16(lane, dt, ks32, 0)), vhi = tr_read(Vl + tr_addr16(lane, dt, ks32, 1));
                const bf16x8 vf = {vlo[0], vlo[1], vlo[2], vlo[3], vhi[0], vhi[1], vhi[2], vhi[3]};
#pragma unroll
                for (int qt = 0; qt < 2; ++qt) acc[dt][qt] = MFMA16(vf, pf[qt], acc[dt][qt]);
            }
        }
    }
#pragma unroll
    for (int qt = 0; qt < 2; ++qt) {
        float l = lrun[qt]; l += __shfl_xor(l, 16); l += __shfl_xor(l, 32);
        const float inv = 1.0f / l;
        bf16* orow = OB + (tok0 + i0 + 16 * qt + c) * QW + hq * HD + 4 * hg;
#pragma unroll
        for (int dt = 0; dt < 8; ++dt) { const f32x4 o = acc[dt][qt] * inv; u32x2_t w; w.x = cvt_pk_bf16(o[0], o[1]); w.y = cvt_pk_bf16(o[2], o[3]); *(GAS u32x2_t*)(orow + 16 * dt) = w; }
    }
}
__device__ __forceinline__ int attn_i0(int wave) { return ((wave & 4) ? 3 - (wave & 3) : (wave & 3)) * 32; }
__device__ __forceinline__ int attn_unit_of(const Frame& F, int un) { const int U = (F.vcu + (un >> 2) * F.G) * 4 + (un & 3); return U < BATCH * 32 * NKV * 2 ? U : -1; }
__device__ __forceinline__ bool attn_next(const Frame& F, int& un, int& kbi) {
    for (;;) {
        ++kbi; if (kbi > 1) { ++un; kbi = -1; }
        const int U = attn_unit_of(F, un); if (U < 0) return false;
        const int kb = ((U >> 3) & 31) + kbi; if (kb >= 0 && kb < SEQ / 128) return true;
    }
}
__device__ __forceinline__ void attn_kv_issue(Frame& F, int U, int kbi, LAS unsigned char* Kl) {
    const int lane = F.lane, kvh = (U >> 1) & 3, nblk = (U >> 3) & 31, b = U >> 8, kb = nblk + kbi;
    const bf16* KB = WSP(const bf16, WS_K); const bf16* VB = WSP(const bf16, WS_V);
    const size_t base = ((size_t)b * SEQ + (size_t)kb * 128) * KVW + kvh * HD;
    const unsigned sw = ((unsigned)(lane >> 4) << 2) | ((unsigned)F.wave & 3u), ch = ((unsigned)lane & 15u) ^ sw;
#pragma unroll
    for (int it = 0; it < 4; ++it) { const int blk = F.wave + 8 * it, row = 4 * blk + (lane >> 4); const size_t src = base + (size_t)row * KVW + ch * 8;
        __builtin_amdgcn_global_load_lds((const unsigned*)(KB + src), (LAS unsigned*)(Kl + blk * 1024), 16, 0, 0);
        __builtin_amdgcn_global_load_lds((const unsigned*)(VB + src), (LAS unsigned*)(Kl + 32768 + blk * 1024), 16, 0, 0); }
}
__device__ __forceinline__ void attn_k_norm(Frame& F, LAS unsigned char* Kl, const LAS float* gkl) {
    const int lane = F.lane;
    const unsigned sw = ((unsigned)(lane >> 4) << 2) | ((unsigned)F.wave & 3u), ch = ((unsigned)lane & 15u) ^ sw;
    const f32x4 gk0 = *(const LAS f32x4*)(gkl + ch * 8), gk1 = *(const LAS f32x4*)(gkl + ch * 8 + 4);
    v4u kr[4];
#pragma unroll
    for (int it = 0; it < 4; ++it) kr[it] = *(const LAS v4u*)(Kl + (F.wave + 8 * it) * 1024 + lane * 16);
#pragma unroll
    for (int it = 0; it < 4; ++it) {
        f32x4 k0, k1; unpack8(kr[it], k0, k1);
        float ss = dot4(k0, k0) + dot4(k1, k1);
        ss += __shfl_xor(ss, 1); ss += __shfl_xor(ss, 2); ss += __shfl_xor(ss, 4); ss += __shfl_xor(ss, 8);
        const float r = rsqrtf(ss * (1.f / HD) + EPS);
        *(LAS v4u*)(Kl + (F.wave + 8 * it) * 1024 + lane * 16) = pack8(k0 * r * gk0, k1 * r * gk1); }
}
__device__ __forceinline__ void attn_q_issue(Frame& F, int U, v4u (&qr)[2][4]) {
    const int lane = F.lane, wave = F.wave, c = lane & 15, hg = lane >> 4;
    const int hp = U & 1, kvh = (U >> 1) & 3, nblk = (U >> 3) & 31, b = U >> 8, hq = kvh * 4 + hp * 2 + (wave >> 2), i0 = attn_i0(wave);
    const size_t tok0 = (size_t)b * SEQ + (size_t)nblk * 128;
    const bf16* QB = WSP(const bf16, WS_Q);
#pragma unroll
    for (int qt = 0; qt < 2; ++qt) { const bf16* qrow = QB + (tok0 + i0 + 16 * qt + c) * QW + hq * HD + 8 * hg;
#pragma unroll
        for (int ks = 0; ks < 4; ++ks) qr[qt][ks] = *(const GAS v4u*)(qrow + 32 * ks); }
}
__device__ __forceinline__ void attn_block(Frame& F, const LAS unsigned char* Kl, int kbi, const bf16x8 (&qf)[2][4], float slope2, float (&mrun)[2], float (&lrun)[2], f32x4 (&acc)[8][2]) {
    const int lane = F.lane, c = lane & 15, hg = lane >> 4, i0 = attn_i0(F.wave);
    const LAS unsigned char* Vl = Kl + 32768;
    const int ks_lo = kbi < 0 ? (i0 >> 5) : 0, ks_hi = kbi > 0 ? (i0 >> 5) + 1 : 4;
#pragma unroll 1
    for (int ks32 = ks_lo; ks32 < ks_hi; ++ks32) {
        f32x4 sa[2], sb[2];
        sa[0] = sa[1] = sb[0] = sb[1] = (f32x4){0.f, 0.f, 0.f, 0.f};
        const bool need_mask = kbi != 0 && ks32 == (i0 >> 5);
        const unsigned krow = 32u * ks32 + 8u * (c >> 2) + (c & 3);
#pragma unroll
        for (int ks = 0; ks < 4; ++ks) {
            const bf16x8 ka = *(const LAS bf16x8*)(Kl + off_b(krow, 4 * ks + hg)), kb2 = *(const LAS bf16x8*)(Kl + off_b(krow + 4, 4 * ks + hg));
#pragma unroll
            for (int qt = 0; qt < 2; ++qt) { sa[qt] = MFMA16(ka, qf[qt][ks], sa[qt]); sb[qt] = MFMA16(kb2, qf[qt][ks], sb[qt]); }
        }
        bf16x8 pf[2];
#pragma unroll
        for (int qt = 0; qt < 2; ++qt) {
            float sv8[8] = {sa[qt][0], sa[qt][1], sa[qt][2], sa[qt][3], sb[qt][0], sb[qt][1], sb[qt][2], sb[qt][3]};
            const float rf = (float)(kbi * 128 + 32 * ks32 + 8 * hg - (i0 + 16 * qt + c));
            float mx = -INFINITY;
#pragma unroll
            for (int j = 0; j < 8; ++j) sv8[j] = __builtin_fmaf(-slope2, __builtin_fabsf(rf + (float)j), sv8[j]);
            if (need_mask) {
#pragma unroll
                for (int j = 0; j < 8; ++j) sv8[j] = (__builtin_fabsf(rf + (float)j) <= 128.f) ? sv8[j] : -INFINITY; }
#pragma unroll
            for (int j = 0; j < 8; ++j) mx = fmaxf(mx, sv8[j]);
            mx = fmaxf(mx, __shfl_xor(mx, 16)); mx = fmaxf(mx, __shfl_xor(mx, 32));
            const float mn = fmaxf(mrun[qt], mx), alpha = __builtin_amdgcn_exp2f(mrun[qt] - mn); mrun[qt] = mn;
            float ps = 0.f;
#pragma unroll
            for (int j = 0; j < 8; ++j) { sv8[j] = __builtin_amdgcn_exp2f(sv8[j] - mn); ps += sv8[j]; }
            lrun[qt] = lrun[qt] * alpha + ps;
            pf[qt] = __builtin_bit_cast(bf16x8, pack8((f32x4){sv8[0], sv8[1], sv8[2], sv8[3]}, (f32x4){sv8[4], sv8[5], sv8[6], sv8[7]}));
#pragma unroll
            for (int dt = 0; dt < 8; ++dt) acc[dt][qt] = acc[dt][qt] * alpha;
        }
#pragma unroll
        for (int h = 0; h < 2; ++h) {
            v4i16_t vlo[4], vhi[4];
#pragma unroll
            for (int d = 0; d < 4; ++d) {
                asm volatile("ds_read_b64_tr_b16 %0, %1" : "=v"(vlo[d]) : "v"((unsigned)(size_t)Vl + tr_addr16(lane, 4 * h + d, ks32, 0)));
                asm volatile("ds_read_b64_tr_b16 %0, %1" : "=v"(vhi[d]) : "v"((unsigned)(size_t)Vl + tr_addr16(lane, 4 * h + d, ks32, 1))); }
            asm volatile("s_waitcnt lgkmcnt(0)" : "+v"(vlo[0]), "+v"(vhi[0]), "+v"(vlo[1]), "+v"(vhi[1]), "+v"(vlo[2]), "+v"(vhi[2]), "+v"(vlo[3]), "+v"(vhi[3]) :: "memory");
#pragma unroll
            for (int d = 0; d < 4; ++d) { const bf16x8 vf = {vlo[d][0], vlo[d][1], vlo[d][2], vlo[d][3], vhi[d][0], vhi[d][1], vhi[d][2], vhi[d][3]};
#pragma unroll
                for (int qt = 0; qt < 2; ++qt) acc[4 * h + d][qt] = MFMA16(vf, pf[qt], acc[4 * h + d][qt]); }
        }
    }
}
__device__ __forceinline__ void attn_phase(Frame& F) {
    const int lane = F.lane, wave = F.wave, c = lane & 15, hg = lane >> 4, tid = F.tid, i0 = attn_i0(wave);
    LAS float* gql = (LAS float*)(F.lds + OBUF_OFF);
    LAS float* gkl = gql + 128;
    if (tid < 128) gql[tid] = F.gq[tid]; else if (tid < 256) gql[tid] = F.gk[tid - 128]; else if (tid < 256 + NH) gql[tid] = F.sink[tid - 256];
    int un = 0, kbi = -2;
    if (!attn_next(F, un, kbi)) return;
    v4u qr[2][4];
    attn_q_issue(F, attn_unit_of(F, un), qr);
    attn_kv_issue(F, attn_unit_of(F, un), kbi, F.lds + RING_OFF);
    __syncthreads();
    asm volatile("s_waitcnt vmcnt(0)" ::: "memory");
    attn_k_norm(F, F.lds + RING_OFF, gkl);
    asm volatile("s_waitcnt lgkmcnt(0)" ::: "memory"); __builtin_amdgcn_s_barrier(); asm volatile("" ::: "memory");
    int bufi = 0; bool first = true;
    bf16x8 qf[2][4]; float slope2 = 0.f, mrun[2] = {0.f, 0.f}, lrun[2] = {0.f, 0.f}; f32x4 acc[8][2];
#pragma unroll 1
    for (;;) {
        const int U = attn_unit_of(F, un);
        int nun = un, nkbi = kbi; const bool has_next = attn_next(F, nun, nkbi);
        if (first) {
            const int hp = U & 1, kvh = (U >> 1) & 3, hq = kvh * 4 + hp * 2 + (wave >> 2);
#pragma unroll
            for (int qt = 0; qt < 2; ++qt) {
                f32x4 lo[4], hi[4]; float ss = 0.f;
#pragma unroll
                for (int ks = 0; ks < 4; ++ks) { unpack8(qr[qt][ks], lo[ks], hi[ks]); ss += dot4(lo[ks], lo[ks]) + dot4(hi[ks], hi[ks]); }
                ss += __shfl_xor(ss, 16); ss += __shfl_xor(ss, 32);
                const float r = rsqrtf(ss * (1.f / HD) + EPS) * (0.08838834764831845f * LOG2E);
#pragma unroll
                for (int ks = 0; ks < 4; ++ks) { const f32x4 ga = *(const LAS f32x4*)(gql + 32 * ks + 8 * hg), gb = *(const LAS f32x4*)(gql + 32 * ks + 8 * hg + 4);
                    qf[qt][ks] = __builtin_bit_cast(bf16x8, pack8(lo[ks] * r * ga, hi[ks] * r * gb)); }
            }
            slope2 = __builtin_amdgcn_exp2f(-0.5f * (float)(hq + 1)) * LOG2E;
            const float sink2 = gql[256 + hq] * LOG2E;
            mrun[0] = mrun[1] = sink2; lrun[0] = lrun[1] = (hg == 0) ? 1.f : 0.f;
#pragma unroll
            for (int dt = 0; dt < 8; ++dt) { acc[dt][0] = (f32x4){0.f, 0.f, 0.f, 0.f}; acc[dt][1] = (f32x4){0.f, 0.f, 0.f, 0.f}; }
        }
        __builtin_amdgcn_sched_barrier(0);
        attn_kv_issue(F, attn_unit_of(F, has_next ? nun : un), has_next ? nkbi : kbi, F.lds + RING_OFF + (bufi ^ 1) * 65536);
        const bool last = !has_next || nun != un;
        __builtin_amdgcn_sched_barrier(0);
        attn_block(F, F.lds + RING_OFF + bufi * 65536, kbi, qf, slope2, mrun, lrun, acc);
        __builtin_amdgcn_sched_barrier(0);
        if (last) {
            if (has_next) attn_q_issue(F, attn_unit_of(F, nun), qr);
            __builtin_amdgcn_sched_barrier(0);
            const int hp = U & 1, kvh = (U >> 1) & 3, nblk = (U >> 3) & 31, b = U >> 8, hq = kvh * 4 + hp * 2 + (wave >> 2);
            const size_t tok0 = (size_t)b * SEQ + (size_t)nblk * 128;
            bf16* OB = WSP(bf16, WS_AB);
#pragma unroll
            for (int qt = 0; qt < 2; ++qt) {
                float l = lrun[qt]; l += __shfl_xor(l, 16); l += __shfl_xor(l, 32);
                const float inv = 1.0f / l;
                bf16* orow = OB + (tok0 + i0 + 16 * qt + c) * QW + hq * HD + 4 * hg;
#pragma unroll
                for (int dt = 0; dt < 8; ++dt) { const f32x4 o = acc[dt][qt] * inv; u32x2_t w; w.x = cvt_pk_bf16(o[0], o[1]); w.y = cvt_pk_bf16(o[2], o[3]); *(GAS u32x2_t*)(orow + 16 * dt) = w; }
            }
        }
        if (!has_next) { asm volatile("s_waitcnt vmcnt(0)" ::: "memory"); break; }
        __builtin_amdgcn_sched_barrier(0);
        if (last) asm volatile("s_waitcnt vmcnt(24)" ::: "memory"); else asm volatile("s_waitcnt vmcnt(0)" ::: "memory");
        __builtin_amdgcn_sched_barrier(0);
        attn_k_norm(F, F.lds + RING_OFF + (bufi ^ 1) * 65536, gkl);
        asm volatile("s_waitcnt lgkmcnt(0)" ::: "memory"); __builtin_amdgcn_s_barrier(); asm volatile("" ::: "memory");
        bufi ^= 1; first = last; un = nun; kbi = nkbi;
    }
    __syncthreads();
}
constexpr int CONV_T = 8;
__device__ __forceinline__ void conv_phase(Frame& F) {
    const bf16* HB = WSP(const bf16, WS_H); const bf16* BB = WSP(const bf16, WS_B); const bf16* CB = WSP(const bf16, WS_C); bf16* OC = WSP(bf16, WS_AB) + (size_t)M * CW;
    const unsigned nitem = (unsigned)(M / CONV_T) * (CW / 8);
    for (unsigned e = (unsigned)F.vcu * 512u + (unsigned)F.tid; e < nitem; e += (unsigned)F.G * 512u) {
        const int t0 = (int)(e >> 8) * CONV_T, cc = (int)(e & 255u) * 8, tl0 = t0 & (SEQ - 1);
        const size_t o = (size_t)t0 * CW + cc;
        const bool has_prev = tl0 > 0, has_next = tl0 + CONV_T < SEQ;
        v4u hw[CONV_T + 2], cw[CONV_T + 2], bw[CONV_T];
        hw[0] = cw[0] = hw[CONV_T + 1] = cw[CONV_T + 1] = (v4u){0u, 0u, 0u, 0u};
        if (has_prev) { hw[0] = *(const GAS v4u*)(HB + o - CW); cw[0] = *(const GAS v4u*)(CB + o - CW); }
#pragma unroll
        for (int k = 0; k < CONV_T; ++k) { hw[k + 1] = *(const GAS v4u*)(HB + o + (size_t)k * CW); cw[k + 1] = *(const GAS v4u*)(CB + o + (size_t)k * CW); bw[k] = *(const GAS v4u*)(BB + o + (size_t)k * CW); }
        if (has_next) { hw[CONV_T + 1] = *(const GAS v4u*)(HB + o + (size_t)CONV_T * CW); cw[CONV_T + 1] = *(const GAS v4u*)(CB + o + (size_t)CONV_T * CW); }
        const GAS f32x4* w = (const GAS f32x4*)(F.conv_w + cc);
        const f32x4 w00 = w[0], w01 = w[1], w10 = w[CW / 4], w11 = w[CW / 4 + 1], w20 = w[2 * CW / 4], w21 = w[2 * CW / 4 + 1];
        f32x4 up0, up1, uc0, uc1;
        { f32x4 h0, h1, c0, c1; unpack8(hw[0], h0, h1); unpack8(cw[0], c0, c1); up0 = h0 * c0; up1 = h1 * c1; unpack8(hw[1], h0, h1); unpack8(cw[1], c0, c1); uc0 = h0 * c0; uc1 = h1 * c1; }
#pragma unroll
        for (int k = 0; k < CONV_T; ++k) {
            f32x4 h0, h1, c0, c1, b0, b1; unpack8(hw[k + 2], h0, h1); unpack8(cw[k + 2], c0, c1); unpack8(bw[k], b0, b1);
            const f32x4 un0 = h0 * c0, un1 = h1 * c1;
            const f32x4 y0 = w00 * up0 + w10 * uc0 + w20 * un0, y1 = w01 * up1 + w11 * uc1 + w21 * un1;
            *(GAS v4u*)(OC + o + (size_t)k * CW) = pack8(b0 * y0, b1 * y1);
            up0 = uc0; up1 = uc1; uc0 = un0; uc1 = un1;
        }
    }
}

__device__ __forceinline__ unsigned ordf(float f) { const unsigned u = __float_as_uint(f); return u ^ ((u >> 31) ? 0xFFFFFFFFu : 0x80000000u); }
__device__ __forceinline__ float unordf(unsigned k) { return __uint_as_float((k & 0x80000000u) ? (k ^ 0x80000000u) : ~k); }
__device__ __forceinline__ u64 shfl64_xor(u64 v, int m) { const unsigned lo = __shfl_xor((unsigned)v, m), hi = __shfl_xor((unsigned)(v >> 32), m); return ((u64)hi << 32) | lo; }
template <int N> __device__ __forceinline__ void bitonic_merge_desc(unsigned (&a)[N]) {
#pragma unroll
    for (int j = N >> 1; j > 0; j >>= 1)
#pragma unroll
        for (int i = 0; i < N; ++i) { const int l = i ^ j; if (l > i) { const unsigned hi = a[i] > a[l] ? a[i] : a[l], lo = a[i] > a[l] ? a[l] : a[i]; a[i] = hi; a[l] = lo; } }
}
template <int N> __device__ __forceinline__ void bitonic_sort_desc(unsigned (&a)[N]) {
#pragma unroll
    for (int k = 2; k <= N; k <<= 1)
#pragma unroll
        for (int j = k >> 1; j > 0; j >>= 1)
#pragma unroll
            for (int i = 0; i < N; ++i) { const int l = i ^ j; if (l > i) { const unsigned hi = a[i] > a[l] ? a[i] : a[l], lo = a[i] > a[l] ? a[l] : a[i]; const bool desc = ((i & k) == 0); a[i] = desc ? hi : lo; a[l] = desc ? lo : hi; } }
}
__device__ __forceinline__ void xlane_top16(unsigned (&t)[16], const int mask) {
    unsigned m[16];
#pragma unroll
    for (int i = 0; i < 16; ++i) { const unsigned p = __shfl_xor(t[15 - i], mask); m[i] = t[i] > p ? t[i] : p; }
    bitonic_merge_desc<16>(m);
#pragma unroll
    for (int i = 0; i < 16; ++i) t[i] = m[i];
}
struct Stair { int i[52], j[52]; };
constexpr Stair make_stair() { Stair s{}; int n = 0; for (int a = 0; a < 16; ++a) for (int b = 0; b < 16; ++b) if ((a + 1) * (b + 1) <= 16) { s.i[n] = a; s.j[n] = b; ++n; } for (; n < 52; ++n) { s.i[n] = -1; s.j[n] = -1; } return s; }
constexpr Stair STAIR = make_stair();
template <int P> __device__ __forceinline__ unsigned cand1(const float (&v1)[16], const float (&v2)[16]) {
    constexpr int i = STAIR.i[P], j = STAIR.j[P];
    if constexpr (i < 0) return 0u;
    else return (ordf(v1[i] + v2[j]) & ~255u) | (unsigned)(16 * i + j);
}
template <int S> __device__ __forceinline__ void cand_fill(unsigned (&ck)[16], const float (&v1)[16], const float (&v2)[16], int hg) {
    const unsigned k0 = cand1<4 * S + 0>(v1, v2), k1 = cand1<4 * S + 1>(v1, v2), k2 = cand1<4 * S + 2>(v1, v2), k3 = cand1<4 * S + 3>(v1, v2);
    ck[S] = hg == 0 ? k0 : hg == 1 ? k1 : hg == 2 ? k2 : k3;
    if constexpr (S + 1 < 13) cand_fill<S + 1>(ck, v1, v2, hg);
}
__device__ __forceinline__ void route_task(Frame& F, const int tg, const int h) {
    const int lane = F.lane, c = lane & 15, hg = lane >> 4;
    const int tok = tg * 16 + c;
    const bf16* QP = WSP(const bf16, WS_QP); LAS unsigned char* SKl = F.lds + RING_OFF;
    unsigned sel[2][16];
#pragma unroll
    for (int half = 0; half < 2; ++half) {
        bf16x8 bq[4];
#pragma unroll
        for (int ks = 0; ks < 4; ++ks) bq[ks] = *(const GAS bf16x8*)(QP + (size_t)tok * PQW + h * 256 + half * 128 + 32 * ks + 8 * hg);
        unsigned k[32];
#pragma unroll
        for (int tile = 0; tile < 8; ++tile) {
            f32x4 s = (f32x4){0.f, 0.f, 0.f, 0.f};
#pragma unroll
            for (int ks = 0; ks < 4; ++ks) { const bf16x8 a = *(const LAS bf16x8*)(SKl + off_b(half * 128 + 16 * tile + c, 4 * ks + hg)); s = MFMA16(a, bq[ks], s); }
#pragma unroll
            for (int r = 0; r < 4; ++r) k[tile * 4 + r] = (ordf(s[r]) & ~127u) | (unsigned)(16 * tile + 4 * hg + r);
            if (tile & 1) asm volatile("" ::: "memory");
        }
        bitonic_sort_desc<32>(k);
        unsigned t[16];
#pragma unroll
        for (int i = 0; i < 16; ++i) t[i] = k[i];
        xlane_top16(t, 16); xlane_top16(t, 32);
#pragma unroll
        for (int i = 0; i < 16; ++i) sel[half][i] = t[i];
        asm volatile("" ::: "memory");
    }
    float v1[16], v2[16]; unsigned n1[16], n2[16];
#pragma unroll
    for (int i = 0; i < 16; ++i) { v1[i] = unordf(sel[0][i] & ~127u); n1[i] = sel[0][i] & 127u; v2[i] = unordf(sel[1][i] & ~127u); n2[i] = sel[1][i] & 127u; }
    LAS unsigned char* scr = F.lds + RING_OFF + 65536 + F.wave * 4096 + c * 256;
    if (hg == 0) {
#pragma unroll
        for (int q4 = 0; q4 < 4; ++q4) { *(LAS f32x4*)(scr + 16 * q4) = (f32x4){v1[4 * q4], v1[4 * q4 + 1], v1[4 * q4 + 2], v1[4 * q4 + 3]}; *(LAS f32x4*)(scr + 64 + 16 * q4) = (f32x4){v2[4 * q4], v2[4 * q4 + 1], v2[4 * q4 + 2], v2[4 * q4 + 3]};
            *(LAS v4u*)(scr + 128 + 16 * q4) = (v4u){n1[4 * q4], n1[4 * q4 + 1], n1[4 * q4 + 2], n1[4 * q4 + 3]}; *(LAS v4u*)(scr + 192 + 16 * q4) = (v4u){n2[4 * q4], n2[4 * q4 + 1], n2[4 * q4 + 2], n2[4 * q4 + 3]}; } }
    unsigned ck[16];
    cand_fill<0>(ck, v1, v2, hg); ck[13] = ck[14] = ck[15] = 0u;
    bitonic_sort_desc<16>(ck);
    xlane_top16(ck, 16); xlane_top16(ck, 32);
    int oi[4]; float sc[4]; float mx = -INFINITY;
#pragma unroll
    for (int jj = 0; jj < 4; ++jj) {
        const unsigned w = hg == 0 ? ck[jj] : hg == 1 ? ck[4 + jj] : hg == 2 ? ck[8 + jj] : ck[12 + jj];
        const unsigned i4 = (w >> 2) & 0x3Cu, j4 = (w & 15u) << 2;
        sc[jj] = *(const LAS float*)(scr + i4) + *(const LAS float*)(scr + 64 + j4);
        oi[jj] = (int)(*(const LAS unsigned*)(scr + 128 + i4) * (unsigned)NKEYS + *(const LAS unsigned*)(scr + 192 + j4));
        mx = fmaxf(mx, sc[jj]);
    }
    mx = fmaxf(mx, __shfl_xor(mx, 16)); mx = fmaxf(mx, __shfl_xor(mx, 32));
    float ev[4], sum = 0.f;
#pragma unroll
    for (int jj = 0; jj < 4; ++jj) { ev[jj] = __builtin_amdgcn_exp2f((sc[jj] - mx) * LOG2E); sum += ev[jj]; }
    sum += __shfl_xor(sum, 16); sum += __shfl_xor(sum, 32);
    const float inv = 1.0f / sum;
    const size_t o = ((size_t)tok * PH + h) * TOPK + 4 * hg;
    *(GAS i32x4_t*)(WSP(int, WS_IDX) + o) = (i32x4_t){oi[0], oi[1], oi[2], oi[3]};
    *(GAS f32x4*)(WSP(float, WS_GATE) + o) = (f32x4){ev[0] * inv, ev[1] * inv, ev[2] * inv, ev[3] * inv};
}

__device__ __forceinline__ float gelu_erf(float v) { return 0.5f * v * (1.0f + erff(v * 0.70710678118654752f)); }
typedef int i32x8_t __attribute__((ext_vector_type(8)));
#define FP4X2(w, b) __builtin_amdgcn_cvt_scalef32_pk_f32_fp4((w), 1.0f, (b))
__device__ __forceinline__ void fmac(float& acc, float a, float b) { asm("v_fmac_f32 %0, %1, %2" : "+v"(acc) : "v"(a), "v"(b)); }
struct PeerDeal { int ox, nx, t0, stride, cnt, ns; };
__device__ __forceinline__ void pd_item(int n, const PeerDeal& d, int& t, int& sl) { const int N = d.ns * d.cnt, nn = n < N ? n : N - 1, j = nn / d.cnt; sl = d.ox + j * d.nx; t = d.t0 + (nn - j * d.cnt) * d.stride; }
__device__ __forceinline__ void pd_idx(Frame& F, int t, int lane, i32x4_t (&idv)[4]) {
    const GAS i32x4_t* ip = (const GAS i32x4_t*)(WSP(const int, WS_IDX) + (size_t)t * 128 + (lane >> 3) * 16);
#pragma unroll
    for (int a = 0; a < 4; ++a) idv[a] = ip[a];
}
__device__ __forceinline__ void pd_rows(Frame& F, int t, int sl, int lane, const i32x4_t (&idv)[4], v4u (&rows)[16], v4u (&xw)[2]) {
    const unsigned char* xr = F.ws + WS_X2N8 + ((size_t)sl * M + t) * 256 + 16 * (lane >> 4) + ((lane & 15) == 1 ? 128 : 0);
#pragma unroll
    for (int ks = 0; ks < 2; ++ks) xw[ks] = *(const GAS v4u*)(xr + 64 * ks);
    const unsigned char* WD = F.ws + WS_W4D + (size_t)sl * SLICE_BYTES;
    const unsigned lo16 = 16u * (unsigned)(lane & 7);
#pragma unroll
    for (int j = 0; j < 16; ++j) rows[j] = *(const GAS v4u*)(WD + (size_t)(((unsigned)idv[j >> 2][j & 3] << 7) + lo16));
}
__device__ __forceinline__ float dpp_swap1(float v) { return __builtin_bit_cast(float, __builtin_amdgcn_update_dpp(0, __builtin_bit_cast(int, v), 0xB1  , 0xF, 0xF, true)); }
__device__ __forceinline__ void pd_compute(Frame& F, int t, int sl, int lane, const v4u (&rows)[16], const v4u (&xw)[2]) {
    const int r = lane & 15, g = lane >> 4;
    LAS unsigned char* tile = F.lds + RING_OFF + F.wave * 16384;
    { LAS unsigned char* wp = tile + (lane >> 3) * 2048;
#pragma unroll
      for (int j = 0; j < 16; ++j) *(LAS v4u*)(wp + j * 128 + (((lane & 7) ^ ((j >> 1) & 7)) << 4)) = rows[j]; }
    float* pp = WSP(float, WS_PART) + ((size_t)sl * M + t) * 128 + 4 * g;
    const int scb = (r == 1) ? 0x7C7C7C7C   : 0x7F7F7F7F;
    i32x8_t xb[2];
#pragma unroll
    for (int ks = 0; ks < 2; ++ks) xb[ks] = (i32x8_t){(int)xw[ks].x, (int)xw[ks].y, (int)xw[ks].z, (int)xw[ks].w, 0, 0, 0, 0};
    const LAS unsigned char* rp = tile + r * 128; const int fr = (r >> 1) & 7;
    v4u a[8][2];
#pragma unroll
    for (int i = 0; i < 8; ++i)
#pragma unroll
        for (int ks = 0; ks < 2; ++ks) a[i][ks] = *(const LAS v4u*)(rp + i * 2048 + (((4 * ks + g) ^ fr) << 4));
    f32x4 c[8];
#pragma unroll
    for (int i = 0; i < 8; ++i) { const v4u w = a[i][0]; c[i] = __builtin_amdgcn_mfma_scale_f32_16x16x128_f8f6f4((i32x8_t){(int)w.x, (int)w.y, (int)w.z, (int)w.w, 0, 0, 0, 0}, xb[0], (f32x4){0.f, 0.f, 0.f, 0.f}, 4  , 4  , 0, 0x7F7F7F7F, 0, scb); }
#pragma unroll
    for (int i = 0; i < 8; ++i) { const v4u w = a[i][1]; c[i] = __builtin_amdgcn_mfma_scale_f32_16x16x128_f8f6f4((i32x8_t){(int)w.x, (int)w.y, (int)w.z, (int)w.w, 0, 0, 0, 0}, xb[1], c[i], 4, 4, 0, 0x7F7F7F7F, 0, scb); }
#pragma unroll
    for (int i = 0; i < 8; ++i)
#pragma unroll
        for (int e = 0; e < 4; ++e) c[i][e] += dpp_swap1(c[i][e]);
    if (r == 0) {
#pragma unroll
        for (int i = 0; i < 8; ++i) *(GAS f32x4*)(pp + 16 * i) = c[i]; }
}
__device__ __forceinline__ void peer_down_pass(Frame& F, const PeerDeal& d) {
    const int lane = F.lane;
    const int N = d.ns * d.cnt; if (N <= 0) return;
    i32x4_t I0[4], I1[4]; v4u R0[16], R1[16], X0[2], X1[2];
    int t0, s0, t1, s1, t2, s2, t3, s3;
    pd_item(0, d, t0, s0); pd_idx(F, t0, lane, I0);
    pd_item(1, d, t1, s1); pd_idx(F, t1, lane, I1);
    pd_rows(F, t0, s0, lane, I0, R0, X0);
#pragma unroll 1
    for (int n = 0; n < N; n += 2) {
        pd_item(n + 2, d, t2, s2); pd_idx(F, t2, lane, I0);
        __builtin_amdgcn_sched_barrier(0);
        pd_rows(F, t1, s1, lane, I1, R1, X1);
        __builtin_amdgcn_sched_barrier(0);
        pd_compute(F, t0, s0, lane, R0, X0);
        __builtin_amdgcn_sched_barrier(0);
        pd_item(n + 3, d, t3, s3); pd_idx(F, t3, lane, I1);
        __builtin_amdgcn_sched_barrier(0);
        pd_rows(F, t2, s2, lane, I0, R0, X0);
        __builtin_amdgcn_sched_barrier(0);
        pd_compute(F, t1, s1, lane, R1, X1);
        __builtin_amdgcn_sched_barrier(0);
        t0 = t2; s0 = s2; t1 = t3; s1 = s3;
    }
}
template <int NT> __device__ __forceinline__ void peer_combine_tokens(Frame& F, const int tbase, const int tstep) {
    const int lane = F.lane;
    f32x2_t a[NT], gt[NT]; int id0[NT], id1[NT];
#pragma unroll
    for (int k = 0; k < NT; ++k) { const int t = tbase + k * tstep;
        const float* PART = WSP(const float, WS_PART) + (size_t)t * 128 + 2 * lane;
        f32x2_t p[16];
#pragma unroll
        for (int sl = 0; sl < 16; ++sl) p[sl] = *(const GAS f32x2_t*)(PART + (size_t)sl * M * 128);
        const u32x2_t idw = *(const GAS u32x2_t*)(WSP(const int, WS_IDX) + (size_t)t * 128 + 2 * lane); id0[k] = (int)idw.x; id1[k] = (int)idw.y;
        gt[k] = *(const GAS f32x2_t*)(WSP(float, WS_GATE) + (size_t)t * 128 + 2 * lane);
        a[k] = (f32x2_t){0.f, 0.f};
#pragma unroll
        for (int sl = 0; sl < 16; ++sl) a[k] += p[sl]; }
    float sd0[NT], sd1[NT], su0[NT], su1[NT];
#pragma unroll
    for (int k = 0; k < NT; ++k) { sd0[k] = WSP(const float, WS_SCD)[id0[k]]; sd1[k] = WSP(const float, WS_SCD)[id1[k]]; su0[k] = WSP(const float, WS_SCU)[id0[k]]; su1[k] = WSP(const float, WS_SCU)[id1[k]]; }
#pragma unroll
    for (int k = 0; k < NT; ++k) { const int t = tbase + k * tstep;
        const float c0 = gt[k].x * gelu_erf(a[k].x * sd0[k]) * su0[k], c1 = gt[k].y * gelu_erf(a[k].y * sd1[k]) * su1[k];
        *(GAS f32x2_t*)(WSP(float, WS_GATE) + (size_t)t * 128 + 2 * lane) = (f32x2_t){c0, c1};
        float bm = fmaxf(fabsf(c0), fabsf(c1));
        bm = fmaxf(bm, __shfl_xor(bm, 1)); bm = fmaxf(bm, __shfl_xor(bm, 2)); bm = fmaxf(bm, __shfl_xor(bm, 4)); bm = fmaxf(bm, __shfl_xor(bm, 8));
        int eb = (int)((__float_as_uint(bm) >> 23) & 255u) - 1;
        eb = eb < 3 ? 3 : eb > 250 ? 250 : eb;
        const float inv = __uint_as_float((unsigned)(254 - eb) << 23);
        const float s0 = c0 * inv, s1 = c1 * inv;
        const unsigned hi = __builtin_amdgcn_cvt_scalef32_pk_fp4_f32(0u, s0, s1, 1.0f, 0);
        const f32x2_t dq = __builtin_amdgcn_cvt_scalef32_pk_f32_fp4(hi, 1.0f, 0);
        const unsigned lo = __builtin_amdgcn_cvt_scalef32_pk_fp4_f32(0u, (s0 - dq.x) * 8.f, (s1 - dq.y) * 8.f, 1.0f, 0);
        unsigned char* cf4 = F.ws + WS_CF4 + (size_t)t * 160;
        ((GAS unsigned char*)cf4)[lane] = (unsigned char)hi; ((GAS unsigned char*)cf4)[64 + lane] = (unsigned char)lo;
        if ((lane & 15) == 0) ((GAS unsigned*)(cf4 + 128))[lane >> 4] = (unsigned)eb * 0x01010101u; }
}
struct PmBuf { v4u rows[16]; v4u aw; unsigned e; u32x2_t xv; };
__device__ __forceinline__ void pm_rows(Frame& F, int t, int sl, int lane, const i32x4_t (&idv)[4], PmBuf& b) {
    const int n = lane & 15, g = lane >> 4;
    const unsigned char* WU = F.ws + WS_W4U + (size_t)sl * SLICE_BYTES;
    const unsigned lo16 = 16u * (unsigned)(lane & 7);
#pragma unroll
    for (int j = 0; j < 16; ++j) b.rows[j] = *(const GAS v4u*)(WU + (size_t)(((unsigned)idv[j >> 2][j & 3] << 7) + lo16));
    const unsigned char* cf4 = F.ws + WS_CF4 + (size_t)t * 160;
    b.aw = *(const GAS v4u*)(cf4 + 64 * (n & 1) + 16 * g); b.e = *(const GAS unsigned*)(cf4 + 128 + 4 * g);
    b.xv = *(const GAS u32x2_t*)(WSP(const bf16, WS_X1B) + (size_t)t * D + 256 * sl + 4 * lane);
}
__device__ __forceinline__ void pm_compute(Frame& F, int t, int sl, int lane, const PmBuf& b) {
    const int n = lane & 15, g = lane >> 4;
    LAS unsigned char* tile = F.lds + RING_OFF + F.wave * 16384;
    LAS float* obuf = (LAS float*)(F.lds + OBUF_OFF + F.wave * 1024);
    { LAS unsigned char* wp = tile + (lane >> 3) * 2048; const int cc = lane & 7;
#pragma unroll
      for (int j = 0; j < 16; ++j) { const v4u w = b.rows[j]; *(LAS v4u*)(wp + j * 128 + ((cc ^ (j >> 1)) << 4)) = (j & 1) ? (v4u){w.z, w.w, w.x, w.y} : w; } }
    const LAS unsigned char* rp = tile + (32 * g + n) * 128;
    const bool arow = n < 2;
    const i32x8_t afr = (i32x8_t){arow ? (int)b.aw.x : 0, arow ? (int)b.aw.y : 0, arow ? (int)b.aw.z : 0, arow ? (int)b.aw.w : 0, 0, 0, 0, 0};
    const unsigned sca = n == 0 ? b.e : n == 1 ? b.e - 0x03030303u : 0x7F7F7F7Fu;
    LAS float* const wdst = g == 0 ? obuf + n : (LAS float*)(F.lds + ODUMP_OFF + F.wave * 256) + lane; const int wstep = g == 0 ? 16 : 0;
#pragma unroll
    for (int h = 0; h < 2; ++h) {
        v2i32_t b0[8], b1[8];
#pragma unroll
        for (int q = 0; q < 8; ++q) { const int off = (((8 * h + q) ^ n) << 3); b0[q] = __builtin_amdgcn_ds_read_tr4_b64_v2i32((LAS v2i32_t*)(rp + off)); b1[q] = __builtin_amdgcn_ds_read_tr4_b64_v2i32((LAS v2i32_t*)(rp + 2048 + off)); }
        f32x4 c[8];
#pragma unroll
        for (int q = 0; q < 8; ++q) c[q] = __builtin_amdgcn_mfma_scale_f32_16x16x128_f8f6f4(afr, (i32x8_t){b0[q].x, b0[q].y, b1[q].x, b1[q].y, 0, 0, 0, 0}, (f32x4){0.f, 0.f, 0.f, 0.f}, 4, 4, 0, (int)sca, 0, 0x7F7F7F7F);
#pragma unroll
        for (int q = 0; q < 8; ++q) wdst[(8 * h + q) * wstep] = c[q][0] + c[q][1];
    }
    *(GAS f32x4*)(F.out + (size_t)t * D + 256 * sl + 4 * lane) = (f32x4){bflo(b.xv.x), bfhi(b.xv.x), bflo(b.xv.y), bfhi(b.xv.y)} + *(const LAS f32x4*)(obuf + 4 * lane);
}
__device__ __forceinline__ void peer_up_pass_mfma(Frame& F, const PeerDeal& d) {
    const int lane = F.lane;
    const int N = d.ns * d.cnt; if (N <= 0) return;
    i32x4_t I0[4], I1[4]; PmBuf B0, B1;
    int t0, s0, t1, s1, t2, s2, t3, s3;
    pd_item(0, d, t0, s0); pd_idx(F, t0, lane, I0);
    pd_item(1, d, t1, s1); pd_idx(F, t1, lane, I1);
    pm_rows(F, t0, s0, lane, I0, B0);
#pragma unroll 1
    for (int n = 0; n < N; n += 2) {
        pd_item(n + 2, d, t2, s2); pd_idx(F, t2, lane, I0);
        __builtin_amdgcn_sched_barrier(0);
        pm_rows(F, t1, s1, lane, I1, B1);
        __builtin_amdgcn_sched_barrier(0);
        pm_compute(F, t0, s0, lane, B0);
        __builtin_amdgcn_sched_barrier(0);
        pd_item(n + 3, d, t3, s3); pd_idx(F, t3, lane, I1);
        __builtin_amdgcn_sched_barrier(0);
        pm_rows(F, t2, s2, lane, I0, B0);
        __builtin_amdgcn_sched_barrier(0);
        pm_compute(F, t1, s1, lane, B1);
        __builtin_amdgcn_sched_barrier(0);
        t0 = t2; s0 = s2; t1 = t3; s1 = s3;
    }
}
typedef _Float16 h2_t __attribute__((ext_vector_type(2)));
#define FP4H2(w, b) __builtin_bit_cast(h2_t, __builtin_amdgcn_cvt_scalef32_pk_f16_fp4((w), 1.0f, (b)))
__device__ __forceinline__ void pu_idx(Frame& F, int t, int lane, i32x4_t (&idv)[8], f32x4 (&cfv)[8]) {
    const GAS i32x4_t* ip = (const GAS i32x4_t*)(WSP(const int, WS_IDX) + (size_t)t * 128 + (lane >> 4) * 32); const GAS f32x4* cp = (const GAS f32x4*)(WSP(const float, WS_GATE) + (size_t)t * 128 + (lane >> 4) * 32);
#pragma unroll
    for (int a = 0; a < 8; ++a) { idv[a] = ip[a]; cfv[a] = cp[a]; }
}
template <int H> __device__ __forceinline__ void pu_rows(Frame& F, int sl, int lane, const i32x4_t (&idv)[8], u32x2_t (&rows)[16]) {
    const unsigned char* WU = F.ws + WS_W4U + (size_t)sl * SLICE_BYTES + (lane & 15) * 8;
#pragma unroll
    for (int i = 0; i < 16; ++i) rows[i] = *(const GAS u32x2_t*)(WU + (size_t)idv[4 * H + (i >> 2)][i & 3] * 128);
}
template <int H> __device__ __forceinline__ void pu_compute(const u32x2_t (&rows)[16], const f32x4 (&cfv)[8], h2_t (&acc)[8]) {
#pragma unroll
    for (int i = 0; i < 16; ++i) { const float c = cfv[4 * H + (i >> 2)][i & 3] * 256.0f; const h2_t cc = __builtin_bit_cast(h2_t, __builtin_amdgcn_cvt_pkrtz(c, c));
#pragma unroll
        for (int k = 0; k < 2; ++k) { const unsigned w = rows[i][k];
            acc[4 * k + 0] = FP4H2(w, 0) * cc + acc[4 * k + 0]; acc[4 * k + 1] = FP4H2(w, 1) * cc + acc[4 * k + 1]; acc[4 * k + 2] = FP4H2(w, 2) * cc + acc[4 * k + 2]; acc[4 * k + 3] = FP4H2(w, 3) * cc + acc[4 * k + 3]; } }
}
__device__ __forceinline__ void pu_finish(Frame& F, int t, int sl, int lane, h2_t (&acc)[8]) {
    const int eg = lane >> 4, q = lane & 15;
#pragma unroll
    for (int a = 0; a < 8; ++a) {
        acc[a] = acc[a] + __builtin_bit_cast(h2_t, __shfl_xor(__builtin_bit_cast(unsigned, acc[a]), 16)); acc[a] = acc[a] + __builtin_bit_cast(h2_t, __shfl_xor(__builtin_bit_cast(unsigned, acc[a]), 32)); }
    const h2_t o01 = eg == 0 ? acc[0] : eg == 1 ? acc[2] : eg == 2 ? acc[4] : acc[6], o23 = eg == 0 ? acc[1] : eg == 1 ? acc[3] : eg == 2 ? acc[5] : acc[7];
    GAS f32x4* op = (GAS f32x4*)(F.out + (size_t)t * D + 256 * sl + 16 * q + 4 * eg);
    f32x4 o; { const u32x2_t w = *(const GAS u32x2_t*)(WSP(const bf16, WS_X1B) + (size_t)t * D + 256 * sl + 16 * q + 4 * eg); o = (f32x4){bflo(w.x), bfhi(w.x), bflo(w.y), bfhi(w.y)}; }
    *op = (f32x4){o[0] + (float)o01.x * (1.0f / 256.0f), o[1] + (float)o01.y * (1.0f / 256.0f), o[2] + (float)o23.x * (1.0f / 256.0f), o[3] + (float)o23.y * (1.0f / 256.0f)};
#pragma unroll
    for (int a = 0; a < 8; ++a) acc[a] = (h2_t){(_Float16)0.f, (_Float16)0.f};
}
__device__ __forceinline__ void peer_up_pass(Frame& F, const PeerDeal& d) {
    const int lane = F.lane;
    const int N = d.ns * d.cnt; if (N <= 0) return;
    i32x4_t IA[8], IB[8]; f32x4 CA[8], CB[8]; u32x2_t Ra[16], Rb[16]; h2_t acc[8];
#pragma unroll
    for (int a = 0; a < 8; ++a) acc[a] = (h2_t){(_Float16)0.f, (_Float16)0.f};
    int ta, sa, tb, sb, tc, sc;
    pd_item(0, d, ta, sa); pu_idx(F, ta, lane, IA, CA);
    pd_item(1, d, tb, sb); pu_idx(F, tb, lane, IB, CB);
    pu_rows<0>(F, sa, lane, IA, Ra);
#pragma unroll 1
    for (int n = 0; n < N; n += 2) {
        pu_rows<1>(F, sa, lane, IA, Rb);
        pu_compute<0>(Ra, CA, acc);
        pu_rows<0>(F, sb, lane, IB, Ra);
        pu_compute<1>(Rb, CA, acc);
        pu_finish(F, ta, sa, lane, acc);
        pd_item(n + 2, d, tc, sc); pu_idx(F, tc, lane, IA, CA);
        if (n + 1 < N) {
            pu_rows<1>(F, sb, lane, IB, Rb);
            pu_compute<0>(Ra, CB, acc);
            pu_rows<0>(F, sc, lane, IA, Ra);
            pu_compute<1>(Rb, CB, acc);
            pu_finish(F, tb, sb, lane, acc);
        }
        pd_item(n + 3, d, tb, sb); pu_idx(F, tb, lane, IB, CB);
        ta = tc; sa = sc;
    }
}
struct Args { const float* in[15]; float* out; unsigned char* ws; int ph_lo, ph_hi, pad0, pad1; };
__global__ void __launch_bounds__(NWAVES * 64, 2) skel_fwd(Args args) {
    extern __shared__ __attribute__((aligned(16))) unsigned char lds[];
    Frame F;
    F.lds = (LAS unsigned char*)lds;
    F.MISC = (volatile LAS unsigned*)(F.lds + MISC_OFF);
    F.tid = threadIdx.x; F.lane = F.tid & 63; F.wave = __builtin_amdgcn_readfirstlane(F.tid >> 6);
    F.G = gridDim.x; { const int bx = blockIdx.x; F.vcu = (F.G % 8 == 0) ? (bx % 8) * (F.G / 8) + bx / 8 : bx; }
    F.ws = args.ws; F.ctl = (gu32*)(args.ws + WS_CTL);
    F.x = args.in[0]; F.g1 = args.in[1]; F.w_in = args.in[2]; F.gq = args.in[3]; F.gk = args.in[4]; F.sink = args.in[5]; F.conv_w = args.in[6]; F.w_oa = args.in[7];
    F.w_oc = args.in[8]; F.w_out = args.in[9]; F.g2 = args.in[10]; F.w_qp = args.in[11]; F.subk = args.in[12]; F.w_down = args.in[13]; F.w_up = args.in[14]; F.out = args.out;
    for (int u = F.tid; u < (LDS_BYTES - LDSCTL_OFF) / 4; u += NWAVES * 64) ((LAS unsigned*)(F.lds + LDSCTL_OFF))[u] = 0u;
    __syncthreads();
    XcdBarrier bar; bar.bar = (unsigned*)(F.ctl + CW_BAR); bar.x = 0; bar.st = nullptr;
    if (MK_ONE_LAUNCH) bar = xcd_barrier_post((unsigned*)(F.ctl + CW_BAR), F.MISC + 8);
    if (MK_ONE_LAUNCH && F.tid == 0) { const unsigned xcc = xb_xcc_id(); F.MISC[10] = xcc; F.MISC[11] = __hip_atomic_fetch_add((unsigned*)(F.ctl + CW_XRANK) + 64 * xcc, 1u, RLX_AGENT); }
    if (F.wave == 0) { const bool ok = tr4_selfcheck(F.lds + RING_OFF, F.lane); if (F.lane == 0) F.MISC[15] = ok ? 1u : 0u; }
    __syncthreads();
    const bool tr4_ok = F.MISC[15] != 0u;
    const int lo = args.ph_lo, hi = args.ph_hi;
#ifndef PHASE_MASK
#define PHASE_MASK 0xfff
#endif
#define IN(k) (((PHASE_MASK >> (k)) & 1) && lo <= (k) && (k) < hi)
#ifndef DUP_MASK
#define DUP_MASK 0
#endif
#define REP(k) _Pragma("unroll") for (int rep_ = 0; rep_ < 1 + ((DUP_MASK >> (k)) & 1); ++rep_)
#define SEAM(k) do { if (MK_ONE_LAUNCH && IN(k) && IN((k) + 1)) xcd_barrier(bar); } while (0)
    const int gw = F.vcu * NWAVES + F.wave, NGW = F.G * NWAVES;

    if (IN(0)) REP(0) { p0_prologue(F); } SEAM(0);

    if (IN(1)) REP(1) { quant_w8(F); if (P4A_I8) quant_w8_oa(F); } SEAM(1);

    if (IN(2)) REP(2) {
        bf16* const pQ = WSP(bf16, WS_Q); bf16* const pK = WSP(bf16, WS_K); bf16* const pV = WSP(bf16, WS_V); bf16* const pH = WSP(bf16, WS_H); bf16* const pB = WSP(bf16, WS_B); bf16* const pC = WSP(bf16, WS_C);
        bf16* const pGA = WSP(bf16, WS_GA); bf16* const pGC = WSP(bf16, WS_GC);
        {   pg8::Gemm g{(const bf16*)(F.ws + WS_XN8), (const bf16*)(F.ws + WS_W8), M, INW, D / 2};
            pg8::RangeOrder S; S.so.init(M, I8_TILES * 256, F.G, (int)blockIdx.x); S.base = 0; S.cut = I8_CUT; S.skip = I8_SKIP;
            pg8::EpiProj<true> E{pQ, pK, pV, pH, pB, pC, pGA, pGC, WSP(const float, WS_SX), WSP(const float, WS_SW)};
            pg8::gemm_phase<pg8::EpiProj<true>, pg8::RangeOrder, PG8_ALIGN, PG8_SP2, true>(F.lds + RING_OFF, g, S, E); }
        {   pg8::Gemm g{WSP(const bf16, WS_XN), WSP(const bf16, WS_WIN), M, INW, D};
            pg8::RangeOrder S; S.so.init(M, BF_TILES * 256, F.G, (int)blockIdx.x); S.base = BF_BASE; S.cut = 68; S.skip = 0;
            pg8::EpiProj<false> E{pQ, pK, pV, pH, pB, pC, pGA, pGC, nullptr, nullptr};
            pg8::gemm_phase<pg8::EpiProj<false>, pg8::RangeOrder, PG8_ALIGN, PG8_SP2, false>(F.lds + RING_OFF, g, S, E); }
    } SEAM(2);

    if (IN(3)) REP(3) {
        attn_phase(F);
#ifdef ATTN_PROBE
        for (int U = F.vcu * 4; U < BATCH * 32 * NKV * 2; U += F.G * 4)
            for (int i = 0; i < 4; ++i) attn_unit<ATTN_PROBE>(F, U + i);
#endif
        conv_phase(F);
#ifdef CONV_DUP
        conv_phase(F);
#endif
        if (DUP_MASK) __syncthreads();
    } SEAM(3);

    if (IN(4)) REP(4) {
#if P4A_I8
        for (int m = gw; m < M; m += NGW) quant_row_i8<4>(WSP(const bf16, WS_AB) + (size_t)m * QW, F.ws + WS_AI8 + (size_t)m * QW, WSP(float, WS_SXA) + m, F.lane);
        if (MK_ONE_LAUNCH) xcd_barrier(bar);
        {   pg8::Gemm g{(const bf16*)(F.ws + WS_AI8), (const bf16*)(F.ws + WS_W8OA), M, D, QW / 2}; pg8::StaticOrder S; S.init(M, D, F.G, (int)blockIdx.x);
            pg8::EpiMergeA8 E{WSP(const bf16, WS_GA), WSP(bf16, WS_T), WSP(const float, WS_SXA), WSP(const float, WS_SWA)};
            pg8::gemm_phase<pg8::EpiMergeA8, pg8::StaticOrder, PG8_ALIGN, PG8_SP2, true>(F.lds + RING_OFF, g, S, E); }
        {   pg8::Gemm g{WSP(const bf16, WS_AB) + (size_t)M * CW, WSP(const bf16, WS_WO) + (size_t)D * QW, M, D, CW}; pg8::StaticOrder S; S.init(M, D, F.G, (int)blockIdx.x);
            pg8::EpiMergeC E{WSP(const bf16, WS_GC), WSP(const bf16, WS_T), WSP(bf16, WS_XN)};
            pg8::gemm_phase<pg8::EpiMergeC, pg8::StaticOrder, PG8_ALIGN, PG8_SP2>(F.lds + RING_OFF, g, S, E); }
#else
        pg8::Gemm g{WSP(const bf16, WS_AB), WSP(const bf16, WS_WO), 2 * M, 2 * D, QW}; pg8::PairOrder S; S.so.init(M, D, F.G, (int)blockIdx.x);
        pg8::EpiMerge E{WSP(const bf16, WS_GA), WSP(const bf16, WS_GC), WSP(bf16, WS_T), WSP(bf16, WS_XN)};
        pg8::gemm_phase<pg8::EpiMerge, pg8::PairOrder, PG8_ALIGN, PG8_SP2>(F.lds + RING_OFF, g, S, E);
#endif
    } SEAM(4);

    if (IN(5)) REP(5) {
#if P5_I8
        for (int m = gw; m < M; m += NGW) quant_row_i8<8>(WSP(const bf16, WS_XN) + (size_t)m * D, F.ws + WS_MI8 + (size_t)m * D, WSP(float, WS_SXM) + m, F.lane);
        if (MK_ONE_LAUNCH) xcd_barrier(bar);
        pg8::Gemm g{(const bf16*)(F.ws + WS_MI8), (const bf16*)(F.ws + WS_W8OUT), M, D, D / 2}; pg8::StaticOrder S; S.init(M, D, F.G, (int)blockIdx.x);
        pg8::EpiResI8 E{F.x, WSP(bf16, WS_X1B), WSP(const float, WS_SXM), WSP(const float, WS_SWO)};
        pg8::gemm_phase<pg8::EpiResI8, pg8::StaticOrder, PG8_ALIGN, PG8_SP2, true>(F.lds + RING_OFF, g, S, E);
#else
        pg8::Gemm g{WSP(const bf16, WS_XN), WSP(const bf16, WS_WOUT), M, D, D}; pg8::StaticOrder S; S.init(M, D, F.G, (int)blockIdx.x);
        pg8::EpiRes E{F.x, WSP(bf16, WS_X1B)};
        pg8::gemm_phase<pg8::EpiRes, pg8::StaticOrder, PG8_ALIGN, PG8_SP2>(F.lds + RING_OFF, g, S, E);
#endif
    } SEAM(5);

    if (IN(6)) REP(6) {
        for (int m = gw; m < M; m += NGW) rms2_row(WSP(const bf16, WS_X1B) + (size_t)m * D, F.g2, F.ws + WS_X2I8 + (size_t)m * D, WSP(float, WS_SX2) + m, F.ws + WS_X2N8 + (size_t)m * 256, F.lane);
    } SEAM(6);

    if (IN(7)) REP(7) {
        pg8::Gemm g{(const bf16*)(F.ws + WS_X2I8), (const bf16*)(F.ws + WS_W8QP), M, PQW, D / 2}; pg8::StaticOrder S; S.init(M, PQW, F.G, (int)blockIdx.x);
        pg8::EpiStoreI8 E{WSP(bf16, WS_QP), PQW, WSP(const float, WS_SX2), WSP(const float, WS_SWQ)};
        pg8::gemm_phase<pg8::EpiStoreI8, pg8::StaticOrder, PG8_ALIGN, PG8_SP2, true>(F.lds + RING_OFF, g, S, E);
    } SEAM(7);

    if (IN(8)) REP(8) {
        const int h = F.vcu & 7;
        { const bf16* SK = WSP(const bf16, WS_SK) + (size_t)h * (2 * NKEYS * 128);
#pragma unroll
          for (int i = 0; i < 8; ++i) { const int q = F.tid + 512 * i, row = q >> 4, ch = q & 15; *(LAS v4u*)(F.lds + RING_OFF + off_b(row, ch)) = *(const GAS v4u*)(SK + (size_t)row * 128 + ch * 8); } }
        __syncthreads();
        for (int tg = (F.vcu >> 3) * NWAVES + F.wave; tg < M / 16; tg += (F.G >> 3) * NWAVES) route_task(F, tg, h);
        if (DUP_MASK) __syncthreads();
    } SEAM(8);

    PeerDeal deal;
    if (IN(9) || IN(11)) {
        if (MK_ONE_LAUNCH) {
            if (F.tid == 0) { const unsigned xcc = F.MISC[10]; unsigned nloc = 0, ox = 0, nx = 0;
                for (unsigned j = 0; j < 16; ++j) { const unsigned c = __hip_atomic_load((unsigned*)(F.ctl + CW_XRANK) + 64 * j, RLX_AGENT); if (c) { ++nx; if (j < xcc) ++ox; } if (j == xcc) nloc = c; }
                F.MISC[12] = nloc; F.MISC[13] = ox; F.MISC[14] = nx; }
            __syncthreads();
            const int nloc = (int)F.MISC[12], rank = (int)F.MISC[11];
            deal.ox = (int)F.MISC[13]; deal.nx = (int)F.MISC[14]; deal.t0 = rank * NWAVES + F.wave; deal.stride = nloc * NWAVES;
        } else { const int nper = F.G >> 3; deal.ox = F.vcu / nper; deal.nx = 8; deal.t0 = (F.vcu % nper) * NWAVES + F.wave; deal.stride = nper * NWAVES; }
        deal.cnt = deal.t0 < M ? (M - deal.t0 + deal.stride - 1) / deal.stride : 0; deal.ns = deal.ox < 16 ? (16 - deal.ox + deal.nx - 1) / deal.nx : 0;
    }
    if (IN(9)) {
        peer_down_pass(F, deal);
    } SEAM(9);
    if (IN(10)) {
        { int t = gw; for (; t + 3 * NGW < M; t += 4 * NGW) peer_combine_tokens<4>(F, t, NGW); for (; t < M; t += NGW) peer_combine_tokens<1>(F, t, NGW); }
    } SEAM(10);
    if (IN(11)) {
        if (tr4_ok) peer_up_pass_mfma(F, deal); else peer_up_pass(F, deal);
    }
#undef IN
#undef SEAM
}

extern "C" void kernel_launch(void* const* d_in, const int* in_sizes, int n_in, void* d_out, int out_size, void* d_ws, size_t ws_size, hipStream_t stream) {
    static int grid = 0;
    if (grid == 0) {
        if (n_in != 15 || in_sizes[0] != M * D || out_size != M * D || ws_size < WS_END) { fprintf(stderr, "kernel_launch: built for 15 inputs, x and out of %d floats, >= %zu bytes of workspace; got n_in %d, in0 %d, out %d, ws %zu; nothing launched\n", M * D, (size_t)WS_END, n_in, n_in > 0 ? in_sizes[0] : -1, out_size, ws_size); grid = -1; return; }
        int dev = 0, cus = 0, per_cu = 0;
        if (hipGetDevice(&dev) != hipSuccess || hipDeviceGetAttribute(&cus, hipDeviceAttributeMultiprocessorCount, dev) != hipSuccess) { fprintf(stderr, "kernel_launch: hipGetDevice / hipDeviceGetAttribute failed; nothing launched\n"); grid = -1; return; }
        if (hipFuncSetAttribute((const void*)skel_fwd, hipFuncAttributeMaxDynamicSharedMemorySize, LDS_BYTES) != hipSuccess) { fprintf(stderr, "kernel_launch: hipFuncSetAttribute failed; nothing launched\n"); grid = -1; return; }
        if (hipOccupancyMaxActiveBlocksPerMultiprocessor(&per_cu, (const void*)skel_fwd, NWAVES * 64, LDS_BYTES) != hipSuccess || per_cu < 1)
            fprintf(stderr, "kernel_launch: note: the occupancy query reports %d workgroups per CU\n", per_cu);
        (void)hipGetLastError();
        grid = cus;
        if (grid % 8 != 0) { fprintf(stderr, "kernel_launch: %d CUs: this kernel deals work in groups of 8 workgroups; nothing launched\n", grid); grid = -1; return; }
    }
    if (grid < 0) return;
    if (hipMemsetAsync((char*)d_ws + WS_CTL, 0, CTL_ZERO_BYTES, stream) != hipSuccess) { fprintf(stderr, "kernel_launch: hipMemsetAsync of the control words failed; nothing launched\n"); return; }
    Args a{};
    for (int i = 0; i < 15; ++i) a.in[i] = (const float*)d_in[i];
    a.out = (float*)d_out; a.ws = (unsigned char*)d_ws;
#if MK_ONE_LAUNCH
    a.ph_lo = 0; a.ph_hi = N_PHASES;
    hipLaunchKernelGGL(skel_fwd, dim3(grid), dim3(NWAVES * 64), LDS_BYTES, stream, a);
    { const hipError_t le = hipPeekAtLastError(); if (le != hipSuccess) fprintf(stderr, "kernel_launch: launch failed: %s\n", hipGetErrorName(le)); }
#else
    for (int p = 0; p < N_PHASES; ++p) {
        a.ph_lo = p; a.ph_hi = p + 1;
        hipLaunchKernelGGL(skel_fwd, dim3(grid), dim3(NWAVES * 64), LDS_BYTES, stream, a);
        const hipError_t le = hipPeekAtLastError();
        if (le != hipSuccess) { fprintf(stderr, "kernel_launch: launch %d failed: %s\n", p, hipGetErrorName(le)); break; }
    }
#endif
}
```

```cpp
#include <hip/hip_runtime.h>
#include <cstdio>
#include <cstdint>
#include <cmath>
namespace pg8 {
#define PG8_LAS __attribute__((address_space(3)))
typedef unsigned short bf16_t;
typedef short bf16x8 __attribute__((ext_vector_type(8)));
typedef float f32x4 __attribute__((ext_vector_type(4)));
typedef unsigned u32x4 __attribute__((ext_vector_type(4)));
typedef int i32x4 __attribute__((ext_vector_type(4)));
constexpr int BM = 256, BK = 64, HALF = 128, HTB = HALF * BK * 2  , STAGE_BYTES = 8 * HTB, NXCD = 8, WGM = 2;

__host__ __device__ __forceinline__ int lds_byte(int r, int c) { const int st = (r >> 4) * 2 + (c >> 5), rr = r & 15, cc = c & 31, ob = rr * 64 + cc * 2; return st * 1024 + (ob ^ (((ob >> 9) & 1) << 5)); }
__host__ __device__ __forceinline__ void stage_rc(int b, int& R, int& C) { const int st = b / 1024, sb = b % 1024, swz = sb ^ (((sb >> 9) & 1) << 5); R = (st >> 1) * 16 + swz / 64; C = (st & 1) * 32 + (swz % 64) / 2; }
__host__ __device__ __forceinline__ int perm32(int rho) { const int n = rho >> 4, i = rho & 15; return 8 * (i >> 2) + 4 * n + (i & 3); }

struct Unit { int pm, pn; };
struct Gemm { const bf16_t* A; const bf16_t* Bt; int M, N, K; };

struct StaticOrder {
    int nM, nN, nwg, G, c;
    __host__ __device__ void init(int M, int N, int G_, int c_) { nM = M / BM; nN = N / BM; nwg = nM * nN; G = G_; c = c_; }
    __host__ __device__ bool next(int i, Unit& u) const {
        const long L = (long)i * G + c; if (L >= nwg) return false;
        int wgid = (int)L; { const int q = nwg / NXCD, r = nwg % NXCD, xcd = wgid % NXCD, off = wgid / NXCD; wgid = (xcd < r ? xcd * (q + 1) : r * (q + 1) + (xcd - r) * q) + off; }
        const int nig = WGM * nN, gid = wgid / nig, fm = gid * WGM, gsz = (nM - fm) < WGM ? (nM - fm) : WGM;
        u.pm = fm + ((wgid % nig) % gsz); u.pn = (wgid % nig) / gsz; return true;
    }
    __device__ __forceinline__ void a_ready(const Unit&) const {}
    __device__ __forceinline__ void done(const Unit&) const {}
};
__device__ __forceinline__ unsigned cvt_pk_bf16(float lo, float hi) { unsigned r; asm volatile("v_cvt_pk_bf16_f32 %0, %1, %2" : "=v"(r) : "v"(lo), "v"(hi)); return r; }
typedef unsigned u32x2 __attribute__((ext_vector_type(2)));
__device__ __forceinline__ float sigm(float v) { return __builtin_amdgcn_rcpf(1.0f + __builtin_amdgcn_exp2f(-1.4426950408889634f * v)); }
__device__ __forceinline__ u32x4 pack8(const f32x4 a, const f32x4 b) { u32x4 w; w.x = cvt_pk_bf16(a[0], a[1]); w.y = cvt_pk_bf16(a[2], a[3]); w.z = cvt_pk_bf16(b[0], b[1]); w.w = cvt_pk_bf16(b[2], b[3]); return w; }
__device__ __forceinline__ void unpack8(const u32x4 w, f32x4& a, f32x4& b) {
    a[0] = __uint_as_float(w.x << 16); a[1] = __uint_as_float(w.x & 0xffff0000u); a[2] = __uint_as_float(w.y << 16); a[3] = __uint_as_float(w.y & 0xffff0000u);
    b[0] = __uint_as_float(w.z << 16); b[1] = __uint_as_float(w.z & 0xffff0000u); b[2] = __uint_as_float(w.w << 16); b[3] = __uint_as_float(w.w & 0xffff0000u);
}
template <bool I8> struct EpiProj {
    static constexpr bool PERM = true, AFTER_DRAIN = false;
    bf16_t *Q, *K, *V, *H, *Bg, *Cg, *GA, *GC; const float *sx, *sw;
    __device__ __forceinline__ void operator()(const f32x4 (&acc)[2][2][4][2], const Unit& u, int wr, int wc, int fr, int fq) const {
        const int pn = u.pn; bf16_t* base; int ldc, ct; bool sg = false;
        if (pn < 8) { base = Q; ldc = 2048; ct = pn; } else if (pn < 10) { base = K; ldc = 512; ct = pn - 8; } else if (pn < 12) { base = V; ldc = 512; ct = pn - 10; }
        else if (pn < 20) { base = H; ldc = 2048; ct = pn - 12; } else if (pn < 28) { base = Bg; ldc = 2048; ct = pn - 20; } else if (pn < 36) { base = Cg; ldc = 2048; ct = pn - 28; }
        else if (pn < 52) { base = GA; ldc = 4096; ct = pn - 36; sg = true; } else { base = GC; ldc = 4096; ct = pn - 52; sg = true; }
        const int row0 = u.pm * BM + wr * 64 + fr, col0 = ct * BM + wc * 32 + 8 * fq;
        f32x4 cs[2][2];
        if constexpr (I8) {
#pragma unroll
            for (int bj = 0; bj < 2; ++bj)
#pragma unroll
                for (int n = 0; n < 2; ++n) cs[bj][n] = *(const f32x4*)(sw + pn * BM + bj * HALF + wc * 32 + 8 * fq + 4 * n);
        }
        float rsv[2][4];
#pragma unroll
        for (int ai = 0; ai < 2; ++ai)
#pragma unroll
            for (int m = 0; m < 4; ++m) { rsv[ai][m] = 1.f; if constexpr (I8) rsv[ai][m] = sx[row0 + ai * HALF + m * 16]; }
        __builtin_amdgcn_sched_barrier(0);
#pragma unroll
        for (int ai = 0; ai < 2; ++ai)
#pragma unroll
            for (int m = 0; m < 4; ++m) { const int row = row0 + ai * HALF + m * 16; bf16_t* rowp = base + (size_t)row * ldc + col0;
                const float rs = rsv[ai][m];
#pragma unroll
                for (int bj = 0; bj < 2; ++bj) { f32x4 v0 = acc[ai][bj][m][0], v1 = acc[ai][bj][m][1];
                    if constexpr (I8) { v0 = __builtin_convertvector(__builtin_bit_cast(i32x4, v0), f32x4) * (cs[bj][0] * rs); v1 = __builtin_convertvector(__builtin_bit_cast(i32x4, v1), f32x4) * (cs[bj][1] * rs); }
                    if (sg) {
#pragma unroll
                        for (int e = 0; e < 4; ++e) { v0[e] = sigm(v0[e]); v1[e] = sigm(v1[e]); } }
                    *(u32x4*)(rowp + bj * HALF) = pack8(v0, v1); } }
    }
};
struct EpiMerge {
    static constexpr bool PERM = true, AFTER_DRAIN = false;
    const bf16_t *GA, *GC; bf16_t *T, *Mg;
    __device__ __forceinline__ void operator()(const f32x4 (&acc)[2][2][4][2], const Unit& u, int wr, int wc, int fr, int fq) const {
        const int which = u.pm >> 6, pm = u.pm & 63, pn = u.pn & 15;
        const bf16_t* G = which ? GC : GA;
        const int row0 = pm * BM + wr * 64 + fr, col0 = pn * BM + wc * 32 + 8 * fq;
#pragma unroll
        for (int ai = 0; ai < 2; ++ai)
#pragma unroll
            for (int m = 0; m < 4; ++m) { const size_t off = (size_t)(row0 + ai * HALF + m * 16) * 4096 + col0;
#pragma unroll
                for (int bj = 0; bj < 2; ++bj) { const size_t o = off + bj * HALF; f32x4 g0, g1; unpack8(*(const u32x4*)(G + o), g0, g1);
                    f32x4 v0 = acc[ai][bj][m][0] * g0, v1 = acc[ai][bj][m][1] * g1;
                    if (which == 0) { *(u32x4*)(T + o) = pack8(v0, v1); }
                    else { f32x4 t0, t1; unpack8(*(const u32x4*)(T + o), t0, t1); *(u32x4*)(Mg + o) = pack8(v0 + t0, v1 + t1); } } }
    }
};
struct EpiRes {
    static constexpr bool PERM = true, AFTER_DRAIN = false;
    const float* X; bf16_t* O;
    __device__ __forceinline__ void operator()(const f32x4 (&acc)[2][2][4][2], const Unit& u, int wr, int wc, int fr, int fq) const {
        const int row0 = u.pm * BM + wr * 64 + fr, col0 = u.pn * BM + wc * 32 + 8 * fq;
#pragma unroll
        for (int ai = 0; ai < 2; ++ai)
#pragma unroll
            for (int m = 0; m < 4; ++m) { const size_t off = (size_t)(row0 + ai * HALF + m * 16) * 4096 + col0;
#pragma unroll
                for (int bj = 0; bj < 2; ++bj) { const size_t o = off + bj * HALF; const f32x4 x0 = *(const f32x4*)(X + o), x1 = *(const f32x4*)(X + o + 4);
                    *(u32x4*)(O + o) = pack8(x0 + acc[ai][bj][m][0], x1 + acc[ai][bj][m][1]); } }
    }
};
struct EpiMergeA8 {
    static constexpr bool PERM = true, AFTER_DRAIN = false;
    const bf16_t* GA; bf16_t* T; const float *sx, *sw;
    __device__ __forceinline__ void operator()(const f32x4 (&acc)[2][2][4][2], const Unit& u, int wr, int wc, int fr, int fq) const {
        const int row0 = u.pm * BM + wr * 64 + fr, col0 = u.pn * BM + wc * 32 + 8 * fq;
        f32x4 cs[2][2];
#pragma unroll
        for (int bj = 0; bj < 2; ++bj)
#pragma unroll
            for (int n = 0; n < 2; ++n) cs[bj][n] = *(const f32x4*)(sw + col0 + bj * HALF + 4 * n);
        float rsv[2][4];
#pragma unroll
        for (int ai = 0; ai < 2; ++ai)
#pragma unroll
            for (int m = 0; m < 4; ++m) rsv[ai][m] = sx[row0 + ai * HALF + m * 16];
#pragma unroll
        for (int ai = 0; ai < 2; ++ai) {
            u32x4 gw[4][2];
#pragma unroll
            for (int m = 0; m < 4; ++m)
#pragma unroll
                for (int bj = 0; bj < 2; ++bj) gw[m][bj] = *(const u32x4*)(GA + (size_t)(row0 + ai * HALF + m * 16) * 4096 + col0 + bj * HALF);
            __builtin_amdgcn_sched_barrier(0);
#pragma unroll
            for (int m = 0; m < 4; ++m) { const float rs = rsv[ai][m];
#pragma unroll
                for (int bj = 0; bj < 2; ++bj) { const size_t o = (size_t)(row0 + ai * HALF + m * 16) * 4096 + col0 + bj * HALF; f32x4 g0, g1; unpack8(gw[m][bj], g0, g1);
                    *(u32x4*)(T + o) = pack8(__builtin_convertvector(__builtin_bit_cast(i32x4, acc[ai][bj][m][0]), f32x4) * (cs[bj][0] * rs) * g0, __builtin_convertvector(__builtin_bit_cast(i32x4, acc[ai][bj][m][1]), f32x4) * (cs[bj][1] * rs) * g1); } }
            __builtin_amdgcn_sched_barrier(0);
        }
    }
};
struct EpiMergeC {
    static constexpr bool PERM = true, AFTER_DRAIN = false;
    const bf16_t *GC, *T; bf16_t* Mg;
    __device__ __forceinline__ void operator()(const f32x4 (&acc)[2][2][4][2], const Unit& u, int wr, int wc, int fr, int fq) const {
        const int row0 = u.pm * BM + wr * 64 + fr, col0 = u.pn * BM + wc * 32 + 8 * fq;
#pragma unroll
        for (int ai = 0; ai < 2; ++ai)
#pragma unroll
            for (int mp = 0; mp < 2; ++mp) {
                u32x4 gw[2][2], tw[2][2];
#pragma unroll
                for (int mm = 0; mm < 2; ++mm)
#pragma unroll
                    for (int bj = 0; bj < 2; ++bj) { const size_t o = (size_t)(row0 + ai * HALF + (2 * mp + mm) * 16) * 4096 + col0 + bj * HALF; gw[mm][bj] = *(const u32x4*)(GC + o); tw[mm][bj] = *(const u32x4*)(T + o); }
                __builtin_amdgcn_sched_barrier(0);
#pragma unroll
                for (int mm = 0; mm < 2; ++mm) { const int m = 2 * mp + mm;
#pragma unroll
                    for (int bj = 0; bj < 2; ++bj) { const size_t o = (size_t)(row0 + ai * HALF + m * 16) * 4096 + col0 + bj * HALF; f32x4 g0, g1, t0, t1; unpack8(gw[mm][bj], g0, g1); unpack8(tw[mm][bj], t0, t1);
                        *(u32x4*)(Mg + o) = pack8(acc[ai][bj][m][0] * g0 + t0, acc[ai][bj][m][1] * g1 + t1); } }
                __builtin_amdgcn_sched_barrier(0);
            }
    }
};
struct EpiResI8 {
    static constexpr bool PERM = true, AFTER_DRAIN = false;
    const float* X; bf16_t* O; const float *sx, *sw;
    __device__ __forceinline__ void operator()(const f32x4 (&acc)[2][2][4][2], const Unit& u, int wr, int wc, int fr, int fq) const {
        const int row0 = u.pm * BM + wr * 64 + fr, col0 = u.pn * BM + wc * 32 + 8 * fq;
        f32x4 cs[2][2];
#pragma unroll
        for (int bj = 0; bj < 2; ++bj)
#pragma unroll
            for (int n = 0; n < 2; ++n) cs[bj][n] = *(const f32x4*)(sw + col0 + bj * HALF + 4 * n);
        float rsv[2][4];
#pragma unroll
        for (int ai = 0; ai < 2; ++ai)
#pragma unroll
            for (int m = 0; m < 4; ++m) rsv[ai][m] = sx[row0 + ai * HALF + m * 16];
#pragma unroll
        for (int ai = 0; ai < 2; ++ai)
#pragma unroll
            for (int mp = 0; mp < 2; ++mp) {
                f32x4 xv[2][2][2];
#pragma unroll
                for (int mm = 0; mm < 2; ++mm)
#pragma unroll
                    for (int bj = 0; bj < 2; ++bj) { const size_t o = (size_t)(row0 + ai * HALF + (2 * mp + mm) * 16) * 4096 + col0 + bj * HALF; xv[mm][bj][0] = *(const f32x4*)(X + o); xv[mm][bj][1] = *(const f32x4*)(X + o + 4); }
                __builtin_amdgcn_sched_barrier(0);
#pragma unroll
                for (int mm = 0; mm < 2; ++mm) { const int m = 2 * mp + mm; const float rs = rsv[ai][m];
#pragma unroll
                    for (int bj = 0; bj < 2; ++bj) { const size_t o = (size_t)(row0 + ai * HALF + m * 16) * 4096 + col0 + bj * HALF;
                        *(u32x4*)(O + o) = pack8(xv[mm][bj][0] + __builtin_convertvector(__builtin_bit_cast(i32x4, acc[ai][bj][m][0]), f32x4) * (cs[bj][0] * rs), xv[mm][bj][1] + __builtin_convertvector(__builtin_bit_cast(i32x4, acc[ai][bj][m][1]), f32x4) * (cs[bj][1] * rs)); } }
                __builtin_amdgcn_sched_barrier(0);
            }
    }
};
struct EpiStoreI8 {
    static constexpr bool PERM = true, AFTER_DRAIN = false;
    bf16_t* O; int ldc; const float *sx, *sw;
    __device__ __forceinline__ void operator()(const f32x4 (&acc)[2][2][4][2], const Unit& u, int wr, int wc, int fr, int fq) const {
        const int row0 = u.pm * BM + wr * 64 + fr, col0 = u.pn * BM + wc * 32 + 8 * fq;
        f32x4 cs[2][2];
#pragma unroll
        for (int bj = 0; bj < 2; ++bj)
#pragma unroll
            for (int n = 0; n < 2; ++n) cs[bj][n] = *(const f32x4*)(sw + col0 + bj * HALF + 4 * n);
        float rsv[2][4];
#pragma unroll
        for (int ai = 0; ai < 2; ++ai)
#pragma unroll
            for (int m = 0; m < 4; ++m) rsv[ai][m] = sx[row0 + ai * HALF + m * 16];
        __builtin_amdgcn_sched_barrier(0);
#pragma unroll
        for (int ai = 0; ai < 2; ++ai)
#pragma unroll
            for (int m = 0; m < 4; ++m) { const int row = row0 + ai * HALF + m * 16; bf16_t* rowp = O + (size_t)row * ldc + col0; const float rs = rsv[ai][m];
#pragma unroll
                for (int bj = 0; bj < 2; ++bj) *(u32x4*)(rowp + bj * HALF) = pack8(__builtin_convertvector(__builtin_bit_cast(i32x4, acc[ai][bj][m][0]), f32x4) * (cs[bj][0] * rs), __builtin_convertvector(__builtin_bit_cast(i32x4, acc[ai][bj][m][1]), f32x4) * (cs[bj][1] * rs)); }
    }
};
struct EpiStore {
    static constexpr bool PERM = true, AFTER_DRAIN = false;
    bf16_t* O; int ldc;
    __device__ __forceinline__ void operator()(const f32x4 (&acc)[2][2][4][2], const Unit& u, int wr, int wc, int fr, int fq) const {
        const int row0 = u.pm * BM + wr * 64 + fr, col0 = u.pn * BM + wc * 32 + 8 * fq;
#pragma unroll
        for (int ai = 0; ai < 2; ++ai)
#pragma unroll
            for (int m = 0; m < 4; ++m) { bf16_t* rowp = O + (size_t)(row0 + ai * HALF + m * 16) * ldc + col0;
#pragma unroll
                for (int bj = 0; bj < 2; ++bj) *(u32x4*)(rowp + bj * HALF) = pack8(acc[ai][bj][m][0], acc[ai][bj][m][1]); }
    }
};
struct PairOrder {
    StaticOrder so;
    __device__ bool next(int i, Unit& u) const { Unit t; if (!so.next(i >> 1, t)) return false; const int w = i & 1; u.pm = t.pm + 64 * w; u.pn = t.pn + 16 * w; return true; }
    __device__ __forceinline__ void a_ready(const Unit&) const {}
    __device__ __forceinline__ void done(const Unit&) const {}
};
struct RangeOrder {
    StaticOrder so; int base, cut, skip;
    __device__ bool next(int i, Unit& u) const { if (!so.next(i, u)) return false; u.pn = base + (u.pn < cut ? u.pn : u.pn + skip); return true; }
    __device__ __forceinline__ void a_ready(const Unit&) const {}
    __device__ __forceinline__ void done(const Unit&) const {}
};
template <class Epi, class Sched, bool ALIGN_EPI = false, bool SP2 = false, bool I8 = false>
__device__ __forceinline__ void gemm_phase(PG8_LAS unsigned char* lds, const Gemm g, const Sched& S, const Epi& E) {
    const int tid = threadIdx.x, wid = __builtin_amdgcn_readfirstlane(tid >> 6), lane = tid & 63, wr = wid >> 2, wc = wid & 3, fr = lane & 15, fq = lane >> 4;
    const int K = g.K, nt = K / BK;
    unsigned voffA[2], voffB[2];
#pragma unroll
    for (int i = 0; i < 2; ++i) { int R, C; stage_rc(tid * 16 + i * 8192, R, C); const int Rb = Epi::PERM ? ((R & ~31) + perm32(R & 31)) : R;
        voffA[i] = (unsigned)(R * K + C) * 2u; voffB[i] = (unsigned)(Rb * K + C) * 2u; }
    const size_t kstep = (size_t)(BK * 2);
    const size_t hstep = (size_t)HALF * K * 2;
    const size_t tstep = 2 * hstep;
    const unsigned ldsw = (unsigned)wid * 1024u;
    const int aoff = lds_byte(wr * 64 + fr, fq * 8), boff = lds_byte(wc * 32 + fr, fq * 8);
#define PG8_SA(b, h) (((b) * 2 + (h)) * HTB)
#define PG8_SB(b, h) ((4 + (b) * 2 + (h)) * HTB)
#define PG8_STAGE(bufoff, gbase, voff) do { _Pragma("unroll") for (int _i = 0; _i < 2; ++_i) \
        __builtin_amdgcn_global_load_lds((const unsigned*)((const char*)(gbase) + (voff)[_i]), (PG8_LAS unsigned*)(lds + (bufoff) + ldsw + _i * 8192), 16, 0, 0); } while (0)
#define PG8_LDA(dst, b, h) do { _Pragma("unroll") for (int m = 0; m < 4; ++m) _Pragma("unroll") for (int k = 0; k < 2; ++k) dst[m][k] = *(const PG8_LAS bf16x8*)(lds + PG8_SA(b, h) + aoff + m * 2048 + k * 1024); } while (0)
#define PG8_LDB(dst, b, h) do { _Pragma("unroll") for (int n = 0; n < 2; ++n) _Pragma("unroll") for (int k = 0; k < 2; ++k) dst[n][k] = *(const PG8_LAS bf16x8*)(lds + PG8_SB(b, h) + boff + n * 2048 + k * 1024); } while (0)
#define PG8_MMA(ai, bj, At, Bt) do { __builtin_amdgcn_s_setprio(1); _Pragma("unroll") for (int m = 0; m < 4; ++m) _Pragma("unroll") for (int n = 0; n < 2; ++n) _Pragma("unroll") for (int k = 0; k < 2; ++k) \
        { if constexpr (I8) acc[ai][bj][m][n] = __builtin_bit_cast(f32x4, __builtin_amdgcn_mfma_i32_16x16x64_i8(__builtin_bit_cast(i32x4, Bt[n][k]), __builtin_bit_cast(i32x4, At[m][k]), __builtin_bit_cast(i32x4, acc[ai][bj][m][n]), 0, 0, 0)); \
          else acc[ai][bj][m][n] = __builtin_amdgcn_mfma_f32_16x16x32_bf16(Bt[n][k], At[m][k], acc[ai][bj][m][n], 0, 0, 0); } __builtin_amdgcn_s_setprio(0); } while (0)
#define PG8_WAIT_V(n) asm volatile("s_waitcnt vmcnt(" #n ")" ::: "memory")
#define PG8_WAIT_L(n) asm volatile("s_waitcnt lgkmcnt(" #n ")" ::: "memory")
#define PG8_BAR __builtin_amdgcn_s_barrier()
#define PG8_SCHED __builtin_amdgcn_sched_barrier(0)
    Unit cur, nxt; int ui = 0;
    if (!S.next(0, cur)) return;
    f32x4 acc[2][2][4][2];
#pragma unroll
    for (int a = 0; a < 2; ++a)
#pragma unroll
        for (int b = 0; b < 2; ++b)
#pragma unroll
            for (int m = 0; m < 4; ++m)
#pragma unroll
                for (int n = 0; n < 2; ++n) acc[a][b][m][n] = (f32x4){0.f, 0.f, 0.f, 0.f};
    bf16x8 At[4][2], B0[2][2], B1[2][2];
    const char* cA = (const char*)g.A + (size_t)cur.pm * tstep; const char* cB = (const char*)g.Bt + (size_t)cur.pn * tstep;
    S.a_ready(cur);
    if constexpr (SP2) {
        PG8_STAGE(PG8_SB(0, 0), cB, voffB); PG8_STAGE(PG8_SB(0, 1), cB + hstep, voffB); PG8_STAGE(PG8_SA(0, 0), cA, voffA); PG8_STAGE(PG8_SA(0, 1), cA + hstep, voffA);
        if (wr == 1) PG8_BAR;
        PG8_WAIT_V(2); PG8_BAR;
        PG8_STAGE(PG8_SB(1, 0), cB + kstep, voffB); PG8_STAGE(PG8_SA(1, 0), cA + kstep, voffA); PG8_STAGE(PG8_SB(1, 1), cB + hstep + kstep, voffB);
        PG8_WAIT_V(6); PG8_BAR;
    } else {
        PG8_STAGE(PG8_SB(0, 0), cB, voffB); PG8_STAGE(PG8_SA(0, 0), cA, voffA); PG8_STAGE(PG8_SB(0, 1), cB + hstep, voffB); PG8_STAGE(PG8_SA(0, 1), cA + hstep, voffA);
        if (wr == 1) PG8_BAR;
        PG8_WAIT_V(4); PG8_BAR;
        PG8_STAGE(PG8_SB(1, 0), cB + kstep, voffB); PG8_STAGE(PG8_SA(1, 0), cA + kstep, voffA); PG8_STAGE(PG8_SB(1, 1), cB + hstep + kstep, voffB);
        PG8_WAIT_V(6); PG8_BAR;
    }
    for (;;) {
        const bool has_next = S.next(ui + 1, nxt);
        const char* nA = has_next ? (const char*)g.A + (size_t)nxt.pm * tstep : cA; const char* nB = has_next ? (const char*)g.Bt + (size_t)nxt.pn * tstep : cB;
        for (int t = 0; t < nt; t += 2) {
            const bool last = (t == nt - 2);
            const char* a1 = cA + (size_t)(t + 1) * kstep;
            const char* a2 = last ? nA : cA + (size_t)(t + 2) * kstep; const char* b2 = last ? nB : cB + (size_t)(t + 2) * kstep;
            const char* a3 = a2 + kstep; const char* b3 = b2 + kstep;
            if (last && has_next) S.a_ready(nxt);
            if constexpr (SP2) {
            PG8_LDB(B0, 0, 0); PG8_LDB(B1, 0, 1); PG8_SCHED; PG8_LDA(At, 0, 0); PG8_STAGE(PG8_SA(1, 1), a1 + hstep, voffA);
            PG8_WAIT_V(8); PG8_WAIT_L(0); PG8_BAR; PG8_MMA(0, 0, At, B0); PG8_MMA(0, 1, At, B1); PG8_BAR; PG8_SCHED;
            PG8_LDA(At, 0, 1); PG8_STAGE(PG8_SB(0, 0), b2, voffB); PG8_STAGE(PG8_SB(0, 1), b2 + hstep, voffB); PG8_STAGE(PG8_SA(0, 0), a2, voffA);
            PG8_WAIT_V(8); PG8_WAIT_L(0); PG8_BAR; PG8_MMA(1, 0, At, B0); PG8_MMA(1, 1, At, B1); PG8_BAR; PG8_SCHED;
            PG8_LDB(B0, 1, 0); PG8_LDB(B1, 1, 1); PG8_SCHED; PG8_LDA(At, 1, 0); PG8_STAGE(PG8_SA(0, 1), a2 + hstep, voffA);
            PG8_WAIT_V(8); PG8_WAIT_L(0); PG8_BAR; PG8_MMA(0, 0, At, B0); PG8_MMA(0, 1, At, B1); PG8_BAR; PG8_SCHED;
            PG8_LDA(At, 1, 1); PG8_STAGE(PG8_SB(1, 0), b3, voffB); PG8_STAGE(PG8_SB(1, 1), b3 + hstep, voffB); PG8_STAGE(PG8_SA(1, 0), a3, voffA);
            PG8_WAIT_V(8); PG8_WAIT_L(0); PG8_BAR; PG8_MMA(1, 0, At, B0); PG8_MMA(1, 1, At, B1); PG8_BAR; PG8_SCHED;
            } else {
            PG8_LDB(B0, 0, 0); PG8_SCHED; PG8_LDA(At, 0, 0); PG8_STAGE(PG8_SA(1, 1), a1 + hstep, voffA);
            PG8_WAIT_L(8); PG8_BAR; PG8_WAIT_L(0); PG8_MMA(0, 0, At, B0); PG8_BAR; PG8_SCHED;
            PG8_LDB(B1, 0, 1); PG8_STAGE(PG8_SB(0, 0), b2, voffB);
            PG8_BAR; PG8_WAIT_L(0); PG8_MMA(0, 1, At, B1); PG8_BAR;
            PG8_LDA(At, 0, 1); PG8_STAGE(PG8_SA(0, 0), a2, voffA);
            PG8_BAR; PG8_WAIT_L(0); PG8_MMA(1, 0, At, B0); PG8_BAR; PG8_SCHED;
            PG8_STAGE(PG8_SB(0, 1), b2 + hstep, voffB);
            PG8_WAIT_V(6); PG8_BAR; PG8_MMA(1, 1, At, B1); PG8_BAR;
            PG8_LDB(B0, 1, 0); PG8_SCHED; PG8_LDA(At, 1, 0); PG8_STAGE(PG8_SA(0, 1), a2 + hstep, voffA);
            PG8_WAIT_L(8); PG8_BAR; PG8_WAIT_L(0); PG8_MMA(0, 0, At, B0); PG8_BAR; PG8_SCHED;
            PG8_LDB(B1, 1, 1); PG8_STAGE(PG8_SB(1, 0), b3, voffB);
            PG8_BAR; PG8_WAIT_L(0); PG8_MMA(0, 1, At, B1); PG8_BAR;
            PG8_LDA(At, 1, 1); PG8_STAGE(PG8_SA(1, 0), a3, voffA);
            PG8_BAR; PG8_WAIT_L(0); PG8_MMA(1, 0, At, B0); PG8_BAR; PG8_SCHED;
            PG8_STAGE(PG8_SB(1, 1), b3 + hstep, voffB);
            PG8_WAIT_V(6); PG8_BAR; PG8_MMA(1, 1, At, B1); PG8_BAR;
            }
        }
        if constexpr (ALIGN_EPI) { if (wr == 0) PG8_BAR; }
        if constexpr (!Epi::AFTER_DRAIN) { E(acc, cur, wr, wc, fr, fq); S.done(cur); }
        if (!has_next) break;
#pragma unroll
        for (int a = 0; a < 2; ++a)
#pragma unroll
            for (int b = 0; b < 2; ++b)
#pragma unroll
                for (int m = 0; m < 4; ++m)
#pragma unroll
                    for (int n = 0; n < 2; ++n) acc[a][b][m][n] = (f32x4){0.f, 0.f, 0.f, 0.f};
        cur = nxt; cA = nA; cB = nB; ++ui;
        if constexpr (ALIGN_EPI) { if (wr == 1) PG8_BAR; }
    }
    PG8_WAIT_V(0);
    if constexpr (!ALIGN_EPI) { if (wr == 0) PG8_BAR; }
    PG8_BAR;
    if constexpr (Epi::AFTER_DRAIN) { E.fused(acc, cur, wr, wc, fr, fq, lds, wid, lane); S.done(cur); }
#undef PG8_SA
#undef PG8_SB
#undef PG8_STAGE
#undef PG8_LDA
#undef PG8_LDB
#undef PG8_MMA
#undef PG8_WAIT_V
#undef PG8_WAIT_L
#undef PG8_BAR
#undef PG8_SCHED
}
}
#ifndef PG8_SP2
#define PG8_SP2 true
#endif
#ifndef PG8_ALIGN
#define PG8_ALIGN true
#endif
constexpr int NWAVES = 8;
#ifndef MK_ONE_LAUNCH
#define MK_ONE_LAUNCH 1
#endif
constexpr int N_PHASES = 12;
#ifndef NIBBLE_SWAP_DOWN
#define NIBBLE_SWAP_DOWN 0
#endif
#ifndef I8_CFG
#define I8_CFG 1
#endif
#ifndef P4A_I8
#define P4A_I8 1
#endif
#ifndef P5_I8
#define P5_I8 1
#endif
#if I8_CFG == 0
constexpr int I8_TILES = 44, I8_CUT = 12, I8_SKIP = 24, BF_BASE = 12, BF_TILES = 24;
#elif I8_CFG == 1
constexpr int I8_TILES = 60, I8_CUT = 12, I8_SKIP = 8, BF_BASE = 12, BF_TILES = 8;
#else
constexpr int I8_TILES = 68, I8_CUT = 68, I8_SKIP = 0, BF_BASE = 12, BF_TILES = 0;
#endif

constexpr int BATCH = 4, SEQ = 4096, D = 4096, M = BATCH * SEQ;
constexpr int HD = 128, NH = 16, NKV = 4, QW = NH * HD, KVW = NKV * HD, CW = 2048, INW = 17408;
constexpr int PH = 8, NKEYS = 128, TOPK = 16, NEXP = NKEYS * NKEYS, PQW = PH * 2 * 128;
constexpr float EPS = 1e-6f;
constexpr size_t SLICE_BYTES = (size_t)NEXP * 128;
constexpr float LOG2E = 1.4426950408889634f;

constexpr size_t MiB = 1u << 20;
constexpr size_t WS_CTL = 0, CTL_ZERO_BYTES = 1 * MiB;
constexpr size_t WS_WIN = 2 * MiB;
constexpr size_t WS_WO = 138 * MiB;
constexpr size_t WS_WOUT = 170 * MiB;
constexpr size_t WS_WQP = 202 * MiB;
constexpr size_t WS_SK = 218 * MiB;
constexpr size_t WS_IDX = 220 * MiB, WS_GATE = 228 * MiB;
constexpr size_t WS_XN = 236 * MiB;
constexpr size_t WS_AB = 364 * MiB;
constexpr size_t WS_Q = 492 * MiB, WS_K = 556 * MiB, WS_V = 572 * MiB, WS_H = 588 * MiB, WS_B = 652 * MiB, WS_C = 716 * MiB;
constexpr size_t WS_GA = 780 * MiB, WS_GC = 908 * MiB;
constexpr size_t WS_T = 492 * MiB;
constexpr size_t WS_X1B = 620 * MiB;
constexpr size_t WS_X2N = 620 * MiB;
constexpr size_t WS_PART = 236 * MiB;
constexpr size_t WS_X2N8 = 492 * MiB;
constexpr size_t WS_CF4 = 780 * MiB;
constexpr size_t WS_QP = 780 * MiB;
constexpr size_t WS_W4D = 1036 * MiB, WS_W4U = 1068 * MiB;
constexpr size_t WS_SCD = 1100 * MiB, WS_SCU = WS_SCD + 65536;
constexpr size_t WS_SX = WS_SCD + 131072, WS_SW = WS_SCD + 262144;
constexpr size_t WS_XN8 = 364 * MiB;
constexpr size_t WS_W8 = 1101 * MiB;
constexpr size_t WS_W8QP = 1169 * MiB;
constexpr size_t WS_SWQ = WS_SCD + 393216, WS_SX2 = WS_SCD + 458752;
constexpr size_t WS_X2I8 = 364 * MiB;
constexpr size_t WS_W8OUT = 1177 * MiB;
constexpr size_t WS_SWO = WS_SCD + 524288, WS_SXM = WS_SCD + 589824;
constexpr size_t WS_MI8 = 364 * MiB;
constexpr size_t WS_W8OA = 1193 * MiB;
constexpr size_t WS_SWA = WS_SCD + 655360, WS_SXA = WS_SCD + 671744;
constexpr size_t WS_AI8 = 748 * MiB;
constexpr size_t WS_END = 1201 * MiB;
static_assert(WS_T + (size_t)M * D * 2 <= WS_X2N && WS_X2N + (size_t)M * D * 2 <= WS_GA && WS_QP + (size_t)M * PQW * 2 <= WS_GC, "d_ws overlays");
static_assert(WS_WIN + (size_t)INW * D * 2 <= WS_WO && WS_C + (size_t)M * CW * 2 <= WS_GA && WS_GC + (size_t)M * D * 2 <= WS_END, "d_ws map");
constexpr int CW_XRANK = 8192;
constexpr int CW_BAR = 4096;

constexpr int RING_OFF = 0, RING_BYTES = 131072;
constexpr int LDSCTL_OFF = RING_BYTES, MISC_OFF = LDSCTL_OFF + 320;
constexpr int OBUF_OFF = 132096;
constexpr int ODUMP_OFF = OBUF_OFF + 8192;
constexpr int LDS_BYTES = 147456;
static_assert(MISC_OFF + 128 <= OBUF_OFF && ODUMP_OFF + 2048 <= LDS_BYTES, "LDS map");
#define GAS __attribute__((address_space(1)))
#define LAS __attribute__((address_space(3)))
typedef unsigned short bf16;
typedef unsigned v4u __attribute__((ext_vector_type(4)));
typedef float f32x4 __attribute__((ext_vector_type(4)));
typedef short bf16x8 __attribute__((ext_vector_type(8)));
typedef GAS unsigned gu32;
typedef GAS unsigned long long gu64;
#define RLX_AGENT __ATOMIC_RELAXED, __HIP_MEMORY_SCOPE_AGENT
#define LDS_WAIT() asm volatile("s_waitcnt lgkmcnt(0)" ::: "memory")
#define VM_WAIT() asm volatile("s_waitcnt vmcnt(0)" ::: "memory")
__device__ __forceinline__ unsigned long long rt() { return __builtin_amdgcn_s_memrealtime(); }
__device__ __forceinline__ unsigned f2bf(float f) { unsigned u = __builtin_bit_cast(unsigned, f); return (u + 0x7fffu + ((u >> 16) & 1u)) >> 16; }
__device__ __forceinline__ unsigned pk2(float lo, float hi) { return f2bf(lo) | (f2bf(hi) << 16); }

#define XB_TMO      128
#define XB_XCNT(j)  (256  + 64 * (j))
#define XB_XSUB(j)  (1280 + 64 * (j))
#define XB_XGEN(j)  (2304 + 64 * (j))
#define XB_TOP      3328
#define XB_TOPGEN   3392
#define XCD_BAR_WORDS 3456
#define XB_SPIN_CAP (1u << 18)

__device__ __forceinline__ unsigned xb_ld(unsigned* p)              { return __hip_atomic_load(p, __ATOMIC_RELAXED, __HIP_MEMORY_SCOPE_AGENT); }
__device__ __forceinline__ unsigned xb_add(unsigned* p, unsigned v) { return __hip_atomic_fetch_add(p, v, __ATOMIC_RELAXED, __HIP_MEMORY_SCOPE_AGENT); }
__device__ __forceinline__ unsigned xb_xcc_id() { return (unsigned)__builtin_amdgcn_s_getreg((3 << 11) | 20) & 0xFu; }
#define XB_SPIN(cond, bar) do { unsigned _sp = 0; while (cond) { __builtin_amdgcn_s_sleep(1); \
    if ((++_sp & 255u) == 0u) { if (xb_ld(&(bar)[XB_TMO])) break; if (_sp > XB_SPIN_CAP) { atomicAdd(&(bar)[XB_TMO], 1u); break; } } } } while (0)

struct XcdBarrier {
    unsigned* bar; unsigned x;
    volatile LAS unsigned* st;
};

__device__ __forceinline__ XcdBarrier xcd_barrier_post(unsigned* bar, volatile LAS unsigned* st) {
    XcdBarrier b; b.bar = bar; b.x = xb_xcc_id(); b.st = st;
    if (threadIdx.x == 0) (void)xb_add(&bar[XB_XCNT(b.x)], 1u);
    return b;
}
__device__ __forceinline__ void xcd_barrier_complete(unsigned* bar, unsigned x, unsigned& nloc, unsigned& nx) {
    const unsigned G = gridDim.x * gridDim.y * gridDim.z;
    unsigned sum, cnt, mine, sp = 0u;
    for (;;) {
        sum = 0u; cnt = 0u; mine = 0u;
#pragma unroll
        for (unsigned j = 0; j < 16; ++j) { const unsigned c = xb_ld(&bar[XB_XCNT(j)]); sum += c; cnt += (c > 0u) ? 1u : 0u; mine = (j == x) ? c : mine; }
        if (sum == G) break;
        __builtin_amdgcn_s_sleep(1);
        if ((++sp & 255u) == 0u) { if (xb_ld(&bar[XB_TMO])) break; if (sp > XB_SPIN_CAP) { atomicAdd(&bar[XB_TMO], 1u); break; } }
    }
    nloc = mine > 0u ? mine : 1u; nx = cnt > 0u ? cnt : 1u;
}

__device__ __forceinline__ void xcd_barrier(const XcdBarrier& b) {
    asm volatile("s_waitcnt vmcnt(0)" ::: "memory");
    __syncthreads();
    if (threadIdx.x == 0) {
        unsigned* bar = b.bar;
        __builtin_amdgcn_s_waitcnt(0);
        unsigned nloc = b.st[0], nx = b.st[1];
        if (nloc == 0u) { xcd_barrier_complete(bar, b.x, nloc, nx); b.st[0] = nloc; b.st[1] = nx; }
        const unsigned old = xb_add(&bar[XB_XSUB(b.x)], 1u);
        const unsigned gen = old / nloc;
        if (old + 1u == (gen + 1u) * nloc) {
            __builtin_amdgcn_fence(__ATOMIC_RELEASE, "agent");
            asm volatile("s_waitcnt vmcnt(0)" ::: "memory");
            const unsigned og = xb_add(&bar[XB_TOP], 1u);
            const unsigned tg = og / nx;
            if (og + 1u == (tg + 1u) * nx) xb_add(&bar[XB_TOPGEN], 1u);
            else XB_SPIN(xb_ld(&bar[XB_TOPGEN]) == tg, bar);
            __builtin_amdgcn_fence(__ATOMIC_ACQUIRE, "agent");
            xb_add(&bar[XB_XGEN(b.x)], 1u);
            asm volatile("s_waitcnt vmcnt(0)" ::: "memory");
        } else {
            XB_SPIN(xb_ld(&bar[XB_XGEN(b.x)]) == gen, bar);
            __builtin_amdgcn_fence(__ATOMIC_ACQUIRE, "agent");
            asm volatile("s_waitcnt vmcnt(0)" ::: "memory");
        }
    }
    __syncthreads();
}
typedef unsigned u32x2_t __attribute__((ext_vector_type(2)));
typedef short v4i16_t __attribute__((ext_vector_type(4)));
typedef unsigned long long u64;
typedef float f32x2_t __attribute__((ext_vector_type(2)));
typedef int i32x4_t __attribute__((ext_vector_type(4)));
struct Frame {
    LAS unsigned char* lds;
    volatile LAS unsigned* MISC;
    gu32* ctl;
    unsigned char* ws;
    int tid, lane, wave;
    int vcu, G;
    const float *x, *g1, *w_in, *gq, *gk, *sink, *conv_w, *w_oa, *w_oc, *w_out, *g2, *w_qp, *subk, *w_down, *w_up;
    float* out;
};
#define WSP(type, off) ((type*)(F.ws + (off)))
using pg8::cvt_pk_bf16; using pg8::pack8; using pg8::unpack8;

__device__ __forceinline__ float wave_sum(float v) {
#pragma unroll
    for (int o = 1; o < 64; o <<= 1) v += __shfl_xor(v, o);
    return v;
}
__device__ __forceinline__ float dot4(const f32x4 a, const f32x4 b) { return (a[0] * b[0] + a[1] * b[1]) + (a[2] * b[2] + a[3] * b[3]); }
__device__ __forceinline__ float bflo(unsigned w) { return __uint_as_float(w << 16); }
__device__ __forceinline__ float bfhi(unsigned w) { return __uint_as_float(w & 0xffff0000u); }

typedef int v2i32_t __attribute__((ext_vector_type(2)));
__device__ __forceinline__ bool tr4_selfcheck(LAS unsigned char* tp, int lane) {
    const int g = lane >> 4, j = lane & 15;
    unsigned lo = 0u, hi = 0u;
#pragma unroll
    for (int c = 0; c < 8; ++c) { lo |= (unsigned)((j * 5 + c * 3 + g + 1) & 15) << (4 * c); hi |= (unsigned)((j * 5 + (c + 8) * 3 + g + 1) & 15) << (4 * c); }
    *(LAS u32x2_t*)(tp + lane * 8) = (u32x2_t){lo, hi};
    LDS_WAIT(); asm volatile("" ::: "memory");
    const v2i32_t rv = __builtin_amdgcn_ds_read_tr4_b64_v2i32((LAS v2i32_t*)(tp + lane * 8));
    bool ok = true;
#pragma unroll
    for (int e = 0; e < 8; ++e) { ok = ok && ((((unsigned)rv.x >> (4 * e)) & 15u) == (unsigned)((e * 5 + j * 3 + g + 1) & 15)) && ((((unsigned)rv.y >> (4 * e)) & 15u) == (unsigned)(((e + 8) * 5 + j * 3 + g + 1) & 15)); }
    return __all(ok);
}

__device__ __forceinline__ void p0_transpose_item(const float* W, int K, int N, bf16* WT, int row_off, LAS float* scr, int item, int lane) {
    const int nblk = N / 32, kb = item / nblk, nb = item % nblk, k0 = 64 * kb, n0 = 32 * nb;
#pragma unroll 8
    for (int i = 0; i < 32; ++i) { const int kk = 2 * i + (lane >> 5); scr[kk * 33 + (lane & 31)] = W[(size_t)(k0 + kk) * N + n0 + (lane & 31)]; }
    LDS_WAIT(); asm volatile("" ::: "memory");
    const int c = lane & 7;
#pragma unroll
    for (int j = 0; j < 4; ++j) { const int n = (lane >> 3) + 8 * j; const LAS float* s = scr + (8 * c) * 33 + n;
        v4u o; o.x = cvt_pk_bf16(s[0 * 33], s[1 * 33]); o.y = cvt_pk_bf16(s[2 * 33], s[3 * 33]); o.z = cvt_pk_bf16(s[4 * 33], s[5 * 33]); o.w = cvt_pk_bf16(s[6 * 33], s[7 * 33]);
        *(GAS v4u*)(WT + (size_t)(row_off + n0 + n) * K + k0 + 8 * c) = o; }
    LDS_WAIT(); asm volatile("" ::: "memory");
}
template <int QMODE  > __device__ __forceinline__ void rms_row_to_bf16(const float* xrow, const float* g, bf16* orow, unsigned* q8row, float* sxp, int lane) {
    const GAS f32x4* xr = (const GAS f32x4*)xrow + lane; const GAS f32x4* gr = (const GAS f32x4*)g + lane;
    f32x4 v[16]; float s = 0.f;
#pragma unroll
    for (int j = 0; j < 16; ++j) { v[j] = xr[64 * j]; s += dot4(v[j], v[j]); }
    const float r = rsqrtf(wave_sum(s) * (1.f / D) + EPS);
    GAS u32x2_t* o8 = (GAS u32x2_t*)orow + lane; float am = 0.f;
#pragma unroll
    for (int j = 0; j < 16; ++j) { v[j] = v[j] * r * gr[64 * j]; u32x2_t w; w.x = cvt_pk_bf16(v[j][0], v[j][1]); w.y = cvt_pk_bf16(v[j][2], v[j][3]); o8[64 * j] = w;
        am = fmaxf(am, fmaxf(fmaxf(fabsf(v[j][0]), fabsf(v[j][1])), fmaxf(fabsf(v[j][2]), fabsf(v[j][3])))); }
    if constexpr (QMODE == 2) {
#pragma unroll
        for (int j = 0; j < 16; ++j) { int p = 0; p = __builtin_amdgcn_cvt_pk_fp8_f32(v[j][0], v[j][1], p, false); p = __builtin_amdgcn_cvt_pk_fp8_f32(v[j][2], v[j][3], p, true); ((GAS unsigned*)q8row)[64 * j + lane] = (unsigned)p; }
    }
    if constexpr (QMODE == 1) {
#pragma unroll
        for (int o = 1; o < 64; o <<= 1) am = fmaxf(am, __shfl_xor(am, o));
        const float qs = am > 0.f ? 127.0f / am : 0.f;
#pragma unroll
        for (int j = 0; j < 16; ++j) { const int q0 = (int)__builtin_rintf(v[j][0] * qs), q1 = (int)__builtin_rintf(v[j][1] * qs), q2 = (int)__builtin_rintf(v[j][2] * qs), q3 = (int)__builtin_rintf(v[j][3] * qs);
            ((GAS unsigned*)q8row)[64 * j + lane] = (unsigned)(q0 & 255) | ((unsigned)(q1 & 255) << 8) | ((unsigned)(q2 & 255) << 16) | ((unsigned)q3 << 24); }
        if (lane == 0) *sxp = am * (1.0f / 127.0f);
    }
}
__device__ __forceinline__ void rms2_row(const bf16* xrow, const float* g, unsigned char* q8row, float* sxp, unsigned char* x4row, int lane) {
    const GAS v4u* xr = (const GAS v4u*)xrow + lane; const GAS f32x4* gr = (const GAS f32x4*)g + 2 * lane;
    f32x4 v[8][2]; float s = 0.f;
#pragma unroll
    for (int j = 0; j < 8; ++j) { unpack8(xr[64 * j], v[j][0], v[j][1]); s += dot4(v[j][0], v[j][0]) + dot4(v[j][1], v[j][1]); }
    const float r = rsqrtf(wave_sum(s) * (1.f / D) + EPS);
    float am = 0.f;
#pragma unroll
    for (int j = 0; j < 8; ++j) { v[j][0] = v[j][0] * r * gr[128 * j]; v[j][1] = v[j][1] * r * gr[128 * j + 1];
#pragma unroll
        for (int e = 0; e < 4; ++e) am = fmaxf(am, fmaxf(fabsf(v[j][0][e]), fabsf(v[j][1][e]))); }
#pragma unroll
    for (int o = 1; o < 64; o <<= 1) am = fmaxf(am, __shfl_xor(am, o));
    const float qs = am > 0.f ? 127.0f / am : 0.f;
    if (lane == 0) *sxp = am * (1.0f / 127.0f);
#pragma unroll
    for (int j = 0; j < 8; ++j) {
        const f32x4 y0 = v[j][0], y1 = v[j][1];
        { u32x2_t w;
          w.x = (unsigned)((int)__builtin_rintf(y0[0] * qs) & 255) | ((unsigned)((int)__builtin_rintf(y0[1] * qs) & 255) << 8) | ((unsigned)((int)__builtin_rintf(y0[2] * qs) & 255) << 16) | ((unsigned)(int)__builtin_rintf(y0[3] * qs) << 24);
          w.y = (unsigned)((int)__builtin_rintf(y1[0] * qs) & 255) | ((unsigned)((int)__builtin_rintf(y1[1] * qs) & 255) << 8) | ((unsigned)((int)__builtin_rintf(y1[2] * qs) & 255) << 16) | ((unsigned)(int)__builtin_rintf(y1[3] * qs) << 24);
          ((GAS u32x2_t*)q8row)[64 * j + lane] = w; }
        unsigned hi = 0u, lo = 0u;
        hi = __builtin_amdgcn_cvt_scalef32_pk_fp4_f32(hi, y0[0], y0[1], 1.0f, 0); hi = __builtin_amdgcn_cvt_scalef32_pk_fp4_f32(hi, y0[2], y0[3], 1.0f, 1);
        hi = __builtin_amdgcn_cvt_scalef32_pk_fp4_f32(hi, y1[0], y1[1], 1.0f, 2); hi = __builtin_amdgcn_cvt_scalef32_pk_fp4_f32(hi, y1[2], y1[3], 1.0f, 3);
        const f32x2_t d0 = __builtin_amdgcn_cvt_scalef32_pk_f32_fp4(hi, 1.0f, 0), d1 = __builtin_amdgcn_cvt_scalef32_pk_f32_fp4(hi, 1.0f, 1), d2 = __builtin_amdgcn_cvt_scalef32_pk_f32_fp4(hi, 1.0f, 2), d3 = __builtin_amdgcn_cvt_scalef32_pk_f32_fp4(hi, 1.0f, 3);
        lo = __builtin_amdgcn_cvt_scalef32_pk_fp4_f32(lo, (y0[0] - d0.x) * 8.f, (y0[1] - d0.y) * 8.f, 1.0f, 0); lo = __builtin_amdgcn_cvt_scalef32_pk_fp4_f32(lo, (y0[2] - d1.x) * 8.f, (y0[3] - d1.y) * 8.f, 1.0f, 1);
        lo = __builtin_amdgcn_cvt_scalef32_pk_fp4_f32(lo, (y1[0] - d2.x) * 8.f, (y1[1] - d2.y) * 8.f, 1.0f, 2); lo = __builtin_amdgcn_cvt_scalef32_pk_fp4_f32(lo, (y1[2] - d3.x) * 8.f, (y1[3] - d3.y) * 8.f, 1.0f, 3);
        unsigned char* const xd = x4row + (size_t)(2 * j + (lane >> 5)) * ((size_t)M * 256) + (lane & 31) * 4;
        *(GAS unsigned*)xd = hi; *(GAS unsigned*)(xd + 128) = lo;
    }
}
__device__ __forceinline__ void quant_w8(Frame& F) {
    const int gw = F.vcu * NWAVES + F.wave, NGW = F.G * NWAVES, lane = F.lane;
    for (int nn = gw; nn < INW + PQW + (P5_I8 ? D : 0); nn += NGW) {
        const int seg = nn >= INW + PQW ? 2 : nn >= INW ? 1 : 0; const bool qp = seg != 0; const int n = seg == 2 ? nn - INW - PQW : seg == 1 ? nn - INW : nn;
        if (!qp && n >= BF_BASE * 256 && n < (BF_BASE + BF_TILES) * 256) continue;
        const GAS v4u* src = (const GAS v4u*)((seg == 2 ? WSP(const bf16, WS_WOUT) : seg == 1 ? WSP(const bf16, WS_WQP) : WSP(const bf16, WS_WIN)) + (size_t)n * D) + lane;
        f32x4 lo[8], hi[8]; float am = 0.f;
#pragma unroll
        for (int j = 0; j < 8; ++j) { unpack8(src[64 * j], lo[j], hi[j]);
            am = fmaxf(am, fmaxf(fmaxf(fmaxf(fabsf(lo[j][0]), fabsf(lo[j][1])), fmaxf(fabsf(lo[j][2]), fabsf(lo[j][3]))), fmaxf(fmaxf(fabsf(hi[j][0]), fabsf(hi[j][1])), fmaxf(fabsf(hi[j][2]), fabsf(hi[j][3]))))); }
#pragma unroll
        for (int o = 1; o < 64; o <<= 1) am = fmaxf(am, __shfl_xor(am, o));
        const float qs = am > 0.f ? 127.0f / am : 0.f;
        GAS u32x2_t* dst = (GAS u32x2_t*)(F.ws + (seg == 2 ? WS_W8OUT : seg == 1 ? WS_W8QP : WS_W8) + (size_t)n * D) + lane;
#pragma unroll
        for (int j = 0; j < 8; ++j) { u32x2_t w;
            w.x = (unsigned)((int)__builtin_rintf(lo[j][0] * qs) & 255) | ((unsigned)((int)__builtin_rintf(lo[j][1] * qs) & 255) << 8) | ((unsigned)((int)__builtin_rintf(lo[j][2] * qs) & 255) << 16) | ((unsigned)(int)__builtin_rintf(lo[j][3] * qs) << 24);
            w.y = (unsigned)((int)__builtin_rintf(hi[j][0] * qs) & 255) | ((unsigned)((int)__builtin_rintf(hi[j][1] * qs) & 255) << 8) | ((unsigned)((int)__builtin_rintf(hi[j][2] * qs) & 255) << 16) | ((unsigned)(int)__builtin_rintf(hi[j][3] * qs) << 24);
            dst[64 * j] = w; }
        if (lane == 0) (seg == 2 ? WSP(float, WS_SWO) : seg == 1 ? WSP(float, WS_SWQ) : WSP(float, WS_SW))[n] = am * (1.0f / 127.0f);
    }
}
template <int NJ  > __device__ __forceinline__ void quant_row_i8(const bf16* xrow, unsigned char* q8row, float* sxp, int lane) {
    const GAS v4u* xr = (const GAS v4u*)xrow + lane;
    v4u w[NJ]; f32x4 v[NJ][2]; float am = 0.f;
#pragma unroll
    for (int j = 0; j < NJ; ++j) w[j] = xr[64 * j];
#pragma unroll
    for (int j = 0; j < NJ; ++j) { unpack8(w[j], v[j][0], v[j][1]);
#pragma unroll
        for (int e = 0; e < 4; ++e) am = fmaxf(am, fmaxf(fabsf(v[j][0][e]), fabsf(v[j][1][e]))); }
#pragma unroll
    for (int o = 1; o < 64; o <<= 1) am = fmaxf(am, __shfl_xor(am, o));
    const float qs = am > 0.f ? 127.0f / am : 0.f;
    if (lane == 0) *sxp = am * (1.0f / 127.0f);
#pragma unroll
    for (int j = 0; j < NJ; ++j) { const f32x4 y0 = v[j][0], y1 = v[j][1]; u32x2_t q;
        q.x = (unsigned)((int)__builtin_rintf(y0[0] * qs) & 255) | ((unsigned)((int)__builtin_rintf(y0[1] * qs) & 255) << 8) | ((unsigned)((int)__builtin_rintf(y0[2] * qs) & 255) << 16) | ((unsigned)(int)__builtin_rintf(y0[3] * qs) << 24);
        q.y = (unsigned)((int)__builtin_rintf(y1[0] * qs) & 255) | ((unsigned)((int)__builtin_rintf(y1[1] * qs) & 255) << 8) | ((unsigned)((int)__builtin_rintf(y1[2] * qs) & 255) << 16) | ((unsigned)(int)__builtin_rintf(y1[3] * qs) << 24);
        ((GAS u32x2_t*)q8row)[64 * j + lane] = q; }
}
__device__ __forceinline__ void quant_w8_oa(Frame& F) {
    const int gw = F.vcu * NWAVES + F.wave, NGW = F.G * NWAVES;
    for (int n = gw; n < D; n += NGW) quant_row_i8<4>(WSP(const bf16, WS_WO) + (size_t)n * QW, F.ws + WS_W8OA + (size_t)n * QW, WSP(float, WS_SWA) + n, F.lane);
}
__device__ __forceinline__ void p0_prologue(Frame& F) {
    LAS float* scr = (LAS float*)(F.lds + RING_OFF + F.wave * 16384);
    const int gw = F.vcu * NWAVES + F.wave, NGW = F.G * NWAVES;
    constexpr int I_IN = (D / 64) * (INW / 32), I_OA = (QW / 64) * (D / 32), I_OC = (CW / 64) * (D / 32), I_OUT = (D / 64) * (D / 32), I_QP = (D / 64) * (PQW / 32);
    constexpr int NITEMS = I_IN + I_OA + I_OC + I_OUT + I_QP;
    bf16* Win_t = WSP(bf16, WS_WIN); bf16* Wo_t = WSP(bf16, WS_WO); bf16* Wout_t = WSP(bf16, WS_WOUT); bf16* Wqp_t = WSP(bf16, WS_WQP);
    for (int it = gw; it < NITEMS; it += NGW) {
        int r = it;
        if (r < I_IN) { p0_transpose_item(F.w_in, D, INW, Win_t, 0, scr, r, F.lane); continue; } r -= I_IN;
        if (r < I_OA) { p0_transpose_item(F.w_oa, QW, D, Wo_t, 0, scr, r, F.lane); continue; } r -= I_OA;
        if (r < I_OC) { p0_transpose_item(F.w_oc, CW, D, Wo_t, D, scr, r, F.lane); continue; } r -= I_OC;
        if (r < I_OUT) { p0_transpose_item(F.w_out, D, D, Wout_t, 0, scr, r, F.lane); continue; } r -= I_OUT;
        p0_transpose_item(F.w_qp, D, PQW, Wqp_t, 0, scr, r, F.lane);
    }
    {
        bf16* SK = WSP(bf16, WS_SK); const int nth = F.G * NWAVES * 64, gt = gw * 64 + F.lane;
        for (int i = gt; i < PH * 2 * NKEYS * 128 / 4; i += nth) { const f32x4 v = ((const GAS f32x4*)F.subk)[i]; u32x2_t w; w.x = cvt_pk_bf16(v[0], v[1]); w.y = cvt_pk_bf16(v[2], v[3]); ((GAS u32x2_t*)SK)[i] = w; }
    }
    bf16* XN = WSP(bf16, WS_XN);
    for (int m = gw; m < M; m += NGW) rms_row_to_bf16<1>(F.x + (size_t)m * D, F.g1, XN + (size_t)m * D, (unsigned*)(F.ws + WS_XN8 + (size_t)m * D), WSP(float, WS_SX) + m, F.lane);
    for (int r = gw; r < 2 * NEXP; r += NGW) {
        const bool up = r >= NEXP; const int rr = up ? r - NEXP : r;
        const GAS f32x4* src = (const GAS f32x4*)((up ? F.w_up : F.w_down) + (size_t)rr * D) + 2 * F.lane;
        f32x4 v[16]; float am = 0.f;
#pragma unroll
        for (int i = 0; i < 8; ++i) { v[2 * i] = src[128 * i]; v[2 * i + 1] = src[128 * i + 1]; }
#pragma unroll
        for (int i = 0; i < 16; ++i) am = fmaxf(am, fmaxf(fmaxf(fabsf(v[i][0]), fabsf(v[i][1])), fmaxf(fabsf(v[i][2]), fabsf(v[i][3]))));
#pragma unroll
        for (int o = 1; o < 64; o <<= 1) am = fmaxf(am, __shfl_xor(am, o));
        const float sc = am > 0.f ? 6.0f / am : 1.0f;
        unsigned char* const dstb = F.ws + (up ? WS_W4U : WS_W4D) + (size_t)rr * 128 + (size_t)(F.lane >> 5) * SLICE_BYTES + (F.lane & 31) * 4;
#pragma unroll
        for (int i = 0; i < 8; ++i) { unsigned p = 0u;
            if (NIBBLE_SWAP_DOWN && !up) {
            p = __builtin_amdgcn_cvt_scalef32_pk_fp4_f32(p, v[2 * i][1] * sc, v[2 * i][0] * sc, 1.0f, 0); p = __builtin_amdgcn_cvt_scalef32_pk_fp4_f32(p, v[2 * i][3] * sc, v[2 * i][2] * sc, 1.0f, 1);
            p = __builtin_amdgcn_cvt_scalef32_pk_fp4_f32(p, v[2 * i + 1][1] * sc, v[2 * i + 1][0] * sc, 1.0f, 2); p = __builtin_amdgcn_cvt_scalef32_pk_fp4_f32(p, v[2 * i + 1][3] * sc, v[2 * i + 1][2] * sc, 1.0f, 3);
            } else {
            p = __builtin_amdgcn_cvt_scalef32_pk_fp4_f32(p, v[2 * i][0] * sc, v[2 * i][1] * sc, 1.0f, 0); p = __builtin_amdgcn_cvt_scalef32_pk_fp4_f32(p, v[2 * i][2] * sc, v[2 * i][3] * sc, 1.0f, 1);
            p = __builtin_amdgcn_cvt_scalef32_pk_fp4_f32(p, v[2 * i + 1][0] * sc, v[2 * i + 1][1] * sc, 1.0f, 2); p = __builtin_amdgcn_cvt_scalef32_pk_fp4_f32(p, v[2 * i + 1][2] * sc, v[2 * i + 1][3] * sc, 1.0f, 3);
            }
            *(GAS unsigned*)(dstb + (size_t)(2 * i) * SLICE_BYTES) = p; }
        if (F.lane == 0) WSP(float, up ? WS_SCU : WS_SCD)[rr] = am > 0.f ? am * (1.0f / 6.0f) : 1.0f;
    }
}

__device__ __forceinline__ unsigned off_b(unsigned row, unsigned ch) { return 256u * row + 16u * (ch ^ (((row & 3u) << 2) | ((row >> 2) & 3u))); }
__device__ __forceinline__ unsigned tr_addr16(unsigned lane, unsigned c, unsigned ks, unsigned t) {
    const unsigned g = lane >> 4, q = (lane & 15u) >> 2, p = lane & 3u;
    return off_b(32u * ks + 8u * g + 4u * t + q, 2u * c + (p >> 1)) + 8u * (p & 1u);
}
__device__ __forceinline__ v4i16_t tr_read(LAS unsigned char* p) { return __builtin_amdgcn_ds_read_tr16_b64_v4i16((LAS v4i16_t*)p); }
#define MFMA16(a, b, c) __builtin_amdgcn_mfma_f32_16x16x32_bf16((a), (b), (c), 0, 0, 0)

template <int PROBE> __device__ __forceinline__ void attn_unit(Frame& F, const int U) {
    const int lane = F.lane, wave = F.wave, c = lane & 15, hg = lane >> 4, tid = F.tid;
    const int hp = U & 1, kvh = (U >> 1) & 3, nblk = (U >> 3) & 31, b = U >> 8;
    const int hq = kvh * 4 + hp * 2 + (wave >> 2), i0 = (wave & 3) * 32;
    const size_t tok0 = (size_t)b * SEQ + (size_t)nblk * 128;
    const bf16* QB = WSP(const bf16, WS_Q); const bf16* KB = WSP(const bf16, WS_K); const bf16* VB = WSP(const bf16, WS_V); bf16* OB = PROBE ? WSP(bf16, WS_XN) : WSP(bf16, WS_AB);
    bf16x8 qf[2][4];
    {
        float g[4][8];
#pragma unroll
        for (int ks = 0; ks < 4; ++ks) { const f32x4 a = *(const GAS f32x4*)(F.gq + 32 * ks + 8 * hg), bb = *(const GAS f32x4*)(F.gq + 32 * ks + 8 * hg + 4);
#pragma unroll
            for (int e = 0; e < 4; ++e) { g[ks][e] = a[e]; g[ks][4 + e] = bb[e]; } }
#pragma unroll
        for (int qt = 0; qt < 2; ++qt) {
            const bf16* qrow = QB + (tok0 + i0 + 16 * qt + c) * QW + hq * HD + 8 * hg;
            f32x4 lo[4], hi[4]; float ss = 0.f;
#pragma unroll
            for (int ks = 0; ks < 4; ++ks) { unpack8(*(const GAS v4u*)(qrow + 32 * ks), lo[ks], hi[ks]); ss += dot4(lo[ks], lo[ks]) + dot4(hi[ks], hi[ks]); }
            ss += __shfl_xor(ss, 16); ss += __shfl_xor(ss, 32);
            const float r = rsqrtf(ss * (1.f / HD) + EPS) * (0.08838834764831845f * LOG2E);
#pragma unroll
            for (int ks = 0; ks < 4; ++ks) { f32x4 a, bb;
#pragma unroll
                for (int e = 0; e < 4; ++e) { a[e] = lo[ks][e] * r * g[ks][e]; bb[e] = hi[ks][e] * r * g[ks][4 + e]; }
                qf[qt][ks] = __builtin_bit_cast(bf16x8, pack8(a, bb)); }
        }
    }
    const float slope2 = __builtin_amdgcn_exp2f(-0.5f * (float)(hq + 1)) * LOG2E;
    const float sink2 = F.sink[hq] * LOG2E;
    float mrun[2] = {sink2, sink2}, lrun[2]; lrun[0] = lrun[1] = (hg == 0) ? 1.f : 0.f;
    f32x4 acc[8][2];
#pragma unroll
    for (int dt = 0; dt < 8; ++dt) { acc[dt][0] = (f32x4){0.f, 0.f, 0.f, 0.f}; acc[dt][1] = (f32x4){0.f, 0.f, 0.f, 0.f}; }
    const f32x4 gk0 = *(const GAS f32x4*)(F.gk + (tid & 15) * 8), gk1 = *(const GAS f32x4*)(F.gk + (tid & 15) * 8 + 4);
    __syncthreads();
    int bufi = 0;
#pragma unroll 1
    for (int kbi = -1; kbi <= 1; ++kbi) {
        const int kb = nblk + kbi; if (kb < 0 || kb >= SEQ / 128) continue;
        LAS unsigned char* Kl = F.lds + RING_OFF + bufi * 65536; LAS unsigned char* Vl = Kl + 32768; bufi ^= 1;
#pragma unroll
        for (int it = 0; it < (PROBE == 3 ? 0 : 4); ++it) {
            const int row = (tid >> 4) + 32 * it, ch = tid & 15;
            const size_t src = ((size_t)b * SEQ + (size_t)kb * 128 + row) * KVW + kvh * HD + ch * 8;
            f32x4 k0, k1; unpack8(*(const GAS v4u*)(KB + src), k0, k1);
            float ss = dot4(k0, k0) + dot4(k1, k1);
            ss += __shfl_xor(ss, 1); ss += __shfl_xor(ss, 2); ss += __shfl_xor(ss, 4); ss += __shfl_xor(ss, 8);
            const float r = rsqrtf(ss * (1.f / HD) + EPS);
            *(LAS v4u*)(Kl + off_b(row, ch)) = pack8(k0 * r * gk0, k1 * r * gk1);
            *(LAS v4u*)(Vl + off_b(row, ch)) = *(const GAS v4u*)(VB + src);
        }
        __syncthreads();
        const int ks_lo = kbi < 0 ? (i0 >> 5) : 0, ks_hi = kbi > 0 ? (i0 >> 5) + 1 : 4;
#pragma unroll 2
        for (int ks32 = (PROBE == 2 ? ks_hi : ks_lo); ks32 < ks_hi; ++ks32) {
            f32x4 sa[2], sb[2];
            sa[0] = sa[1] = sb[0] = sb[1] = (f32x4){0.f, 0.f, 0.f, 0.f};
            const unsigned krow = 32u * ks32 + 8u * (c >> 2) + (c & 3);
#pragma unroll
            for (int ks = 0; ks < 4; ++ks) {
                const bf16x8 ka = *(const LAS bf16x8*)(Kl + off_b(krow, 4 * ks + hg)), kb2 = *(const LAS bf16x8*)(Kl + off_b(krow + 4, 4 * ks + hg));
#pragma unroll
                for (int qt = 0; qt < 2; ++qt) { sa[qt] = MFMA16(ka, qf[qt][ks], sa[qt]); sb[qt] = MFMA16(kb2, qf[qt][ks], sb[qt]); }
            }
            bf16x8 pf[2];
#pragma unroll
            for (int qt = 0; qt < 2; ++qt) {
                float s[8] = {sa[qt][0], sa[qt][1], sa[qt][2], sa[qt][3], sb[qt][0], sb[qt][1], sb[qt][2], sb[qt][3]};
                const int rel0 = kbi * 128 + 32 * ks32 + 8 * hg - (i0 + 16 * qt + c);
                float mx = -INFINITY;
#pragma unroll
                for (int j = 0; j < 8; ++j) { const int rel = rel0 + j, dist = rel < 0 ? -rel : rel; const float sv = s[j] - slope2 * (float)dist; s[j] = (dist <= 128) ? sv : -INFINITY; mx = fmaxf(mx, s[j]); }
                mx = fmaxf(mx, __shfl_xor(mx, 16)); mx = fmaxf(mx, __shfl_xor(mx, 32));
                const float mn = fmaxf(mrun[qt], mx), alpha = __builtin_amdgcn_exp2f(mrun[qt] - mn); mrun[qt] = mn;
                float ps = 0.f;
#pragma unroll
                for (int j = 0; j < 8; ++j) { s[j] = __builtin_amdgcn_exp2f(s[j] - mn); ps += s[j]; }
                lrun[qt] = lrun[qt] * alpha + ps;
                pf[qt] = __builtin_bit_cast(bf16x8, pack8((f32x4){s[0], s[1], s[2], s[3]}, (f32x4){s[4], s[5], s[6], s[7]}));
#pragma unroll
                for (int dt = 0; dt < 8; ++dt) acc[dt][qt] = acc[dt][qt] * alpha;
            }
#pragma unroll
            for (int dt = 0; dt < 8; ++dt) {
                const v4i16_t vlo = tr_read(Vl + tr_addr16(lane, dt, ks32, 0)), vhi = tr_read(Vl + tr_addr16(lane, dt, ks32, 1));
                const bf16x8 vf = {vlo[0], vlo[1], vlo[2], vlo[3], vhi[0], vhi[1], vhi[2], vhi[3]};
#pragma unroll
                for (int qt = 0; qt < 2; ++qt) acc[dt][qt] = MFMA16(vf, pf[qt], acc[dt][qt]);
            }
        }
    }
#pragma unroll
    for (int qt = 0; qt < 2; ++qt) {
        float l = lrun[qt]; l += __shfl_xor(l, 16); l += __shfl_xor(l, 32);
        const float inv = 1.0f / l;
        bf16* orow = OB + (tok0 + i0 + 16 * qt + c) * QW + hq * HD + 4 * hg;
#pragma unroll
        for (int dt = 0; dt < 8; ++dt) { const f32x4 o = acc[dt][qt] * inv; u32x2_t w; w.x = cvt_pk_bf16(o[0], o[1]); w.y = cvt_pk_bf16(o[2], o[3]); *(GAS u32x2_t*)(orow + 16 * dt) = w; }
    }
}
__device__ __forceinline__ int attn_i0(int wave) { return ((wave & 4) ? 3 - (wave & 3) : (wave & 3)) * 32; }
__device__ __forceinline__ int attn_unit_of(const Frame& F, int un) { const int U = (F.vcu + (un >> 2) * F.G) * 4 + (un & 3); return U < BATCH * 32 * NKV * 2 ? U : -1; }
__device__ __forceinline__ bool attn_next(const Frame& F, int& un, int& kbi) {
    for (;;) {
        ++kbi; if (kbi > 1) { ++un; kbi = -1; }
        const int U = attn_unit_of(F, un); if (U < 0) return false;
        const int kb = ((U >> 3) & 31) + kbi; if (kb >= 0 && kb < SEQ / 128) return true;
    }
}
__device__ __forceinline__ void attn_kv_issue(Frame& F, int U, int kbi, LAS unsigned char* Kl) {
    const int lane = F.lane, kvh = (U >> 1) & 3, nblk = (U >> 3) & 31, b = U >> 8, kb = nblk + kbi;
    const bf16* KB = WSP(const bf16, WS_K); const bf16* VB = WSP(const bf16, WS_V);
    const size_t base = ((size_t)b * SEQ + (size_t)kb * 128) * KVW + kvh * HD;
    const unsigned sw = ((unsigned)(lane >> 4) << 2) | ((unsigned)F.wave & 3u), ch = ((unsigned)lane & 15u) ^ sw;
#pragma unroll
    for (int it = 0; it < 4; ++it) { const int blk = F.wave + 8 * it, row = 4 * blk + (lane >> 4); const size_t src = base + (size_t)row * KVW + ch * 8;
        __builtin_amdgcn_global_load_lds((const unsigned*)(KB + src), (LAS unsigned*)(Kl + blk * 1024), 16, 0, 0);
        __builtin_amdgcn_global_load_lds((const unsigned*)(VB + src), (LAS unsigned*)(Kl + 32768 + blk * 1024), 16, 0, 0); }
}
__device__ __forceinline__ void attn_k_norm(Frame& F, LAS unsigned char* Kl, const LAS float* gkl) {
    const int lane = F.lane;
    const unsigned sw = ((unsigned)(lane >> 4) << 2) | ((unsigned)F.wave & 3u), ch = ((unsigned)lane & 15u) ^ sw;
    const f32x4 gk0 = *(const LAS f32x4*)(gkl + ch * 8), gk1 = *(const LAS f32x4*)(gkl + ch * 8 + 4);
    v4u kr[4];
#pragma unroll
    for (int it = 0; it < 4; ++it) kr[it] = *(const LAS v4u*)(Kl + (F.wave + 8 * it) * 1024 + lane * 16);
#pragma unroll
    for (int it = 0; it < 4; ++it) {
        f32x4 k0, k1; unpack8(kr[it], k0, k1);
        float ss = dot4(k0, k0) + dot4(k1, k1);
        ss += __shfl_xor(ss, 1); ss += __shfl_xor(ss, 2); ss += __shfl_xor(ss, 4); ss += __shfl_xor(ss, 8);
        const float r = rsqrtf(ss * (1.f / HD) + EPS);
        *(LAS v4u*)(Kl + (F.wave + 8 * it) * 1024 + lane * 16) = pack8(k0 * r * gk0, k1 * r * gk1); }
}
__device__ __forceinline__ void attn_q_issue(Frame& F, int U, v4u (&qr)[2][4]) {
    const int lane = F.lane, wave = F.wave, c = lane & 15, hg = lane >> 4;
    const int hp = U & 1, kvh = (U >> 1) & 3, nblk = (U >> 3) & 31, b = U >> 8, hq = kvh * 4 + hp * 2 + (wave >> 2), i0 = attn_i0(wave);
    const size_t tok0 = (size_t)b * SEQ + (size_t)nblk * 128;
    const bf16* QB = WSP(const bf16, WS_Q);
#pragma unroll
    for (int qt = 0; qt < 2; ++qt) { const bf16* qrow = QB + (tok0 + i0 + 16 * qt + c) * QW + hq * HD + 8 * hg;
#pragma unroll
        for (int ks = 0; ks < 4; ++ks) qr[qt][ks] = *(const GAS v4u*)(qrow + 32 * ks); }
}
__device__ __forceinline__ void attn_block(Frame& F, const LAS unsigned char* Kl, int kbi, const bf16x8 (&qf)[2][4], float slope2, float (&mrun)[2], float (&lrun)[2], f32x4 (&acc)[8][2]) {
    const int lane = F.lane, c = lane & 15, hg = lane >> 4, i0 = attn_i0(F.wave);
    const LAS unsigned char* Vl = Kl + 32768;
    const int ks_lo = kbi < 0 ? (i0 >> 5) : 0, ks_hi = kbi > 0 ? (i0 >> 5) + 1 : 4;
#pragma unroll 1
    for (int ks32 = ks_lo; ks32 < ks_hi; ++ks32) {
        f32x4 sa[2], sb[2];
        sa[0] = sa[1] = sb[0] = sb[1] = (f32x4){0.f, 0.f, 0.f, 0.f};
        const bool need_mask = kbi != 0 && ks32 == (i0 >> 5);
        const unsigned krow = 32u * ks32 + 8u * (c >> 2) + (c & 3);
#pragma unroll
        for (int ks = 0; ks < 4; ++ks) {
            const bf16x8 ka = *(const LAS bf16x8*)(Kl + off_b(krow, 4 * ks + hg)), kb2 = *(const LAS bf16x8*)(Kl + off_b(krow + 4, 4 * ks + hg));
#pragma unroll
            for (int qt = 0; qt < 2; ++qt) { sa[qt] = MFMA16(ka, qf[qt][ks], sa[qt]); sb[qt] = MFMA16(kb2, qf[qt][ks], sb[qt]); }
        }
        bf16x8 pf[2];
#pragma unroll
        for (int qt = 0; qt < 2; ++qt) {
            float sv8[8] = {sa[qt][0], sa[qt][1], sa[qt][2], sa[qt][3], sb[qt][0], sb[qt][1], sb[qt][2], sb[qt][3]};
            const float rf = (float)(kbi * 128 + 32 * ks32 + 8 * hg - (i0 + 16 * qt + c));
            float mx = -INFINITY;
#pragma unroll
            for (int j = 0; j < 8; ++j) sv8[j] = __builtin_fmaf(-slope2, __builtin_fabsf(rf + (float)j), sv8[j]);
            if (need_mask) {
#pragma unroll
                for (int j = 0; j < 8; ++j) sv8[j] = (__builtin_fabsf(rf + (float)j) <= 128.f) ? sv8[j] : -INFINITY; }
#pragma unroll
            for (int j = 0; j < 8; ++j) mx = fmaxf(mx, sv8[j]);
            mx = fmaxf(mx, __shfl_xor(mx, 16)); mx = fmaxf(mx, __shfl_xor(mx, 32));
            const float mn = fmaxf(mrun[qt], mx), alpha = __builtin_amdgcn_exp2f(mrun[qt] - mn); mrun[qt] = mn;
            float ps = 0.f;
#pragma unroll
            for (int j = 0; j < 8; ++j) { sv8[j] = __builtin_amdgcn_exp2f(sv8[j] - mn); ps += sv8[j]; }
            lrun[qt] = lrun[qt] * alpha + ps;
            pf[qt] = __builtin_bit_cast(bf16x8, pack8((f32x4){sv8[0], sv8[1], sv8[2], sv8[3]}, (f32x4){sv8[4], sv8[5], sv8[6], sv8[7]}));
#pragma unroll
            for (int dt = 0; dt < 8; ++dt) acc[dt][qt] = acc[dt][qt] * alpha;
        }
#pragma unroll
        for (int h = 0; h < 2; ++h) {
            v4i16_t vlo[4], vhi[4];
#pragma unroll
            for (int d = 0; d < 4; ++d) {
                asm volatile("ds_read_b64_tr_b16 %0, %1" : "=v"(vlo[d]) : "v"((unsigned)(size_t)Vl + tr_addr16(lane, 4 * h + d, ks32, 0)));
                asm volatile("ds_read_b64_tr_b16 %0, %1" : "=v"(vhi[d]) : "v"((unsigned)(size_t)Vl + tr_addr16(lane, 4 * h + d, ks32, 1))); }
            asm volatile("s_waitcnt lgkmcnt(0)" : "+v"(vlo[0]), "+v"(vhi[0]), "+v"(vlo[1]), "+v"(vhi[1]), "+v"(vlo[2]), "+v"(vhi[2]), "+v"(vlo[3]), "+v"(vhi[3]) :: "memory");
#pragma unroll
            for (int d = 0; d < 4; ++d) { const bf16x8 vf = {vlo[d][0], vlo[d][1], vlo[d][2], vlo[d][3], vhi[d][0], vhi[d][1], vhi[d][2], vhi[d][3]};
#pragma unroll
                for (int qt = 0; qt < 2; ++qt) acc[4 * h + d][qt] = MFMA16(vf, pf[qt], acc[4 * h + d][qt]); }
        }
    }
}
__device__ __forceinline__ void attn_phase(Frame& F) {
    const int lane = F.lane, wave = F.wave, c = lane & 15, hg = lane >> 4, tid = F.tid, i0 = attn_i0(wave);
    LAS float* gql = (LAS float*)(F.lds + OBUF_OFF);
    LAS float* gkl = gql + 128;
    if (tid < 128) gql[tid] = F.gq[tid]; else if (tid < 256) gql[tid] = F.gk[tid - 128]; else if (tid < 256 + NH) gql[tid] = F.sink[tid - 256];
    int un = 0, kbi = -2;
    if (!attn_next(F, un, kbi)) return;
    v4u qr[2][4];
    attn_q_issue(F, attn_unit_of(F, un), qr);
    attn_kv_issue(F, attn_unit_of(F, un), kbi, F.lds + RING_OFF);
    __syncthreads();
    asm volatile("s_waitcnt vmcnt(0)" ::: "memory");
    attn_k_norm(F, F.lds + RING_OFF, gkl);
    asm volatile("s_waitcnt lgkmcnt(0)" ::: "memory"); __builtin_amdgcn_s_barrier(); asm volatile("" ::: "memory");
    int bufi = 0; bool first = true;
    bf16x8 qf[2][4]; float slope2 = 0.f, mrun[2] = {0.f, 0.f}, lrun[2] = {0.f, 0.f}; f32x4 acc[8][2];
#pragma unroll 1
    for (;;) {
        const int U = attn_unit_of(F, un);
        int nun = un, nkbi = kbi; const bool has_next = attn_next(F, nun, nkbi);
        if (first) {
            const int hp = U & 1, kvh = (U >> 1) & 3, hq = kvh * 4 + hp * 2 + (wave >> 2);
#pragma unroll
            for (int qt = 0; qt < 2; ++qt) {
                f32x4 lo[4], hi[4]; float ss = 0.f;
#pragma unroll
                for (int ks = 0; ks < 4; ++ks) { unpack8(qr[qt][ks], lo[ks], hi[ks]); ss += dot4(lo[ks], lo[ks]) + dot4(hi[ks], hi[ks]); }
                ss += __shfl_xor(ss, 16); ss += __shfl_xor(ss, 32);
                const float r = rsqrtf(ss * (1.f / HD) + EPS) * (0.08838834764831845f * LOG2E);
#pragma unroll
                for (int ks = 0; ks < 4; ++ks) { const f32x4 ga = *(const LAS f32x4*)(gql + 32 * ks + 8 * hg), gb = *(const LAS f32x4*)(gql + 32 * ks + 8 * hg + 4);
                    qf[qt][ks] = __builtin_bit_cast(bf16x8, pack8(lo[ks] * r * ga, hi[ks] * r * gb)); }
            }
            slope2 = __builtin_amdgcn_exp2f(-0.5f * (float)(hq + 1)) * LOG2E;
            const float sink2 = gql[256 + hq] * LOG2E;
            mrun[0] = mrun[1] = sink2; lrun[0] = lrun[1] = (hg == 0) ? 1.f : 0.f;
#pragma unroll
            for (int dt = 0; dt < 8; ++dt) { acc[dt][0] = (f32x4){0.f, 0.f, 0.f, 0.f}; acc[dt][1] = (f32x4){0.f, 0.f, 0.f, 0.f}; }
        }
        __builtin_amdgcn_sched_barrier(0);
        attn_kv_issue(F, attn_unit_of(F, has_next ? nun : un), has_next ? nkbi : kbi, F.lds + RING_OFF + (bufi ^ 1) * 65536);
        const bool last = !has_next || nun != un;
        __builtin_amdgcn_sched_barrier(0);
        attn_block(F, F.lds + RING_OFF + bufi * 65536, kbi, qf, slope2, mrun, lrun, acc);
        __builtin_amdgcn_sched_barrier(0);
        if (last) {
            if (has_next) attn_q_issue(F, attn_unit_of(F, nun), qr);
            __builtin_amdgcn_sched_barrier(0);
            const int hp = U & 1, kvh = (U >> 1) & 3, nblk = (U >> 3) & 31, b = U >> 8, hq = kvh * 4 + hp * 2 + (wave >> 2);
            const size_t tok0 = (size_t)b * SEQ + (size_t)nblk * 128;
            bf16* OB = WSP(bf16, WS_AB);
#pragma unroll
            for (int qt = 0; qt < 2; ++qt) {
                float l = lrun[qt]; l += __shfl_xor(l, 16); l += __shfl_xor(l, 32);
                const float inv = 1.0f / l;
                bf16* orow = OB + (tok0 + i0 + 16 * qt + c) * QW + hq * HD + 4 * hg;
#pragma unroll
                for (int dt = 0; dt < 8; ++dt) { const f32x4 o = acc[dt][qt] * inv; u32x2_t w; w.x = cvt_pk_bf16(o[0], o[1]); w.y = cvt_pk_bf16(o[2], o[3]); *(GAS u32x2_t*)(orow + 16 * dt) = w; }
            }
        }
        if (!has_next) { asm volatile("s_waitcnt vmcnt(0)" ::: "memory"); break; }
        __builtin_amdgcn_sched_barrier(0);
        if (last) asm volatile("s_waitcnt vmcnt(24)" ::: "memory"); else asm volatile("s_waitcnt vmcnt(0)" ::: "memory");
        __builtin_amdgcn_sched_barrier(0);
        attn_k_norm(F, F.lds + RING_OFF + (bufi ^ 1) * 65536, gkl);
        asm volatile("s_waitcnt lgkmcnt(0)" ::: "memory"); __builtin_amdgcn_s_barrier(); asm volatile("" ::: "memory");
        bufi ^= 1; first = last; un = nun; kbi = nkbi;
    }
    __syncthreads();
}
constexpr int CONV_T = 8;
__device__ __forceinline__ void conv_phase(Frame& F) {
    const bf16* HB = WSP(const bf16, WS_H); const bf16* BB = WSP(const bf16, WS_B); const bf16* CB = WSP(const bf16, WS_C); bf16* OC = WSP(bf16, WS_AB) + (size_t)M * CW;
    const unsigned nitem = (unsigned)(M / CONV_T) * (CW / 8);
    for (unsigned e = (unsigned)F.vcu * 512u + (unsigned)F.tid; e < nitem; e += (unsigned)F.G * 512u) {
        const int t0 = (int)(e >> 8) * CONV_T, cc = (int)(e & 255u) * 8, tl0 = t0 & (SEQ - 1);
        const size_t o = (size_t)t0 * CW + cc;
        const bool has_prev = tl0 > 0, has_next = tl0 + CONV_T < SEQ;
        v4u hw[CONV_T + 2], cw[CONV_T + 2], bw[CONV_T];
        hw[0] = cw[0] = hw[CONV_T + 1] = cw[CONV_T + 1] = (v4u){0u, 0u, 0u, 0u};
        if (has_prev) { hw[0] = *(const GAS v4u*)(HB + o - CW); cw[0] = *(const GAS v4u*)(CB + o - CW); }
#pragma unroll
        for (int k = 0; k < CONV_T; ++k) { hw[k + 1] = *(const GAS v4u*)(HB + o + (size_t)k * CW); cw[k + 1] = *(const GAS v4u*)(CB + o + (size_t)k * CW); bw[k] = *(const GAS v4u*)(BB + o + (size_t)k * CW); }
        if (has_next) { hw[CONV_T + 1] = *(const GAS v4u*)(HB + o + (size_t)CONV_T * CW); cw[CONV_T + 1] = *(const GAS v4u*)(CB + o + (size_t)CONV_T * CW); }
        const GAS f32x4* w = (const GAS f32x4*)(F.conv_w + cc);
        const f32x4 w00 = w[0], w01 = w[1], w10 = w[CW / 4], w11 = w[CW / 4 + 1], w20 = w[2 * CW / 4], w21 = w[2 * CW / 4 + 1];
        f32x4 up0, up1, uc0, uc1;
        { f32x4 h0, h1, c0, c1; unpack8(hw[0], h0, h1); unpack8(cw[0], c0, c1); up0 = h0 * c0; up1 = h1 * c1; unpack8(hw[1], h0, h1); unpack8(cw[1], c0, c1); uc0 = h0 * c0; uc1 = h1 * c1; }
#pragma unroll
        for (int k = 0; k < CONV_T; ++k) {
            f32x4 h0, h1, c0, c1, b0, b1; unpack8(hw[k + 2], h0, h1); unpack8(cw[k + 2], c0, c1); unpack8(bw[k], b0, b1);
            const f32x4 un0 = h0 * c0, un1 = h1 * c1;
            const f32x4 y0 = w00 * up0 + w10 * uc0 + w20 * un0, y1 = w01 * up1 + w11 * uc1 + w21 * un1;
            *(GAS v4u*)(OC + o + (size_t)k * CW) = pack8(b0 * y0, b1 * y1);
            up0 = uc0; up1 = uc1; uc0 = un0; uc1 = un1;
        }
    }
}

__device__ __forceinline__ unsigned ordf(float f) { const unsigned u = __float_as_uint(f); return u ^ ((u >> 31) ? 0xFFFFFFFFu : 0x80000000u); }
__device__ __forceinline__ float unordf(unsigned k) { return __uint_as_float((k & 0x80000000u) ? (k ^ 0x80000000u) : ~k); }
__device__ __forceinline__ u64 shfl64_xor(u64 v, int m) { const unsigned lo = __shfl_xor((unsigned)v, m), hi = __shfl_xor((unsigned)(v >> 32), m); return ((u64)hi << 32) | lo; }
template <int N> __device__ __forceinline__ void bitonic_merge_desc(unsigned (&a)[N]) {
#pragma unroll
    for (int j = N >> 1; j > 0; j >>= 1)
#pragma unroll
        for (int i = 0; i < N; ++i) { const int l = i ^ j; if (l > i) { const unsigned hi = a[i] > a[l] ? a[i] : a[l], lo = a[i] > a[l] ? a[l] : a[i]; a[i] = hi; a[l] = lo; } }
}
template <int N> __device__ __forceinline__ void bitonic_sort_desc(unsigned (&a)[N]) {
#pragma unroll
    for (int k = 2; k <= N; k <<= 1)
#pragma unroll
        for (int j = k >> 1; j > 0; j >>= 1)
#pragma unroll
            for (int i = 0; i < N; ++i) { const int l = i ^ j; if (l > i) { const unsigned hi = a[i] > a[l] ? a[i] : a[l], lo = a[i] > a[l] ? a[l] : a[i]; const bool desc = ((i & k) == 0); a[i] = desc ? hi : lo; a[l] = desc ? lo : hi; } }
}
__device__ __forceinline__ void xlane_top16(unsigned (&t)[16], const int mask) {
    unsigned m[16];
#pragma unroll
    for (int i = 0; i < 16; ++i) { const unsigned p = __shfl_xor(t[15 - i], mask); m[i] = t[i] > p ? t[i] : p; }
    bitonic_merge_desc<16>(m);
#pragma unroll
    for (int i = 0; i < 16; ++i) t[i] = m[i];
}
struct Stair { int i[52], j[52]; };
constexpr Stair make_stair() { Stair s{}; int n = 0; for (int a = 0; a < 16; ++a) for (int b = 0; b < 16; ++b) if ((a + 1) * (b + 1) <= 16) { s.i[n] = a; s.j[n] = b; ++n; } for (; n < 52; ++n) { s.i[n] = -1; s.j[n] = -1; } return s; }
constexpr Stair STAIR = make_stair();
template <int P> __device__ __forceinline__ unsigned cand1(const float (&v1)[16], const float (&v2)[16]) {
    constexpr int i = STAIR.i[P], j = STAIR.j[P];
    if constexpr (i < 0) return 0u;
    else return (ordf(v1[i] + v2[j]) & ~255u) | (unsigned)(16 * i + j);
}
template <int S> __device__ __forceinline__ void cand_fill(unsigned (&ck)[16], const float (&v1)[16], const float (&v2)[16], int hg) {
    const unsigned k0 = cand1<4 * S + 0>(v1, v2), k1 = cand1<4 * S + 1>(v1, v2), k2 = cand1<4 * S + 2>(v1, v2), k3 = cand1<4 * S + 3>(v1, v2);
    ck[S] = hg == 0 ? k0 : hg == 1 ? k1 : hg == 2 ? k2 : k3;
    if constexpr (S + 1 < 13) cand_fill<S + 1>(ck, v1, v2, hg);
}
__device__ __forceinline__ void route_task(Frame& F, const int tg, const int h) {
    const int lane = F.lane, c = lane & 15, hg = lane >> 4;
    const int tok = tg * 16 + c;
    const bf16* QP = WSP(const bf16, WS_QP); LAS unsigned char* SKl = F.lds + RING_OFF;
    unsigned sel[2][16];
#pragma unroll
    for (int half = 0; half < 2; ++half) {
        bf16x8 bq[4];
#pragma unroll
        for (int ks = 0; ks < 4; ++ks) bq[ks] = *(const GAS bf16x8*)(QP + (size_t)tok * PQW + h * 256 + half * 128 + 32 * ks + 8 * hg);
        unsigned k[32];
#pragma unroll
        for (int tile = 0; tile < 8; ++tile) {
            f32x4 s = (f32x4){0.f, 0.f, 0.f, 0.f};
#pragma unroll
            for (int ks = 0; ks < 4; ++ks) { const bf16x8 a = *(const LAS bf16x8*)(SKl + off_b(half * 128 + 16 * tile + c, 4 * ks + hg)); s = MFMA16(a, bq[ks], s); }
#pragma unroll
            for (int r = 0; r < 4; ++r) k[tile * 4 + r] = (ordf(s[r]) & ~127u) | (unsigned)(16 * tile + 4 * hg + r);
            if (tile & 1) asm volatile("" ::: "memory");
        }
        bitonic_sort_desc<32>(k);
        unsigned t[16];
#pragma unroll
        for (int i = 0; i < 16; ++i) t[i] = k[i];
        xlane_top16(t, 16); xlane_top16(t, 32);
#pragma unroll
        for (int i = 0; i < 16; ++i) sel[half][i] = t[i];
        asm volatile("" ::: "memory");
    }
    float v1[16], v2[16]; unsigned n1[16], n2[16];
#pragma unroll
    for (int i = 0; i < 16; ++i) { v1[i] = unordf(sel[0][i] & ~127u); n1[i] = sel[0][i] & 127u; v2[i] = unordf(sel[1][i] & ~127u); n2[i] = sel[1][i] & 127u; }
    LAS unsigned char* scr = F.lds + RING_OFF + 65536 + F.wave * 4096 + c * 256;
    if (hg == 0) {
#pragma unroll
        for (int q4 = 0; q4 < 4; ++q4) { *(LAS f32x4*)(scr + 16 * q4) = (f32x4){v1[4 * q4], v1[4 * q4 + 1], v1[4 * q4 + 2], v1[4 * q4 + 3]}; *(LAS f32x4*)(scr + 64 + 16 * q4) = (f32x4){v2[4 * q4], v2[4 * q4 + 1], v2[4 * q4 + 2], v2[4 * q4 + 3]};
            *(LAS v4u*)(scr + 128 + 16 * q4) = (v4u){n1[4 * q4], n1[4 * q4 + 1], n1[4 * q4 + 2], n1[4 * q4 + 3]}; *(LAS v4u*)(scr + 192 + 16 * q4) = (v4u){n2[4 * q4], n2[4 * q4 + 1], n2[4 * q4 + 2], n2[4 * q4 + 3]}; } }
    unsigned ck[16];
    cand_fill<0>(ck, v1, v2, hg); ck[13] = ck[14] = ck[15] = 0u;
    bitonic_sort_desc<16>(ck);
    xlane_top16(ck, 16); xlane_top16(ck, 32);
    int oi[4]; float sc[4]; float mx = -INFINITY;
#pragma unroll
    for (int jj = 0; jj < 4; ++jj) {
        const unsigned w = hg == 0 ? ck[jj] : hg == 1 ? ck[4 + jj] : hg == 2 ? ck[8 + jj] : ck[12 + jj];
        const unsigned i4 = (w >> 2) & 0x3Cu, j4 = (w & 15u) << 2;
        sc[jj] = *(const LAS float*)(scr + i4) + *(const LAS float*)(scr + 64 + j4);
        oi[jj] = (int)(*(const LAS unsigned*)(scr + 128 + i4) * (unsigned)NKEYS + *(const LAS unsigned*)(scr + 192 + j4));
        mx = fmaxf(mx, sc[jj]);
    }
    mx = fmaxf(mx, __shfl_xor(mx, 16)); mx = fmaxf(mx, __shfl_xor(mx, 32));
    float ev[4], sum = 0.f;
#pragma unroll
    for (int jj = 0; jj < 4; ++jj) { ev[jj] = __builtin_amdgcn_exp2f((sc[jj] - mx) * LOG2E); sum += ev[jj]; }
    sum += __shfl_xor(sum, 16); sum += __shfl_xor(sum, 32);
    const float inv = 1.0f / sum;
    const size_t o = ((size_t)tok * PH + h) * TOPK + 4 * hg;
    *(GAS i32x4_t*)(WSP(int, WS_IDX) + o) = (i32x4_t){oi[0], oi[1], oi[2], oi[3]};
    *(GAS f32x4*)(WSP(float, WS_GATE) + o) = (f32x4){ev[0] * inv, ev[1] * inv, ev[2] * inv, ev[3] * inv};
}

__device__ __forceinline__ float gelu_erf(float v) { return 0.5f * v * (1.0f + erff(v * 0.70710678118654752f)); }
typedef int i32x8_t __attribute__((ext_vector_type(8)));
#define FP4X2(w, b) __builtin_amdgcn_cvt_scalef32_pk_f32_fp4((w), 1.0f, (b))
__device__ __forceinline__ void fmac(float& acc, float a, float b) { asm("v_fmac_f32 %0, %1, %2" : "+v"(acc) : "v"(a), "v"(b)); }
struct PeerDeal { int ox, nx, t0, stride, cnt, ns; };
__device__ __forceinline__ void pd_item(int n, const PeerDeal& d, int& t, int& sl) { const int N = d.ns * d.cnt, nn = n < N ? n : N - 1, j = nn / d.cnt; sl = d.ox + j * d.nx; t = d.t0 + (nn - j * d.cnt) * d.stride; }
__device__ __forceinline__ void pd_idx(Frame& F, int t, int lane, i32x4_t (&idv)[4]) {
    const GAS i32x4_t* ip = (const GAS i32x4_t*)(WSP(const int, WS_IDX) + (size_t)t * 128 + (lane >> 3) * 16);
#pragma unroll
    for (int a = 0; a < 4; ++a) idv[a] = ip[a];
}
__device__ __forceinline__ void pd_rows(Frame& F, int t, int sl, int lane, const i32x4_t (&idv)[4], v4u (&rows)[16], v4u (&xw)[2]) {
    const unsigned char* xr = F.ws + WS_X2N8 + ((size_t)sl * M + t) * 256 + 16 * (lane >> 4) + ((lane & 15) == 1 ? 128 : 0);
#pragma unroll
    for (int ks = 0; ks < 2; ++ks) xw[ks] = *(const GAS v4u*)(xr + 64 * ks);
    const unsigned char* WD = F.ws + WS_W4D + (size_t)sl * SLICE_BYTES;
    const unsigned lo16 = 16u * (unsigned)(lane & 7);
#pragma unroll
    for (int j = 0; j < 16; ++j) rows[j] = *(const GAS v4u*)(WD + (size_t)(((unsigned)idv[j >> 2][j & 3] << 7) + lo16));
}
__device__ __forceinline__ float dpp_swap1(float v) { return __builtin_bit_cast(float, __builtin_amdgcn_update_dpp(0, __builtin_bit_cast(int, v), 0xB1  , 0xF, 0xF, true)); }
__device__ __forceinline__ void pd_compute(Frame& F, int t, int sl, int lane, const v4u (&rows)[16], const v4u (&xw)[2]) {
    const int r = lane & 15, g = lane >> 4;
    LAS unsigned char* tile = F.lds + RING_OFF + F.wave * 16384;
    { LAS unsigned char* wp = tile + (lane >> 3) * 2048;
#pragma unroll
      for (int j = 0; j < 16; ++j) *(LAS v4u*)(wp + j * 128 + (((lane & 7) ^ ((j >> 1) & 7)) << 4)) = rows[j]; }
    float* pp = WSP(float, WS_PART) + ((size_t)sl * M + t) * 128 + 4 * g;
    const int scb = (r == 1) ? 0x7C7C7C7C   : 0x7F7F7F7F;
    i32x8_t xb[2];
#pragma unroll
    for (int ks = 0; ks < 2; ++ks) xb[ks] = (i32x8_t){(int)xw[ks].x, (int)xw[ks].y, (int)xw[ks].z, (int)xw[ks].w, 0, 0, 0, 0};
    const LAS unsigned char* rp = tile + r * 128; const int fr = (r >> 1) & 7;
    v4u a[8][2];
#pragma unroll
    for (int i = 0; i < 8; ++i)
#pragma unroll
        for (int ks = 0; ks < 2; ++ks) a[i][ks] = *(const LAS v4u*)(rp + i * 2048 + (((4 * ks + g) ^ fr) << 4));
    f32x4 c[8];
#pragma unroll
    for (int i = 0; i < 8; ++i) { const v4u w = a[i][0]; c[i] = __builtin_amdgcn_mfma_scale_f32_16x16x128_f8f6f4((i32x8_t){(int)w.x, (int)w.y, (int)w.z, (int)w.w, 0, 0, 0, 0}, xb[0], (f32x4){0.f, 0.f, 0.f, 0.f}, 4  , 4  , 0, 0x7F7F7F7F, 0, scb); }
#pragma unroll
    for (int i = 0; i < 8; ++i) { const v4u w = a[i][1]; c[i] = __builtin_amdgcn_mfma_scale_f32_16x16x128_f8f6f4((i32x8_t){(int)w.x, (int)w.y, (int)w.z, (int)w.w, 0, 0, 0, 0}, xb[1], c[i], 4, 4, 0, 0x7F7F7F7F, 0, scb); }
#pragma unroll
    for (int i = 0; i < 8; ++i)
#pragma unroll
        for (int e = 0; e < 4; ++e) c[i][e] += dpp_swap1(c[i][e]);
    if (r == 0) {
#pragma unroll
        for (int i = 0; i < 8; ++i) *(GAS f32x4*)(pp + 16 * i) = c[i]; }
}
__device__ __forceinline__ void peer_down_pass(Frame& F, const PeerDeal& d) {
    const int lane = F.lane;
    const int N = d.ns * d.cnt; if (N <= 0) return;
    i32x4_t I0[4], I1[4]; v4u R0[16], R1[16], X0[2], X1[2];
    int t0, s0, t1, s1, t2, s2, t3, s3;
    pd_item(0, d, t0, s0); pd_idx(F, t0, lane, I0);
    pd_item(1, d, t1, s1); pd_idx(F, t1, lane, I1);
    pd_rows(F, t0, s0, lane, I0, R0, X0);
#pragma unroll 1
    for (int n = 0; n < N; n += 2) {
        pd_item(n + 2, d, t2, s2); pd_idx(F, t2, lane, I0);
        __builtin_amdgcn_sched_barrier(0);
        pd_rows(F, t1, s1, lane, I1, R1, X1);
        __builtin_amdgcn_sched_barrier(0);
        pd_compute(F, t0, s0, lane, R0, X0);
        __builtin_amdgcn_sched_barrier(0);
        pd_item(n + 3, d, t3, s3); pd_idx(F, t3, lane, I1);
        __builtin_amdgcn_sched_barrier(0);
        pd_rows(F, t2, s2, lane, I0, R0, X0);
        __builtin_amdgcn_sched_barrier(0);
        pd_compute(F, t1, s1, lane, R1, X1);
        __builtin_amdgcn_sched_barrier(0);
        t0 = t2; s0 = s2; t1 = t3; s1 = s3;
    }
}
template <int NT> __device__ __forceinline__ void peer_combine_tokens(Frame& F, const int tbase, const int tstep) {
    const int lane = F.lane;
    f32x2_t a[NT], gt[NT]; int id0[NT], id1[NT];
#pragma unroll
    for (int k = 0; k < NT; ++k) { const int t = tbase + k * tstep;
        const float* PART = WSP(const float, WS_PART) + (size_t)t * 128 + 2 * lane;
        f32x2_t p[16];
#pragma unroll
        for (int sl = 0; sl < 16; ++sl) p[sl] = *(const GAS f32x2_t*)(PART + (size_t)sl * M * 128);
        const u32x2_t idw = *(const GAS u32x2_t*)(WSP(const int, WS_IDX) + (size_t)t * 128 + 2 * lane); id0[k] = (int)idw.x; id1[k] = (int)idw.y;
        gt[k] = *(const GAS f32x2_t*)(WSP(float, WS_GATE) + (size_t)t * 128 + 2 * lane);
        a[k] = (f32x2_t){0.f, 0.f};
#pragma unroll
        for (int sl = 0; sl < 16; ++sl) a[k] += p[sl]; }
    float sd0[NT], sd1[NT], su0[NT], su1[NT];
#pragma unroll
    for (int k = 0; k < NT; ++k) { sd0[k] = WSP(const float, WS_SCD)[id0[k]]; sd1[k] = WSP(const float, WS_SCD)[id1[k]]; su0[k] = WSP(const float, WS_SCU)[id0[k]]; su1[k] = WSP(const float, WS_SCU)[id1[k]]; }
#pragma unroll
    for (int k = 0; k < NT; ++k) { const int t = tbase + k * tstep;
        const float c0 = gt[k].x * gelu_erf(a[k].x * sd0[k]) * su0[k], c1 = gt[k].y * gelu_erf(a[k].y * sd1[k]) * su1[k];
        *(GAS f32x2_t*)(WSP(float, WS_GATE) + (size_t)t * 128 + 2 * lane) = (f32x2_t){c0, c1};
        float bm = fmaxf(fabsf(c0), fabsf(c1));
        bm = fmaxf(bm, __shfl_xor(bm, 1)); bm = fmaxf(bm, __shfl_xor(bm, 2)); bm = fmaxf(bm, __shfl_xor(bm, 4)); bm = fmaxf(bm, __shfl_xor(bm, 8));
        int eb = (int)((__float_as_uint(bm) >> 23) & 255u) - 1;
        eb = eb < 3 ? 3 : eb > 250 ? 250 : eb;
        const float inv = __uint_as_float((unsigned)(254 - eb) << 23);
        const float s0 = c0 * inv, s1 = c1 * inv;
        const unsigned hi = __builtin_amdgcn_cvt_scalef32_pk_fp4_f32(0u, s0, s1, 1.0f, 0);
        const f32x2_t dq = __builtin_amdgcn_cvt_scalef32_pk_f32_fp4(hi, 1.0f, 0);
        const unsigned lo = __builtin_amdgcn_cvt_scalef32_pk_fp4_f32(0u, (s0 - dq.x) * 8.f, (s1 - dq.y) * 8.f, 1.0f, 0);
        unsigned char* cf4 = F.ws + WS_CF4 + (size_t)t * 160;
        ((GAS unsigned char*)cf4)[lane] = (unsigned char)hi; ((GAS unsigned char*)cf4)[64 + lane] = (unsigned char)lo;
        if ((lane & 15) == 0) ((GAS unsigned*)(cf4 + 128))[lane >> 4] = (unsigned)eb * 0x01010101u; }
}
struct PmBuf { v4u rows[16]; v4u aw; unsigned e; u32x2_t xv; };
__device__ __forceinline__ void pm_rows(Frame& F, int t, int sl, int lane, const i32x4_t (&idv)[4], PmBuf& b) {
    const int n = lane & 15, g = lane >> 4;
    const unsigned char* WU = F.ws + WS_W4U + (size_t)sl * SLICE_BYTES;
    const unsigned lo16 = 16u * (unsigned)(lane & 7);
#pragma unroll
    for (int j = 0; j < 16; ++j) b.rows[j] = *(const GAS v4u*)(WU + (size_t)(((unsigned)idv[j >> 2][j & 3] << 7) + lo16));
    const unsigned char* cf4 = F.ws + WS_CF4 + (size_t)t * 160;
    b.aw = *(const GAS v4u*)(cf4 + 64 * (n & 1) + 16 * g); b.e = *(const GAS unsigned*)(cf4 + 128 + 4 * g);
    b.xv = *(const GAS u32x2_t*)(WSP(const bf16, WS_X1B) + (size_t)t * D + 256 * sl + 4 * lane);
}
__device__ __forceinline__ void pm_compute(Frame& F, int t, int sl, int lane, const PmBuf& b) {
    const int n = lane & 15, g = lane >> 4;
    LAS unsigned char* tile = F.lds + RING_OFF + F.wave * 16384;
    LAS float* obuf = (LAS float*)(F.lds + OBUF_OFF + F.wave * 1024);
    { LAS unsigned char* wp = tile + (lane >> 3) * 2048; const int cc = lane & 7;
#pragma unroll
      for (int j = 0; j < 16; ++j) { const v4u w = b.rows[j]; *(LAS v4u*)(wp + j * 128 + ((cc ^ (j >> 1)) << 4)) = (j & 1) ? (v4u){w.z, w.w, w.x, w.y} : w; } }
    const LAS unsigned char* rp = tile + (32 * g + n) * 128;
    const bool arow = n < 2;
    const i32x8_t afr = (i32x8_t){arow ? (int)b.aw.x : 0, arow ? (int)b.aw.y : 0, arow ? (int)b.aw.z : 0, arow ? (int)b.aw.w : 0, 0, 0, 0, 0};
    const unsigned sca = n == 0 ? b.e : n == 1 ? b.e - 0x03030303u : 0x7F7F7F7Fu;
    LAS float* const wdst = g == 0 ? obuf + n : (LAS float*)(F.lds + ODUMP_OFF + F.wave * 256) + lane; const int wstep = g == 0 ? 16 : 0;
#pragma unroll
    for (int h = 0; h < 2; ++h) {
        v2i32_t b0[8], b1[8];
#pragma unroll
        for (int q = 0; q < 8; ++q) { const int off = (((8 * h + q) ^ n) << 3); b0[q] = __builtin_amdgcn_ds_read_tr4_b64_v2i32((LAS v2i32_t*)(rp + off)); b1[q] = __builtin_amdgcn_ds_read_tr4_b64_v2i32((LAS v2i32_t*)(rp + 2048 + off)); }
        f32x4 c[8];
#pragma unroll
        for (int q = 0; q < 8; ++q) c[q] = __builtin_amdgcn_mfma_scale_f32_16x16x128_f8f6f4(afr, (i32x8_t){b0[q].x, b0[q].y, b1[q].x, b1[q].y, 0, 0, 0, 0}, (f32x4){0.f, 0.f, 0.f, 0.f}, 4, 4, 0, (int)sca, 0, 0x7F7F7F7F);
#pragma unroll
        for (int q = 0; q < 8; ++q) wdst[(8 * h + q) * wstep] = c[q][0] + c[q][1];
    }
    *(GAS f32x4*)(F.out + (size_t)t * D + 256 * sl + 4 * lane) = (f32x4){bflo(b.xv.x), bfhi(b.xv.x), bflo(b.xv.y), bfhi(b.xv.y)} + *(const LAS f32x4*)(obuf + 4 * lane);
}
__device__ __forceinline__ void peer_up_pass_mfma(Frame& F, const PeerDeal& d) {
    const int lane = F.lane;
    const int N = d.ns * d.cnt; if (N <= 0) return;
    i32x4_t I0[4], I1[4]; PmBuf B0, B1;
    int t0, s0, t1, s1, t2, s2, t3, s3;
    pd_item(0, d, t0, s0); pd_idx(F, t0, lane, I0);
    pd_item(1, d, t1, s1); pd_idx(F, t1, lane, I1);
    pm_rows(F, t0, s0, lane, I0, B0);
#pragma unroll 1
    for (int n = 0; n < N; n += 2) {
        pd_item(n + 2, d, t2, s2); pd_idx(F, t2, lane, I0);
        __builtin_amdgcn_sched_barrier(0);
        pm_rows(F, t1, s1, lane, I1, B1);
        __builtin_amdgcn_sched_barrier(0);
        pm_compute(F, t0, s0, lane, B0);
        __builtin_amdgcn_sched_barrier(0);
        pd_item(n + 3, d, t3, s3); pd_idx(F, t3, lane, I1);
        __builtin_amdgcn_sched_barrier(0);
        pm_rows(F, t2, s2, lane, I0, B0);
        __builtin_amdgcn_sched_barrier(0);
        pm_compute(F, t1, s1, lane, B1);
        __builtin_amdgcn_sched_barrier(0);
        t0 = t2; s0 = s2; t1 = t3; s1 = s3;
    }
}
typedef _Float16 h2_t __attribute__((ext_vector_type(2)));
#define FP4H2(w, b) __builtin_bit_cast(h2_t, __builtin_amdgcn_cvt_scalef32_pk_f16_fp4((w), 1.0f, (b)))
__device__ __forceinline__ void pu_idx(Frame& F, int t, int lane, i32x4_t (&idv)[8], f32x4 (&cfv)[8]) {
    const GAS i32x4_t* ip = (const GAS i32x4_t*)(WSP(const int, WS_IDX) + (size_t)t * 128 + (lane >> 4) * 32); const GAS f32x4* cp = (const GAS f32x4*)(WSP(const float, WS_GATE) + (size_t)t * 128 + (lane >> 4) * 32);
#pragma unroll
    for (int a = 0; a < 8; ++a) { idv[a] = ip[a]; cfv[a] = cp[a]; }
}
template <int H> __device__ __forceinline__ void pu_rows(Frame& F, int sl, int lane, const i32x4_t (&idv)[8], u32x2_t (&rows)[16]) {
    const unsigned char* WU = F.ws + WS_W4U + (size_t)sl * SLICE_BYTES + (lane & 15) * 8;
#pragma unroll
    for (int i = 0; i < 16; ++i) rows[i] = *(const GAS u32x2_t*)(WU + (size_t)idv[4 * H + (i >> 2)][i & 3] * 128);
}
template <int H> __device__ __forceinline__ void pu_compute(const u32x2_t (&rows)[16], const f32x4 (&cfv)[8], h2_t (&acc)[8]) {
#pragma unroll
    for (int i = 0; i < 16; ++i) { const float c = cfv[4 * H + (i >> 2)][i & 3] * 256.0f; const h2_t cc = __builtin_bit_cast(h2_t, __builtin_amdgcn_cvt_pkrtz(c, c));
#pragma unroll
        for (int k = 0; k < 2; ++k) { const unsigned w = rows[i][k];
            acc[4 * k + 0] = FP4H2(w, 0) * cc + acc[4 * k + 0]; acc[4 * k + 1] = FP4H2(w, 1) * cc + acc[4 * k + 1]; acc[4 * k + 2] = FP4H2(w, 2) * cc + acc[4 * k + 2]; acc[4 * k + 3] = FP4H2(w, 3) * cc + acc[4 * k + 3]; } }
}
__device__ __forceinline__ void pu_finish(Frame& F, int t, int sl, int lane, h2_t (&acc)[8]) {
    const int eg = lane >> 4, q = lane & 15;
#pragma unroll
    for (int a = 0; a < 8; ++a) {
        acc[a] = acc[a] + __builtin_bit_cast(h2_t, __shfl_xor(__builtin_bit_cast(unsigned, acc[a]), 16)); acc[a] = acc[a] + __builtin_bit_cast(h2_t, __shfl_xor(__builtin_bit_cast(unsigned, acc[a]), 32)); }
    const h2_t o01 = eg == 0 ? acc[0] : eg == 1 ? acc[2] : eg == 2 ? acc[4] : acc[6], o23 = eg == 0 ? acc[1] : eg == 1 ? acc[3] : eg == 2 ? acc[5] : acc[7];
    GAS f32x4* op = (GAS f32x4*)(F.out + (size_t)t * D + 256 * sl + 16 * q + 4 * eg);
    f32x4 o; { const u32x2_t w = *(const GAS u32x2_t*)(WSP(const bf16, WS_X1B) + (size_t)t * D + 256 * sl + 16 * q + 4 * eg); o = (f32x4){bflo(w.x), bfhi(w.x), bflo(w.y), bfhi(w.y)}; }
    *op = (f32x4){o[0] + (float)o01.x * (1.0f / 256.0f), o[1] + (float)o01.y * (1.0f / 256.0f), o[2] + (float)o23.x * (1.0f / 256.0f), o[3] + (float)o23.y * (1.0f / 256.0f)};
#pragma unroll
    for (int a = 0; a < 8; ++a) acc[a] = (h2_t){(_Float16)0.f, (_Float16)0.f};
}
__device__ __forceinline__ void peer_up_pass(Frame& F, const PeerDeal& d) {
    const int lane = F.lane;
    const int N = d.ns * d.cnt; if (N <= 0) return;
    i32x4_t IA[8], IB[8]; f32x4 CA[8], CB[8]; u32x2_t Ra[16], Rb[16]; h2_t acc[8];
#pragma unroll
    for (int a = 0; a < 8; ++a) acc[a] = (h2_t){(_Float16)0.f, (_Float16)0.f};
    int ta, sa, tb, sb, tc, sc;
    pd_item(0, d, ta, sa); pu_idx(F, ta, lane, IA, CA);
    pd_item(1, d, tb, sb); pu_idx(F, tb, lane, IB, CB);
    pu_rows<0>(F, sa, lane, IA, Ra);
#pragma unroll 1
    for (int n = 0; n < N; n += 2) {
        pu_rows<1>(F, sa, lane, IA, Rb);
        pu_compute<0>(Ra, CA, acc);
        pu_rows<0>(F, sb, lane, IB, Ra);
        pu_compute<1>(Rb, CA, acc);
        pu_finish(F, ta, sa, lane, acc);
        pd_item(n + 2, d, tc, sc); pu_idx(F, tc, lane, IA, CA);
        if (n + 1 < N) {
            pu_rows<1>(F, sb, lane, IB, Rb);
            pu_compute<0>(Ra, CB, acc);
            pu_rows<0>(F, sc, lane, IA, Ra);
            pu_compute<1>(Rb, CB, acc);
            pu_finish(F, tb, sb, lane, acc);
        }
        pd_item(n + 3, d, tb, sb); pu_idx(F, tb, lane, IB, CB);
        ta = tc; sa = sc;
    }
}
struct Args { const float* in[15]; float* out; unsigned char* ws; int ph_lo, ph_hi, pad0, pad1; };
__global__ void __launch_bounds__(NWAVES * 64, 2) skel_fwd(Args args) {
    extern __shared__ __attribute__((aligned(16))) unsigned char lds[];
    Frame F;
    F.lds = (LAS unsigned char*)lds;
    F.MISC = (volatile LAS unsigned*)(F.lds + MISC_OFF);
    F.tid = threadIdx.x; F.lane = F.tid & 63; F.wave = __builtin_amdgcn_readfirstlane(F.tid >> 6);
    F.G = gridDim.x; { const int bx = blockIdx.x; F.vcu = (F.G % 8 == 0) ? (bx % 8) * (F.G / 8) + bx / 8 : bx; }
    F.ws = args.ws; F.ctl = (gu32*)(args.ws + WS_CTL);
    F.x = args.in[0]; F.g1 = args.in[1]; F.w_in = args.in[2]; F.gq = args.in[3]; F.gk = args.in[4]; F.sink = args.in[5]; F.conv_w = args.in[6]; F.w_oa = args.in[7];
    F.w_oc = args.in[8]; F.w_out = args.in[9]; F.g2 = args.in[10]; F.w_qp = args.in[11]; F.subk = args.in[12]; F.w_down = args.in[13]; F.w_up = args.in[14]; F.out = args.out;
    for (int u = F.tid; u < (LDS_BYTES - LDSCTL_OFF) / 4; u += NWAVES * 64) ((LAS unsigned*)(F.lds + LDSCTL_OFF))[u] = 0u;
    __syncthreads();
    XcdBarrier bar; bar.bar = (unsigned*)(F.ctl + CW_BAR); bar.x = 0; bar.st = nullptr;
    if (MK_ONE_LAUNCH) bar = xcd_barrier_post((unsigned*)(F.ctl + CW_BAR), F.MISC + 8);
    if (MK_ONE_LAUNCH && F.tid == 0) { const unsigned xcc = xb_xcc_id(); F.MISC[10] = xcc; F.MISC[11] = __hip_atomic_fetch_add((unsigned*)(F.ctl + CW_XRANK) + 64 * xcc, 1u, RLX_AGENT); }
    if (F.wave == 0) { const bool ok = tr4_selfcheck(F.lds + RING_OFF, F.lane); if (F.lane == 0) F.MISC[15] = ok ? 1u : 0u; }
    __syncthreads();
    const bool tr4_ok = F.MISC[15] != 0u;
    const int lo = args.ph_lo, hi = args.ph_hi;
#ifndef PHASE_MASK
#define PHASE_MASK 0xfff
#endif
#define IN(k) (((PHASE_MASK >> (k)) & 1) && lo <= (k) && (k) < hi)
#ifndef DUP_MASK
#define DUP_MASK 0
#endif
#define REP(k) _Pragma("unroll") for (int rep_ = 0; rep_ < 1 + ((DUP_MASK >> (k)) & 1); ++rep_)
#define SEAM(k) do { if (MK_ONE_LAUNCH && IN(k) && IN((k) + 1)) xcd_barrier(bar); } while (0)
    const int gw = F.vcu * NWAVES + F.wave, NGW = F.G * NWAVES;

    if (IN(0)) REP(0) { p0_prologue(F); } SEAM(0);

    if (IN(1)) REP(1) { quant_w8(F); if (P4A_I8) quant_w8_oa(F); } SEAM(1);

    if (IN(2)) REP(2) {
        bf16* const pQ = WSP(bf16, WS_Q); bf16* const pK = WSP(bf16, WS_K); bf16* const pV = WSP(bf16, WS_V); bf16* const pH = WSP(bf16, WS_H); bf16* const pB = WSP(bf16, WS_B); bf16* const pC = WSP(bf16, WS_C);
        bf16* const pGA = WSP(bf16, WS_GA); bf16* const pGC = WSP(bf16, WS_GC);
        {   pg8::Gemm g{(const bf16*)(F.ws + WS_XN8), (const bf16*)(F.ws + WS_W8), M, INW, D / 2};
            pg8::RangeOrder S; S.so.init(M, I8_TILES * 256, F.G, (int)blockIdx.x); S.base = 0; S.cut = I8_CUT; S.skip = I8_SKIP;
            pg8::EpiProj<true> E{pQ, pK, pV, pH, pB, pC, pGA, pGC, WSP(const float, WS_SX), WSP(const float, WS_SW)};
            pg8::gemm_phase<pg8::EpiProj<true>, pg8::RangeOrder, PG8_ALIGN, PG8_SP2, true>(F.lds + RING_OFF, g, S, E); }
        {   pg8::Gemm g{WSP(const bf16, WS_XN), WSP(const bf16, WS_WIN), M, INW, D};
            pg8::RangeOrder S; S.so.init(M, BF_TILES * 256, F.G, (int)blockIdx.x); S.base = BF_BASE; S.cut = 68; S.skip = 0;
            pg8::EpiProj<false> E{pQ, pK, pV, pH, pB, pC, pGA, pGC, nullptr, nullptr};
            pg8::gemm_phase<pg8::EpiProj<false>, pg8::RangeOrder, PG8_ALIGN, PG8_SP2, false>(F.lds + RING_OFF, g, S, E); }
    } SEAM(2);

    if (IN(3)) REP(3) {
        attn_phase(F);
#ifdef ATTN_PROBE
        for (int U = F.vcu * 4; U < BATCH * 32 * NKV * 2; U += F.G * 4)
            for (int i = 0; i < 4; ++i) attn_unit<ATTN_PROBE>(F, U + i);
#endif
        conv_phase(F);
#ifdef CONV_DUP
        conv_phase(F);
#endif
        if (DUP_MASK) __syncthreads();
    } SEAM(3);

    if (IN(4)) REP(4) {
#if P4A_I8
        for (int m = gw; m < M; m += NGW) quant_row_i8<4>(WSP(const bf16, WS_AB) + (size_t)m * QW, F.ws + WS_AI8 + (size_t)m * QW, WSP(float, WS_SXA) + m, F.lane);
        if (MK_ONE_LAUNCH) xcd_barrier(bar);
        {   pg8::Gemm g{(const bf16*)(F.ws + WS_AI8), (const bf16*)(F.ws + WS_W8OA), M, D, QW / 2}; pg8::StaticOrder S; S.init(M, D, F.G, (int)blockIdx.x);
            pg8::EpiMergeA8 E{WSP(const bf16, WS_GA), WSP(bf16, WS_T), WSP(const float, WS_SXA), WSP(const float, WS_SWA)};
            pg8::gemm_phase<pg8::EpiMergeA8, pg8::StaticOrder, PG8_ALIGN, PG8_SP2, true>(F.lds + RING_OFF, g, S, E); }
        {   pg8::Gemm g{WSP(const bf16, WS_AB) + (size_t)M * CW, WSP(const bf16, WS_WO) + (size_t)D * QW, M, D, CW}; pg8::StaticOrder S; S.init(M, D, F.G, (int)blockIdx.x);
            pg8::EpiMergeC E{WSP(const bf16, WS_GC), WSP(const bf16, WS_T), WSP(bf16, WS_XN)};
            pg8::gemm_phase<pg8::EpiMergeC, pg8::StaticOrder, PG8_ALIGN, PG8_SP2>(F.lds + RING_OFF, g, S, E); }
#else
        pg8::Gemm g{WSP(const bf16, WS_AB), WSP(const bf16, WS_WO), 2 * M, 2 * D, QW}; pg8::PairOrder S; S.so.init(M, D, F.G, (int)blockIdx.x);
        pg8::EpiMerge E{WSP(const bf16, WS_GA), WSP(const bf16, WS_GC), WSP(bf16, WS_T), WSP(bf16, WS_XN)};
        pg8::gemm_phase<pg8::EpiMerge, pg8::PairOrder, PG8_ALIGN, PG8_SP2>(F.lds + RING_OFF, g, S, E);
#endif
    } SEAM(4);

    if (IN(5)) REP(5) {
#if P5_I8
        for (int m = gw; m < M; m += NGW) quant_row_i8<8>(WSP(const bf16, WS_XN) + (size_t)m * D, F.ws + WS_MI8 + (size_t)m * D, WSP(float, WS_SXM) + m, F.lane);
        if (MK_ONE_LAUNCH) xcd_barrier(bar);
        pg8::Gemm g{(const bf16*)(F.ws + WS_MI8), (const bf16*)(F.ws + WS_W8OUT), M, D, D / 2}; pg8::StaticOrder S; S.init(M, D, F.G, (int)blockIdx.x);
        pg8::EpiResI8 E{F.x, WSP(bf16, WS_X1B), WSP(const float, WS_SXM), WSP(const float, WS_SWO)};
        pg8::gemm_phase<pg8::EpiResI8, pg8::StaticOrder, PG8_ALIGN, PG8_SP2, true>(F.lds + RING_OFF, g, S, E);
#else
        pg8::Gemm g{WSP(const bf16, WS_XN), WSP(const bf16, WS_WOUT), M, D, D}; pg8::StaticOrder S; S.init(M, D, F.G, (int)blockIdx.x);
        pg8::EpiRes E{F.x, WSP(bf16, WS_X1B)};
        pg8::gemm_phase<pg8::EpiRes, pg8::StaticOrder, PG8_ALIGN, PG8_SP2>(F.lds + RING_OFF, g, S, E);
#endif
    } SEAM(5);

    if (IN(6)) REP(6) {
        for (int m = gw; m < M; m += NGW) rms2_row(WSP(const bf16, WS_X1B) + (size_t)m * D, F.g2, F.ws + WS_X2I8 + (size_t)m * D, WSP(float, WS_SX2) + m, F.ws + WS_X2N8 + (size_t)m * 256, F.lane);
    } SEAM(6);

    if (IN(7)) REP(7) {
        pg8::Gemm g{(const bf16*)(F.ws + WS_X2I8), (const bf16*)(F.ws + WS_W8QP), M, PQW, D / 2}; pg8::StaticOrder S; S.init(M, PQW, F.G, (int)blockIdx.x);
        pg8::EpiStoreI8 E{WSP(bf16, WS_QP), PQW, WSP(const float, WS_SX2), WSP(const float, WS_SWQ)};
        pg8::gemm_phase<pg8::EpiStoreI8, pg8::StaticOrder, PG8_ALIGN, PG8_SP2, true>(F.lds + RING_OFF, g, S, E);
    } SEAM(7);

    if (IN(8)) REP(8) {
        const int h = F.vcu & 7;
        { const bf16* SK = WSP(const bf16, WS_SK) + (size_t)h * (2 * NKEYS * 128);
#pragma unroll
          for (int i = 0; i < 8; ++i) { const int q = F.tid + 512 * i, row = q >> 4, ch = q & 15; *(LAS v4u*)(F.lds + RING_OFF + off_b(row, ch)) = *(const GAS v4u*)(SK + (size_t)row * 128 + ch * 8); } }
        __syncthreads();
        for (int tg = (F.vcu >> 3) * NWAVES + F.wave; tg < M / 16; tg += (F.G >> 3) * NWAVES) route_task(F, tg, h);
        if (DUP_MASK) __syncthreads();
    } SEAM(8);

    PeerDeal deal;
    if (IN(9) || IN(11)) {
        if (MK_ONE_LAUNCH) {
            if (F.tid == 0) { const unsigned xcc = F.MISC[10]; unsigned nloc = 0, ox = 0, nx = 0;
                for (unsigned j = 0; j < 16; ++j) { const unsigned c = __hip_atomic_load((unsigned*)(F.ctl + CW_XRANK) + 64 * j, RLX_AGENT); if (c) { ++nx; if (j < xcc) ++ox; } if (j == xcc) nloc = c; }
                F.MISC[12] = nloc; F.MISC[13] = ox; F.MISC[14] = nx; }
            __syncthreads();
            const int nloc = (int)F.MISC[12], rank = (int)F.MISC[11];
            deal.ox = (int)F.MISC[13]; deal.nx = (int)F.MISC[14]; deal.t0 = rank * NWAVES + F.wave; deal.stride = nloc * NWAVES;
        } else { const int nper = F.G >> 3; deal.ox = F.vcu / nper; deal.nx = 8; deal.t0 = (F.vcu % nper) * NWAVES + F.wave; deal.stride = nper * NWAVES; }
        deal.cnt = deal.t0 < M ? (M - deal.t0 + deal.stride - 1) / deal.stride : 0; deal.ns = deal.ox < 16 ? (16 - deal.ox + deal.nx - 1) / deal.nx : 0;
    }
    if (IN(9)) {
        peer_down_pass(F, deal);
    } SEAM(9);
    if (IN(10)) {
        { int t = gw; for (; t + 3 * NGW < M; t += 4 * NGW) peer_combine_tokens<4>(F, t, NGW); for (; t < M; t += NGW) peer_combine_tokens<1>(F, t, NGW); }
    } SEAM(10);
    if (IN(11)) {
        if (tr4_ok) peer_up_pass_mfma(F, deal); else peer_up_pass(F, deal);
    }
#undef IN
#undef SEAM
}

extern "C" void kernel_launch(void* const* d_in, const int* in_sizes, int n_in, void* d_out, int out_size, void* d_ws, size_t ws_size, hipStream_t stream) {
    static int grid = 0;
    if (grid == 0) {
        if (n_in != 15 || in_sizes[0] != M * D || out_size != M * D || ws_size < WS_END) { fprintf(stderr, "kernel_launch: built for 15 inputs, x and out of %d floats, >= %zu bytes of workspace; got n_in %d, in0 %d, out %d, ws %zu; nothing launched\n", M * D, (size_t)WS_END, n_in, n_in > 0 ? in_sizes[0] : -1, out_size, ws_size); grid = -1; return; }
        int dev = 0, cus = 0, per_cu = 0;
        if (hipGetDevice(&dev) != hipSuccess || hipDeviceGetAttribute(&cus, hipDeviceAttributeMultiprocessorCount, dev) != hipSuccess) { fprintf(stderr, "kernel_launch: hipGetDevice / hipDeviceGetAttribute failed; nothing launched\n"); grid = -1; return; }
        if (hipFuncSetAttribute((const void*)skel_fwd, hipFuncAttributeMaxDynamicSharedMemorySize, LDS_BYTES) != hipSuccess) { fprintf(stderr, "kernel_launch: hipFuncSetAttribute failed; nothing launched\n"); grid = -1; return; }
        if (hipOccupancyMaxActiveBlocksPerMultiprocessor(&per_cu, (const void*)skel_fwd, NWAVES * 64, LDS_BYTES) != hipSuccess || per_cu < 1)
            fprintf(stderr, "kernel_launch: note: the occupancy query reports %d workgroups per CU\n", per_cu);
        (void)hipGetLastError();
        grid = cus;
        if (grid % 8 != 0) { fprintf(stderr, "kernel_launch: %d CUs: this kernel deals work in groups of 8 workgroups; nothing launched\n", grid); grid = -1; return; }
    }
    if (grid < 0) return;
    if (hipMemsetAsync((char*)d_ws + WS_CTL, 0, CTL_ZERO_BYTES, stream) != hipSuccess) { fprintf(stderr, "kernel_launch: hipMemsetAsync of the control words failed; nothing launched\n"); return; }
    Args a{};
    for (int i = 0; i < 15; ++i) a.in[i] = (const float*)d_in[i];
    a.out = (float*)d_out; a.ws = (unsigned char*)d_ws;
#if MK_ONE_LAUNCH
    a.ph_lo = 0; a.ph_hi = N_PHASES;
    hipLaunchKernelGGL(skel_fwd, dim3(grid), dim3(NWAVES * 64), LDS_BYTES, stream, a);
    { const hipError_t le = hipPeekAtLastError(); if (le != hipSuccess) fprintf(stderr, "kernel_launch: launch failed: %s\n", hipGetErrorName(le)); }
#else
    for (int p = 0; p < N_PHASES; ++p) {
        a.ph_lo = p; a.ph_hi = p + 1;
        hipLaunchKernelGGL(skel_fwd, dim3(grid), dim3(NWAVES * 64), LDS_BYTES, stream, a);
        const hipError_t le = hipPeekAtLastError();
        if (le != hipSuccess) { fprintf(stderr, "kernel_launch: launch %d failed: %s\n", p, hipGetErrorName(le)); break; }
    }
#endif
}
```
